# Optimizing an MI355X kernel written in HIP

```python
import math
import jax
import jax.numpy as jnp
from jax import lax
import numpy as np

D_MODEL = 1024
BATCH = 8
SEQ = 4096
DEPTH = 2

CHUNK = 64
D_MIX = D_MODEL
EPS = 1e-6

GM_WIDTH = D_MIX // 4
GM_HEADS = 4
GM_HEAD_DIM = GM_WIDTH // GM_HEADS
GM_BLOCK = 128

CV_WIDTH = D_MIX // 4
CV_KERNEL = 31

DN_WIDTH = D_MIX // 2
DN_HEAD_DIM = 128
DN_HEADS = DN_WIDTH // DN_HEAD_DIM
DN_CONV = 4

D_FF = -(-8 * D_MODEL // (3 * 256)) * 256

SPLIT_SIZES = (GM_WIDTH, GM_WIDTH, CV_WIDTH, CV_WIDTH,
               DN_WIDTH, DN_WIDTH, DN_WIDTH, DN_WIDTH, DN_HEADS, DN_HEADS)
D_PROJ = 2 * GM_WIDTH + 2 * CV_WIDTH + 4 * DN_WIDTH + 2 * DN_HEADS

kernel_name = "hybrid_gmlp_conv_deltanet_block"


def _split_offsets(sizes):
    out, s = [], 0
    for n in sizes[:-1]:
        s += n
        out.append(s)
    return out


def rms_norm(x, g):
    xf = x.astype(jnp.float32)
    y = xf * lax.rsqrt(jnp.mean(xf * xf, axis=-1, keepdims=True) + EPS)
    return (y * g.astype(jnp.float32)).astype(x.dtype)


def layer_norm(x, g, b):
    xf = x.astype(jnp.float32)
    mu = jnp.mean(xf, axis=-1, keepdims=True)
    var = jnp.mean(jnp.square(xf - mu), axis=-1, keepdims=True)
    y = (xf - mu) * lax.rsqrt(var + EPS)
    return (y * g.astype(jnp.float32) + b.astype(jnp.float32)).astype(x.dtype)


def causal_depthwise_conv(x, w):
    k = w.shape[0]
    return lax.conv_general_dilated(
        x, w[:, None, :].astype(x.dtype), window_strides=(1,), padding=[(k - 1, 0)],
        dimension_numbers=("NWC", "WIO", "NWC"), feature_group_count=x.shape[-1])


def spatial_gating(u, v, ln_g, ln_b, ws, bs):
    b, t, _ = v.shape
    v = layer_norm(v, ln_g, ln_b)
    causal = jnp.tril(jnp.ones((GM_BLOCK, GM_BLOCK), dtype=bool))
    ws = jnp.where(causal, ws, jnp.zeros_like(ws))
    vb = v.reshape(b, t // GM_BLOCK, GM_BLOCK, GM_HEADS, GM_HEAD_DIM)
    s = jnp.einsum("hij,bnjhd->bnihd", ws, vb) + bs.T[:, :, None]
    return u * s.reshape(b, t, GM_WIDTH)


def conformer_conv(a, gate, dw_w, dw_b, ln_g, ln_b):
    y = a * jax.nn.sigmoid(gate)
    y = causal_depthwise_conv(y, dw_w) + dw_b
    y = layer_norm(y, ln_g, ln_b)
    return jax.nn.silu(y)


def l2_normalize(x):
    return x * lax.rsqrt(jnp.sum(x * x, axis=-1, keepdims=True) + EPS)


def chunked_gated_delta_rule(q, k, v, beta, log_alpha):
    b, t, h, dk = q.shape
    dv = v.shape[-1]
    n = t // CHUNK

    def chunks(z):
        return z.reshape(b, n, CHUNK, h, -1).transpose(0, 3, 1, 2, 4)

    def chunks_scalar(z):
        return z.reshape(b, n, CHUNK, h).transpose(0, 3, 1, 2)

    qc, kc, vc = chunks(q), chunks(k), chunks(v)
    bc = chunks_scalar(beta)
    gam = jnp.cumsum(chunks_scalar(log_alpha), axis=-1)

    diff = gam[..., :, None] - gam[..., None, :]
    strict = jnp.tril(jnp.ones((CHUNK, CHUNK), dtype=bool), -1)
    incl = jnp.tril(jnp.ones((CHUNK, CHUNK), dtype=bool))
    decay_strict = jnp.exp(jnp.where(strict, diff, -jnp.inf))
    decay_incl = jnp.exp(jnp.where(incl, diff, -jnp.inf))

    kk = jnp.einsum("bhnid,bhnjd->bhnij", kc, kc)
    lower = jnp.eye(CHUNK, dtype=jnp.float32) + bc[..., :, None] * kk * decay_strict
    rhs = jnp.concatenate([bc[..., None] * vc, (bc * jnp.exp(gam))[..., None] * kc], axis=-1)
    sol = lax.linalg.triangular_solve(lower, rhs, left_side=True, lower=True)
    u_part, w_part = sol[..., :dv], sol[..., dv:]

    qk = jnp.einsum("bhnid,bhnjd->bhnij", qc, kc) * decay_incl
    q_dec = qc * jnp.exp(gam)[..., None]
    k_dec = kc * jnp.exp(gam[..., -1:] - gam)[..., None]
    chunk_decay = jnp.exp(gam[..., -1])

    def step(state, inp):
        u_n, w_n, qk_n, qd_n, kd_n, cd_n = inp
        u = u_n - jnp.einsum("bhck,bhkv->bhcv", w_n, state)
        o = jnp.einsum("bhck,bhkv->bhcv", qd_n, state) + jnp.einsum("bhij,bhjv->bhiv", qk_n, u)
        state = cd_n[..., None, None] * state + jnp.einsum("bhck,bhcv->bhkv", kd_n, u)
        return state, o

    xs = tuple(jnp.moveaxis(z, 2, 0) for z in (u_part, w_part, qk, q_dec, k_dec, chunk_decay))
    s0 = jnp.zeros((b, h, dk, dv), jnp.float32)
    _, o = lax.scan(step, s0, xs)
    return o.transpose(1, 0, 3, 2, 4).reshape(b, t, h, dv)


def gated_deltanet(q, k, v, gate, beta_logit, alpha_logit, conv_w, a_log, dt_bias, norm_g):
    b, t, _ = q.shape
    dtype = q.dtype
    qkv = jax.nn.silu(causal_depthwise_conv(jnp.concatenate([q, k, v], axis=-1), conv_w))
    q, k, v = jnp.split(qkv.astype(jnp.float32), 3, axis=-1)
    q = l2_normalize(q.reshape(b, t, DN_HEADS, DN_HEAD_DIM)) * (DN_HEAD_DIM ** -0.5)
    k = l2_normalize(k.reshape(b, t, DN_HEADS, DN_HEAD_DIM))
    v = v.reshape(b, t, DN_HEADS, DN_HEAD_DIM)
    beta = jax.nn.sigmoid(beta_logit.astype(jnp.float32))
    log_alpha = -jnp.exp(a_log.astype(jnp.float32)) * jax.nn.softplus(
        alpha_logit.astype(jnp.float32) + dt_bias.astype(jnp.float32))
    o = chunked_gated_delta_rule(q, k, v, beta, log_alpha)
    g = gate.astype(jnp.float32).reshape(b, t, DN_HEADS, DN_HEAD_DIM)
    o = rms_norm(o, norm_g) * jax.nn.silu(g)
    return o.reshape(b, t, DN_WIDTH).astype(dtype)


def setup_inputs(seed: int = 0) -> dict:
    key = jax.random.key(seed)
    ks = jax.random.split(key, 22)
    f32 = jnp.float32
    L = DEPTH

    def normal(k, shape, scale):
        return scale * jax.random.normal(k, shape, f32)

    def gain(k, shape):
        return 1.0 + 0.05 * jax.random.normal(k, shape, f32)

    dt = jnp.exp(jax.random.uniform(ks[13], (L, DN_HEADS), f32, math.log(1e-3), math.log(1e-1)))
    return {
        "x": normal(ks[0], (BATCH, SEQ, D_MODEL), 1.0),
        "mix_norm_g": gain(ks[1], (L, D_MODEL)),
        "w_in": normal(ks[2], (L, D_MODEL, D_PROJ), D_MODEL ** -0.5),
        "gm_ln_g": gain(ks[3], (L, GM_WIDTH)),
        "gm_ln_b": normal(ks[4], (L, GM_WIDTH), 0.02),
        "gm_ws": normal(ks[5], (L, GM_HEADS, GM_BLOCK, GM_BLOCK), GM_BLOCK ** -0.5),
        "gm_bs": 1.0 + normal(ks[6], (L, GM_HEADS, GM_BLOCK), 0.02),
        "cv_dw_w": normal(ks[7], (L, CV_KERNEL, CV_WIDTH), CV_KERNEL ** -0.5),
        "cv_dw_b": normal(ks[8], (L, CV_WIDTH), 0.02),
        "cv_ln_g": gain(ks[9], (L, CV_WIDTH)),
        "cv_ln_b": normal(ks[10], (L, CV_WIDTH), 0.02),
        "dn_conv_w": normal(ks[11], (L, DN_CONV, 3 * DN_WIDTH), DN_CONV ** -0.5),
        "dn_a_log": jnp.log(jax.random.uniform(ks[12], (L, DN_HEADS), f32, 1.0, 16.0)),
        "dn_dt_bias": dt + jnp.log(-jnp.expm1(-dt)),
        "dn_norm_g": gain(ks[14], (L, DN_HEAD_DIM)),
        "w_out": normal(ks[15], (L, D_MIX, D_MODEL), D_MIX ** -0.5),
        "ffn_norm_g": gain(ks[16], (L, D_MODEL)),
        "w_gate": normal(ks[17], (L, D_MODEL, D_FF), D_MODEL ** -0.5),
        "w_up": normal(ks[18], (L, D_MODEL, D_FF), D_MODEL ** -0.5),
        "w_down": normal(ks[19], (L, D_FF, D_MODEL), D_FF ** -0.5),
        "final_norm_g": gain(ks[20], (D_MODEL,)),
    }


def reference(x, mix_norm_g, w_in, gm_ln_g, gm_ln_b, gm_ws, gm_bs, cv_dw_w, cv_dw_b,
              cv_ln_g, cv_ln_b, dn_conv_w, dn_a_log, dn_dt_bias, dn_norm_g, w_out,
              ffn_norm_g, w_gate, w_up, w_down, final_norm_g):
    offsets = _split_offsets(SPLIT_SIZES)
    for l in range(DEPTH):
        h = rms_norm(x, mix_norm_g[l])
        p = jnp.einsum("btd,de->bte", h, w_in[l])
        (gm_u, gm_v, cv_a, cv_g, dn_q, dn_k, dn_v, dn_g,
         dn_beta, dn_alpha) = jnp.split(p, offsets, axis=-1)
        y_a = spatial_gating(jax.nn.gelu(gm_u, approximate=False), jax.nn.gelu(gm_v, approximate=False),
                             gm_ln_g[l], gm_ln_b[l], gm_ws[l], gm_bs[l])
        y_b = conformer_conv(cv_a, cv_g, cv_dw_w[l], cv_dw_b[l], cv_ln_g[l], cv_ln_b[l])
        y_c = gated_deltanet(dn_q, dn_k, dn_v, dn_g, dn_beta, dn_alpha, dn_conv_w[l],
                             dn_a_log[l], dn_dt_bias[l], dn_norm_g[l])
        mix = jnp.concatenate([y_a, y_b, y_c], axis=-1)
        x = x + jnp.einsum("bte,ed->btd", mix, w_out[l])
        h = rms_norm(x, ffn_norm_g[l])
        ff = jax.nn.silu(jnp.einsum("btd,df->btf", h, w_gate[l])) * jnp.einsum("btd,df->btf", h, w_up[l])
        x = x + jnp.einsum("btf,fd->btd", ff, w_down[l])
    return rms_norm(x, final_norm_g)
```

```cpp
#include <hip/hip_runtime.h>
#include <cstdio>
#include <cstdint>
#include <cmath>
namespace pg8 {
#define PG8_LAS __attribute__((address_space(3)))
typedef unsigned short bf16_t;
typedef short bf16x8 __attribute__((ext_vector_type(8)));
typedef float f32x4 __attribute__((ext_vector_type(4)));
typedef unsigned u32x4 __attribute__((ext_vector_type(4)));
constexpr int BM = 256, BK = 64, HALF = 128, HTB = HALF * BK * 2  , STAGE_BYTES = 8 * HTB, NXCD = 8, WGM = 8;

__host__ __device__ __forceinline__ int lds_byte(int r, int c) { const int st = (r >> 4) * 2 + (c >> 5), rr = r & 15, cc = c & 31, ob = rr * 64 + cc * 2; return st * 1024 + (ob ^ (((ob >> 9) & 1) << 5)); }
__host__ __device__ __forceinline__ void stage_rc(int b, int& R, int& C) { const int st = b / 1024, sb = b % 1024, swz = sb ^ (((sb >> 9) & 1) << 5); R = (st >> 1) * 16 + swz / 64; C = (st & 1) * 32 + (swz % 64) / 2; }
__host__ __device__ __forceinline__ int perm32(int rho) { const int n = rho >> 4, i = rho & 15; return 8 * (i >> 2) + 4 * n + (i & 3); }

struct Unit { int pm, pn; };
struct Gemm { const bf16_t* A; const bf16_t* Bt; int M, N, K; };

struct StaticOrder {
    int nM, nN, nwg, G, c;
    __host__ __device__ void init(int M, int N, int G_, int c_) { nM = M / BM; nN = N / BM; nwg = nM * nN; G = G_; c = c_; }
    __host__ __device__ bool next(int i, Unit& u) const {
        const long L = (long)i * G + c; if (L >= nwg) return false;
        int wgid = (int)L; { const int q = nwg / NXCD, r = nwg % NXCD, xcd = wgid % NXCD, off = wgid / NXCD; wgid = (xcd < r ? xcd * (q + 1) : r * (q + 1) + (xcd - r) * q) + off; }
        const int nig = WGM * nN, gid = wgid / nig, fm = gid * WGM, gsz = (nM - fm) < WGM ? (nM - fm) : WGM;
        u.pm = fm + ((wgid % nig) % gsz); u.pn = (wgid % nig) / gsz; return true;
    }
    __device__ __forceinline__ void a_ready(const Unit&) const {}
    __device__ __forceinline__ void done(const Unit&) const {}
};

__device__ __forceinline__ unsigned cvt_pk_bf16(float lo, float hi) { unsigned r; asm volatile("v_cvt_pk_bf16_f32 %0, %1, %2" : "=v"(r) : "v"(lo), "v"(hi)); return r; }
typedef float f32x2 __attribute__((ext_vector_type(2)));
__device__ __forceinline__ f32x2 gelu_pk(f32x2 v) {
    const f32x2 av = __builtin_elementwise_abs(v), d = av * 0.2316418882f + 1.0f;
    f32x2 t; t.x = __builtin_amdgcn_rcpf(d.x); t.y = __builtin_amdgcn_rcpf(d.y);
    f32x2 q = t * 0.5307027145f + (-0.7265760135f); q = q * t + 0.7107068705f; q = q * t + (-0.142248368f); q = q * t + 0.127414796f; q = q * t;
    const f32x2 s = (v * v) * (-0.72134752044f);
    f32x2 e; e.x = __builtin_amdgcn_exp2f(s.x); e.y = __builtin_amdgcn_exp2f(s.y);
    const f32x2 m = v * (q * e), r = v - m;
    f32x2 o; o.x = v.x < 0.f ? m.x : r.x; o.y = v.y < 0.f ? m.y : r.y; return o;
}

template <int ACT  > struct EpiBf16 {
    static constexpr bool PERM = true, AFTER_DRAIN = false; static_assert(ACT == 0 || ACT == 1, "EpiBf16: ACT is 0 (none) or 1 (gelu_pk)");
    bf16_t* O; int ldc; const float* bias; int split_cols; size_t split_stride; float scale0;
    __device__ __forceinline__ void operator()(const f32x4 (&acc)[2][2][4][2], const Unit& u, int wr, int wc, int fr, int fq) const {
        const int row0 = u.pm * BM + wr * 64 + fr; int colt = u.pn * BM; bf16_t* base = O;
        float sc = 1.f; if (split_cols) { const int t = colt / split_cols; base += (size_t)t * split_stride; colt -= t * split_cols; if (t == 0) sc = scale0; }
        const int col0 = colt + wc * 32 + 8 * fq, bcol0 = u.pn * BM + wc * 32 + 8 * fq;
        f32x4 bv[2][2];
#pragma unroll
        for (int bj = 0; bj < 2; ++bj)
#pragma unroll
            for (int n = 0; n < 2; ++n) bv[bj][n] = bias ? *(const f32x4*)(bias + bcol0 + bj * HALF + 4 * n) : (f32x4){0.f, 0.f, 0.f, 0.f};
#pragma unroll
        for (int ai = 0; ai < 2; ++ai)
#pragma unroll
            for (int m = 0; m < 4; ++m) { bf16_t* rowp = base + (size_t)(row0 + ai * HALF + m * 16) * ldc + col0;
#pragma unroll
                for (int bj = 0; bj < 2; ++bj) { f32x4 v0 = acc[ai][bj][m][0] + bv[bj][0], v1 = acc[ai][bj][m][1] + bv[bj][1];
                    if (ACT == 1) { f32x2 a = gelu_pk((f32x2){v0[0], v0[1]}), b = gelu_pk((f32x2){v0[2], v0[3]}), c = gelu_pk((f32x2){v1[0], v1[1]}), d = gelu_pk((f32x2){v1[2], v1[3]});
                        v0 = (f32x4){a.x, a.y, b.x, b.y}; v1 = (f32x4){c.x, c.y, d.x, d.y}; }
                    v0 = v0 * sc; v1 = v1 * sc; u32x4 w; w.x = cvt_pk_bf16(v0[0], v0[1]); w.y = cvt_pk_bf16(v0[2], v0[3]); w.z = cvt_pk_bf16(v1[0], v1[1]); w.w = cvt_pk_bf16(v1[2], v1[3]);
                    *(u32x4*)(rowp + bj * HALF) = w; } }
    }
};
struct EpiRes {
    static constexpr bool PERM = false, AFTER_DRAIN = false;
    const float* base; float* out; int ldc;
    __device__ __forceinline__ void operator()(const f32x4 (&acc)[2][2][4][2], const Unit& u, int wr, int wc, int fr, int fq) const {
        const int row0 = u.pm * BM + wr * 64 + fr, col0 = u.pn * BM + wc * 32 + 4 * fq;
#pragma unroll
        for (int ai = 0; ai < 2; ++ai)
#pragma unroll
            for (int m = 0; m < 4; ++m) { const size_t off = (size_t)(row0 + ai * HALF + m * 16) * ldc + col0;
#pragma unroll
                for (int bj = 0; bj < 2; ++bj)
#pragma unroll
                    for (int n = 0; n < 2; ++n) { const f32x4 bs = *(const f32x4*)(base + off + bj * HALF + n * 16); *(f32x4*)(out + off + bj * HALF + n * 16) = bs + acc[ai][bj][m][n]; } }
    }
};
struct EpiSwiGLU {
    static constexpr bool PERM = true, AFTER_DRAIN = false;
    bf16_t* O; int ldo;
    __device__ __forceinline__ void operator()(const f32x4 (&acc)[2][2][4][2], const Unit& u, int wr, int wc, int fr, int fq) const {
        const int row0 = u.pm * BM + wr * 64 + fr, col0 = u.pn * HALF + wc * 32 + 8 * fq;
#pragma unroll
        for (int ai = 0; ai < 2; ++ai)
#pragma unroll
            for (int m = 0; m < 4; ++m) { bf16_t* rowp = O + (size_t)(row0 + ai * HALF + m * 16) * ldo + col0;
                float r[8];
#pragma unroll
                for (int n = 0; n < 2; ++n)
#pragma unroll
                    for (int e = 0; e < 4; ++e) { const float g = acc[ai][0][m][n][e], up = acc[ai][1][m][n][e]; r[4 * n + e] = g * __builtin_amdgcn_rcpf(1.0f + __expf(-g)) * up; }
                u32x4 w; w.x = cvt_pk_bf16(r[0], r[1]); w.y = cvt_pk_bf16(r[2], r[3]); w.z = cvt_pk_bf16(r[4], r[5]); w.w = cvt_pk_bf16(r[6], r[7]);
                *(u32x4*)rowp = w; }
    }
};
template <class Epi, class Sched, bool ALIGN_EPI = false, bool SP2 = false>
__device__ __forceinline__ void gemm_phase(PG8_LAS unsigned char* lds, const Gemm g, const Sched& S, const Epi& E, const int tid) {
    const int wid = __builtin_amdgcn_readfirstlane(tid >> 6), lane = tid & 63, wr = wid >> 2, wc = wid & 3, fr = lane & 15, fq = lane >> 4;
    const int K = g.K, nt = K / BK;
    unsigned voffA[2], voffB[2];
#pragma unroll
    for (int i = 0; i < 2; ++i) { int R, C; stage_rc(tid * 16 + i * 8192, R, C); const int Rb = Epi::PERM ? ((R & ~31) + perm32(R & 31)) : R;
        voffA[i] = (unsigned)(R * K + C) * 2u; voffB[i] = (unsigned)(Rb * K + C) * 2u; }
    const size_t kstep = (size_t)(BK * 2);
    const size_t hstep = (size_t)HALF * K * 2;
    const size_t tstep = 2 * hstep;
    const unsigned ldsw = (unsigned)wid * 1024u;
    const int aoff = lds_byte(wr * 64 + fr, fq * 8), boff = lds_byte(wc * 32 + fr, fq * 8);
#define PG8_SA(b, h) (((b) * 2 + (h)) * HTB)
#define PG8_SB(b, h) ((4 + (b) * 2 + (h)) * HTB)
#define PG8_STAGE(bufoff, gbase, voff) do { _Pragma("unroll") for (int _i = 0; _i < 2; ++_i) \
        __builtin_amdgcn_global_load_lds((const unsigned*)((const char*)(gbase) + (voff)[_i]), (PG8_LAS unsigned*)(lds + (bufoff) + ldsw + _i * 8192), 16, 0, 0); } while (0)
#define PG8_LDA(dst, b, h) do { _Pragma("unroll") for (int m = 0; m < 4; ++m) _Pragma("unroll") for (int k = 0; k < 2; ++k) dst[m][k] = *(const PG8_LAS bf16x8*)(lds + PG8_SA(b, h) + aoff + m * 2048 + k * 1024); } while (0)
#define PG8_LDB(dst, b, h) do { _Pragma("unroll") for (int n = 0; n < 2; ++n) _Pragma("unroll") for (int k = 0; k < 2; ++k) dst[n][k] = *(const PG8_LAS bf16x8*)(lds + PG8_SB(b, h) + boff + n * 2048 + k * 1024); } while (0)
#define PG8_MMA(ai, bj, At, Bt) do { __builtin_amdgcn_s_setprio(1); _Pragma("unroll") for (int m = 0; m < 4; ++m) _Pragma("unroll") for (int n = 0; n < 2; ++n) _Pragma("unroll") for (int k = 0; k < 2; ++k) \
        acc[ai][bj][m][n] = __builtin_amdgcn_mfma_f32_16x16x32_bf16(Bt[n][k], At[m][k], acc[ai][bj][m][n], 0, 0, 0); __builtin_amdgcn_s_setprio(0); } while (0)
#define PG8_WAIT_V(n) asm volatile("s_waitcnt vmcnt(" #n ")" ::: "memory")
#define PG8_WAIT_L(n) asm volatile("s_waitcnt lgkmcnt(" #n ")" ::: "memory")
#define PG8_BAR __builtin_amdgcn_s_barrier()
#define PG8_SCHED __builtin_amdgcn_sched_barrier(0)
    Unit cur, nxt; int ui = 0;
    if (!S.next(0, cur)) return;
    f32x4 acc[2][2][4][2];
#pragma unroll
    for (int a = 0; a < 2; ++a)
#pragma unroll
        for (int b = 0; b < 2; ++b)
#pragma unroll
            for (int m = 0; m < 4; ++m)
#pragma unroll
                for (int n = 0; n < 2; ++n) acc[a][b][m][n] = (f32x4){0.f, 0.f, 0.f, 0.f};
    bf16x8 At[4][2], B0[2][2], B1[2][2];
    const char* cA = (const char*)g.A + (size_t)cur.pm * tstep; const char* cB = (const char*)g.Bt + (size_t)cur.pn * tstep;
    S.a_ready(cur);
    if constexpr (SP2) {
        PG8_STAGE(PG8_SB(0, 0), cB, voffB); PG8_STAGE(PG8_SB(0, 1), cB + hstep, voffB); PG8_STAGE(PG8_SA(0, 0), cA, voffA); PG8_STAGE(PG8_SA(0, 1), cA + hstep, voffA);
        if (wr == 1) PG8_BAR;
        PG8_WAIT_V(2); PG8_BAR;
        PG8_STAGE(PG8_SB(1, 0), cB + kstep, voffB); PG8_STAGE(PG8_SA(1, 0), cA + kstep, voffA); PG8_STAGE(PG8_SB(1, 1), cB + hstep + kstep, voffB);
        PG8_WAIT_V(6); PG8_BAR;
    } else {
        PG8_STAGE(PG8_SB(0, 0), cB, voffB); PG8_STAGE(PG8_SA(0, 0), cA, voffA); PG8_STAGE(PG8_SB(0, 1), cB + hstep, voffB); PG8_STAGE(PG8_SA(0, 1), cA + hstep, voffA);
        if (wr == 1) PG8_BAR;
        PG8_WAIT_V(4); PG8_BAR;
        PG8_STAGE(PG8_SB(1, 0), cB + kstep, voffB); PG8_STAGE(PG8_SA(1, 0), cA + kstep, voffA); PG8_STAGE(PG8_SB(1, 1), cB + hstep + kstep, voffB);
        PG8_WAIT_V(6); PG8_BAR;
    }
    for (;;) {
        const bool has_next = S.next(ui + 1, nxt);
        const char* nA = has_next ? (const char*)g.A + (size_t)nxt.pm * tstep : cA; const char* nB = has_next ? (const char*)g.Bt + (size_t)nxt.pn * tstep : cB;
        for (int t = 0; t < nt; t += 2) {
            const bool last = (t == nt - 2);
            const char* a1 = cA + (size_t)(t + 1) * kstep;
            const char* a2 = last ? nA : cA + (size_t)(t + 2) * kstep; const char* b2 = last ? nB : cB + (size_t)(t + 2) * kstep;
            const char* a3 = a2 + kstep; const char* b3 = b2 + kstep;
            if (last && has_next) S.a_ready(nxt);
            if constexpr (SP2) {
            PG8_LDB(B0, 0, 0); PG8_LDB(B1, 0, 1); PG8_SCHED; PG8_LDA(At, 0, 0); PG8_STAGE(PG8_SA(1, 1), a1 + hstep, voffA);
            PG8_WAIT_V(8); PG8_WAIT_L(0); PG8_BAR; PG8_MMA(0, 0, At, B0); PG8_MMA(0, 1, At, B1); PG8_BAR; PG8_SCHED;
            PG8_LDA(At, 0, 1); PG8_STAGE(PG8_SB(0, 0), b2, voffB); PG8_STAGE(PG8_SB(0, 1), b2 + hstep, voffB); PG8_STAGE(PG8_SA(0, 0), a2, voffA);
            PG8_WAIT_V(8); PG8_WAIT_L(0); PG8_BAR; PG8_MMA(1, 0, At, B0); PG8_MMA(1, 1, At, B1); PG8_BAR; PG8_SCHED;
            PG8_LDB(B0, 1, 0); PG8_LDB(B1, 1, 1); PG8_SCHED; PG8_LDA(At, 1, 0); PG8_STAGE(PG8_SA(0, 1), a2 + hstep, voffA);
            PG8_WAIT_V(8); PG8_WAIT_L(0); PG8_BAR; PG8_MMA(0, 0, At, B0); PG8_MMA(0, 1, At, B1); PG8_BAR; PG8_SCHED;
            PG8_LDA(At, 1, 1); PG8_STAGE(PG8_SB(1, 0), b3, voffB); PG8_STAGE(PG8_SB(1, 1), b3 + hstep, voffB); PG8_STAGE(PG8_SA(1, 0), a3, voffA);
            PG8_WAIT_V(8); PG8_WAIT_L(0); PG8_BAR; PG8_MMA(1, 0, At, B0); PG8_MMA(1, 1, At, B1); PG8_BAR; PG8_SCHED;
            } else {
            PG8_LDB(B0, 0, 0); PG8_SCHED; PG8_LDA(At, 0, 0); PG8_STAGE(PG8_SA(1, 1), a1 + hstep, voffA);
            PG8_WAIT_L(8); PG8_BAR; PG8_WAIT_L(0); PG8_MMA(0, 0, At, B0); PG8_BAR; PG8_SCHED;
            PG8_LDB(B1, 0, 1); PG8_STAGE(PG8_SB(0, 0), b2, voffB);
            PG8_BAR; PG8_WAIT_L(0); PG8_MMA(0, 1, At, B1); PG8_BAR;
            PG8_LDA(At, 0, 1); PG8_STAGE(PG8_SA(0, 0), a2, voffA);
            PG8_BAR; PG8_WAIT_L(0); PG8_MMA(1, 0, At, B0); PG8_BAR; PG8_SCHED;
            PG8_STAGE(PG8_SB(0, 1), b2 + hstep, voffB);
            PG8_WAIT_V(6); PG8_BAR; PG8_MMA(1, 1, At, B1); PG8_BAR;
            PG8_LDB(B0, 1, 0); PG8_SCHED; PG8_LDA(At, 1, 0); PG8_STAGE(PG8_SA(0, 1), a2 + hstep, voffA);
            PG8_WAIT_L(8); PG8_BAR; PG8_WAIT_L(0); PG8_MMA(0, 0, At, B0); PG8_BAR; PG8_SCHED;
            PG8_LDB(B1, 1, 1); PG8_STAGE(PG8_SB(1, 0), b3, voffB);
            PG8_BAR; PG8_WAIT_L(0); PG8_MMA(0, 1, At, B1); PG8_BAR;
            PG8_LDA(At, 1, 1); PG8_STAGE(PG8_SA(1, 0), a3, voffA);
            PG8_BAR; PG8_WAIT_L(0); PG8_MMA(1, 0, At, B0); PG8_BAR; PG8_SCHED;
            PG8_STAGE(PG8_SB(1, 1), b3 + hstep, voffB);
            PG8_WAIT_V(6); PG8_BAR; PG8_MMA(1, 1, At, B1); PG8_BAR;
            }
        }
        if constexpr (ALIGN_EPI) { if (wr == 0) PG8_BAR; }
        if constexpr (!Epi::AFTER_DRAIN) { E(acc, cur, wr, wc, fr, fq); S.done(cur); }
        if (!has_next) break;
#pragma unroll
        for (int a = 0; a < 2; ++a)
#pragma unroll
            for (int b = 0; b < 2; ++b)
#pragma unroll
                for (int m = 0; m < 4; ++m)
#pragma unroll
                    for (int n = 0; n < 2; ++n) acc[a][b][m][n] = (f32x4){0.f, 0.f, 0.f, 0.f};
        cur = nxt; cA = nA; cB = nB; ++ui;
        if constexpr (ALIGN_EPI) { if (wr == 1) PG8_BAR; }
    }
    PG8_WAIT_V(0);
    if constexpr (!ALIGN_EPI) { if (wr == 0) PG8_BAR; }
    PG8_BAR;
    if constexpr (Epi::AFTER_DRAIN) { E.fused(acc, cur, wr, wc, fr, fq, lds, wid, lane); S.done(cur); }
#undef PG8_SA
#undef PG8_SB
#undef PG8_STAGE
#undef PG8_LDA
#undef PG8_LDB
#undef PG8_MMA
#undef PG8_WAIT_V
#undef PG8_WAIT_L
#undef PG8_BAR
#undef PG8_SCHED
}
}
#define GAS __attribute__((address_space(1)))
#define LAS __attribute__((address_space(3)))
typedef unsigned short bf16;
typedef unsigned v4u __attribute__((ext_vector_type(4)));
typedef float f32x4 __attribute__((ext_vector_type(4)));
typedef short bf16x8 __attribute__((ext_vector_type(8)));
typedef GAS unsigned gu32;
typedef GAS unsigned long long gu64;
#define RLX_AGENT __ATOMIC_RELAXED, __HIP_MEMORY_SCOPE_AGENT
#define LDS_WAIT() asm volatile("s_waitcnt lgkmcnt(0)" ::: "memory")
#define VM_WAIT() asm volatile("s_waitcnt vmcnt(0)" ::: "memory")
__device__ __forceinline__ unsigned long long rt() { return __builtin_amdgcn_s_memrealtime(); }
__device__ __forceinline__ unsigned f2bf(float f) { unsigned u = __builtin_bit_cast(unsigned, f); return (u + 0x7fffu + ((u >> 16) & 1u)) >> 16; }
__device__ __forceinline__ unsigned pk2(float lo, float hi) { return f2bf(lo) | (f2bf(hi) << 16); }

#define XB_TMO      128
#define XB_XCNT(j)  (256  + 64 * (j))
#define XB_XSUB(j)  (1280 + 64 * (j))
#define XB_XGEN(j)  (2304 + 64 * (j))
#define XB_TOP      3328
#define XB_TOPGEN   3392
#define XCD_BAR_WORDS 3456
#define XB_SPIN_CAP (1u << 18)

__device__ __forceinline__ unsigned xb_ld(unsigned* p)              { return __hip_atomic_load(p, __ATOMIC_RELAXED, __HIP_MEMORY_SCOPE_AGENT); }
__device__ __forceinline__ unsigned xb_add(unsigned* p, unsigned v) { return __hip_atomic_fetch_add(p, v, __ATOMIC_RELAXED, __HIP_MEMORY_SCOPE_AGENT); }
__device__ __forceinline__ unsigned xb_xcc_id() { return (unsigned)__builtin_amdgcn_s_getreg((3 << 11) | 20) & 0xFu; }
#define XB_SPIN(cond, bar) do { unsigned _sp = 0; while (cond) { __builtin_amdgcn_s_sleep(1); \
    if ((++_sp & 255u) == 0u) { if (xb_ld(&(bar)[XB_TMO])) break; if (_sp > XB_SPIN_CAP) { atomicAdd(&(bar)[XB_TMO], 1u); break; } } } } while (0)

struct XcdBarrier {
    unsigned* bar; unsigned x;
    volatile LAS unsigned* st;
};

__device__ __forceinline__ XcdBarrier xcd_barrier_post(unsigned* bar, volatile LAS unsigned* st) {
    XcdBarrier b; b.bar = bar; b.x = xb_xcc_id(); b.st = st;
    if (threadIdx.x == 0) (void)xb_add(&bar[XB_XCNT(b.x)], 1u);
    return b;
}
__device__ __forceinline__ void xcd_barrier_complete(unsigned* bar, unsigned x, unsigned& nloc, unsigned& nx) {
    const unsigned G = gridDim.x * gridDim.y * gridDim.z;
    unsigned sum, cnt, mine, sp = 0u;
    for (;;) {
        sum = 0u; cnt = 0u; mine = 0u;
#pragma unroll
        for (unsigned j = 0; j < 16; ++j) { const unsigned c = xb_ld(&bar[XB_XCNT(j)]); sum += c; cnt += (c > 0u) ? 1u : 0u; mine = (j == x) ? c : mine; }
        if (sum == G) break;
        __builtin_amdgcn_s_sleep(1);
        if ((++sp & 255u) == 0u) { if (xb_ld(&bar[XB_TMO])) break; if (sp > XB_SPIN_CAP) { atomicAdd(&bar[XB_TMO], 1u); break; } }
    }
    nloc = mine > 0u ? mine : 1u; nx = cnt > 0u ? cnt : 1u;
}

__device__ __forceinline__ void xcd_barrier(const XcdBarrier& b) {
    asm volatile("s_waitcnt vmcnt(0)" ::: "memory");
    __syncthreads();
    if (threadIdx.x == 0) {
        unsigned* bar = b.bar;
        __builtin_amdgcn_s_waitcnt(0);
        unsigned nloc = b.st[0], nx = b.st[1];
        if (nloc == 0u) { xcd_barrier_complete(bar, b.x, nloc, nx); b.st[0] = nloc; b.st[1] = nx; }
        const unsigned old = xb_add(&bar[XB_XSUB(b.x)], 1u);
        const unsigned gen = old / nloc;
        if (old + 1u == (gen + 1u) * nloc) {
            __builtin_amdgcn_fence(__ATOMIC_RELEASE, "agent");
            asm volatile("s_waitcnt vmcnt(0)" ::: "memory");
            const unsigned og = xb_add(&bar[XB_TOP], 1u);
            const unsigned tg = og / nx;
            if (og + 1u == (tg + 1u) * nx) xb_add(&bar[XB_TOPGEN], 1u);
            else XB_SPIN(xb_ld(&bar[XB_TOPGEN]) == tg, bar);
            __builtin_amdgcn_fence(__ATOMIC_ACQUIRE, "agent");
            xb_add(&bar[XB_XGEN(b.x)], 1u);
            asm volatile("s_waitcnt vmcnt(0)" ::: "memory");
        } else {
            XB_SPIN(xb_ld(&bar[XB_XGEN(b.x)]) == gen, bar);
            __builtin_amdgcn_fence(__ATOMIC_ACQUIRE, "agent");
            asm volatile("s_waitcnt vmcnt(0)" ::: "memory");
        }
    }
    __syncthreads();
}

#ifndef MK_PH_HI
#define MK_PH_HI 17
#endif
#ifndef MK_SUB
#define MK_SUB 7
#endif
#ifndef MK_DNSTEP
#define MK_DNSTEP 9
#endif
#ifndef MK_W6
#define MK_W6 1
#endif
#ifndef MK_CVSTEP
#define MK_CVSTEP 9
#endif
#ifndef MK_NEG
#define MK_NEG 1
#endif

constexpr int NWAVES = 8;
constexpr int D = 1024, BATCH = 8, SEQ = 4096, M = BATCH * SEQ, DEPTH = 2;
constexpr int DFF = 2816, DPROJ = 3080, NP = 3072;
constexpr int CVK = 31, DNCONV = 4;
constexpr float EPS = 1e-6f;
constexpr int NCHUNK = BATCH * 4 * 64;

constexpr size_t MiB = 1u << 20;
constexpr size_t WS_CTL = 0, CTL_ZERO_BYTES = 64 * 1024;
constexpr size_t WS_W = 2 * MiB;
constexpr size_t W_IN_OFF = 0, W_O_OFF = 6 * MiB, W_GU_OFF = 8 * MiB, W_D_OFF = 19 * MiB, W_LAYER = 25 * MiB;
constexpr size_t WS_BA = 53 * MiB;
constexpr size_t WS_CD = 54 * MiB + 512 * 1024;
constexpr size_t WS_HN = 64 * MiB;
constexpr size_t WS_P = 128 * MiB;
constexpr size_t WS_U = 320 * MiB, WS_WW = 352 * MiB, WS_QD = 384 * MiB, WS_KDT = 416 * MiB, WS_QK = 448 * MiB, WS_END = 464 * MiB;
constexpr int CW_BAR = 4096;

constexpr int RING_BYTES = 131072;
constexpr int MISC_OFF = 147456 - 256;
constexpr int LDS_BYTES = 147456;

__device__ __forceinline__ float bf2f(unsigned short b) { return __uint_as_float(((unsigned)b) << 16); }
__device__ __forceinline__ float wave_sum(float v) {
#pragma unroll
    for (int o = 1; o < 64; o <<= 1) v += __shfl_xor(v, o);
    return v;
}
__device__ __forceinline__ float sigmoidf_(float x) { return 1.0f / (1.0f + __expf(-x)); }
__device__ __forceinline__ float gelu_erf(float x) { return 0.5f * x * (1.0f + erff(x * 0.70710678118654752f)); }
typedef float f32x16 __attribute__((ext_vector_type(16)));
typedef unsigned u32x2 __attribute__((ext_vector_type(2)));
#define MFMA32(a, b, c) __builtin_amdgcn_mfma_f32_32x32x16_bf16((a), (b), (c), 0, 0, 0)
__device__ __forceinline__ int crow(int reg, int hh) { return (reg & 3) + 8 * (reg >> 2) + 4 * hh; }

#define AS4 __attribute__((address_space(4)))
struct Frame {
    LAS unsigned char* lds;
    int tid, lane, wave, vcu, G;
    const AS4 unsigned char* kp;
    float* out; unsigned char* ws;
    __device__ __forceinline__ const float* inp(int k) const { return *(const float* const AS4*)(kp + 8 * k); }
};

__device__ __forceinline__ void tr_item(const float* W, int ldw, int K, bf16* WT, int kb, int nsrc0, int ndst0, LAS float* scr, int lane) {
    const int k0 = 64 * kb;
#pragma unroll 8
    for (int i = 0; i < 32; ++i) { const int kk = 2 * i + (lane >> 5); scr[kk * 33 + (lane & 31)] = W[(size_t)(k0 + kk) * ldw + nsrc0 + (lane & 31)]; }
    LDS_WAIT(); asm volatile("" ::: "memory");
    const int c = lane & 7;
#pragma unroll
    for (int j = 0; j < 4; ++j) { const int n = (lane >> 3) + 8 * j; const LAS float* s = scr + (8 * c) * 33 + n;
        v4u o; o.x = pk2(s[0 * 33], s[1 * 33]); o.y = pk2(s[2 * 33], s[3 * 33]); o.z = pk2(s[4 * 33], s[5 * 33]); o.w = pk2(s[6 * 33], s[7 * 33]);
        *(GAS v4u*)(WT + (size_t)(ndst0 + n) * K + k0 + 8 * c) = o; }
    LDS_WAIT(); asm volatile("" ::: "memory");
}
__device__ __forceinline__ void weights_phase(Frame& F) {
    LAS float* scr = (LAS float*)(F.lds + F.wave * 16384);
    const int gw = F.vcu * NWAVES + F.wave, NGW = F.G * NWAVES;
    constexpr int I_IN = 16 * 96, I_O = 16 * 32, I_GU = 16 * 176, I_D = 44 * 32, I_L = I_IN + I_O + I_GU + I_D;
    for (int it = gw; it < DEPTH * I_L; it += NGW) {
        const int l = it / I_L; int r = it % I_L;
        bf16* wb = (bf16*)(F.ws + WS_W + (size_t)l * W_LAYER);
        if (r < I_IN) { const int kb = r / 96, nb = r % 96; tr_item(F.inp(2) + (size_t)l * D * DPROJ, DPROJ, D, (bf16*)((unsigned char*)wb + W_IN_OFF), kb, 32 * nb, 32 * nb, scr, F.lane); continue; } r -= I_IN;
        if (r < I_O) { const int kb = r / 32, nb = r % 32; tr_item(F.inp(15) + (size_t)l * D * D, D, D, (bf16*)((unsigned char*)wb + W_O_OFF), kb, 32 * nb, 32 * nb, scr, F.lane); continue; } r -= I_O;
        if (r < I_GU) { const int kb = r / 176, nb = r % 176; const int drow = 32 * nb, tile = drow >> 8, within = drow & 255;
            const float* src = (within < 128 ? F.inp(17) : F.inp(18)) + (size_t)l * D * DFF;
            tr_item(src, DFF, D, (bf16*)((unsigned char*)wb + W_GU_OFF), kb, tile * 128 + (within & 127), drow, scr, F.lane); continue; } r -= I_GU;
        { const int kb = r / 32, nb = r % 32; tr_item(F.inp(19) + (size_t)l * DFF * D, D, DFF, (bf16*)((unsigned char*)wb + W_D_OFF), kb, 32 * nb, 32 * nb, scr, F.lane); }
    }
}

template <int MODE>
__device__ __forceinline__ void norm_phase(Frame& F, const float* xin, const float* g, bf16* hn, const float* wlog, float* ba, float* fout) {
    const int gw = F.vcu * NWAVES + F.wave, NGW = F.G * NWAVES;
    f32x4 gv[4];
#pragma unroll
    for (int j = 0; j < 4; ++j) gv[j] = ((const f32x4*)g)[64 * j + F.lane];
    for (int m = gw; m < M; m += NGW) {
        const f32x4* xr = (const f32x4*)(xin + (size_t)m * D) + F.lane;
        f32x4 v[4]; float ss = 0.f;
#pragma unroll
        for (int j = 0; j < 4; ++j) { v[j] = xr[64 * j]; ss += (v[j].x * v[j].x + v[j].y * v[j].y) + (v[j].z * v[j].z + v[j].w * v[j].w); }
        const float rstd = 1.0f / sqrtf(wave_sum(ss) * (1.0f / D) + EPS);
#pragma unroll
        for (int j = 0; j < 4; ++j) v[j] = v[j] * rstd * gv[j];
        if (MODE == 0) {
            unsigned long long* o8 = (unsigned long long*)(hn + (size_t)m * D) + F.lane;
#pragma unroll
            for (int j = 0; j < 4; ++j) o8[64 * j] = (unsigned long long)pk2(v[j].x, v[j].y) | ((unsigned long long)pk2(v[j].z, v[j].w) << 32);
            if (wlog) {
                float acc[8];
#pragma unroll
                for (int t = 0; t < 8; ++t) acc[t] = 0.f;
#pragma unroll
                for (int j = 0; j < 4; ++j)
#pragma unroll
                    for (int e = 0; e < 4; ++e) { const int k = 256 * j + 4 * F.lane + e; const f32x4* wr = (const f32x4*)(wlog + (size_t)k * DPROJ + NP);
                        const f32x4 w0 = wr[0], w1 = wr[1]; const float y = v[j][e];
                        acc[0] += y * w0.x; acc[1] += y * w0.y; acc[2] += y * w0.z; acc[3] += y * w0.w; acc[4] += y * w1.x; acc[5] += y * w1.y; acc[6] += y * w1.z; acc[7] += y * w1.w; }
#pragma unroll
                for (int t = 0; t < 8; ++t) acc[t] = wave_sum(acc[t]);
                if (F.lane == 0) { *(f32x4*)(ba + (size_t)m * 8) = (f32x4){acc[0], acc[1], acc[2], acc[3]}; *(f32x4*)(ba + (size_t)m * 8 + 4) = (f32x4){acc[4], acc[5], acc[6], acc[7]}; }
            }
        } else {
            f32x4* o = (f32x4*)(fout + (size_t)m * D) + F.lane;
#pragma unroll
            for (int j = 0; j < 4; ++j) o[64 * j] = v[j];
        }
    }
}

__device__ __forceinline__ void gmlp_unit(Frame& F, int l, int unit, const bf16* P, bf16* MIX) {
    const int m0 = unit * 128;
    LAS float* sV = (LAS float*)F.lds;
    const float* lng = F.inp(3) + l * 256; const float* lnb = F.inp(4) + l * 256;
    const f32x4 g4 = *(const f32x4*)(lng + 4 * F.lane), b4 = *(const f32x4*)(lnb + 4 * F.lane);
    for (int j = F.wave; j < 128; j += NWAVES) {
        const u32x2 raw = *(const u32x2*)(P + (size_t)(m0 + j) * NP + 256 + 4 * F.lane);
        f32x4 v; v.x = gelu_erf(bf2f((unsigned short)(raw.x & 0xffffu))); v.y = gelu_erf(bf2f((unsigned short)(raw.x >> 16)));
        v.z = gelu_erf(bf2f((unsigned short)(raw.y & 0xffffu))); v.w = gelu_erf(bf2f((unsigned short)(raw.y >> 16)));
        const float mean = wave_sum((v.x + v.y) + (v.z + v.w)) * (1.0f / 256.0f);
        v = v - mean;
        const float var = wave_sum((v.x * v.x + v.y * v.y) + (v.z * v.z + v.w * v.w)) * (1.0f / 256.0f);
        const float r = 1.0f / sqrtf(var + EPS);
        *(LAS f32x4*)(sV + j * 256 + 4 * F.lane) = v * r * g4 + b4;
    }
    __syncthreads();
    const int c = F.tid & 255, h = F.wave & 3, ih = F.wave >> 2;
    const float* wsh = F.inp(5) + (size_t)(l * 4 + h) * 128 * 128;
    const float* bsh = F.inp(6) + (l * 4 + h) * 128;
    for (int ib = 0; ib < 8; ++ib) {
        const int i0 = ih * 64 + ib * 8;
        float acc[8];
#pragma unroll
        for (int ii = 0; ii < 8; ++ii) acc[ii] = 0.f;
        for (int j = 0; j < i0 + 8; ++j) {
            const float vv = sV[j * 256 + c];
#pragma unroll
            for (int ii = 0; ii < 8; ++ii) { const float w = (j <= i0 + ii) ? wsh[(i0 + ii) * 128 + j] : 0.f; acc[ii] += w * vv; }
        }
#pragma unroll
        for (int ii = 0; ii < 8; ++ii) { const int i = i0 + ii; const float s = acc[ii] + bsh[i];
            const float u = gelu_erf(bf2f(P[(size_t)(m0 + i) * NP + c]));
            MIX[(size_t)(m0 + i) * D + c] = (bf16)f2bf(u * s); }
    }
    __syncthreads();
}

__device__ __forceinline__ void conv_unit(Frame& F, int l, int unit, const bf16* P, bf16* MIX) {
    const int b = unit >> 6, t0 = (unit & 63) * 64, m0 = b * SEQ + t0;
    LAS float* sY = (LAS float*)F.lds;
    for (int r = F.wave; r < 94; r += NWAVES) {
        const int t = t0 - 30 + r; f32x4 y = (f32x4){0.f, 0.f, 0.f, 0.f};
        if (t >= 0) {
            const bf16* pr = P + (size_t)(b * SEQ + t) * NP + 4 * F.lane;
            const u32x2 ra = *(const u32x2*)(pr + 512), rg = *(const u32x2*)(pr + 768);
            y.x = bf2f((unsigned short)(ra.x & 0xffffu)) * sigmoidf_(bf2f((unsigned short)(rg.x & 0xffffu)));
            y.y = bf2f((unsigned short)(ra.x >> 16)) * sigmoidf_(bf2f((unsigned short)(rg.x >> 16)));
            y.z = bf2f((unsigned short)(ra.y & 0xffffu)) * sigmoidf_(bf2f((unsigned short)(rg.y & 0xffffu)));
            y.w = bf2f((unsigned short)(ra.y >> 16)) * sigmoidf_(bf2f((unsigned short)(rg.y >> 16)));
        }
        *(LAS f32x4*)(sY + r * 256 + 4 * F.lane) = y;
    }
    __syncthreads();
    if (MK_CVSTEP < 2) return;
    const int c = F.tid & 255, hf = F.wave >> 2;
    float w[CVK];
#pragma unroll
    for (int k = 0; k < CVK; ++k) w[k] = F.inp(7)[(size_t)(l * CVK + k) * 256 + c];
    const float bias = F.inp(8)[l * 256 + c];
    float o[32];
#pragma unroll
    for (int g = 0; g < 4; ++g) {
        float y[38];
#pragma unroll
        for (int q = 0; q < 38; ++q) y[q] = sY[(hf * 32 + 8 * g + q) * 256 + c];
#pragma unroll
        for (int t8 = 0; t8 < 8; ++t8) {
            float a = bias;
#pragma unroll
            for (int k = 0; k < CVK; ++k) a += w[k] * y[t8 + k];
            o[8 * g + t8] = a;
        }
    }
    __syncthreads();
#pragma unroll
    for (int tt = 0; tt < 32; ++tt) sY[(hf * 32 + tt) * 256 + c] = o[tt];
    __syncthreads();
    if (MK_CVSTEP < 3) return;
    const f32x4 g4 = *(const f32x4*)(F.inp(9) + l * 256 + 4 * F.lane), b4 = *(const f32x4*)(F.inp(10) + l * 256 + 4 * F.lane);
    for (int i = F.wave; i < 64; i += NWAVES) {
        f32x4 v = *(LAS f32x4*)(sY + i * 256 + 4 * F.lane);
        const float mean = wave_sum((v.x + v.y) + (v.z + v.w)) * (1.0f / 256.0f);
        v = v - mean;
        const float var = wave_sum((v.x * v.x + v.y * v.y) + (v.z * v.z + v.w * v.w)) * (1.0f / 256.0f);
        const float r = 1.0f / sqrtf(var + EPS);
        v = v * r * g4 + b4;
        v.x *= sigmoidf_(v.x); v.y *= sigmoidf_(v.y); v.z *= sigmoidf_(v.z); v.w *= sigmoidf_(v.w);
        *(unsigned long long*)(MIX + (size_t)(m0 + i) * D + 256 + 4 * F.lane) = (unsigned long long)pk2(v.x, v.y) | ((unsigned long long)pk2(v.z, v.w) << 32);
    }
    __syncthreads();
}

__device__ __forceinline__ void dn_chunk_unit(Frame& F, int l, int cu, const bf16* P, const float* BA) {
    const int b = cu >> 8, h = (cu >> 6) & 3, n = cu & 63, m0 = b * SEQ + n * 64;
    LAS float* sQ = (LAS float*)F.lds;
    LAS float* sK = (LAS float*)(F.lds + 32768);
    LAS float* sV = (LAS float*)(F.lds + 65536);
    LAS bf16* sQb = (LAS bf16*)(F.lds + 98304);
    LAS bf16* sKb = (LAS bf16*)(F.lds + 115712);
    LAS float* sGam = (LAS float*)(F.lds + 133120);
    LAS float* sBeta = (LAS float*)(F.lds + 133376);
    LAS float* sA = sQ;
    bf16* Uo = (bf16*)(F.ws + WS_U) + (size_t)cu * 8192; bf16* Wo = (bf16*)(F.ws + WS_WW) + (size_t)cu * 8192;
    bf16* QDo = (bf16*)(F.ws + WS_QD) + (size_t)cu * 8192; bf16* KDTo = (bf16*)(F.ws + WS_KDT) + (size_t)cu * 8192;
    bf16* QKo = (bf16*)(F.ws + WS_QK) + (size_t)cu * 4096; float* CD = (float*)(F.ws + WS_CD);
    if (F.wave < 6) {
        const int sel = F.wave >> 1, c = F.tid & 127;
        const int pcol = 1024 + sel * 512 + h * 128 + c, wch = sel * 512 + h * 128 + c;
        const float* cw = F.inp(11) + (size_t)l * DNCONV * 1536 + wch;
        const float w0 = cw[0], w1 = cw[1536], w2 = cw[2 * 1536], w3 = cw[3 * 1536];
        const bf16* pc = P + (size_t)m0 * NP + pcol;
        float x0 = 0.f, x1 = 0.f, x2 = 0.f;
        if (n > 0 && MK_NEG) { x0 = bf2f(pc[-3 * NP]); x1 = bf2f(pc[-2 * NP]); x2 = bf2f(pc[-1 * NP]); }
        LAS float* dst = (sel == 0 ? sQ : (sel == 1 ? sK : sV)) + c;
#pragma unroll 8
        for (int i = 0; i < 64; ++i) {
            const float x3 = bf2f(pc[(size_t)i * NP]);
            const float y = (w0 * x0 + w1 * x1) + (w2 * x2 + w3 * x3);
            dst[i * 128] = y * sigmoidf_(y);
            x0 = x1; x1 = x2; x2 = x3;
        }
    } else if (F.wave == 6 && MK_W6) {
        const int i = F.lane;
        const float bl = BA[(size_t)(m0 + i) * 8 + h], al = BA[(size_t)(m0 + i) * 8 + 4 + h];
        const float beta = 1.0f / (1.0f + expf(-bl));
        const float z = al + F.inp(13)[l * 4 + h];
        const float sp = fmaxf(z, 0.f) + log1pf(expf(-fabsf(z)));
        float la = -expf(F.inp(12)[l * 4 + h]) * sp;
#pragma unroll
        for (int off = 1; off < 64; off <<= 1) { const float t = __shfl_up(la, off); if (i >= off) la += t; }
        sGam[i] = la; sBeta[i] = beta;
        if (i == 63) CD[cu] = expf(la);
    }
    __syncthreads();
    if (MK_DNSTEP < 2) return;
#pragma unroll
    for (int rr = 0; rr < 8; ++rr) {
        const int i = 8 * F.wave + rr;
        const float q0 = sQ[i * 128 + F.lane], q1 = sQ[i * 128 + 64 + F.lane], k0 = sK[i * 128 + F.lane], k1 = sK[i * 128 + 64 + F.lane];
        const float rq = (1.0f / sqrtf(wave_sum(q0 * q0 + q1 * q1) + EPS)) * 0.08838834764831845f;
        const float rk = 1.0f / sqrtf(wave_sum(k0 * k0 + k1 * k1) + EPS);
        sQ[i * 128 + F.lane] = q0 * rq; sQ[i * 128 + 64 + F.lane] = q1 * rq; sK[i * 128 + F.lane] = k0 * rk; sK[i * 128 + 64 + F.lane] = k1 * rk;
    }
    __syncthreads();
    if (MK_DNSTEP < 3) return;
    {
        const int i = F.tid >> 3, cb = (F.tid & 7) * 16;
        const float eg = expf(sGam[i]);
        f32x4 q[4], k[4];
#pragma unroll
        for (int t = 0; t < 4; ++t) { q[t] = *(LAS f32x4*)(sQ + i * 128 + cb + 4 * t); k[t] = *(LAS f32x4*)(sK + i * 128 + cb + 4 * t); }
        v4u a, bq, ck;
        a.x = pk2(q[0].x, q[0].y); a.y = pk2(q[0].z, q[0].w); a.z = pk2(q[1].x, q[1].y); a.w = pk2(q[1].z, q[1].w);
        *(LAS v4u*)(sQb + i * 136 + cb) = a;
        a.x = pk2(q[2].x, q[2].y); a.y = pk2(q[2].z, q[2].w); a.z = pk2(q[3].x, q[3].y); a.w = pk2(q[3].z, q[3].w);
        *(LAS v4u*)(sQb + i * 136 + cb + 8) = a;
        ck.x = pk2(k[0].x, k[0].y); ck.y = pk2(k[0].z, k[0].w); ck.z = pk2(k[1].x, k[1].y); ck.w = pk2(k[1].z, k[1].w);
        *(LAS v4u*)(sKb + i * 136 + cb) = ck;
        ck.x = pk2(k[2].x, k[2].y); ck.y = pk2(k[2].z, k[2].w); ck.z = pk2(k[3].x, k[3].y); ck.w = pk2(k[3].z, k[3].w);
        *(LAS v4u*)(sKb + i * 136 + cb + 8) = ck;
        bq.x = pk2(q[0].x * eg, q[0].y * eg); bq.y = pk2(q[0].z * eg, q[0].w * eg); bq.z = pk2(q[1].x * eg, q[1].y * eg); bq.w = pk2(q[1].z * eg, q[1].w * eg);
        *(v4u*)(QDo + i * 128 + cb) = bq;
        bq.x = pk2(q[2].x * eg, q[2].y * eg); bq.y = pk2(q[2].z * eg, q[2].w * eg); bq.z = pk2(q[3].x * eg, q[3].y * eg); bq.w = pk2(q[3].z * eg, q[3].w * eg);
        *(v4u*)(QDo + i * 128 + cb + 8) = bq;
    }
    {
        const int c = F.tid >> 2, jb = (F.tid & 3) * 16;
        const float gl = sGam[63];
        float kv[16];
#pragma unroll
        for (int jj = 0; jj < 16; ++jj) kv[jj] = sK[(jb + jj) * 128 + c] * expf(gl - sGam[jb + jj]);
        v4u a;
        a.x = pk2(kv[0], kv[1]); a.y = pk2(kv[2], kv[3]); a.z = pk2(kv[4], kv[5]); a.w = pk2(kv[6], kv[7]);
        *(v4u*)(KDTo + c * 64 + jb) = a;
        a.x = pk2(kv[8], kv[9]); a.y = pk2(kv[10], kv[11]); a.z = pk2(kv[12], kv[13]); a.w = pk2(kv[14], kv[15]);
        *(v4u*)(KDTo + c * 64 + jb + 8) = a;
    }
    __syncthreads();
    if (MK_DNSTEP < 4) return;
    {
        const int mat = F.wave >> 2, ti = (F.wave >> 1) & 1, tj = F.wave & 1, r = F.lane & 31, hh = F.lane >> 5;
        f32x16 acc;
#pragma unroll
        for (int e = 0; e < 16; ++e) acc[e] = 0.f;
        if (!(ti == 0 && tj == 1)) {
            const LAS bf16* Ab = (mat ? sQb : sKb) + (32 * ti + r) * 136 + 8 * hh;
            const LAS bf16* Bb = sKb + (32 * tj + r) * 136 + 8 * hh;
#pragma unroll
            for (int s = 0; s < 8; ++s) { const bf16x8 a = *(const LAS bf16x8*)(Ab + 16 * s), bb = *(const LAS bf16x8*)(Bb + 16 * s); acc = MFMA32(a, bb, acc); }
        }
        const int j = 32 * tj + r; const float gj = sGam[j];
#pragma unroll
        for (int reg = 0; reg < 16; ++reg) {
            const int i = 32 * ti + crow(reg, hh); const float gi = sGam[i];
            if (mat == 0) sA[i * 64 + j] = (j < i) ? sBeta[i] * acc[reg] * expf(gi - gj) : 0.f;
            else QKo[i * 64 + j] = (bf16)f2bf((j <= i) ? acc[reg] * expf(gi - gj) : 0.f);
        }
    }
    __syncthreads();
    if (MK_DNSTEP < 5) return;
    if (F.wave < 4) {
        const int col = F.tid & 127; const bool isw = F.wave >= 2;
        const LAS float* src = (isw ? sK : sV) + col;
        bf16* dsto = (isw ? Wo : Uo) + col;
        float sol[64];
#pragma unroll
        for (int i = 0; i < 64; ++i) {
            float rv = sBeta[i] * src[i * 128]; if (isw) rv *= expf(sGam[i]);
#pragma unroll
            for (int j = 0; j < i; ++j) rv -= sA[i * 64 + j] * sol[j];
            sol[i] = rv;
            dsto[i * 128] = (bf16)f2bf(rv);
        }
    }
    __syncthreads();
}

__device__ __forceinline__ void dn_scan(Frame& F, int l, int bh, const bf16* P, bf16* MIX) {
    const int b = bh >> 2, h = bh & 3;
    LAS bf16* St = (LAS bf16*)F.lds;
    LAS bf16* ut = (LAS bf16*)(F.lds + 34816);
    LAS float* sO = (LAS float*)(F.lds + 53248);
    for (int idx = F.tid; idx < 34816 / 4; idx += NWAVES * 64) ((LAS unsigned*)St)[idx] = 0u;
    f32x16 S0, S1;
#pragma unroll
    for (int e = 0; e < 16; ++e) { S0[e] = 0.f; S1[e] = 0.f; }
    const int r = F.lane & 31, hh = F.lane >> 5;
    const int ti = F.wave >> 2, tv = F.wave & 3;
    const int sa = F.wave >> 1, sb0 = 2 * (F.wave & 1), sb1 = sb0 + 1;
    const float ng0 = F.inp(14)[l * 128 + F.lane], ng1 = F.inp(14)[l * 128 + 64 + F.lane];
    const float* CD = (const float*)(F.ws + WS_CD);
    __syncthreads();
    for (int n = 0; n < 64; ++n) {
        const int cu = bh * 64 + n, m0 = b * SEQ + n * 64;
        const bf16* Uc = (const bf16*)(F.ws + WS_U) + (size_t)cu * 8192; const bf16* Wc = (const bf16*)(F.ws + WS_WW) + (size_t)cu * 8192;
        const bf16* QDc = (const bf16*)(F.ws + WS_QD) + (size_t)cu * 8192; const bf16* KDTc = (const bf16*)(F.ws + WS_KDT) + (size_t)cu * 8192;
        const bf16* QKc = (const bf16*)(F.ws + WS_QK) + (size_t)cu * 4096;
        const LAS bf16* Sb = St + (32 * tv + r) * 136 + 8 * hh;
        {
            f32x16 acc;
#pragma unroll
            for (int e = 0; e < 16; ++e) acc[e] = 0.f;
            const bf16* Ap = Wc + (32 * ti + r) * 128 + 8 * hh;
#pragma unroll
            for (int s = 0; s < 8; ++s) { const bf16x8 a = *(const bf16x8*)(Ap + 16 * s), bb = *(const LAS bf16x8*)(Sb + 16 * s); acc = MFMA32(a, bb, acc); }
            const int col = 32 * tv + r;
#pragma unroll
            for (int g = 0; g < 4; ++g) {
                const int i0 = 32 * ti + 8 * g + 4 * hh;
                const float u0 = bf2f(Uc[(i0 + 0) * 128 + col]) - acc[4 * g + 0], u1 = bf2f(Uc[(i0 + 1) * 128 + col]) - acc[4 * g + 1];
                const float u2 = bf2f(Uc[(i0 + 2) * 128 + col]) - acc[4 * g + 2], u3 = bf2f(Uc[(i0 + 3) * 128 + col]) - acc[4 * g + 3];
                u32x2 w; w.x = pk2(u0, u1); w.y = pk2(u2, u3);
                *(LAS u32x2*)(ut + col * 72 + i0) = w;
            }
        }
        __syncthreads();
        {
            f32x16 acc;
#pragma unroll
            for (int e = 0; e < 16; ++e) acc[e] = 0.f;
            const bf16* Ap = QDc + (32 * ti + r) * 128 + 8 * hh;
#pragma unroll
            for (int s = 0; s < 8; ++s) { const bf16x8 a = *(const bf16x8*)(Ap + 16 * s), bb = *(const LAS bf16x8*)(Sb + 16 * s); acc = MFMA32(a, bb, acc); }
            const bf16* Aq = QKc + (32 * ti + r) * 64 + 8 * hh; const LAS bf16* Ub = ut + (32 * tv + r) * 72 + 8 * hh;
#pragma unroll
            for (int s = 0; s < 4; ++s) { const bf16x8 a = *(const bf16x8*)(Aq + 16 * s), bb = *(const LAS bf16x8*)(Ub + 16 * s); acc = MFMA32(a, bb, acc); }
            const int col = 32 * tv + r;
#pragma unroll
            for (int reg = 0; reg < 16; ++reg) sO[(32 * ti + crow(reg, hh)) * 132 + col] = acc[reg];
        }
        {
            const float cd = CD[cu];
            S0 = S0 * cd; S1 = S1 * cd;
            const bf16* Ak = KDTc + (32 * sa + r) * 64 + 8 * hh;
            const LAS bf16* U0 = ut + (32 * sb0 + r) * 72 + 8 * hh; const LAS bf16* U1 = ut + (32 * sb1 + r) * 72 + 8 * hh;
#pragma unroll
            for (int s = 0; s < 4; ++s) { const bf16x8 a = *(const bf16x8*)(Ak + 16 * s); const bf16x8 b0 = *(const LAS bf16x8*)(U0 + 16 * s), b1 = *(const LAS bf16x8*)(U1 + 16 * s);
                S0 = MFMA32(a, b0, S0); S1 = MFMA32(a, b1, S1); }
        }
        __syncthreads();
#pragma unroll
        for (int g = 0; g < 4; ++g) {
            const int k0 = 32 * sa + 8 * g + 4 * hh;
            u32x2 w; w.x = pk2(S0[4 * g + 0], S0[4 * g + 1]); w.y = pk2(S0[4 * g + 2], S0[4 * g + 3]);
            *(LAS u32x2*)(St + (32 * sb0 + r) * 136 + k0) = w;
            w.x = pk2(S1[4 * g + 0], S1[4 * g + 1]); w.y = pk2(S1[4 * g + 2], S1[4 * g + 3]);
            *(LAS u32x2*)(St + (32 * sb1 + r) * 136 + k0) = w;
        }
#pragma unroll
        for (int rr = 0; rr < 8; ++rr) {
            const int i = 8 * F.wave + rr;
            const float v0 = sO[i * 132 + F.lane], v1 = sO[i * 132 + 64 + F.lane];
            const float rs = 1.0f / sqrtf(wave_sum(v0 * v0 + v1 * v1) * (1.0f / 128.0f) + EPS);
            const bf16* gp = P + (size_t)(m0 + i) * NP + 2560 + h * 128;
            const float g0 = bf2f(gp[F.lane]), g1 = bf2f(gp[64 + F.lane]);
            bf16* op = MIX + (size_t)(m0 + i) * D + 512 + h * 128;
            op[F.lane] = (bf16)f2bf(v0 * rs * ng0 * (g0 * sigmoidf_(g0)));
            op[64 + F.lane] = (bf16)f2bf(v1 * rs * ng1 * (g1 * sigmoidf_(g1)));
        }
        __syncthreads();
    }
}

struct Args { const float* in[21]; float* out; unsigned char* ws; int ph_lo, ph_hi; };
constexpr int N_PHASES = 1 + 8 * DEPTH;

__global__ void __launch_bounds__(NWAVES * 64, 2) mk_fwd(Args args) {
    extern __shared__ __attribute__((aligned(16))) unsigned char lds[];
    {
        volatile LAS unsigned* MISC0 = (volatile LAS unsigned*)((LAS unsigned char*)lds + MISC_OFF);
        if (threadIdx.x < 32) MISC0[threadIdx.x] = 0u;
    }
    __syncthreads();
    const int lo = args.ph_lo, hi = args.ph_hi;
    XcdBarrier bar; bar.bar = (unsigned*)(args.ws + WS_CTL) + CW_BAR; bar.x = 0; bar.st = nullptr;
    if (hi - lo > 1) bar = xcd_barrier_post((unsigned*)(args.ws + WS_CTL) + CW_BAR, (volatile LAS unsigned*)((LAS unsigned char*)lds + MISC_OFF) + 8);

    for (int ph = lo; ph < hi; ++ph) {
        int tid = threadIdx.x; asm volatile("" : "+v"(tid));
        Frame F;
        F.kp = (const AS4 unsigned char*)__builtin_amdgcn_kernarg_segment_ptr(); asm volatile("" : "+s"(F.kp));
        F.lds = (LAS unsigned char*)lds;
        F.tid = tid; F.lane = tid & 63; F.wave = __builtin_amdgcn_readfirstlane(tid >> 6);
        F.G = gridDim.x; { const int bx = blockIdx.x; F.vcu = (F.G % 8 == 0) ? (bx % 8) * (F.G / 8) + bx / 8 : bx; }
        F.out = *(float* const AS4*)(F.kp + 168); F.ws = *(unsigned char* const AS4*)(F.kp + 176);
        bf16* HN = (bf16*)(F.ws + WS_HN); bf16* MIX = HN; bf16* P = (bf16*)(F.ws + WS_P); bf16* HFF = P;
        float* BA = (float*)(F.ws + WS_BA);
        if (ph == 0) {
            weights_phase(F);
            norm_phase<0>(F, F.inp(0), F.inp(1), HN, F.inp(2), BA, nullptr);
        } else {
#ifdef MK_ONLY_K
            const int l = (ph - 1) >> 3, k = MK_ONLY_K;
#else
            const int l = (ph - 1) >> 3, k = (ph - 1) & 7;
#endif
            const unsigned char* wb = F.ws + WS_W + (size_t)l * W_LAYER;
            if (k == 0) {
                pg8::Gemm g{(const pg8::bf16_t*)HN, (const pg8::bf16_t*)(wb + W_IN_OFF), M, NP, D}; pg8::StaticOrder S; S.init(M, NP, F.G, (int)blockIdx.x);
                pg8::EpiBf16<0> E{(pg8::bf16_t*)P, NP, nullptr, 0, 0, 1.f};
                pg8::gemm_phase<pg8::EpiBf16<0>, pg8::StaticOrder, true, true>(F.lds, g, S, E, tid);
            } else if (k == 1) {
                if (MK_SUB & 1) for (int u = blockIdx.x; u < NCHUNK; u += F.G) dn_chunk_unit(F, l, u, P, BA);
                if (MK_SUB & 2) for (int u = blockIdx.x; u < M / 128; u += F.G) gmlp_unit(F, l, u, P, MIX);
                if (MK_SUB & 4) for (int u = blockIdx.x; u < M / 64; u += F.G) conv_unit(F, l, u, P, MIX);
            } else if (k == 2) {
                for (int u = blockIdx.x; u < BATCH * 4; u += F.G) dn_scan(F, l, u, P, MIX);
            } else if (k == 3 || k == 6) {
                const float* base = (l == 0 && k == 3) ? F.inp(0) : F.out;
                pg8::Gemm g{(const pg8::bf16_t*)(k == 3 ? MIX : HFF), (const pg8::bf16_t*)(wb + (k == 3 ? W_O_OFF : W_D_OFF)), M, D, k == 3 ? D : DFF}; pg8::StaticOrder S; S.init(M, D, F.G, (int)blockIdx.x);
                pg8::EpiRes E{base, F.out, D};
                pg8::gemm_phase<pg8::EpiRes, pg8::StaticOrder, true, true>(F.lds, g, S, E, tid);
            } else if (k == 4) {
                norm_phase<0>(F, F.out, F.inp(16) + l * D, HN, nullptr, nullptr, nullptr);
            } else if (k == 5) {
                pg8::Gemm g{(const pg8::bf16_t*)HN, (const pg8::bf16_t*)(wb + W_GU_OFF), M, 2 * DFF, D}; pg8::StaticOrder S; S.init(M, 2 * DFF, F.G, (int)blockIdx.x);
                pg8::EpiSwiGLU E{(pg8::bf16_t*)HFF, DFF};
                pg8::gemm_phase<pg8::EpiSwiGLU, pg8::StaticOrder, true, true>(F.lds, g, S, E, tid);
            } else {
                if (l + 1 < DEPTH) norm_phase<0>(F, F.out, F.inp(1) + (l + 1) * D, HN, F.inp(2) + (size_t)(l + 1) * D * DPROJ, BA, nullptr);
                else norm_phase<1>(F, F.out, F.inp(20), nullptr, nullptr, nullptr, F.out);
            }
        }
        if (ph + 1 < hi) xcd_barrier(bar);
    }
}

#ifndef MK_SINGLE
#define MK_SINGLE 0
#endif

extern "C" void kernel_launch(void* const* d_in, const int* in_sizes, int n_in, void* d_out, int out_size, void* d_ws, size_t ws_size, hipStream_t stream) {
    static int grid = 0;
    if (grid == 0) {
        if (n_in != 21 || in_sizes[0] != M * D || out_size != M * D || ws_size < WS_END) { fprintf(stderr, "kernel_launch: unexpected shapes (n_in %d, in0 %d, out %d, ws %zu)\n", n_in, n_in > 0 ? in_sizes[0] : -1, out_size, ws_size); grid = -1; return; }
        int dev = 0, cus = 0, per_cu = 0;
        if (hipGetDevice(&dev) != hipSuccess || hipDeviceGetAttribute(&cus, hipDeviceAttributeMultiprocessorCount, dev) != hipSuccess) { grid = -1; return; }
        if (hipFuncSetAttribute((const void*)mk_fwd, hipFuncAttributeMaxDynamicSharedMemorySize, LDS_BYTES) != hipSuccess) { fprintf(stderr, "kernel_launch: hipFuncSetAttribute failed\n"); grid = -1; return; }
        if (hipOccupancyMaxActiveBlocksPerMultiprocessor(&per_cu, (const void*)mk_fwd, NWAVES * 64, LDS_BYTES) != hipSuccess || per_cu < 1) { fprintf(stderr, "kernel_launch: occupancy query says %d blocks per CU\n", per_cu); per_cu = 1; }
        (void)hipGetLastError();
        grid = cus;
        if (grid % 8 != 0 || grid < 32) fprintf(stderr, "kernel_launch: unexpected CU count %d\n", grid);
    }
    if (grid < 0) return;
    (void)hipMemsetAsync((char*)d_ws + WS_CTL, 0, CTL_ZERO_BYTES, stream);
    Args a{};
    for (int i = 0; i < 21; ++i) a.in[i] = (const float*)d_in[i];
    a.out = (float*)d_out; a.ws = (unsigned char*)d_ws;
#if MK_SINGLE
    a.ph_lo = 0; a.ph_hi = N_PHASES;
    hipLaunchKernelGGL(mk_fwd, dim3(grid), dim3(NWAVES * 64), LDS_BYTES, stream, a);
#else
    for (int ph = 0; ph < MK_PH_HI; ++ph) { a.ph_lo = ph; a.ph_hi = ph + 1; hipLaunchKernelGGL(mk_fwd, dim3(grid), dim3(NWAVES * 64), LDS_BYTES, stream, a); }
#endif
}
```

```cpp
#include <hip/hip_runtime.h>
#include <cstdio>
#include <cstdint>
#include <cmath>
#define MK_SINGLE 1
namespace pg8 {
#define PG8_LAS __attribute__((address_space(3)))
typedef unsigned short bf16_t;
typedef short bf16x8 __attribute__((ext_vector_type(8)));
typedef float f32x4 __attribute__((ext_vector_type(4)));
typedef unsigned u32x4 __attribute__((ext_vector_type(4)));
constexpr int BM = 256, BK = 64, HALF = 128, HTB = HALF * BK * 2  , STAGE_BYTES = 8 * HTB, NXCD = 8, WGM = 8;

__host__ __device__ __forceinline__ int lds_byte(int r, int c) { const int st = (r >> 4) * 2 + (c >> 5), rr = r & 15, cc = c & 31, ob = rr * 64 + cc * 2; return st * 1024 + (ob ^ (((ob >> 9) & 1) << 5)); }
__host__ __device__ __forceinline__ void stage_rc(int b, int& R, int& C) { const int st = b / 1024, sb = b % 1024, swz = sb ^ (((sb >> 9) & 1) << 5); R = (st >> 1) * 16 + swz / 64; C = (st & 1) * 32 + (swz % 64) / 2; }
__host__ __device__ __forceinline__ int perm32(int rho) { const int n = rho >> 4, i = rho & 15; return 8 * (i >> 2) + 4 * n + (i & 3); }

struct Unit { int pm, pn; };
struct Gemm { const bf16_t* A; const bf16_t* Bt; int M, N, K; };

struct StaticOrder {
    int nM, nN, nwg, G, c;
    __host__ __device__ void init(int M, int N, int G_, int c_) { nM = M / BM; nN = N / BM; nwg = nM * nN; G = G_; c = c_; }
    __host__ __device__ bool next(int i, Unit& u) const {
        const long L = (long)i * G + c; if (L >= nwg) return false;
        int wgid = (int)L; { const int q = nwg / NXCD, r = nwg % NXCD, xcd = wgid % NXCD, off = wgid / NXCD; wgid = (xcd < r ? xcd * (q + 1) : r * (q + 1) + (xcd - r) * q) + off; }
        const int nig = WGM * nN, gid = wgid / nig, fm = gid * WGM, gsz = (nM - fm) < WGM ? (nM - fm) : WGM;
        u.pm = fm + ((wgid % nig) % gsz); u.pn = (wgid % nig) / gsz; return true;
    }
    __device__ __forceinline__ void a_ready(const Unit&) const {}
    __device__ __forceinline__ void done(const Unit&) const {}
};

__device__ __forceinline__ unsigned cvt_pk_bf16(float lo, float hi) { unsigned r; asm volatile("v_cvt_pk_bf16_f32 %0, %1, %2" : "=v"(r) : "v"(lo), "v"(hi)); return r; }
typedef float f32x2 __attribute__((ext_vector_type(2)));
__device__ __forceinline__ f32x2 gelu_pk(f32x2 v) {
    const f32x2 av = __builtin_elementwise_abs(v), d = av * 0.2316418882f + 1.0f;
    f32x2 t; t.x = __builtin_amdgcn_rcpf(d.x); t.y = __builtin_amdgcn_rcpf(d.y);
    f32x2 q = t * 0.5307027145f + (-0.7265760135f); q = q * t + 0.7107068705f; q = q * t + (-0.142248368f); q = q * t + 0.127414796f; q = q * t;
    const f32x2 s = (v * v) * (-0.72134752044f);
    f32x2 e; e.x = __builtin_amdgcn_exp2f(s.x); e.y = __builtin_amdgcn_exp2f(s.y);
    const f32x2 m = v * (q * e), r = v - m;
    f32x2 o; o.x = v.x < 0.f ? m.x : r.x; o.y = v.y < 0.f ? m.y : r.y; return o;
}

template <int ACT  > struct EpiBf16 {
    static constexpr bool PERM = true, AFTER_DRAIN = false; static_assert(ACT == 0 || ACT == 1, "EpiBf16: ACT is 0 (none) or 1 (gelu_pk)");
    bf16_t* O; int ldc; const float* bias; int split_cols; size_t split_stride; float scale0;
    __device__ __forceinline__ void operator()(const f32x4 (&acc)[2][2][4][2], const Unit& u, int wr, int wc, int fr, int fq) const {
        const int row0 = u.pm * BM + wr * 64 + fr; int colt = u.pn * BM; bf16_t* base = O;
        float sc = 1.f; if (split_cols) { const int t = colt / split_cols; base += (size_t)t * split_stride; colt -= t * split_cols; if (t == 0) sc = scale0; }
        const int col0 = colt + wc * 32 + 8 * fq, bcol0 = u.pn * BM + wc * 32 + 8 * fq;
        f32x4 bv[2][2];
#pragma unroll
        for (int bj = 0; bj < 2; ++bj)
#pragma unroll
            for (int n = 0; n < 2; ++n) bv[bj][n] = bias ? *(const f32x4*)(bias + bcol0 + bj * HALF + 4 * n) : (f32x4){0.f, 0.f, 0.f, 0.f};
#pragma unroll
        for (int ai = 0; ai < 2; ++ai)
#pragma unroll
            for (int m = 0; m < 4; ++m) { bf16_t* rowp = base + (size_t)(row0 + ai * HALF + m * 16) * ldc + col0;
#pragma unroll
                for (int bj = 0; bj < 2; ++bj) { f32x4 v0 = acc[ai][bj][m][0] + bv[bj][0], v1 = acc[ai][bj][m][1] + bv[bj][1];
                    if (ACT == 1) { f32x2 a = gelu_pk((f32x2){v0[0], v0[1]}), b = gelu_pk((f32x2){v0[2], v0[3]}), c = gelu_pk((f32x2){v1[0], v1[1]}), d = gelu_pk((f32x2){v1[2], v1[3]});
                        v0 = (f32x4){a.x, a.y, b.x, b.y}; v1 = (f32x4){c.x, c.y, d.x, d.y}; }
                    v0 = v0 * sc; v1 = v1 * sc; u32x4 w; w.x = cvt_pk_bf16(v0[0], v0[1]); w.y = cvt_pk_bf16(v0[2], v0[3]); w.z = cvt_pk_bf16(v1[0], v1[1]); w.w = cvt_pk_bf16(v1[2], v1[3]);
                    *(u32x4*)(rowp + bj * HALF) = w; } }
    }
};
struct EpiRes {
    static constexpr bool PERM = false, AFTER_DRAIN = false;
    const float* base; float* out; int ldc;
    __device__ __forceinline__ void operator()(const f32x4 (&acc)[2][2][4][2], const Unit& u, int wr, int wc, int fr, int fq) const {
        const int row0 = u.pm * BM + wr * 64 + fr, col0 = u.pn * BM + wc * 32 + 4 * fq;
#pragma unroll
        for (int ai = 0; ai < 2; ++ai)
#pragma unroll
            for (int m = 0; m < 4; ++m) { const size_t off = (size_t)(row0 + ai * HALF + m * 16) * ldc + col0;
#pragma unroll
                for (int bj = 0; bj < 2; ++bj)
#pragma unroll
                    for (int n = 0; n < 2; ++n) { const f32x4 bs = *(const f32x4*)(base + off + bj * HALF + n * 16); *(f32x4*)(out + off + bj * HALF + n * 16) = bs + acc[ai][bj][m][n]; } }
    }
};
struct EpiSwiGLU {
    static constexpr bool PERM = true, AFTER_DRAIN = false;
    bf16_t* O; int ldo;
    __device__ __forceinline__ void operator()(const f32x4 (&acc)[2][2][4][2], const Unit& u, int wr, int wc, int fr, int fq) const {
        const int row0 = u.pm * BM + wr * 64 + fr, col0 = u.pn * HALF + wc * 32 + 8 * fq;
#pragma unroll
        for (int ai = 0; ai < 2; ++ai)
#pragma unroll
            for (int m = 0; m < 4; ++m) { bf16_t* rowp = O + (size_t)(row0 + ai * HALF + m * 16) * ldo + col0;
                float r[8];
#pragma unroll
                for (int n = 0; n < 2; ++n)
#pragma unroll
                    for (int e = 0; e < 4; ++e) { const float g = acc[ai][0][m][n][e], up = acc[ai][1][m][n][e]; r[4 * n + e] = g * __builtin_amdgcn_rcpf(1.0f + __expf(-g)) * up; }
                u32x4 w; w.x = cvt_pk_bf16(r[0], r[1]); w.y = cvt_pk_bf16(r[2], r[3]); w.z = cvt_pk_bf16(r[4], r[5]); w.w = cvt_pk_bf16(r[6], r[7]);
                *(u32x4*)rowp = w; }
    }
};
template <class Epi, class Sched, bool ALIGN_EPI = false, bool SP2 = false>
__device__ __forceinline__ void gemm_phase(PG8_LAS unsigned char* lds, const Gemm g, const Sched& S, const Epi& E, const int tid) {
    const int wid = __builtin_amdgcn_readfirstlane(tid >> 6), lane = tid & 63, wr = wid >> 2, wc = wid & 3, fr = lane & 15, fq = lane >> 4;
    const int K = g.K, nt = K / BK;
    unsigned voffA[2], voffB[2];
#pragma unroll
    for (int i = 0; i < 2; ++i) { int R, C; stage_rc(tid * 16 + i * 8192, R, C); const int Rb = Epi::PERM ? ((R & ~31) + perm32(R & 31)) : R;
        voffA[i] = (unsigned)(R * K + C) * 2u; voffB[i] = (unsigned)(Rb * K + C) * 2u; }
    const size_t kstep = (size_t)(BK * 2);
    const size_t hstep = (size_t)HALF * K * 2;
    const size_t tstep = 2 * hstep;
    const unsigned ldsw = (unsigned)wid * 1024u;
    const int aoff = lds_byte(wr * 64 + fr, fq * 8), boff = lds_byte(wc * 32 + fr, fq * 8);
#define PG8_SA(b, h) (((b) * 2 + (h)) * HTB)
#define PG8_SB(b, h) ((4 + (b) * 2 + (h)) * HTB)
#define PG8_STAGE(bufoff, gbase, voff) do { _Pragma("unroll") for (int _i = 0; _i < 2; ++_i) \
        __builtin_amdgcn_global_load_lds((const unsigned*)((const char*)(gbase) + (voff)[_i]), (PG8_LAS unsigned*)(lds + (bufoff) + ldsw + _i * 8192), 16, 0, 0); } while (0)
#define PG8_LDA(dst, b, h) do { _Pragma("unroll") for (int m = 0; m < 4; ++m) _Pragma("unroll") for (int k = 0; k < 2; ++k) dst[m][k] = *(const PG8_LAS bf16x8*)(lds + PG8_SA(b, h) + aoff + m * 2048 + k * 1024); } while (0)
#define PG8_LDB(dst, b, h) do { _Pragma("unroll") for (int n = 0; n < 2; ++n) _Pragma("unroll") for (int k = 0; k < 2; ++k) dst[n][k] = *(const PG8_LAS bf16x8*)(lds + PG8_SB(b, h) + boff + n * 2048 + k * 1024); } while (0)
#define PG8_MMA(ai, bj, At, Bt) do { __builtin_amdgcn_s_setprio(1); _Pragma("unroll") for (int m = 0; m < 4; ++m) _Pragma("unroll") for (int n = 0; n < 2; ++n) _Pragma("unroll") for (int k = 0; k < 2; ++k) \
        acc[ai][bj][m][n] = __builtin_amdgcn_mfma_f32_16x16x32_bf16(Bt[n][k], At[m][k], acc[ai][bj][m][n], 0, 0, 0); __builtin_amdgcn_s_setprio(0); } while (0)
#define PG8_WAIT_V(n) asm volatile("s_waitcnt vmcnt(" #n ")" ::: "memory")
#define PG8_WAIT_L(n) asm volatile("s_waitcnt lgkmcnt(" #n ")" ::: "memory")
#define PG8_BAR __builtin_amdgcn_s_barrier()
#define PG8_SCHED __builtin_amdgcn_sched_barrier(0)
    Unit cur, nxt; int ui = 0;
    if (!S.next(0, cur)) return;
    f32x4 acc[2][2][4][2];
#pragma unroll
    for (int a = 0; a < 2; ++a)
#pragma unroll
        for (int b = 0; b < 2; ++b)
#pragma unroll
            for (int m = 0; m < 4; ++m)
#pragma unroll
                for (int n = 0; n < 2; ++n) acc[a][b][m][n] = (f32x4){0.f, 0.f, 0.f, 0.f};
    bf16x8 At[4][2], B0[2][2], B1[2][2];
    const char* cA = (const char*)g.A + (size_t)cur.pm * tstep; const char* cB = (const char*)g.Bt + (size_t)cur.pn * tstep;
    S.a_ready(cur);
    if constexpr (SP2) {
        PG8_STAGE(PG8_SB(0, 0), cB, voffB); PG8_STAGE(PG8_SB(0, 1), cB + hstep, voffB); PG8_STAGE(PG8_SA(0, 0), cA, voffA); PG8_STAGE(PG8_SA(0, 1), cA + hstep, voffA);
        if (wr == 1) PG8_BAR;
        PG8_WAIT_V(2); PG8_BAR;
        PG8_STAGE(PG8_SB(1, 0), cB + kstep, voffB); PG8_STAGE(PG8_SA(1, 0), cA + kstep, voffA); PG8_STAGE(PG8_SB(1, 1), cB + hstep + kstep, voffB);
        PG8_WAIT_V(6); PG8_BAR;
    } else {
        PG8_STAGE(PG8_SB(0, 0), cB, voffB); PG8_STAGE(PG8_SA(0, 0), cA, voffA); PG8_STAGE(PG8_SB(0, 1), cB + hstep, voffB); PG8_STAGE(PG8_SA(0, 1), cA + hstep, voffA);
        if (wr == 1) PG8_BAR;
        PG8_WAIT_V(4); PG8_BAR;
        PG8_STAGE(PG8_SB(1, 0), cB + kstep, voffB); PG8_STAGE(PG8_SA(1, 0), cA + kstep, voffA); PG8_STAGE(PG8_SB(1, 1), cB + hstep + kstep, voffB);
        PG8_WAIT_V(6); PG8_BAR;
    }
    for (;;) {
        const bool has_next = S.next(ui + 1, nxt);
        const char* nA = has_next ? (const char*)g.A + (size_t)nxt.pm * tstep : cA; const char* nB = has_next ? (const char*)g.Bt + (size_t)nxt.pn * tstep : cB;
        for (int t = 0; t < nt; t += 2) {
            const bool last = (t == nt - 2);
            const char* a1 = cA + (size_t)(t + 1) * kstep;
            const char* a2 = last ? nA : cA + (size_t)(t + 2) * kstep; const char* b2 = last ? nB : cB + (size_t)(t + 2) * kstep;
            const char* a3 = a2 + kstep; const char* b3 = b2 + kstep;
            if (last && has_next) S.a_ready(nxt);
            if constexpr (SP2) {
            PG8_LDB(B0, 0, 0); PG8_LDB(B1, 0, 1); PG8_SCHED; PG8_LDA(At, 0, 0); PG8_STAGE(PG8_SA(1, 1), a1 + hstep, voffA);
            PG8_WAIT_V(8); PG8_WAIT_L(0); PG8_BAR; PG8_MMA(0, 0, At, B0); PG8_MMA(0, 1, At, B1); PG8_BAR; PG8_SCHED;
            PG8_LDA(At, 0, 1); PG8_STAGE(PG8_SB(0, 0), b2, voffB); PG8_STAGE(PG8_SB(0, 1), b2 + hstep, voffB); PG8_STAGE(PG8_SA(0, 0), a2, voffA);
            PG8_WAIT_V(8); PG8_WAIT_L(0); PG8_BAR; PG8_MMA(1, 0, At, B0); PG8_MMA(1, 1, At, B1); PG8_BAR; PG8_SCHED;
            PG8_LDB(B0, 1, 0); PG8_LDB(B1, 1, 1); PG8_SCHED; PG8_LDA(At, 1, 0); PG8_STAGE(PG8_SA(0, 1), a2 + hstep, voffA);
            PG8_WAIT_V(8); PG8_WAIT_L(0); PG8_BAR; PG8_MMA(0, 0, At, B0); PG8_MMA(0, 1, At, B1); PG8_BAR; PG8_SCHED;
            PG8_LDA(At, 1, 1); PG8_STAGE(PG8_SB(1, 0), b3, voffB); PG8_STAGE(PG8_SB(1, 1), b3 + hstep, voffB); PG8_STAGE(PG8_SA(1, 0), a3, voffA);
            PG8_WAIT_V(8); PG8_WAIT_L(0); PG8_BAR; PG8_MMA(1, 0, At, B0); PG8_MMA(1, 1, At, B1); PG8_BAR; PG8_SCHED;
            } else {
            PG8_LDB(B0, 0, 0); PG8_SCHED; PG8_LDA(At, 0, 0); PG8_STAGE(PG8_SA(1, 1), a1 + hstep, voffA);
            PG8_WAIT_L(8); PG8_BAR; PG8_WAIT_L(0); PG8_MMA(0, 0, At, B0); PG8_BAR; PG8_SCHED;
            PG8_LDB(B1, 0, 1); PG8_STAGE(PG8_SB(0, 0), b2, voffB);
            PG8_BAR; PG8_WAIT_L(0); PG8_MMA(0, 1, At, B1); PG8_BAR;
            PG8_LDA(At, 0, 1); PG8_STAGE(PG8_SA(0, 0), a2, voffA);
            PG8_BAR; PG8_WAIT_L(0); PG8_MMA(1, 0, At, B0); PG8_BAR; PG8_SCHED;
            PG8_STAGE(PG8_SB(0, 1), b2 + hstep, voffB);
            PG8_WAIT_V(6); PG8_BAR; PG8_MMA(1, 1, At, B1); PG8_BAR;
            PG8_LDB(B0, 1, 0); PG8_SCHED; PG8_LDA(At, 1, 0); PG8_STAGE(PG8_SA(0, 1), a2 + hstep, voffA);
            PG8_WAIT_L(8); PG8_BAR; PG8_WAIT_L(0); PG8_MMA(0, 0, At, B0); PG8_BAR; PG8_SCHED;
            PG8_LDB(B1, 1, 1); PG8_STAGE(PG8_SB(1, 0), b3, voffB);
            PG8_BAR; PG8_WAIT_L(0); PG8_MMA(0, 1, At, B1); PG8_BAR;
            PG8_LDA(At, 1, 1); PG8_STAGE(PG8_SA(1, 0), a3, voffA);
            PG8_BAR; PG8_WAIT_L(0); PG8_MMA(1, 0, At, B0); PG8_BAR; PG8_SCHED;
            PG8_STAGE(PG8_SB(1, 1), b3 + hstep, voffB);
            PG8_WAIT_V(6); PG8_BAR; PG8_MMA(1, 1, At, B1); PG8_BAR;
            }
        }
        if constexpr (ALIGN_EPI) { if (wr == 0) PG8_BAR; }
        if constexpr (!Epi::AFTER_DRAIN) { E(acc, cur, wr, wc, fr, fq); S.done(cur); }
        if (!has_next) break;
#pragma unroll
        for (int a = 0; a < 2; ++a)
#pragma unroll
            for (int b = 0; b < 2; ++b)
#pragma unroll
                for (int m = 0; m < 4; ++m)
#pragma unroll
                    for (int n = 0; n < 2; ++n) acc[a][b][m][n] = (f32x4){0.f, 0.f, 0.f, 0.f};
        cur = nxt; cA = nA; cB = nB; ++ui;
        if constexpr (ALIGN_EPI) { if (wr == 1) PG8_BAR; }
    }
    PG8_WAIT_V(0);
    if constexpr (!ALIGN_EPI) { if (wr == 0) PG8_BAR; }
    PG8_BAR;
    if constexpr (Epi::AFTER_DRAIN) { E.fused(acc, cur, wr, wc, fr, fq, lds, wid, lane); S.done(cur); }
#undef PG8_SA
#undef PG8_SB
#undef PG8_STAGE
#undef PG8_LDA
#undef PG8_LDB
#undef PG8_MMA
#undef PG8_WAIT_V
#undef PG8_WAIT_L
#undef PG8_BAR
#undef PG8_SCHED
}
}
#define GAS __attribute__((address_space(1)))
#define LAS __attribute__((address_space(3)))
typedef unsigned short bf16;
typedef unsigned v4u __attribute__((ext_vector_type(4)));
typedef float f32x4 __attribute__((ext_vector_type(4)));
typedef short bf16x8 __attribute__((ext_vector_type(8)));
typedef GAS unsigned gu32;
typedef GAS unsigned long long gu64;
#define RLX_AGENT __ATOMIC_RELAXED, __HIP_MEMORY_SCOPE_AGENT
#define LDS_WAIT() asm volatile("s_waitcnt lgkmcnt(0)" ::: "memory")
#define VM_WAIT() asm volatile("s_waitcnt vmcnt(0)" ::: "memory")
__device__ __forceinline__ unsigned long long rt() { return __builtin_amdgcn_s_memrealtime(); }
__device__ __forceinline__ unsigned f2bf(float f) { unsigned u = __builtin_bit_cast(unsigned, f); return (u + 0x7fffu + ((u >> 16) & 1u)) >> 16; }
__device__ __forceinline__ unsigned pk2(float lo, float hi) { return f2bf(lo) | (f2bf(hi) << 16); }

#define XB_TMO      128
#define XB_XCNT(j)  (256  + 64 * (j))
#define XB_XSUB(j)  (1280 + 64 * (j))
#define XB_XGEN(j)  (2304 + 64 * (j))
#define XB_TOP      3328
#define XB_TOPGEN   3392
#define XCD_BAR_WORDS 3456
#define XB_SPIN_CAP (1u << 18)

__device__ __forceinline__ unsigned xb_ld(unsigned* p)              { return __hip_atomic_load(p, __ATOMIC_RELAXED, __HIP_MEMORY_SCOPE_AGENT); }
__device__ __forceinline__ unsigned xb_add(unsigned* p, unsigned v) { return __hip_atomic_fetch_add(p, v, __ATOMIC_RELAXED, __HIP_MEMORY_SCOPE_AGENT); }
__device__ __forceinline__ unsigned xb_xcc_id() { return (unsigned)__builtin_amdgcn_s_getreg((3 << 11) | 20) & 0xFu; }
#define XB_SPIN(cond, bar) do { unsigned _sp = 0; while (cond) { __builtin_amdgcn_s_sleep(1); \
    if ((++_sp & 255u) == 0u) { if (xb_ld(&(bar)[XB_TMO])) break; if (_sp > XB_SPIN_CAP) { atomicAdd(&(bar)[XB_TMO], 1u); break; } } } } while (0)

struct XcdBarrier {
    unsigned* bar; unsigned x;
    volatile LAS unsigned* st;
};

__device__ __forceinline__ XcdBarrier xcd_barrier_post(unsigned* bar, volatile LAS unsigned* st) {
    XcdBarrier b; b.bar = bar; b.x = xb_xcc_id(); b.st = st;
    if (threadIdx.x == 0) (void)xb_add(&bar[XB_XCNT(b.x)], 1u);
    return b;
}
__device__ __forceinline__ void xcd_barrier_complete(unsigned* bar, unsigned x, unsigned& nloc, unsigned& nx) {
    const unsigned G = gridDim.x * gridDim.y * gridDim.z;
    unsigned sum, cnt, mine, sp = 0u;
    for (;;) {
        sum = 0u; cnt = 0u; mine = 0u;
#pragma unroll
        for (unsigned j = 0; j < 16; ++j) { const unsigned c = xb_ld(&bar[XB_XCNT(j)]); sum += c; cnt += (c > 0u) ? 1u : 0u; mine = (j == x) ? c : mine; }
        if (sum == G) break;
        __builtin_amdgcn_s_sleep(1);
        if ((++sp & 255u) == 0u) { if (xb_ld(&bar[XB_TMO])) break; if (sp > XB_SPIN_CAP) { atomicAdd(&bar[XB_TMO], 1u); break; } }
    }
    nloc = mine > 0u ? mine : 1u; nx = cnt > 0u ? cnt : 1u;
}

__device__ __forceinline__ void xcd_barrier(const XcdBarrier& b) {
    asm volatile("s_waitcnt vmcnt(0)" ::: "memory");
    __syncthreads();
    if (threadIdx.x == 0) {
        unsigned* bar = b.bar;
        __builtin_amdgcn_s_waitcnt(0);
        unsigned nloc = b.st[0], nx = b.st[1];
        if (nloc == 0u) { xcd_barrier_complete(bar, b.x, nloc, nx); b.st[0] = nloc; b.st[1] = nx; }
        const unsigned old = xb_add(&bar[XB_XSUB(b.x)], 1u);
        const unsigned gen = old / nloc;
        if (old + 1u == (gen + 1u) * nloc) {
            __builtin_amdgcn_fence(__ATOMIC_RELEASE, "agent");
            asm volatile("s_waitcnt vmcnt(0)" ::: "memory");
            const unsigned og = xb_add(&bar[XB_TOP], 1u);
            const unsigned tg = og / nx;
            if (og + 1u == (tg + 1u) * nx) xb_add(&bar[XB_TOPGEN], 1u);
            else XB_SPIN(xb_ld(&bar[XB_TOPGEN]) == tg, bar);
            __builtin_amdgcn_fence(__ATOMIC_ACQUIRE, "agent");
            xb_add(&bar[XB_XGEN(b.x)], 1u);
            asm volatile("s_waitcnt vmcnt(0)" ::: "memory");
        } else {
            XB_SPIN(xb_ld(&bar[XB_XGEN(b.x)]) == gen, bar);
            __builtin_amdgcn_fence(__ATOMIC_ACQUIRE, "agent");
            asm volatile("s_waitcnt vmcnt(0)" ::: "memory");
        }
    }
    __syncthreads();
}

#ifndef MK_PH_HI
#define MK_PH_HI 17
#endif
#ifndef MK_SUB
#define MK_SUB 7
#endif
#ifndef MK_DNSTEP
#define MK_DNSTEP 9
#endif
#ifndef MK_W6
#define MK_W6 1
#endif
#ifndef MK_CVSTEP
#define MK_CVSTEP 9
#endif
#ifndef MK_NEG
#define MK_NEG 1
#endif

constexpr int NWAVES = 8;
constexpr int D = 1024, BATCH = 8, SEQ = 4096, M = BATCH * SEQ, DEPTH = 2;
constexpr int DFF = 2816, DPROJ = 3080, NP = 3072;
constexpr int CVK = 31, DNCONV = 4;
constexpr float EPS = 1e-6f;
constexpr int NCHUNK = BATCH * 4 * 64;

constexpr size_t MiB = 1u << 20;
constexpr size_t WS_CTL = 0, CTL_ZERO_BYTES = 64 * 1024;
constexpr size_t WS_W = 2 * MiB;
constexpr size_t W_IN_OFF = 0, W_O_OFF = 6 * MiB, W_GU_OFF = 8 * MiB, W_D_OFF = 19 * MiB, W_LAYER = 25 * MiB;
constexpr size_t WS_BA = 53 * MiB;
constexpr size_t WS_CD = 54 * MiB + 512 * 1024;
constexpr size_t WS_HN = 64 * MiB;
constexpr size_t WS_P = 128 * MiB;
constexpr size_t WS_U = 320 * MiB, WS_WW = 352 * MiB, WS_QD = 384 * MiB, WS_KDT = 416 * MiB, WS_QK = 448 * MiB, WS_END = 464 * MiB;
constexpr int CW_BAR = 4096;

constexpr int RING_BYTES = 131072;
constexpr int MISC_OFF = 147456 - 256;
constexpr int LDS_BYTES = 147456;

__device__ __forceinline__ float bf2f(unsigned short b) { return __uint_as_float(((unsigned)b) << 16); }
__device__ __forceinline__ float wave_sum(float v) {
#pragma unroll
    for (int o = 1; o < 64; o <<= 1) v += __shfl_xor(v, o);
    return v;
}
__device__ __forceinline__ float sigmoidf_(float x) { return 1.0f / (1.0f + __expf(-x)); }
__device__ __forceinline__ float gelu_erf(float x) { return 0.5f * x * (1.0f + erff(x * 0.70710678118654752f)); }
typedef float f32x16 __attribute__((ext_vector_type(16)));
typedef unsigned u32x2 __attribute__((ext_vector_type(2)));
#define MFMA32(a, b, c) __builtin_amdgcn_mfma_f32_32x32x16_bf16((a), (b), (c), 0, 0, 0)
__device__ __forceinline__ int crow(int reg, int hh) { return (reg & 3) + 8 * (reg >> 2) + 4 * hh; }

#define AS4 __attribute__((address_space(4)))
struct Frame {
    LAS unsigned char* lds;
    int tid, lane, wave, vcu, G;
    const AS4 unsigned char* kp;
    float* out; unsigned char* ws;
    __device__ __forceinline__ const float* inp(int k) const { return *(const float* const AS4*)(kp + 8 * k); }
};

__device__ __forceinline__ void tr_item(const float* W, int ldw, int K, bf16* WT, int kb, int nsrc0, int ndst0, LAS float* scr, int lane) {
    const int k0 = 64 * kb;
#pragma unroll 8
    for (int i = 0; i < 32; ++i) { const int kk = 2 * i + (lane >> 5); scr[kk * 33 + (lane & 31)] = W[(size_t)(k0 + kk) * ldw + nsrc0 + (lane & 31)]; }
    LDS_WAIT(); asm volatile("" ::: "memory");
    const int c = lane & 7;
#pragma unroll
    for (int j = 0; j < 4; ++j) { const int n = (lane >> 3) + 8 * j; const LAS float* s = scr + (8 * c) * 33 + n;
        v4u o; o.x = pk2(s[0 * 33], s[1 * 33]); o.y = pk2(s[2 * 33], s[3 * 33]); o.z = pk2(s[4 * 33], s[5 * 33]); o.w = pk2(s[6 * 33], s[7 * 33]);
        *(GAS v4u*)(WT + (size_t)(ndst0 + n) * K + k0 + 8 * c) = o; }
    LDS_WAIT(); asm volatile("" ::: "memory");
}
__device__ __forceinline__ void weights_phase(Frame& F) {
    LAS float* scr = (LAS float*)(F.lds + F.wave * 16384);
    const int gw = F.vcu * NWAVES + F.wave, NGW = F.G * NWAVES;
    constexpr int I_IN = 16 * 96, I_O = 16 * 32, I_GU = 16 * 176, I_D = 44 * 32, I_L = I_IN + I_O + I_GU + I_D;
    for (int it = gw; it < DEPTH * I_L; it += NGW) {
        const int l = it / I_L; int r = it % I_L;
        bf16* wb = (bf16*)(F.ws + WS_W + (size_t)l * W_LAYER);
        if (r < I_IN) { const int kb = r / 96, nb = r % 96; tr_item(F.inp(2) + (size_t)l * D * DPROJ, DPROJ, D, (bf16*)((unsigned char*)wb + W_IN_OFF), kb, 32 * nb, 32 * nb, scr, F.lane); continue; } r -= I_IN;
        if (r < I_O) { const int kb = r / 32, nb = r % 32; tr_item(F.inp(15) + (size_t)l * D * D, D, D, (bf16*)((unsigned char*)wb + W_O_OFF), kb, 32 * nb, 32 * nb, scr, F.lane); continue; } r -= I_O;
        if (r < I_GU) { const int kb = r / 176, nb = r % 176; const int drow = 32 * nb, tile = drow >> 8, within = drow & 255;
            const float* src = (within < 128 ? F.inp(17) : F.inp(18)) + (size_t)l * D * DFF;
            tr_item(src, DFF, D, (bf16*)((unsigned char*)wb + W_GU_OFF), kb, tile * 128 + (within & 127), drow, scr, F.lane); continue; } r -= I_GU;
        { const int kb = r / 32, nb = r % 32; tr_item(F.inp(19) + (size_t)l * DFF * D, D, DFF, (bf16*)((unsigned char*)wb + W_D_OFF), kb, 32 * nb, 32 * nb, scr, F.lane); }
    }
}

template <int MODE>
__device__ __forceinline__ void norm_phase(Frame& F, const float* xin, const float* g, bf16* hn, const float* wlog, float* ba, float* fout) {
    const int gw = F.vcu * NWAVES + F.wave, NGW = F.G * NWAVES;
    f32x4 gv[4];
#pragma unroll
    for (int j = 0; j < 4; ++j) gv[j] = ((const f32x4*)g)[64 * j + F.lane];
    for (int m = gw; m < M; m += NGW) {
        const f32x4* xr = (const f32x4*)(xin + (size_t)m * D) + F.lane;
        f32x4 v[4]; float ss = 0.f;
#pragma unroll
        for (int j = 0; j < 4; ++j) { v[j] = xr[64 * j]; ss += (v[j].x * v[j].x + v[j].y * v[j].y) + (v[j].z * v[j].z + v[j].w * v[j].w); }
        const float rstd = 1.0f / sqrtf(wave_sum(ss) * (1.0f / D) + EPS);
#pragma unroll
        for (int j = 0; j < 4; ++j) v[j] = v[j] * rstd * gv[j];
        if (MODE == 0) {
            unsigned long long* o8 = (unsigned long long*)(hn + (size_t)m * D) + F.lane;
#pragma unroll
            for (int j = 0; j < 4; ++j) o8[64 * j] = (unsigned long long)pk2(v[j].x, v[j].y) | ((unsigned long long)pk2(v[j].z, v[j].w) << 32);
            if (wlog) {
                float acc[8];
#pragma unroll
                for (int t = 0; t < 8; ++t) acc[t] = 0.f;
#pragma unroll
                for (int j = 0; j < 4; ++j)
#pragma unroll
                    for (int e = 0; e < 4; ++e) { const int k = 256 * j + 4 * F.lane + e; const f32x4* wr = (const f32x4*)(wlog + (size_t)k * DPROJ + NP);
                        const f32x4 w0 = wr[0], w1 = wr[1]; const float y = v[j][e];
                        acc[0] += y * w0.x; acc[1] += y * w0.y; acc[2] += y * w0.z; acc[3] += y * w0.w; acc[4] += y * w1.x; acc[5] += y * w1.y; acc[6] += y * w1.z; acc[7] += y * w1.w; }
#pragma unroll
                for (int t = 0; t < 8; ++t) acc[t] = wave_sum(acc[t]);
                if (F.lane == 0) { *(f32x4*)(ba + (size_t)m * 8) = (f32x4){acc[0], acc[1], acc[2], acc[3]}; *(f32x4*)(ba + (size_t)m * 8 + 4) = (f32x4){acc[4], acc[5], acc[6], acc[7]}; }
            }
        } else {
            f32x4* o = (f32x4*)(fout + (size_t)m * D) + F.lane;
#pragma unroll
            for (int j = 0; j < 4; ++j) o[64 * j] = v[j];
        }
    }
}

__device__ __forceinline__ void gmlp_unit(Frame& F, int l, int unit, const bf16* P, bf16* MIX) {
    const int m0 = unit * 128;
    LAS float* sV = (LAS float*)F.lds;
    const float* lng = F.inp(3) + l * 256; const float* lnb = F.inp(4) + l * 256;
    const f32x4 g4 = *(const f32x4*)(lng + 4 * F.lane), b4 = *(const f32x4*)(lnb + 4 * F.lane);
    for (int j = F.wave; j < 128; j += NWAVES) {
        const u32x2 raw = *(const u32x2*)(P + (size_t)(m0 + j) * NP + 256 + 4 * F.lane);
        f32x4 v; v.x = gelu_erf(bf2f((unsigned short)(raw.x & 0xffffu))); v.y = gelu_erf(bf2f((unsigned short)(raw.x >> 16)));
        v.z = gelu_erf(bf2f((unsigned short)(raw.y & 0xffffu))); v.w = gelu_erf(bf2f((unsigned short)(raw.y >> 16)));
        const float mean = wave_sum((v.x + v.y) + (v.z + v.w)) * (1.0f / 256.0f);
        v = v - mean;
        const float var = wave_sum((v.x * v.x + v.y * v.y) + (v.z * v.z + v.w * v.w)) * (1.0f / 256.0f);
        const float r = 1.0f / sqrtf(var + EPS);
        *(LAS f32x4*)(sV + j * 256 + 4 * F.lane) = v * r * g4 + b4;
    }
    __syncthreads();
    const int c = F.tid & 255, h = F.wave & 3, ih = F.wave >> 2;
    const float* wsh = F.inp(5) + (size_t)(l * 4 + h) * 128 * 128;
    const float* bsh = F.inp(6) + (l * 4 + h) * 128;
    for (int ib = 0; ib < 8; ++ib) {
        const int i0 = ih * 64 + ib * 8;
        float acc[8];
#pragma unroll
        for (int ii = 0; ii < 8; ++ii) acc[ii] = 0.f;
        for (int j = 0; j < i0 + 8; ++j) {
            const float vv = sV[j * 256 + c];
#pragma unroll
            for (int ii = 0; ii < 8; ++ii) { const float w = (j <= i0 + ii) ? wsh[(i0 + ii) * 128 + j] : 0.f; acc[ii] += w * vv; }
        }
#pragma unroll
        for (int ii = 0; ii < 8; ++ii) { const int i = i0 + ii; const float s = acc[ii] + bsh[i];
            const float u = gelu_erf(bf2f(P[(size_t)(m0 + i) * NP + c]));
            MIX[(size_t)(m0 + i) * D + c] = (bf16)f2bf(u * s); }
    }
    __syncthreads();
}

__device__ __forceinline__ void conv_unit(Frame& F, int l, int unit, const bf16* P, bf16* MIX) {
    const int b = unit >> 6, t0 = (unit & 63) * 64, m0 = b * SEQ + t0;
    LAS float* sY = (LAS float*)F.lds;
    for (int r = F.wave; r < 94; r += NWAVES) {
        const int t = t0 - 30 + r; f32x4 y = (f32x4){0.f, 0.f, 0.f, 0.f};
        if (t >= 0) {
            const bf16* pr = P + (size_t)(b * SEQ + t) * NP + 4 * F.lane;
            const u32x2 ra = *(const u32x2*)(pr + 512), rg = *(const u32x2*)(pr + 768);
            y.x = bf2f((unsigned short)(ra.x & 0xffffu)) * sigmoidf_(bf2f((unsigned short)(rg.x & 0xffffu)));
            y.y = bf2f((unsigned short)(ra.x >> 16)) * sigmoidf_(bf2f((unsigned short)(rg.x >> 16)));
            y.z = bf2f((unsigned short)(ra.y & 0xffffu)) * sigmoidf_(bf2f((unsigned short)(rg.y & 0xffffu)));
            y.w = bf2f((unsigned short)(ra.y >> 16)) * sigmoidf_(bf2f((unsigned short)(rg.y >> 16)));
        }
        *(LAS f32x4*)(sY + r * 256 + 4 * F.lane) = y;
    }
    __syncthreads();
    if (MK_CVSTEP < 2) return;
    const int c = F.tid & 255, hf = F.wave >> 2;
    float w[CVK];
#pragma unroll
    for (int k = 0; k < CVK; ++k) w[k] = F.inp(7)[(size_t)(l * CVK + k) * 256 + c];
    const float bias = F.inp(8)[l * 256 + c];
    float o[32];
#pragma unroll
    for (int g = 0; g < 4; ++g) {
        float y[38];
#pragma unroll
        for (int q = 0; q < 38; ++q) y[q] = sY[(hf * 32 + 8 * g + q) * 256 + c];
#pragma unroll
        for (int t8 = 0; t8 < 8; ++t8) {
            float a = bias;
#pragma unroll
            for (int k = 0; k < CVK; ++k) a += w[k] * y[t8 + k];
            o[8 * g + t8] = a;
        }
    }
    __syncthreads();
#pragma unroll
    for (int tt = 0; tt < 32; ++tt) sY[(hf * 32 + tt) * 256 + c] = o[tt];
    __syncthreads();
    if (MK_CVSTEP < 3) return;
    const f32x4 g4 = *(const f32x4*)(F.inp(9) + l * 256 + 4 * F.lane), b4 = *(const f32x4*)(F.inp(10) + l * 256 + 4 * F.lane);
    for (int i = F.wave; i < 64; i += NWAVES) {
        f32x4 v = *(LAS f32x4*)(sY + i * 256 + 4 * F.lane);
        const float mean = wave_sum((v.x + v.y) + (v.z + v.w)) * (1.0f / 256.0f);
        v = v - mean;
        const float var = wave_sum((v.x * v.x + v.y * v.y) + (v.z * v.z + v.w * v.w)) * (1.0f / 256.0f);
        const float r = 1.0f / sqrtf(var + EPS);
        v = v * r * g4 + b4;
        v.x *= sigmoidf_(v.x); v.y *= sigmoidf_(v.y); v.z *= sigmoidf_(v.z); v.w *= sigmoidf_(v.w);
        *(unsigned long long*)(MIX + (size_t)(m0 + i) * D + 256 + 4 * F.lane) = (unsigned long long)pk2(v.x, v.y) | ((unsigned long long)pk2(v.z, v.w) << 32);
    }
    __syncthreads();
}

__device__ __forceinline__ void dn_chunk_unit(Frame& F, int l, int cu, const bf16* P, const float* BA) {
    const int b = cu >> 8, h = (cu >> 6) & 3, n = cu & 63, m0 = b * SEQ + n * 64;
    LAS float* sQ = (LAS float*)F.lds;
    LAS float* sK = (LAS float*)(F.lds + 32768);
    LAS float* sV = (LAS float*)(F.lds + 65536);
    LAS bf16* sQb = (LAS bf16*)(F.lds + 98304);
    LAS bf16* sKb = (LAS bf16*)(F.lds + 115712);
    LAS float* sGam = (LAS float*)(F.lds + 133120);
    LAS float* sBeta = (LAS float*)(F.lds + 133376);
    LAS float* sA = sQ;
    bf16* Uo = (bf16*)(F.ws + WS_U) + (size_t)cu * 8192; bf16* Wo = (bf16*)(F.ws + WS_WW) + (size_t)cu * 8192;
    bf16* QDo = (bf16*)(F.ws + WS_QD) + (size_t)cu * 8192; bf16* KDTo = (bf16*)(F.ws + WS_KDT) + (size_t)cu * 8192;
    bf16* QKo = (bf16*)(F.ws + WS_QK) + (size_t)cu * 4096; float* CD = (float*)(F.ws + WS_CD);
    if (F.wave < 6) {
        const int sel = F.wave >> 1, c = F.tid & 127;
        const int pcol = 1024 + sel * 512 + h * 128 + c, wch = sel * 512 + h * 128 + c;
        const float* cw = F.inp(11) + (size_t)l * DNCONV * 1536 + wch;
        const float w0 = cw[0], w1 = cw[1536], w2 = cw[2 * 1536], w3 = cw[3 * 1536];
        const bf16* pc = P + (size_t)m0 * NP + pcol;
        float x0 = 0.f, x1 = 0.f, x2 = 0.f;
        if (n > 0 && MK_NEG) { x0 = bf2f(pc[-3 * NP]); x1 = bf2f(pc[-2 * NP]); x2 = bf2f(pc[-1 * NP]); }
        LAS float* dst = (sel == 0 ? sQ : (sel == 1 ? sK : sV)) + c;
#pragma unroll 8
        for (int i = 0; i < 64; ++i) {
            const float x3 = bf2f(pc[(size_t)i * NP]);
            const float y = (w0 * x0 + w1 * x1) + (w2 * x2 + w3 * x3);
            dst[i * 128] = y * sigmoidf_(y);
            x0 = x1; x1 = x2; x2 = x3;
        }
    } else if (F.wave == 6 && MK_W6) {
        const int i = F.lane;
        const float bl = BA[(size_t)(m0 + i) * 8 + h], al = BA[(size_t)(m0 + i) * 8 + 4 + h];
        const float beta = 1.0f / (1.0f + expf(-bl));
        const float z = al + F.inp(13)[l * 4 + h];
        const float sp = fmaxf(z, 0.f) + log1pf(expf(-fabsf(z)));
        float la = -expf(F.inp(12)[l * 4 + h]) * sp;
#pragma unroll
        for (int off = 1; off < 64; off <<= 1) { const float t = __shfl_up(la, off); if (i >= off) la += t; }
        sGam[i] = la; sBeta[i] = beta;
        if (i == 63) CD[cu] = expf(la);
    }
    __syncthreads();
    if (MK_DNSTEP < 2) return;
#pragma unroll
    for (int rr = 0; rr < 8; ++rr) {
        const int i = 8 * F.wave + rr;
        const float q0 = sQ[i * 128 + F.lane], q1 = sQ[i * 128 + 64 + F.lane], k0 = sK[i * 128 + F.lane], k1 = sK[i * 128 + 64 + F.lane];
        const float rq = (1.0f / sqrtf(wave_sum(q0 * q0 + q1 * q1) + EPS)) * 0.08838834764831845f;
        const float rk = 1.0f / sqrtf(wave_sum(k0 * k0 + k1 * k1) + EPS);
        sQ[i * 128 + F.lane] = q0 * rq; sQ[i * 128 + 64 + F.lane] = q1 * rq; sK[i * 128 + F.lane] = k0 * rk; sK[i * 128 + 64 + F.lane] = k1 * rk;
    }
    __syncthreads();
    if (MK_DNSTEP < 3) return;
    {
        const int i = F.tid >> 3, cb = (F.tid & 7) * 16;
        const float eg = expf(sGam[i]);
        f32x4 q[4], k[4];
#pragma unroll
        for (int t = 0; t < 4; ++t) { q[t] = *(LAS f32x4*)(sQ + i * 128 + cb + 4 * t); k[t] = *(LAS f32x4*)(sK + i * 128 + cb + 4 * t); }
        v4u a, bq, ck;
        a.x = pk2(q[0].x, q[0].y); a.y = pk2(q[0].z, q[0].w); a.z = pk2(q[1].x, q[1].y); a.w = pk2(q[1].z, q[1].w);
        *(LAS v4u*)(sQb + i * 136 + cb) = a;
        a.x = pk2(q[2].x, q[2].y); a.y = pk2(q[2].z, q[2].w); a.z = pk2(q[3].x, q[3].y); a.w = pk2(q[3].z, q[3].w);
        *(LAS v4u*)(sQb + i * 136 + cb + 8) = a;
        ck.x = pk2(k[0].x, k[0].y); ck.y = pk2(k[0].z, k[0].w); ck.z = pk2(k[1].x, k[1].y); ck.w = pk2(k[1].z, k[1].w);
        *(LAS v4u*)(sKb + i * 136 + cb) = ck;
        ck.x = pk2(k[2].x, k[2].y); ck.y = pk2(k[2].z, k[2].w); ck.z = pk2(k[3].x, k[3].y); ck.w = pk2(k[3].z, k[3].w);
        *(LAS v4u*)(sKb + i * 136 + cb + 8) = ck;
        bq.x = pk2(q[0].x * eg, q[0].y * eg); bq.y = pk2(q[0].z * eg, q[0].w * eg); bq.z = pk2(q[1].x * eg, q[1].y * eg); bq.w = pk2(q[1].z * eg, q[1].w * eg);
        *(v4u*)(QDo + i * 128 + cb) = bq;
        bq.x = pk2(q[2].x * eg, q[2].y * eg); bq.y = pk2(q[2].z * eg, q[2].w * eg); bq.z = pk2(q[3].x * eg, q[3].y * eg); bq.w = pk2(q[3].z * eg, q[3].w * eg);
        *(v4u*)(QDo + i * 128 + cb + 8) = bq;
    }
    {
        const int c = F.tid >> 2, jb = (F.tid & 3) * 16;
        const float gl = sGam[63];
        float kv[16];
#pragma unroll
        for (int jj = 0; jj < 16; ++jj) kv[jj] = sK[(jb + jj) * 128 + c] * expf(gl - sGam[jb + jj]);
        v4u a;
        a.x = pk2(kv[0], kv[1]); a.y = pk2(kv[2], kv[3]); a.z = pk2(kv[4], kv[5]); a.w = pk2(kv[6], kv[7]);
        *(v4u*)(KDTo + c * 64 + jb) = a;
        a.x = pk2(kv[8], kv[9]); a.y = pk2(kv[10], kv[11]); a.z = pk2(kv[12], kv[13]); a.w = pk2(kv[14], kv[15]);
        *(v4u*)(KDTo + c * 64 + jb + 8) = a;
    }
    __syncthreads();
    if (MK_DNSTEP < 4) return;
    {
        const int mat = F.wave >> 2, ti = (F.wave >> 1) & 1, tj = F.wave & 1, r = F.lane & 31, hh = F.lane >> 5;
        f32x16 acc;
#pragma unroll
        for (int e = 0; e < 16; ++e) acc[e] = 0.f;
        if (!(ti == 0 && tj == 1)) {
            const LAS bf16* Ab = (mat ? sQb : sKb) + (32 * ti + r) * 136 + 8 * hh;
            const LAS bf16* Bb = sKb + (32 * tj + r) * 136 + 8 * hh;
#pragma unroll
            for (int s = 0; s < 8; ++s) { const bf16x8 a = *(const LAS bf16x8*)(Ab + 16 * s), bb = *(const LAS bf16x8*)(Bb + 16 * s); acc = MFMA32(a, bb, acc); }
        }
        const int j = 32 * tj + r; const float gj = sGam[j];
#pragma unroll
        for (int reg = 0; reg < 16; ++reg) {
            const int i = 32 * ti + crow(reg, hh); const float gi = sGam[i];
            if (mat == 0) sA[i * 64 + j] = (j < i) ? sBeta[i] * acc[reg] * expf(gi - gj) : 0.f;
            else QKo[i * 64 + j] = (bf16)f2bf((j <= i) ? acc[reg] * expf(gi - gj) : 0.f);
        }
    }
    __syncthreads();
    if (MK_DNSTEP < 5) return;
    if (F.wave < 4) {
        const int col = F.tid & 127; const bool isw = F.wave >= 2;
        const LAS float* src = (isw ? sK : sV) + col;
        bf16* dsto = (isw ? Wo : Uo) + col;
        float sol[64];
#pragma unroll
        for (int i = 0; i < 64; ++i) {
            float rv = sBeta[i] * src[i * 128]; if (isw) rv *= expf(sGam[i]);
#pragma unroll
            for (int j = 0; j < i; ++j) rv -= sA[i * 64 + j] * sol[j];
            sol[i] = rv;
            dsto[i * 128] = (bf16)f2bf(rv);
        }
    }
    __syncthreads();
}

__device__ __forceinline__ void dn_scan(Frame& F, int l, int bh, const bf16* P, bf16* MIX) {
    const int b = bh >> 2, h = bh & 3;
    LAS bf16* St = (LAS bf16*)F.lds;
    LAS bf16* ut = (LAS bf16*)(F.lds + 34816);
    LAS float* sO = (LAS float*)(F.lds + 53248);
    for (int idx = F.tid; idx < 34816 / 4; idx += NWAVES * 64) ((LAS unsigned*)St)[idx] = 0u;
    f32x16 S0, S1;
#pragma unroll
    for (int e = 0; e < 16; ++e) { S0[e] = 0.f; S1[e] = 0.f; }
    const int r = F.lane & 31, hh = F.lane >> 5;
    const int ti = F.wave >> 2, tv = F.wave & 3;
    const int sa = F.wave >> 1, sb0 = 2 * (F.wave & 1), sb1 = sb0 + 1;
    const float ng0 = F.inp(14)[l * 128 + F.lane], ng1 = F.inp(14)[l * 128 + 64 + F.lane];
    const float* CD = (const float*)(F.ws + WS_CD);
    __syncthreads();
    for (int n = 0; n < 64; ++n) {
        const int cu = bh * 64 + n, m0 = b * SEQ + n * 64;
        const bf16* Uc = (const bf16*)(F.ws + WS_U) + (size_t)cu * 8192; const bf16* Wc = (const bf16*)(F.ws + WS_WW) + (size_t)cu * 8192;
        const bf16* QDc = (const bf16*)(F.ws + WS_QD) + (size_t)cu * 8192; const bf16* KDTc = (const bf16*)(F.ws + WS_KDT) + (size_t)cu * 8192;
        const bf16* QKc = (const bf16*)(F.ws + WS_QK) + (size_t)cu * 4096;
        const LAS bf16* Sb = St + (32 * tv + r) * 136 + 8 * hh;
        {
            f32x16 acc;
#pragma unroll
            for (int e = 0; e < 16; ++e) acc[e] = 0.f;
            const bf16* Ap = Wc + (32 * ti + r) * 128 + 8 * hh;
#pragma unroll
            for (int s = 0; s < 8; ++s) { const bf16x8 a = *(const bf16x8*)(Ap + 16 * s), bb = *(const LAS bf16x8*)(Sb + 16 * s); acc = MFMA32(a, bb, acc); }
            const int col = 32 * tv + r;
#pragma unroll
            for (int g = 0; g < 4; ++g) {
                const int i0 = 32 * ti + 8 * g + 4 * hh;
                const float u0 = bf2f(Uc[(i0 + 0) * 128 + col]) - acc[4 * g + 0], u1 = bf2f(Uc[(i0 + 1) * 128 + col]) - acc[4 * g + 1];
                const float u2 = bf2f(Uc[(i0 + 2) * 128 + col]) - acc[4 * g + 2], u3 = bf2f(Uc[(i0 + 3) * 128 + col]) - acc[4 * g + 3];
                u32x2 w; w.x = pk2(u0, u1); w.y = pk2(u2, u3);
                *(LAS u32x2*)(ut + col * 72 + i0) = w;
            }
        }
        __syncthreads();
        {
            f32x16 acc;
#pragma unroll
            for (int e = 0; e < 16; ++e) acc[e] = 0.f;
            const bf16* Ap = QDc + (32 * ti + r) * 128 + 8 * hh;
#pragma unroll
            for (int s = 0; s < 8; ++s) { const bf16x8 a = *(const bf16x8*)(Ap + 16 * s), bb = *(const LAS bf16x8*)(Sb + 16 * s); acc = MFMA32(a, bb, acc); }
            const bf16* Aq = QKc + (32 * ti + r) * 64 + 8 * hh; const LAS bf16* Ub = ut + (32 * tv + r) * 72 + 8 * hh;
#pragma unroll
            for (int s = 0; s < 4; ++s) { const bf16x8 a = *(const bf16x8*)(Aq + 16 * s), bb = *(const LAS bf16x8*)(Ub + 16 * s); acc = MFMA32(a, bb, acc); }
            const int col = 32 * tv + r;
#pragma unroll
            for (int reg = 0; reg < 16; ++reg) sO[(32 * ti + crow(reg, hh)) * 132 + col] = acc[reg];
        }
        {
            const float cd = CD[cu];
            S0 = S0 * cd; S1 = S1 * cd;
            const bf16* Ak = KDTc + (32 * sa + r) * 64 + 8 * hh;
            const LAS bf16* U0 = ut + (32 * sb0 + r) * 72 + 8 * hh; const LAS bf16* U1 = ut + (32 * sb1 + r) * 72 + 8 * hh;
#pragma unroll
            for (int s = 0; s < 4; ++s) { const bf16x8 a = *(const bf16x8*)(Ak + 16 * s); const bf16x8 b0 = *(const LAS bf16x8*)(U0 + 16 * s), b1 = *(const LAS bf16x8*)(U1 + 16 * s);
                S0 = MFMA32(a, b0, S0); S1 = MFMA32(a, b1, S1); }
        }
        __syncthreads();
#pragma unroll
        for (int g = 0; g < 4; ++g) {
            const int k0 = 32 * sa + 8 * g + 4 * hh;
            u32x2 w; w.x = pk2(S0[4 * g + 0], S0[4 * g + 1]); w.y = pk2(S0[4 * g + 2], S0[4 * g + 3]);
            *(LAS u32x2*)(St + (32 * sb0 + r) * 136 + k0) = w;
            w.x = pk2(S1[4 * g + 0], S1[4 * g + 1]); w.y = pk2(S1[4 * g + 2], S1[4 * g + 3]);
            *(LAS u32x2*)(St + (32 * sb1 + r) * 136 + k0) = w;
        }
#pragma unroll
        for (int rr = 0; rr < 8; ++rr) {
            const int i = 8 * F.wave + rr;
            const float v0 = sO[i * 132 + F.lane], v1 = sO[i * 132 + 64 + F.lane];
            const float rs = 1.0f / sqrtf(wave_sum(v0 * v0 + v1 * v1) * (1.0f / 128.0f) + EPS);
            const bf16* gp = P + (size_t)(m0 + i) * NP + 2560 + h * 128;
            const float g0 = bf2f(gp[F.lane]), g1 = bf2f(gp[64 + F.lane]);
            bf16* op = MIX + (size_t)(m0 + i) * D + 512 + h * 128;
            op[F.lane] = (bf16)f2bf(v0 * rs * ng0 * (g0 * sigmoidf_(g0)));
            op[64 + F.lane] = (bf16)f2bf(v1 * rs * ng1 * (g1 * sigmoidf_(g1)));
        }
        __syncthreads();
    }
}

struct Args { const float* in[21]; float* out; unsigned char* ws; int ph_lo, ph_hi; };
constexpr int N_PHASES = 1 + 8 * DEPTH;

__global__ void __launch_bounds__(NWAVES * 64, 2) mk_fwd(Args args) {
    extern __shared__ __attribute__((aligned(16))) unsigned char lds[];
    {
        volatile LAS unsigned* MISC0 = (volatile LAS unsigned*)((LAS unsigned char*)lds + MISC_OFF);
        if (threadIdx.x < 32) MISC0[threadIdx.x] = 0u;
    }
    __syncthreads();
    const int lo = args.ph_lo, hi = args.ph_hi;
    XcdBarrier bar; bar.bar = (unsigned*)(args.ws + WS_CTL) + CW_BAR; bar.x = 0; bar.st = nullptr;
    if (hi - lo > 1) bar = xcd_barrier_post((unsigned*)(args.ws + WS_CTL) + CW_BAR, (volatile LAS unsigned*)((LAS unsigned char*)lds + MISC_OFF) + 8);

    for (int ph = lo; ph < hi; ++ph) {
        int tid = threadIdx.x; asm volatile("" : "+v"(tid));
        Frame F;
        F.kp = (const AS4 unsigned char*)__builtin_amdgcn_kernarg_segment_ptr(); asm volatile("" : "+s"(F.kp));
        F.lds = (LAS unsigned char*)lds;
        F.tid = tid; F.lane = tid & 63; F.wave = __builtin_amdgcn_readfirstlane(tid >> 6);
        F.G = gridDim.x; { const int bx = blockIdx.x; F.vcu = (F.G % 8 == 0) ? (bx % 8) * (F.G / 8) + bx / 8 : bx; }
        F.out = *(float* const AS4*)(F.kp + 168); F.ws = *(unsigned char* const AS4*)(F.kp + 176);
        bf16* HN = (bf16*)(F.ws + WS_HN); bf16* MIX = HN; bf16* P = (bf16*)(F.ws + WS_P); bf16* HFF = P;
        float* BA = (float*)(F.ws + WS_BA);
        if (ph == 0) {
            weights_phase(F);
            norm_phase<0>(F, F.inp(0), F.inp(1), HN, F.inp(2), BA, nullptr);
        } else {
#ifdef MK_ONLY_K
            const int l = (ph - 1) >> 3, k = MK_ONLY_K;
#else
            const int l = (ph - 1) >> 3, k = (ph - 1) & 7;
#endif
            const unsigned char* wb = F.ws + WS_W + (size_t)l * W_LAYER;
            if (k == 0) {
                pg8::Gemm g{(const pg8::bf16_t*)HN, (const pg8::bf16_t*)(wb + W_IN_OFF), M, NP, D}; pg8::StaticOrder S; S.init(M, NP, F.G, (int)blockIdx.x);
                pg8::EpiBf16<0> E{(pg8::bf16_t*)P, NP, nullptr, 0, 0, 1.f};
                pg8::gemm_phase<pg8::EpiBf16<0>, pg8::StaticOrder, true, true>(F.lds, g, S, E, tid);
            } else if (k == 1) {
                if (MK_SUB & 1) for (int u = blockIdx.x; u < NCHUNK; u += F.G) dn_chunk_unit(F, l, u, P, BA);
                if (MK_SUB & 2) for (int u = blockIdx.x; u < M / 128; u += F.G) gmlp_unit(F, l, u, P, MIX);
                if (MK_SUB & 4) for (int u = blockIdx.x; u < M / 64; u += F.G) conv_unit(F, l, u, P, MIX);
            } else if (k == 2) {
                for (int u = blockIdx.x; u < BATCH * 4; u += F.G) dn_scan(F, l, u, P, MIX);
            } else if (k == 3 || k == 6) {
                const float* base = (l == 0 && k == 3) ? F.inp(0) : F.out;
                pg8::Gemm g{(const pg8::bf16_t*)(k == 3 ? MIX : HFF), (const pg8::bf16_t*)(wb + (k == 3 ? W_O_OFF : W_D_OFF)), M, D, k == 3 ? D : DFF}; pg8::StaticOrder S; S.init(M, D, F.G, (int)blockIdx.x);
                pg8::EpiRes E{base, F.out, D};
                pg8::gemm_phase<pg8::EpiRes, pg8::StaticOrder, true, true>(F.lds, g, S, E, tid);
            } else if (k == 4) {
                norm_phase<0>(F, F.out, F.inp(16) + l * D, HN, nullptr, nullptr, nullptr);
            } else if (k == 5) {
                pg8::Gemm g{(const pg8::bf16_t*)HN, (const pg8::bf16_t*)(wb + W_GU_OFF), M, 2 * DFF, D}; pg8::StaticOrder S; S.init(M, 2 * DFF, F.G, (int)blockIdx.x);
                pg8::EpiSwiGLU E{(pg8::bf16_t*)HFF, DFF};
                pg8::gemm_phase<pg8::EpiSwiGLU, pg8::StaticOrder, true, true>(F.lds, g, S, E, tid);
            } else {
                if (l + 1 < DEPTH) norm_phase<0>(F, F.out, F.inp(1) + (l + 1) * D, HN, F.inp(2) + (size_t)(l + 1) * D * DPROJ, BA, nullptr);
                else norm_phase<1>(F, F.out, F.inp(20), nullptr, nullptr, nullptr, F.out);
            }
        }
        if (ph + 1 < hi) xcd_barrier(bar);
    }
}

#ifndef MK_SINGLE
#define MK_SINGLE 0
#endif

extern "C" void kernel_launch(void* const* d_in, const int* in_sizes, int n_in, void* d_out, int out_size, void* d_ws, size_t ws_size, hipStream_t stream) {
    static int grid = 0;
    if (grid == 0) {
        if (n_in != 21 || in_sizes[0] != M * D || out_size != M * D || ws_size < WS_END) { fprintf(stderr, "kernel_launch: unexpected shapes (n_in %d, in0 %d, out %d, ws %zu)\n", n_in, n_in > 0 ? in_sizes[0] : -1, out_size, ws_size); grid = -1; return; }
        int dev = 0, cus = 0, per_cu = 0;
        if (hipGetDevice(&dev) != hipSuccess || hipDeviceGetAttribute(&cus, hipDeviceAttributeMultiprocessorCount, dev) != hipSuccess) { grid = -1; return; }
        if (hipFuncSetAttribute((const void*)mk_fwd, hipFuncAttributeMaxDynamicSharedMemorySize, LDS_BYTES) != hipSuccess) { fprintf(stderr, "kernel_launch: hipFuncSetAttribute failed\n"); grid = -1; return; }
        if (hipOccupancyMaxActiveBlocksPerMultiprocessor(&per_cu, (const void*)mk_fwd, NWAVES * 64, LDS_BYTES) != hipSuccess || per_cu < 1) { fprintf(stderr, "kernel_launch: occupancy query says %d blocks per CU\n", per_cu); per_cu = 1; }
        (void)hipGetLastError();
        grid = cus;
        if (grid % 8 != 0 || grid < 32) fprintf(stderr, "kernel_launch: unexpected CU count %d\n", grid);
    }
    if (grid < 0) return;
    (void)hipMemsetAsync((char*)d_ws + WS_CTL, 0, CTL_ZERO_BYTES, stream);
    Args a{};
    for (int i = 0; i < 21; ++i) a.in[i] = (const float*)d_in[i];
    a.out = (float*)d_out; a.ws = (unsigned char*)d_ws;
#if MK_SINGLE
    a.ph_lo = 0; a.ph_hi = N_PHASES;
    hipLaunchKernelGGL(mk_fwd, dim3(grid), dim3(NWAVES * 64), LDS_BYTES, stream, a);
#else
    for (int ph = 0; ph < MK_PH_HI; ++ph) { a.ph_lo = ph; a.ph_hi = ph + 1; hipLaunchKernelGGL(mk_fwd, dim3(grid), dim3(NWAVES * 64), LDS_BYTES, stream, a); }
#endif
}
```

```cpp
#include <hip/hip_runtime.h>
#include <cstdio>
#include <cstdint>
#include <cmath>
#define MK_SINGLE 1
#define MK_REP 4
namespace pg8 {
#define PG8_LAS __attribute__((address_space(3)))
typedef unsigned short bf16_t;
typedef short bf16x8 __attribute__((ext_vector_type(8)));
typedef float f32x4 __attribute__((ext_vector_type(4)));
typedef unsigned u32x4 __attribute__((ext_vector_type(4)));
constexpr int BM = 256, BK = 64, HALF = 128, HTB = HALF * BK * 2  , STAGE_BYTES = 8 * HTB, NXCD = 8, WGM = 8;

__host__ __device__ __forceinline__ int lds_byte(int r, int c) { const int st = (r >> 4) * 2 + (c >> 5), rr = r & 15, cc = c & 31, ob = rr * 64 + cc * 2; return st * 1024 + (ob ^ (((ob >> 9) & 1) << 5)); }
__host__ __device__ __forceinline__ void stage_rc(int b, int& R, int& C) { const int st = b / 1024, sb = b % 1024, swz = sb ^ (((sb >> 9) & 1) << 5); R = (st >> 1) * 16 + swz / 64; C = (st & 1) * 32 + (swz % 64) / 2; }
__host__ __device__ __forceinline__ int perm32(int rho) { const int n = rho >> 4, i = rho & 15; return 8 * (i >> 2) + 4 * n + (i & 3); }

struct Unit { int pm, pn; };
struct Gemm { const bf16_t* A; const bf16_t* Bt; int M, N, K; };

struct StaticOrder {
    int nM, nN, nwg, G, c;
    __host__ __device__ void init(int M, int N, int G_, int c_) { nM = M / BM; nN = N / BM; nwg = nM * nN; G = G_; c = c_; }
    __host__ __device__ bool next(int i, Unit& u) const {
        const long L = (long)i * G + c; if (L >= nwg) return false;
        int wgid = (int)L; { const int q = nwg / NXCD, r = nwg % NXCD, xcd = wgid % NXCD, off = wgid / NXCD; wgid = (xcd < r ? xcd * (q + 1) : r * (q + 1) + (xcd - r) * q) + off; }
        const int nig = WGM * nN, gid = wgid / nig, fm = gid * WGM, gsz = (nM - fm) < WGM ? (nM - fm) : WGM;
        u.pm = fm + ((wgid % nig) % gsz); u.pn = (wgid % nig) / gsz; return true;
    }
    __device__ __forceinline__ void a_ready(const Unit&) const {}
    __device__ __forceinline__ void done(const Unit&) const {}
};

__device__ __forceinline__ unsigned cvt_pk_bf16(float lo, float hi) { unsigned r; asm volatile("v_cvt_pk_bf16_f32 %0, %1, %2" : "=v"(r) : "v"(lo), "v"(hi)); return r; }
typedef float f32x2 __attribute__((ext_vector_type(2)));
__device__ __forceinline__ f32x2 gelu_pk(f32x2 v) {
    const f32x2 av = __builtin_elementwise_abs(v), d = av * 0.2316418882f + 1.0f;
    f32x2 t; t.x = __builtin_amdgcn_rcpf(d.x); t.y = __builtin_amdgcn_rcpf(d.y);
    f32x2 q = t * 0.5307027145f + (-0.7265760135f); q = q * t + 0.7107068705f; q = q * t + (-0.142248368f); q = q * t + 0.127414796f; q = q * t;
    const f32x2 s = (v * v) * (-0.72134752044f);
    f32x2 e; e.x = __builtin_amdgcn_exp2f(s.x); e.y = __builtin_amdgcn_exp2f(s.y);
    const f32x2 m = v * (q * e), r = v - m;
    f32x2 o; o.x = v.x < 0.f ? m.x : r.x; o.y = v.y < 0.f ? m.y : r.y; return o;
}

template <int ACT  > struct EpiBf16 {
    static constexpr bool PERM = true, AFTER_DRAIN = false; static_assert(ACT == 0 || ACT == 1, "EpiBf16: ACT is 0 (none) or 1 (gelu_pk)");
    bf16_t* O; int ldc; const float* bias; int split_cols; size_t split_stride; float scale0;
    __device__ __forceinline__ void operator()(const f32x4 (&acc)[2][2][4][2], const Unit& u, int wr, int wc, int fr, int fq) const {
        const int row0 = u.pm * BM + wr * 64 + fr; int colt = u.pn * BM; bf16_t* base = O;
        float sc = 1.f; if (split_cols) { const int t = colt / split_cols; base += (size_t)t * split_stride; colt -= t * split_cols; if (t == 0) sc = scale0; }
        const int col0 = colt + wc * 32 + 8 * fq, bcol0 = u.pn * BM + wc * 32 + 8 * fq;
        f32x4 bv[2][2];
#pragma unroll
        for (int bj = 0; bj < 2; ++bj)
#pragma unroll
            for (int n = 0; n < 2; ++n) bv[bj][n] = bias ? *(const f32x4*)(bias + bcol0 + bj * HALF + 4 * n) : (f32x4){0.f, 0.f, 0.f, 0.f};
#pragma unroll
        for (int ai = 0; ai < 2; ++ai)
#pragma unroll
            for (int m = 0; m < 4; ++m) { bf16_t* rowp = base + (size_t)(row0 + ai * HALF + m * 16) * ldc + col0;
#pragma unroll
                for (int bj = 0; bj < 2; ++bj) { f32x4 v0 = acc[ai][bj][m][0] + bv[bj][0], v1 = acc[ai][bj][m][1] + bv[bj][1];
                    if (ACT == 1) { f32x2 a = gelu_pk((f32x2){v0[0], v0[1]}), b = gelu_pk((f32x2){v0[2], v0[3]}), c = gelu_pk((f32x2){v1[0], v1[1]}), d = gelu_pk((f32x2){v1[2], v1[3]});
                        v0 = (f32x4){a.x, a.y, b.x, b.y}; v1 = (f32x4){c.x, c.y, d.x, d.y}; }
                    v0 = v0 * sc; v1 = v1 * sc; u32x4 w; w.x = cvt_pk_bf16(v0[0], v0[1]); w.y = cvt_pk_bf16(v0[2], v0[3]); w.z = cvt_pk_bf16(v1[0], v1[1]); w.w = cvt_pk_bf16(v1[2], v1[3]);
                    *(u32x4*)(rowp + bj * HALF) = w; } }
    }
};
struct EpiRes {
    static constexpr bool PERM = false, AFTER_DRAIN = false;
    const float* base; float* out; int ldc;
    __device__ __forceinline__ void operator()(const f32x4 (&acc)[2][2][4][2], const Unit& u, int wr, int wc, int fr, int fq) const {
        const int row0 = u.pm * BM + wr * 64 + fr, col0 = u.pn * BM + wc * 32 + 4 * fq;
#pragma unroll
        for (int ai = 0; ai < 2; ++ai)
#pragma unroll
            for (int m = 0; m < 4; ++m) { const size_t off = (size_t)(row0 + ai * HALF + m * 16) * ldc + col0;
#pragma unroll
                for (int bj = 0; bj < 2; ++bj)
#pragma unroll
                    for (int n = 0; n < 2; ++n) { const f32x4 bs = *(const f32x4*)(base + off + bj * HALF + n * 16); *(f32x4*)(out + off + bj * HALF + n * 16) = bs + acc[ai][bj][m][n]; } }
    }
};
struct EpiSwiGLU {
    static constexpr bool PERM = true, AFTER_DRAIN = false;
    bf16_t* O; int ldo;
    __device__ __forceinline__ void operator()(const f32x4 (&acc)[2][2][4][2], const Unit& u, int wr, int wc, int fr, int fq) const {
        const int row0 = u.pm * BM + wr * 64 + fr, col0 = u.pn * HALF + wc * 32 + 8 * fq;
#pragma unroll
        for (int ai = 0; ai < 2; ++ai)
#pragma unroll
            for (int m = 0; m < 4; ++m) { bf16_t* rowp = O + (size_t)(row0 + ai * HALF + m * 16) * ldo + col0;
                float r[8];
#pragma unroll
                for (int n = 0; n < 2; ++n)
#pragma unroll
                    for (int e = 0; e < 4; ++e) { const float g = acc[ai][0][m][n][e], up = acc[ai][1][m][n][e]; r[4 * n + e] = g * __builtin_amdgcn_rcpf(1.0f + __expf(-g)) * up; }
                u32x4 w; w.x = cvt_pk_bf16(r[0], r[1]); w.y = cvt_pk_bf16(r[2], r[3]); w.z = cvt_pk_bf16(r[4], r[5]); w.w = cvt_pk_bf16(r[6], r[7]);
                *(u32x4*)rowp = w; }
    }
};
template <class Epi, class Sched, bool ALIGN_EPI = false, bool SP2 = false>
__device__ __forceinline__ void gemm_phase(PG8_LAS unsigned char* lds, const Gemm g, const Sched& S, const Epi& E, const int tid) {
    const int wid = __builtin_amdgcn_readfirstlane(tid >> 6), lane = tid & 63, wr = wid >> 2, wc = wid & 3, fr = lane & 15, fq = lane >> 4;
    const int K = g.K, nt = K / BK;
    unsigned voffA[2], voffB[2];
#pragma unroll
    for (int i = 0; i < 2; ++i) { int R, C; stage_rc(tid * 16 + i * 8192, R, C); const int Rb = Epi::PERM ? ((R & ~31) + perm32(R & 31)) : R;
        voffA[i] = (unsigned)(R * K + C) * 2u; voffB[i] = (unsigned)(Rb * K + C) * 2u; }
    const size_t kstep = (size_t)(BK * 2);
    const size_t hstep = (size_t)HALF * K * 2;
    const size_t tstep = 2 * hstep;
    const unsigned ldsw = (unsigned)wid * 1024u;
    const int aoff = lds_byte(wr * 64 + fr, fq * 8), boff = lds_byte(wc * 32 + fr, fq * 8);
#define PG8_SA(b, h) (((b) * 2 + (h)) * HTB)
#define PG8_SB(b, h) ((4 + (b) * 2 + (h)) * HTB)
#define PG8_STAGE(bufoff, gbase, voff) do { _Pragma("unroll") for (int _i = 0; _i < 2; ++_i) \
        __builtin_amdgcn_global_load_lds((const unsigned*)((const char*)(gbase) + (voff)[_i]), (PG8_LAS unsigned*)(lds + (bufoff) + ldsw + _i * 8192), 16, 0, 0); } while (0)
#define PG8_LDA(dst, b, h) do { _Pragma("unroll") for (int m = 0; m < 4; ++m) _Pragma("unroll") for (int k = 0; k < 2; ++k) dst[m][k] = *(const PG8_LAS bf16x8*)(lds + PG8_SA(b, h) + aoff + m * 2048 + k * 1024); } while (0)
#define PG8_LDB(dst, b, h) do { _Pragma("unroll") for (int n = 0; n < 2; ++n) _Pragma("unroll") for (int k = 0; k < 2; ++k) dst[n][k] = *(const PG8_LAS bf16x8*)(lds + PG8_SB(b, h) + boff + n * 2048 + k * 1024); } while (0)
#define PG8_MMA(ai, bj, At, Bt) do { __builtin_amdgcn_s_setprio(1); _Pragma("unroll") for (int m = 0; m < 4; ++m) _Pragma("unroll") for (int n = 0; n < 2; ++n) _Pragma("unroll") for (int k = 0; k < 2; ++k) \
        acc[ai][bj][m][n] = __builtin_amdgcn_mfma_f32_16x16x32_bf16(Bt[n][k], At[m][k], acc[ai][bj][m][n], 0, 0, 0); __builtin_amdgcn_s_setprio(0); } while (0)
#define PG8_WAIT_V(n) asm volatile("s_waitcnt vmcnt(" #n ")" ::: "memory")
#define PG8_WAIT_L(n) asm volatile("s_waitcnt lgkmcnt(" #n ")" ::: "memory")
#define PG8_BAR __builtin_amdgcn_s_barrier()
#define PG8_SCHED __builtin_amdgcn_sched_barrier(0)
    Unit cur, nxt; int ui = 0;
    if (!S.next(0, cur)) return;
    f32x4 acc[2][2][4][2];
#pragma unroll
    for (int a = 0; a < 2; ++a)
#pragma unroll
        for (int b = 0; b < 2; ++b)
#pragma unroll
            for (int m = 0; m < 4; ++m)
#pragma unroll
                for (int n = 0; n < 2; ++n) acc[a][b][m][n] = (f32x4){0.f, 0.f, 0.f, 0.f};
    bf16x8 At[4][2], B0[2][2], B1[2][2];
    const char* cA = (const char*)g.A + (size_t)cur.pm * tstep; const char* cB = (const char*)g.Bt + (size_t)cur.pn * tstep;
    S.a_ready(cur);
    if constexpr (SP2) {
        PG8_STAGE(PG8_SB(0, 0), cB, voffB); PG8_STAGE(PG8_SB(0, 1), cB + hstep, voffB); PG8_STAGE(PG8_SA(0, 0), cA, voffA); PG8_STAGE(PG8_SA(0, 1), cA + hstep, voffA);
        if (wr == 1) PG8_BAR;
        PG8_WAIT_V(2); PG8_BAR;
        PG8_STAGE(PG8_SB(1, 0), cB + kstep, voffB); PG8_STAGE(PG8_SA(1, 0), cA + kstep, voffA); PG8_STAGE(PG8_SB(1, 1), cB + hstep + kstep, voffB);
        PG8_WAIT_V(6); PG8_BAR;
    } else {
        PG8_STAGE(PG8_SB(0, 0), cB, voffB); PG8_STAGE(PG8_SA(0, 0), cA, voffA); PG8_STAGE(PG8_SB(0, 1), cB + hstep, voffB); PG8_STAGE(PG8_SA(0, 1), cA + hstep, voffA);
        if (wr == 1) PG8_BAR;
        PG8_WAIT_V(4); PG8_BAR;
        PG8_STAGE(PG8_SB(1, 0), cB + kstep, voffB); PG8_STAGE(PG8_SA(1, 0), cA + kstep, voffA); PG8_STAGE(PG8_SB(1, 1), cB + hstep + kstep, voffB);
        PG8_WAIT_V(6); PG8_BAR;
    }
    for (;;) {
        const bool has_next = S.next(ui + 1, nxt);
        const char* nA = has_next ? (const char*)g.A + (size_t)nxt.pm * tstep : cA; const char* nB = has_next ? (const char*)g.Bt + (size_t)nxt.pn * tstep : cB;
        for (int t = 0; t < nt; t += 2) {
            const bool last = (t == nt - 2);
            const char* a1 = cA + (size_t)(t + 1) * kstep;
            const char* a2 = last ? nA : cA + (size_t)(t + 2) * kstep; const char* b2 = last ? nB : cB + (size_t)(t + 2) * kstep;
            const char* a3 = a2 + kstep; const char* b3 = b2 + kstep;
            if (last && has_next) S.a_ready(nxt);
            if constexpr (SP2) {
            PG8_LDB(B0, 0, 0); PG8_LDB(B1, 0, 1); PG8_SCHED; PG8_LDA(At, 0, 0); PG8_STAGE(PG8_SA(1, 1), a1 + hstep, voffA);
            PG8_WAIT_V(8); PG8_WAIT_L(0); PG8_BAR; PG8_MMA(0, 0, At, B0); PG8_MMA(0, 1, At, B1); PG8_BAR; PG8_SCHED;
            PG8_LDA(At, 0, 1); PG8_STAGE(PG8_SB(0, 0), b2, voffB); PG8_STAGE(PG8_SB(0, 1), b2 + hstep, voffB); PG8_STAGE(PG8_SA(0, 0), a2, voffA);
            PG8_WAIT_V(8); PG8_WAIT_L(0); PG8_BAR; PG8_MMA(1, 0, At, B0); PG8_MMA(1, 1, At, B1); PG8_BAR; PG8_SCHED;
            PG8_LDB(B0, 1, 0); PG8_LDB(B1, 1, 1); PG8_SCHED; PG8_LDA(At, 1, 0); PG8_STAGE(PG8_SA(0, 1), a2 + hstep, voffA);
            PG8_WAIT_V(8); PG8_WAIT_L(0); PG8_BAR; PG8_MMA(0, 0, At, B0); PG8_MMA(0, 1, At, B1); PG8_BAR; PG8_SCHED;
            PG8_LDA(At, 1, 1); PG8_STAGE(PG8_SB(1, 0), b3, voffB); PG8_STAGE(PG8_SB(1, 1), b3 + hstep, voffB); PG8_STAGE(PG8_SA(1, 0), a3, voffA);
            PG8_WAIT_V(8); PG8_WAIT_L(0); PG8_BAR; PG8_MMA(1, 0, At, B0); PG8_MMA(1, 1, At, B1); PG8_BAR; PG8_SCHED;
            } else {
            PG8_LDB(B0, 0, 0); PG8_SCHED; PG8_LDA(At, 0, 0); PG8_STAGE(PG8_SA(1, 1), a1 + hstep, voffA);
            PG8_WAIT_L(8); PG8_BAR; PG8_WAIT_L(0); PG8_MMA(0, 0, At, B0); PG8_BAR; PG8_SCHED;
            PG8_LDB(B1, 0, 1); PG8_STAGE(PG8_SB(0, 0), b2, voffB);
            PG8_BAR; PG8_WAIT_L(0); PG8_MMA(0, 1, At, B1); PG8_BAR;
            PG8_LDA(At, 0, 1); PG8_STAGE(PG8_SA(0, 0), a2, voffA);
            PG8_BAR; PG8_WAIT_L(0); PG8_MMA(1, 0, At, B0); PG8_BAR; PG8_SCHED;
            PG8_STAGE(PG8_SB(0, 1), b2 + hstep, voffB);
            PG8_WAIT_V(6); PG8_BAR; PG8_MMA(1, 1, At, B1); PG8_BAR;
            PG8_LDB(B0, 1, 0); PG8_SCHED; PG8_LDA(At, 1, 0); PG8_STAGE(PG8_SA(0, 1), a2 + hstep, voffA);
            PG8_WAIT_L(8); PG8_BAR; PG8_WAIT_L(0); PG8_MMA(0, 0, At, B0); PG8_BAR; PG8_SCHED;
            PG8_LDB(B1, 1, 1); PG8_STAGE(PG8_SB(1, 0), b3, voffB);
            PG8_BAR; PG8_WAIT_L(0); PG8_MMA(0, 1, At, B1); PG8_BAR;
            PG8_LDA(At, 1, 1); PG8_STAGE(PG8_SA(1, 0), a3, voffA);
            PG8_BAR; PG8_WAIT_L(0); PG8_MMA(1, 0, At, B0); PG8_BAR; PG8_SCHED;
            PG8_STAGE(PG8_SB(1, 1), b3 + hstep, voffB);
            PG8_WAIT_V(6); PG8_BAR; PG8_MMA(1, 1, At, B1); PG8_BAR;
            }
        }
        if constexpr (ALIGN_EPI) { if (wr == 0) PG8_BAR; }
        if constexpr (!Epi::AFTER_DRAIN) { E(acc, cur, wr, wc, fr, fq); S.done(cur); }
        if (!has_next) break;
#pragma unroll
        for (int a = 0; a < 2; ++a)
#pragma unroll
            for (int b = 0; b < 2; ++b)
#pragma unroll
                for (int m = 0; m < 4; ++m)
#pragma unroll
                    for (int n = 0; n < 2; ++n) acc[a][b][m][n] = (f32x4){0.f, 0.f, 0.f, 0.f};
        cur = nxt; cA = nA; cB = nB; ++ui;
        if constexpr (ALIGN_EPI) { if (wr == 1) PG8_BAR; }
    }
    PG8_WAIT_V(0);
    if constexpr (!ALIGN_EPI) { if (wr == 0) PG8_BAR; }
    PG8_BAR;
    if constexpr (Epi::AFTER_DRAIN) { E.fused(acc, cur, wr, wc, fr, fq, lds, wid, lane); S.done(cur); }
#undef PG8_SA
#undef PG8_SB
#undef PG8_STAGE
#undef PG8_LDA
#undef PG8_LDB
#undef PG8_MMA
#undef PG8_WAIT_V
#undef PG8_WAIT_L
#undef PG8_BAR
#undef PG8_SCHED
}
}
#define GAS __attribute__((address_space(1)))
#define LAS __attribute__((address_space(3)))
typedef unsigned short bf16;
typedef unsigned v4u __attribute__((ext_vector_type(4)));
typedef float f32x4 __attribute__((ext_vector_type(4)));
typedef short bf16x8 __attribute__((ext_vector_type(8)));
typedef GAS unsigned gu32;
typedef GAS unsigned long long gu64;
#define RLX_AGENT __ATOMIC_RELAXED, __HIP_MEMORY_SCOPE_AGENT
#define LDS_WAIT() asm volatile("s_waitcnt lgkmcnt(0)" ::: "memory")
#define VM_WAIT() asm volatile("s_waitcnt vmcnt(0)" ::: "memory")
__device__ __forceinline__ unsigned long long rt() { return __builtin_amdgcn_s_memrealtime(); }
__device__ __forceinline__ unsigned f2bf(float f) { unsigned u = __builtin_bit_cast(unsigned, f); return (u + 0x7fffu + ((u >> 16) & 1u)) >> 16; }
typedef __bf16 bf16v2q __attribute__((ext_vector_type(2))); typedef float f32v2q __attribute__((ext_vector_type(2)));
__device__ __forceinline__ unsigned pk2(float lo, float hi) { const f32v2q v = {lo, hi}; return __builtin_bit_cast(unsigned, __builtin_convertvector(v, bf16v2q)); }

#define XB_TMO      128
#define XB_XCNT(j)  (256  + 64 * (j))
#define XB_XSUB(j)  (1280 + 64 * (j))
#define XB_XGEN(j)  (2304 + 64 * (j))
#define XB_TOP      3328
#define XB_TOPGEN   3392
#define XCD_BAR_WORDS 3456
#define XB_SPIN_CAP (1u << 18)

__device__ __forceinline__ unsigned xb_ld(unsigned* p)              { return __hip_atomic_load(p, __ATOMIC_RELAXED, __HIP_MEMORY_SCOPE_AGENT); }
__device__ __forceinline__ unsigned xb_add(unsigned* p, unsigned v) { return __hip_atomic_fetch_add(p, v, __ATOMIC_RELAXED, __HIP_MEMORY_SCOPE_AGENT); }
__device__ __forceinline__ unsigned xb_xcc_id() { return (unsigned)__builtin_amdgcn_s_getreg((3 << 11) | 20) & 0xFu; }
#define XB_SPIN(cond, bar) do { unsigned _sp = 0; while (cond) { __builtin_amdgcn_s_sleep(1); \
    if ((++_sp & 255u) == 0u) { if (xb_ld(&(bar)[XB_TMO])) break; if (_sp > XB_SPIN_CAP) { atomicAdd(&(bar)[XB_TMO], 1u); break; } } } } while (0)

struct XcdBarrier {
    unsigned* bar; unsigned x;
    volatile LAS unsigned* st;
};

__device__ __forceinline__ XcdBarrier xcd_barrier_post(unsigned* bar, volatile LAS unsigned* st) {
    XcdBarrier b; b.bar = bar; b.x = xb_xcc_id(); b.st = st;
    if (threadIdx.x == 0) (void)xb_add(&bar[XB_XCNT(b.x)], 1u);
    return b;
}
__device__ __forceinline__ void xcd_barrier_complete(unsigned* bar, unsigned x, unsigned& nloc, unsigned& nx) {
    const unsigned G = gridDim.x * gridDim.y * gridDim.z;
    unsigned sum, cnt, mine, sp = 0u;
    for (;;) {
        sum = 0u; cnt = 0u; mine = 0u;
#pragma unroll
        for (unsigned j = 0; j < 16; ++j) { const unsigned c = xb_ld(&bar[XB_XCNT(j)]); sum += c; cnt += (c > 0u) ? 1u : 0u; mine = (j == x) ? c : mine; }
        if (sum == G) break;
        __builtin_amdgcn_s_sleep(1);
        if ((++sp & 255u) == 0u) { if (xb_ld(&bar[XB_TMO])) break; if (sp > XB_SPIN_CAP) { atomicAdd(&bar[XB_TMO], 1u); break; } }
    }
    nloc = mine > 0u ? mine : 1u; nx = cnt > 0u ? cnt : 1u;
}

__device__ __forceinline__ void xcd_barrier(const XcdBarrier& b) {
    asm volatile("s_waitcnt vmcnt(0)" ::: "memory");
    __syncthreads();
    if (threadIdx.x == 0) {
        unsigned* bar = b.bar;
        __builtin_amdgcn_s_waitcnt(0);
        unsigned nloc = b.st[0], nx = b.st[1];
        if (nloc == 0u) { xcd_barrier_complete(bar, b.x, nloc, nx); b.st[0] = nloc; b.st[1] = nx; }
        const unsigned old = xb_add(&bar[XB_XSUB(b.x)], 1u);
        const unsigned gen = old / nloc;
        if (old + 1u == (gen + 1u) * nloc) {
            __builtin_amdgcn_fence(__ATOMIC_RELEASE, "agent");
            asm volatile("s_waitcnt vmcnt(0)" ::: "memory");
            const unsigned og = xb_add(&bar[XB_TOP], 1u);
            const unsigned tg = og / nx;
            if (og + 1u == (tg + 1u) * nx) xb_add(&bar[XB_TOPGEN], 1u);
            else XB_SPIN(xb_ld(&bar[XB_TOPGEN]) == tg, bar);
            __builtin_amdgcn_fence(__ATOMIC_ACQUIRE, "agent");
            xb_add(&bar[XB_XGEN(b.x)], 1u);
            asm volatile("s_waitcnt vmcnt(0)" ::: "memory");
        } else {
            XB_SPIN(xb_ld(&bar[XB_XGEN(b.x)]) == gen, bar);
            __builtin_amdgcn_fence(__ATOMIC_ACQUIRE, "agent");
            asm volatile("s_waitcnt vmcnt(0)" ::: "memory");
        }
    }
    __syncthreads();
}

#ifndef MK_PH_HI
#define MK_PH_HI 19
#endif
#ifndef MK_SUB
#define MK_SUB 7
#endif
#ifndef MK_DNSTEP
#define MK_DNSTEP 9
#endif
#ifndef MK_W6
#define MK_W6 1
#endif
#ifndef MK_CVSTEP
#define MK_CVSTEP 9
#endif
#ifndef MK_REP
#define MK_REP 0
#endif
#ifndef MK_REPSUB
#define MK_REPSUB 7
#endif
#ifndef MK_NEG
#define MK_NEG 1
#endif

constexpr int NWAVES = 8;
constexpr int D = 1024, BATCH = 8, SEQ = 4096, M = BATCH * SEQ, DEPTH = 2;
constexpr int DFF = 2816, DPROJ = 3080, NP = 3072;
constexpr int CVK = 31, DNCONV = 4;
constexpr float EPS = 1e-6f;
constexpr int NCHUNK = BATCH * 4 * 64;

constexpr size_t MiB = 1u << 20;
constexpr size_t WS_CTL = 0, CTL_ZERO_BYTES = 64 * 1024;
constexpr size_t WS_W = 2 * MiB;
constexpr size_t W_IN_OFF = 0, W_O_OFF = 6 * MiB, W_GU_OFF = 8 * MiB, W_D_OFF = 19 * MiB, W_LAYER = 25 * MiB;
constexpr size_t WS_BA = 53 * MiB;
constexpr size_t WS_CD = 54 * MiB + 512 * 1024;
constexpr size_t WS_HN = 64 * MiB;
constexpr size_t WS_P = 128 * MiB;
constexpr size_t WS_REC = 320 * MiB;
constexpr size_t REC_BYTES = 74752, REC_W = 0, REC_QD = 16384, REC_QK = 32768, REC_KDT = 40960, REC_U = 57344, REC_CD = 73728;
constexpr size_t WS_O = 468 * MiB, WS_END = 500 * MiB;
constexpr int CW_BAR = 4096;

constexpr int RING_BYTES = 131072;
constexpr int MISC_OFF = 163840 - 256;
constexpr int LDS_BYTES = 163840;

__device__ __forceinline__ float bf2f(unsigned short b) { return __uint_as_float(((unsigned)b) << 16); }
__device__ __forceinline__ float wave_sum(float v) {
#pragma unroll
    for (int o = 1; o < 64; o <<= 1) v += __shfl_xor(v, o);
    return v;
}
__device__ __forceinline__ float sigmoidf_(float x) { return 1.0f / (1.0f + __expf(-x)); }
__device__ __forceinline__ float gelu_erf(float x) { return 0.5f * x * (1.0f + erff(x * 0.70710678118654752f)); }
typedef float f32x16 __attribute__((ext_vector_type(16)));
typedef unsigned u32x2 __attribute__((ext_vector_type(2)));
#define MFMA32(a, b, c) __builtin_amdgcn_mfma_f32_32x32x16_bf16((a), (b), (c), 0, 0, 0)
__device__ __forceinline__ int crow(int reg, int hh) { return (reg & 3) + 8 * (reg >> 2) + 4 * hh; }

#define AS4 __attribute__((address_space(4)))
struct Frame {
    LAS unsigned char* lds;
    int tid, lane, wave, vcu, G;
    const AS4 unsigned char* kp;
    float* out; unsigned char* ws;
    __device__ __forceinline__ const float* inp(int k) const { return *(const float* const AS4*)(kp + 8 * k); }
};

__device__ __forceinline__ void tr_item(const float* W, int ldw, int K, bf16* WT, int kb, int nsrc0, int ndst0, LAS float* scr, int lane) {
    const int k0 = 64 * kb;
#pragma unroll 8
    for (int i = 0; i < 32; ++i) { const int kk = 2 * i + (lane >> 5); scr[kk * 33 + (lane & 31)] = W[(size_t)(k0 + kk) * ldw + nsrc0 + (lane & 31)]; }
    LDS_WAIT(); asm volatile("" ::: "memory");
    const int c = lane & 7;
#pragma unroll
    for (int j = 0; j < 4; ++j) { const int n = (lane >> 3) + 8 * j; const LAS float* s = scr + (8 * c) * 33 + n;
        v4u o; o.x = pk2(s[0 * 33], s[1 * 33]); o.y = pk2(s[2 * 33], s[3 * 33]); o.z = pk2(s[4 * 33], s[5 * 33]); o.w = pk2(s[6 * 33], s[7 * 33]);
        *(GAS v4u*)(WT + (size_t)(ndst0 + n) * K + k0 + 8 * c) = o; }
    LDS_WAIT(); asm volatile("" ::: "memory");
}
__device__ __forceinline__ void weights_phase(Frame& F) {
    LAS float* scr = (LAS float*)(F.lds + F.wave * 16384);
    const int gw = F.vcu * NWAVES + F.wave, NGW = F.G * NWAVES;
    constexpr int I_IN = 16 * 96, I_O = 16 * 32, I_GU = 16 * 176, I_D = 44 * 32, I_L = I_IN + I_O + I_GU + I_D;
    for (int it = gw; it < DEPTH * I_L; it += NGW) {
        const int l = it / I_L; int r = it % I_L;
        bf16* wb = (bf16*)(F.ws + WS_W + (size_t)l * W_LAYER);
        if (r < I_IN) { const int kb = r / 96, nb = r % 96; tr_item(F.inp(2) + (size_t)l * D * DPROJ, DPROJ, D, (bf16*)((unsigned char*)wb + W_IN_OFF), kb, 32 * nb, 32 * nb, scr, F.lane); continue; } r -= I_IN;
        if (r < I_O) { const int kb = r / 32, nb = r % 32; tr_item(F.inp(15) + (size_t)l * D * D, D, D, (bf16*)((unsigned char*)wb + W_O_OFF), kb, 32 * nb, 32 * nb, scr, F.lane); continue; } r -= I_O;
        if (r < I_GU) { const int kb = r / 176, nb = r % 176; const int drow = 32 * nb, tile = drow >> 8, within = drow & 255;
            const float* src = (within < 128 ? F.inp(17) : F.inp(18)) + (size_t)l * D * DFF;
            tr_item(src, DFF, D, (bf16*)((unsigned char*)wb + W_GU_OFF), kb, tile * 128 + (within & 127), drow, scr, F.lane); continue; } r -= I_GU;
        { const int kb = r / 32, nb = r % 32; tr_item(F.inp(19) + (size_t)l * DFF * D, D, DFF, (bf16*)((unsigned char*)wb + W_D_OFF), kb, 32 * nb, 32 * nb, scr, F.lane); }
    }
}

template <int MODE>
__device__ __forceinline__ void norm_phase(Frame& F, const float* xin, const float* g, bf16* hn, const float* wlog, float* ba, float* fout) {
    const int gw = F.vcu * NWAVES + F.wave, NGW = F.G * NWAVES;
    f32x4 gv[4];
#pragma unroll
    for (int j = 0; j < 4; ++j) gv[j] = ((const f32x4*)g)[64 * j + F.lane];
    for (int m = gw; m < M; m += NGW) {
        const f32x4* xr = (const f32x4*)(xin + (size_t)m * D) + F.lane;
        f32x4 v[4]; float ss = 0.f;
#pragma unroll
        for (int j = 0; j < 4; ++j) { v[j] = xr[64 * j]; ss += (v[j].x * v[j].x + v[j].y * v[j].y) + (v[j].z * v[j].z + v[j].w * v[j].w); }
        const float rstd = 1.0f / sqrtf(wave_sum(ss) * (1.0f / D) + EPS);
#pragma unroll
        for (int j = 0; j < 4; ++j) v[j] = v[j] * rstd * gv[j];
        if (MODE == 0) {
            unsigned long long* o8 = (unsigned long long*)(hn + (size_t)m * D) + F.lane;
#pragma unroll
            for (int j = 0; j < 4; ++j) o8[64 * j] = (unsigned long long)pk2(v[j].x, v[j].y) | ((unsigned long long)pk2(v[j].z, v[j].w) << 32);
            if (wlog) {
                float acc[8];
#pragma unroll
                for (int t = 0; t < 8; ++t) acc[t] = 0.f;
#pragma unroll
                for (int j = 0; j < 4; ++j)
#pragma unroll
                    for (int e = 0; e < 4; ++e) { const int k = 256 * j + 4 * F.lane + e; const f32x4* wr = (const f32x4*)(wlog + (size_t)k * DPROJ + NP);
                        const f32x4 w0 = wr[0], w1 = wr[1]; const float y = v[j][e];
                        acc[0] += y * w0.x; acc[1] += y * w0.y; acc[2] += y * w0.z; acc[3] += y * w0.w; acc[4] += y * w1.x; acc[5] += y * w1.y; acc[6] += y * w1.z; acc[7] += y * w1.w; }
#pragma unroll
                for (int t = 0; t < 8; ++t) acc[t] = wave_sum(acc[t]);
                if (F.lane == 0) { *(f32x4*)(ba + (size_t)m * 8) = (f32x4){acc[0], acc[1], acc[2], acc[3]}; *(f32x4*)(ba + (size_t)m * 8 + 4) = (f32x4){acc[4], acc[5], acc[6], acc[7]}; }
            }
        } else {
            f32x4* o = (f32x4*)(fout + (size_t)m * D) + F.lane;
#pragma unroll
            for (int j = 0; j < 4; ++j) o[64 * j] = v[j];
        }
    }
}

__device__ __forceinline__ void gmlp_unit(Frame& F, int l, int unit, const bf16* P, bf16* MIX) {
    const int m0 = unit * 128;
    LAS float* sV = (LAS float*)F.lds;
    const float* lng = F.inp(3) + l * 256; const float* lnb = F.inp(4) + l * 256;
    const f32x4 g4 = *(const f32x4*)(lng + 4 * F.lane), b4 = *(const f32x4*)(lnb + 4 * F.lane);
    for (int j = F.wave; j < 128; j += NWAVES) {
        const u32x2 raw = *(const u32x2*)(P + (size_t)(m0 + j) * NP + 256 + 4 * F.lane);
        f32x4 v; v.x = gelu_erf(bf2f((unsigned short)(raw.x & 0xffffu))); v.y = gelu_erf(bf2f((unsigned short)(raw.x >> 16)));
        v.z = gelu_erf(bf2f((unsigned short)(raw.y & 0xffffu))); v.w = gelu_erf(bf2f((unsigned short)(raw.y >> 16)));
        const float mean = wave_sum((v.x + v.y) + (v.z + v.w)) * (1.0f / 256.0f);
        v = v - mean;
        const float var = wave_sum((v.x * v.x + v.y * v.y) + (v.z * v.z + v.w * v.w)) * (1.0f / 256.0f);
        const float r = 1.0f / sqrtf(var + EPS);
        *(LAS f32x4*)(sV + j * 256 + 4 * F.lane) = v * r * g4 + b4;
    }
    __syncthreads();
    const int c = F.tid & 255, h = F.wave & 3, ih = F.wave >> 2;
    const float* wsh = F.inp(5) + (size_t)(l * 4 + h) * 128 * 128;
    const float* bsh = F.inp(6) + (l * 4 + h) * 128;
    for (int ib = 0; ib < 8; ++ib) {
        const int i0 = ih * 64 + ib * 8;
        float acc[8];
#pragma unroll
        for (int ii = 0; ii < 8; ++ii) acc[ii] = 0.f;
        for (int j = 0; j < i0 + 8; ++j) {
            const float vv = sV[j * 256 + c];
#pragma unroll
            for (int ii = 0; ii < 8; ++ii) { const float w = (j <= i0 + ii) ? wsh[(i0 + ii) * 128 + j] : 0.f; acc[ii] += w * vv; }
        }
#pragma unroll
        for (int ii = 0; ii < 8; ++ii) { const int i = i0 + ii; const float s = acc[ii] + bsh[i];
            const float u = gelu_erf(bf2f(P[(size_t)(m0 + i) * NP + c]));
            MIX[(size_t)(m0 + i) * D + c] = (bf16)f2bf(u * s); }
    }
    __syncthreads();
}

__device__ __forceinline__ void conv_unit(Frame& F, int l, int unit, const bf16* P, bf16* MIX) {
    const int b = unit >> 6, t0 = (unit & 63) * 64, m0 = b * SEQ + t0;
    LAS float* sY = (LAS float*)F.lds;
    for (int r = F.wave; r < 94; r += NWAVES) {
        const int t = t0 - 30 + r; f32x4 y = (f32x4){0.f, 0.f, 0.f, 0.f};
        if (t >= 0) {
            const bf16* pr = P + (size_t)(b * SEQ + t) * NP + 4 * F.lane;
            const u32x2 ra = *(const u32x2*)(pr + 512), rg = *(const u32x2*)(pr + 768);
            y.x = bf2f((unsigned short)(ra.x & 0xffffu)) * sigmoidf_(bf2f((unsigned short)(rg.x & 0xffffu)));
            y.y = bf2f((unsigned short)(ra.x >> 16)) * sigmoidf_(bf2f((unsigned short)(rg.x >> 16)));
            y.z = bf2f((unsigned short)(ra.y & 0xffffu)) * sigmoidf_(bf2f((unsigned short)(rg.y & 0xffffu)));
            y.w = bf2f((unsigned short)(ra.y >> 16)) * sigmoidf_(bf2f((unsigned short)(rg.y >> 16)));
        }
        *(LAS f32x4*)(sY + r * 256 + 4 * F.lane) = y;
    }
    __syncthreads();
    if (MK_CVSTEP < 2) return;
    const int c = F.tid & 255, hf = F.wave >> 2;
    float w[CVK];
#pragma unroll
    for (int k = 0; k < CVK; ++k) w[k] = F.inp(7)[(size_t)(l * CVK + k) * 256 + c];
    const float bias = F.inp(8)[l * 256 + c];
    float o[32];
#pragma unroll
    for (int g = 0; g < 4; ++g) {
        float y[38];
#pragma unroll
        for (int q = 0; q < 38; ++q) y[q] = sY[(hf * 32 + 8 * g + q) * 256 + c];
#pragma unroll
        for (int t8 = 0; t8 < 8; ++t8) {
            float a = bias;
#pragma unroll
            for (int k = 0; k < CVK; ++k) a += w[k] * y[t8 + k];
            o[8 * g + t8] = a;
        }
    }
    __syncthreads();
#pragma unroll
    for (int tt = 0; tt < 32; ++tt) sY[(hf * 32 + tt) * 256 + c] = o[tt];
    __syncthreads();
    if (MK_CVSTEP < 3) return;
    const f32x4 g4 = *(const f32x4*)(F.inp(9) + l * 256 + 4 * F.lane), b4 = *(const f32x4*)(F.inp(10) + l * 256 + 4 * F.lane);
    for (int i = F.wave; i < 64; i += NWAVES) {
        f32x4 v = *(LAS f32x4*)(sY + i * 256 + 4 * F.lane);
        const float mean = wave_sum((v.x + v.y) + (v.z + v.w)) * (1.0f / 256.0f);
        v = v - mean;
        const float var = wave_sum((v.x * v.x + v.y * v.y) + (v.z * v.z + v.w * v.w)) * (1.0f / 256.0f);
        const float r = 1.0f / sqrtf(var + EPS);
        v = v * r * g4 + b4;
        v.x *= sigmoidf_(v.x); v.y *= sigmoidf_(v.y); v.z *= sigmoidf_(v.z); v.w *= sigmoidf_(v.w);
        *(unsigned long long*)(MIX + (size_t)(m0 + i) * D + 256 + 4 * F.lane) = (unsigned long long)pk2(v.x, v.y) | ((unsigned long long)pk2(v.z, v.w) << 32);
    }
    __syncthreads();
}

typedef __bf16 bf16v2_t __attribute__((ext_vector_type(2)));
typedef __bf16 bf16v8_t __attribute__((ext_vector_type(8)));
typedef float f32x2_t __attribute__((ext_vector_type(2)));
typedef float f32x8_t __attribute__((ext_vector_type(8)));
__device__ __forceinline__ unsigned cpk2(float lo, float hi) { const f32x2_t v = {lo, hi}; return __builtin_bit_cast(unsigned, __builtin_convertvector(v, bf16v2_t)); }
__device__ __forceinline__ v4u cpk8(float a0, float a1, float a2, float a3, float a4, float a5, float a6, float a7) { const f32x8_t v = {a0, a1, a2, a3, a4, a5, a6, a7}; return __builtin_bit_cast(v4u, __builtin_convertvector(v, bf16v8_t)); }
__device__ __forceinline__ bf16x8 pack_step(const f32x16& x, int s) { return __builtin_bit_cast(bf16x8, cpk8(x[8 * s], x[8 * s + 1], x[8 * s + 2], x[8 * s + 3], x[8 * s + 4], x[8 * s + 5], x[8 * s + 6], x[8 * s + 7])); }

template <int I> __device__ __forceinline__ void dn_solve_rows(float (&sol)[64], const LAS float* sA, const LAS float* sBeta, const LAS float* sEg, const LAS float* src, const bool isw) {
    if constexpr (I < 64) {
        float rv = sBeta[I] * src[I * 128] * (isw ? sEg[I] : 1.0f);
        const LAS float* arow = sA + I * 64;
        if constexpr (I >= 2) asm volatile("" : "+v"(arow) : "v"(sol[I - 2]));
#pragma unroll
        for (int j = 0; j < I; ++j) rv -= arow[j] * sol[j];
        sol[I] = rv;
        dn_solve_rows<I + 1>(sol, sA, sBeta, sEg, src, isw);
    }
}

__device__ __forceinline__ void dn_chunk_unit(Frame& F, int l, int cu, const bf16* P, const float* BA) {
    const int b = cu >> 8, h = (cu >> 6) & 3, n = cu & 63, m0 = b * SEQ + n * 64;
    LAS float* sQ = (LAS float*)F.lds;
    LAS float* sK = (LAS float*)(F.lds + 32768);
    LAS float* sV = (LAS float*)(F.lds + 65536);
    LAS bf16* sQb = (LAS bf16*)(F.lds + 98304);
    LAS bf16* sKb = (LAS bf16*)(F.lds + 115712);
    LAS float* sGam = (LAS float*)(F.lds + 133120);
    LAS float* sBeta = (LAS float*)(F.lds + 133376);
    LAS float* sEg = (LAS float*)(F.lds + 133632);
    LAS float* sEd = (LAS float*)(F.lds + 133888);
    LAS float* sA = sQ;
    bf16* rec = (bf16*)(F.ws + WS_REC + (size_t)cu * REC_BYTES);
    bf16* Uo = rec + REC_U / 2; float* CD = (float*)((unsigned char*)rec + REC_CD);
    if (F.wave < 6) {
        const int sel = F.wave >> 1, c = F.tid & 127;
        const int pcol = 1024 + sel * 512 + h * 128 + c, wch = sel * 512 + h * 128 + c;
        const float* cw = F.inp(11) + (size_t)l * DNCONV * 1536 + wch;
        const float w0 = cw[0], w1 = cw[1536], w2 = cw[2 * 1536], w3 = cw[3 * 1536];
        const bf16* pc = P + (size_t)m0 * NP + pcol;
        float x0 = 0.f, x1 = 0.f, x2 = 0.f;
        if (n > 0) { x0 = bf2f(pc[-3 * NP]); x1 = bf2f(pc[-2 * NP]); x2 = bf2f(pc[-1 * NP]); }
        LAS float* dst = (sel == 0 ? sQ : (sel == 1 ? sK : sV)) + c;
#pragma unroll 8
        for (int i = 0; i < 64; ++i) {
            const float x3 = bf2f(pc[(size_t)i * NP]);
            const float y = (w0 * x0 + w1 * x1) + (w2 * x2 + w3 * x3);
            dst[i * 128] = y * sigmoidf_(y);
            x0 = x1; x1 = x2; x2 = x3;
        }
    } else if (F.wave == 6) {
        const int i = F.lane;
        const float bl = BA[(size_t)(m0 + i) * 8 + h], al = BA[(size_t)(m0 + i) * 8 + 4 + h];
        const float beta = 1.0f / (1.0f + expf(-bl));
        const float z = al + F.inp(13)[l * 4 + h];
        const float sp = fmaxf(z, 0.f) + log1pf(expf(-fabsf(z)));
        float la = -expf(F.inp(12)[l * 4 + h]) * sp;
#pragma unroll
        for (int off = 1; off < 64; off <<= 1) { const float t = __shfl_up(la, off); if (i >= off) la += t; }
        const float glast = __shfl(la, 63);
        sGam[i] = la; sBeta[i] = beta; sEg[i] = expf(la); sEd[i] = expf(glast - la);
        if (i == 63) CD[0] = expf(la);
    }
    __syncthreads();
#pragma unroll
    for (int rr = 0; rr < 8; ++rr) {
        const int i = 8 * F.wave + rr;
        const float q0 = sQ[i * 128 + F.lane], q1 = sQ[i * 128 + 64 + F.lane], k0 = sK[i * 128 + F.lane], k1 = sK[i * 128 + 64 + F.lane];
        const float rq = (1.0f / sqrtf(wave_sum(q0 * q0 + q1 * q1) + EPS)) * 0.08838834764831845f;
        const float rk = 1.0f / sqrtf(wave_sum(k0 * k0 + k1 * k1) + EPS);
        sQ[i * 128 + F.lane] = q0 * rq; sQ[i * 128 + 64 + F.lane] = q1 * rq; sK[i * 128 + F.lane] = k0 * rk; sK[i * 128 + 64 + F.lane] = k1 * rk;
    }
    __syncthreads();
    {
        const int i = F.tid >> 3, cb = (F.tid & 7) * 16;
        f32x4 q[4], k[4];
#pragma unroll
        for (int t = 0; t < 4; ++t) { q[t] = *(LAS f32x4*)(sQ + i * 128 + cb + 4 * t); k[t] = *(LAS f32x4*)(sK + i * 128 + cb + 4 * t); }
        *(LAS v4u*)(sQb + i * 136 + cb) = cpk8(q[0].x, q[0].y, q[0].z, q[0].w, q[1].x, q[1].y, q[1].z, q[1].w);
        *(LAS v4u*)(sQb + i * 136 + cb + 8) = cpk8(q[2].x, q[2].y, q[2].z, q[2].w, q[3].x, q[3].y, q[3].z, q[3].w);
        *(LAS v4u*)(sKb + i * 136 + cb) = cpk8(k[0].x, k[0].y, k[0].z, k[0].w, k[1].x, k[1].y, k[1].z, k[1].w);
        *(LAS v4u*)(sKb + i * 136 + cb + 8) = cpk8(k[2].x, k[2].y, k[2].z, k[2].w, k[3].x, k[3].y, k[3].z, k[3].w);
    }
#pragma unroll
    for (int it = 0; it < 2; ++it) {
        const int item = F.tid + 512 * it, f = item >> 6, ln = item & 63, r = ln & 31, hh = ln >> 5;
        const int rt = f >> 3, kt = (f >> 1) & 3, s = f & 1, i = 32 * rt + r, d0 = 32 * kt + 16 * s + 4 * hh;
        const float eg = sEg[i];
        const f32x4 a = *(LAS f32x4*)(sQ + i * 128 + d0), c = *(LAS f32x4*)(sQ + i * 128 + d0 + 8);
        *(v4u*)(rec + REC_QD / 2 + f * 512 + ln * 8) = cpk8(a.x * eg, a.y * eg, a.z * eg, a.w * eg, c.x * eg, c.y * eg, c.z * eg, c.w * eg);
    }
#pragma unroll
    for (int it = 0; it < 2; ++it) {
        const int item = F.tid + 512 * it, f = item >> 6, ln = item & 63, r = ln & 31, hh = ln >> 5;
        const int a = f >> 2, t = (f >> 1) & 1, s = f & 1, dk = 32 * a + r, j0 = 32 * t + 16 * s + 4 * hh;
        float kv[8];
#pragma unroll
        for (int jj = 0; jj < 8; ++jj) { const int j = j0 + 8 * (jj >> 2) + (jj & 3); kv[jj] = sK[j * 128 + dk] * sEd[j]; }
        *(v4u*)(rec + REC_KDT / 2 + f * 512 + ln * 8) = cpk8(kv[0], kv[1], kv[2], kv[3], kv[4], kv[5], kv[6], kv[7]);
    }
    __syncthreads();
    {
        const int mat = F.wave >> 2, ti = (F.wave >> 1) & 1, tj = F.wave & 1, r = F.lane & 31, hh = F.lane >> 5;
        f32x16 acc;
#pragma unroll
        for (int e = 0; e < 16; ++e) acc[e] = 0.f;
        if (!(ti == 0 && tj == 1)) {
            const LAS bf16* Ab = sKb + (32 * (mat ? tj : ti) + r) * 136 + 8 * hh;
            const LAS bf16* Bb = (mat ? sQb + (32 * ti + r) * 136 : sKb + (32 * tj + r) * 136) + 8 * hh;
#pragma unroll
            for (int s = 0; s < 8; ++s) { const bf16x8 a = *(const LAS bf16x8*)(Ab + 16 * s), bb = *(const LAS bf16x8*)(Bb + 16 * s); acc = MFMA32(a, bb, acc); }
        }
        if (mat == 0) {
            const int j = 32 * tj + r; const float gj = sGam[j];
#pragma unroll
            for (int e = 0; e < 16; ++e) { const int i = 32 * ti + crow(e, hh); sA[i * 64 + j] = (j < i) ? sBeta[i] * acc[e] * expf(sGam[i] - gj) : 0.f; }
        } else {
            const int i = 32 * ti + r; const float gi = sGam[i];
            float v[16];
#pragma unroll
            for (int e = 0; e < 16; ++e) { const int j = 32 * tj + crow(e, hh); v[e] = (j <= i) ? acc[e] * expf(gi - sGam[j]) : 0.f; }
            bf16* qk = rec + REC_QK / 2 + ((ti * 2 + tj) * 2) * 512 + F.lane * 8;
            *(v4u*)qk = cpk8(v[0], v[1], v[2], v[3], v[4], v[5], v[6], v[7]);
            *(v4u*)(qk + 512) = cpk8(v[8], v[9], v[10], v[11], v[12], v[13], v[14], v[15]);
        }
    }
    __syncthreads();
    if (F.wave < 4) {
        const int col = F.tid & 127; const bool isw = F.wave >= 2;
        const LAS float* src = (isw ? sK : sV) + col;
        float sol[64];
        dn_solve_rows<0>(sol, sA, sBeta, sEg, src, isw);
        if (!isw) {
            bf16* ub = Uo + ((col >> 5) * 2) * 1024 + (col & 31) * 8;
#pragma unroll
            for (int t = 0; t < 2; ++t)
#pragma unroll
                for (int hh = 0; hh < 2; ++hh) { bf16* p = ub + t * 1024 + hh * 256;
                    *(v4u*)p = cpk8(sol[32 * t + 4 * hh + 0], sol[32 * t + 4 * hh + 1], sol[32 * t + 4 * hh + 2], sol[32 * t + 4 * hh + 3], sol[32 * t + 4 * hh + 8], sol[32 * t + 4 * hh + 9], sol[32 * t + 4 * hh + 10], sol[32 * t + 4 * hh + 11]);
                    *(v4u*)(p + 512) = cpk8(sol[32 * t + 4 * hh + 16], sol[32 * t + 4 * hh + 17], sol[32 * t + 4 * hh + 18], sol[32 * t + 4 * hh + 19], sol[32 * t + 4 * hh + 24], sol[32 * t + 4 * hh + 25], sol[32 * t + 4 * hh + 26], sol[32 * t + 4 * hh + 27]); }
        } else {
            LAS bf16* wrow = sQb + col;
#pragma unroll
            for (int i = 0; i < 64; ++i) wrow[i * 136] = (bf16)(cpk2(sol[i], 0.f) & 0xffffu);
        }
    }
    __syncthreads();
#pragma unroll
    for (int it = 0; it < 2; ++it) {
        const int item = F.tid + 512 * it, f = item >> 6, ln = item & 63, r = ln & 31, hh = ln >> 5;
        const int rt = f >> 3, kt = (f >> 1) & 3, s = f & 1;
        const LAS bf16* wp = sQb + (32 * rt + r) * 136 + 32 * kt + 16 * s + 4 * hh;
        const u32x2 lo = *(const LAS u32x2*)wp, hi = *(const LAS u32x2*)(wp + 8);
        v4u o; o.x = lo.x; o.y = lo.y; o.z = hi.x; o.w = hi.y;
        *(v4u*)(rec + REC_W / 2 + f * 512 + ln * 8) = o;
    }
    __syncthreads();
}

#define DN_BAR() do { asm volatile("s_waitcnt lgkmcnt(0)" ::: "memory"); __builtin_amdgcn_s_barrier(); asm volatile("" ::: "memory"); } while (0)
__device__ __forceinline__ void dn_scan(Frame& F, int l, int bh) {
    LAS unsigned char* ring = F.lds;
    const unsigned char* recs = F.ws + WS_REC + (size_t)(bh * 64) * REC_BYTES;
    if (F.wave >= 4) {
        const int v = F.wave - 4;
#define DN_DMA(n_) do { const unsigned char* src_ = recs + (size_t)(n_) * REC_BYTES + v * 1024 + F.lane * 16; LAS unsigned char* dst_ = ring + ((n_) & 1) * (int)REC_BYTES + v * 1024; \
        _Pragma("unroll") for (int q_ = 0; q_ < 19; ++q_) if (v + 4 * q_ < 73) __builtin_amdgcn_global_load_lds((const unsigned*)(src_ + q_ * 4096), (LAS unsigned*)(dst_ + q_ * 4096), 16, 0, 0); } while (0)
        DN_DMA(0);
        asm volatile("s_waitcnt vmcnt(0)" ::: "memory");
        DN_BAR();
        for (int n = 0; n < 64; ++n) {
            if (n + 1 < 64) DN_DMA(n + 1);
            asm volatile("s_waitcnt vmcnt(0)" ::: "memory");
            DN_BAR();
        }
#undef DN_DMA
    } else {
        const int w = F.wave;
        f32x16 S0, S1, S2, S3;
#pragma unroll
        for (int e = 0; e < 16; ++e) { S0[e] = 0.f; S1[e] = 0.f; S2[e] = 0.f; S3[e] = 0.f; }
        bf16* Ob = (bf16*)(F.ws + WS_O) + (size_t)(bh * 64) * 8192 + (w * 2) * 1024 + F.lane * 8;
        DN_BAR();
        for (int n = 0; n < 64; ++n) {
            const LAS unsigned char* buf = ring + (n & 1) * (int)REC_BYTES + F.lane * 16;
            const float cd = *(const LAS float*)(ring + (n & 1) * (int)REC_BYTES + REC_CD);
#define DN_A(off_, f_) (*(const LAS bf16x8*)(buf + (off_) + (f_) * 1024))
            f32x16 W0, W1, Q0, Q1;
#pragma unroll
            for (int e = 0; e < 16; ++e) { W0[e] = 0.f; W1[e] = 0.f; Q0[e] = 0.f; Q1[e] = 0.f; }
#define DN_KSTEP(Sa_, a_, s_) do { const bf16x8 sb_ = pack_step(Sa_, s_); \
                W0 = MFMA32(DN_A(REC_W, (0 * 4 + (a_)) * 2 + (s_)), sb_, W0); W1 = MFMA32(DN_A(REC_W, (1 * 4 + (a_)) * 2 + (s_)), sb_, W1); \
                Q0 = MFMA32(DN_A(REC_QD, (0 * 4 + (a_)) * 2 + (s_)), sb_, Q0); Q1 = MFMA32(DN_A(REC_QD, (1 * 4 + (a_)) * 2 + (s_)), sb_, Q1); } while (0)
            DN_KSTEP(S0, 0, 0); DN_KSTEP(S0, 0, 1); DN_KSTEP(S1, 1, 0); DN_KSTEP(S1, 1, 1); DN_KSTEP(S2, 2, 0); DN_KSTEP(S2, 2, 1); DN_KSTEP(S3, 3, 0); DN_KSTEP(S3, 3, 1);
#undef DN_KSTEP
            {
                const v4u u00 = *(const LAS v4u*)(buf + REC_U + (w * 2 + 0) * 2048), u01 = *(const LAS v4u*)(buf + REC_U + (w * 2 + 0) * 2048 + 1024);
                const v4u u10 = *(const LAS v4u*)(buf + REC_U + (w * 2 + 1) * 2048), u11 = *(const LAS v4u*)(buf + REC_U + (w * 2 + 1) * 2048 + 1024);
                const unsigned uu0[8] = {u00.x, u00.y, u00.z, u00.w, u01.x, u01.y, u01.z, u01.w}, uu1[8] = {u10.x, u10.y, u10.z, u10.w, u11.x, u11.y, u11.z, u11.w};
#pragma unroll
                for (int e = 0; e < 16; ++e) { const unsigned a0 = uu0[e >> 1], a1 = uu1[e >> 1];
                    W0[e] = ((e & 1) ? __uint_as_float(a0 & 0xffff0000u) : __uint_as_float(a0 << 16)) - W0[e];
                    W1[e] = ((e & 1) ? __uint_as_float(a1 & 0xffff0000u) : __uint_as_float(a1 << 16)) - W1[e]; }
            }
            const bf16x8 ub00 = pack_step(W0, 0), ub01 = pack_step(W0, 1), ub10 = pack_step(W1, 0), ub11 = pack_step(W1, 1);
            Q0 = MFMA32(DN_A(REC_QK, (0 * 2 + 0) * 2 + 0), ub00, Q0); Q0 = MFMA32(DN_A(REC_QK, (0 * 2 + 0) * 2 + 1), ub01, Q0); Q0 = MFMA32(DN_A(REC_QK, (0 * 2 + 1) * 2 + 0), ub10, Q0); Q0 = MFMA32(DN_A(REC_QK, (0 * 2 + 1) * 2 + 1), ub11, Q0);
            Q1 = MFMA32(DN_A(REC_QK, (1 * 2 + 0) * 2 + 0), ub00, Q1); Q1 = MFMA32(DN_A(REC_QK, (1 * 2 + 0) * 2 + 1), ub01, Q1); Q1 = MFMA32(DN_A(REC_QK, (1 * 2 + 1) * 2 + 0), ub10, Q1); Q1 = MFMA32(DN_A(REC_QK, (1 * 2 + 1) * 2 + 1), ub11, Q1);
            S0 = S0 * cd; S1 = S1 * cd; S2 = S2 * cd; S3 = S3 * cd;
#define DN_SUPD(Sa_, a_) do { Sa_ = MFMA32(DN_A(REC_KDT, ((a_) * 2 + 0) * 2 + 0), ub00, Sa_); Sa_ = MFMA32(DN_A(REC_KDT, ((a_) * 2 + 0) * 2 + 1), ub01, Sa_); \
                Sa_ = MFMA32(DN_A(REC_KDT, ((a_) * 2 + 1) * 2 + 0), ub10, Sa_); Sa_ = MFMA32(DN_A(REC_KDT, ((a_) * 2 + 1) * 2 + 1), ub11, Sa_); } while (0)
            DN_SUPD(S0, 0); DN_SUPD(S1, 1); DN_SUPD(S2, 2); DN_SUPD(S3, 3);
#undef DN_SUPD
#undef DN_A
            bf16* op = Ob + (size_t)n * 8192;
            *(v4u*)op = cpk8(Q0[0], Q0[1], Q0[2], Q0[3], Q0[4], Q0[5], Q0[6], Q0[7]); *(v4u*)(op + 512) = cpk8(Q0[8], Q0[9], Q0[10], Q0[11], Q0[12], Q0[13], Q0[14], Q0[15]);
            *(v4u*)(op + 1024) = cpk8(Q1[0], Q1[1], Q1[2], Q1[3], Q1[4], Q1[5], Q1[6], Q1[7]); *(v4u*)(op + 1536) = cpk8(Q1[8], Q1[9], Q1[10], Q1[11], Q1[12], Q1[13], Q1[14], Q1[15]);
            DN_BAR();
        }
    }
}
#undef DN_BAR

__device__ __forceinline__ void dn_finish_unit(Frame& F, int l, int cu, const bf16* P, bf16* MIX) {
    const int b = cu >> 8, h = (cu >> 6) & 3, n = cu & 63, m0 = b * SEQ + n * 64;
    LAS float* sO = (LAS float*)F.lds;
    {
        const int wt = F.wave, w = wt >> 1, t = wt & 1, r = F.lane & 31, hh = F.lane >> 5;
        const bf16* ip = (const bf16*)(F.ws + WS_O) + (size_t)cu * 8192 + wt * 1024 + F.lane * 8;
        const v4u a = *(const v4u*)ip, c = *(const v4u*)(ip + 512);
        const unsigned uu[8] = {a.x, a.y, a.z, a.w, c.x, c.y, c.z, c.w};
#pragma unroll
        for (int e = 0; e < 16; ++e) { const unsigned x = uu[e >> 1]; sO[(32 * t + crow(e, hh)) * 132 + 32 * w + r] = (e & 1) ? __uint_as_float(x & 0xffff0000u) : __uint_as_float(x << 16); }
    }
    __syncthreads();
    const float ng0 = F.inp(14)[l * 128 + 2 * F.lane], ng1 = F.inp(14)[l * 128 + 2 * F.lane + 1];
#pragma unroll
    for (int rr = 0; rr < 8; ++rr) {
        const int i = 8 * F.wave + rr;
        const f32x2_t o = *(const LAS f32x2_t*)(sO + i * 132 + 2 * F.lane);
        const unsigned g = *((const unsigned*)(P + (size_t)(m0 + i) * NP + 2560 + h * 128) + F.lane);
        const float rs = 1.0f / sqrtf(wave_sum(o.x * o.x + o.y * o.y) * (1.0f / 128.0f) + EPS);
        const float g0 = __uint_as_float(g << 16), g1 = __uint_as_float(g & 0xffff0000u);
        *((unsigned*)(MIX + (size_t)(m0 + i) * D + 512 + h * 128) + F.lane) = cpk2(o.x * rs * ng0 * (g0 * sigmoidf_(g0)), o.y * rs * ng1 * (g1 * sigmoidf_(g1)));
    }
    __syncthreads();
}
struct Args { const float* in[21]; float* out; unsigned char* ws; int ph_lo, ph_hi; };
constexpr int PH_PER_LAYER = 9, N_PHASES = 1 + PH_PER_LAYER * DEPTH;

#define RELAUNDER(Fx) do { asm volatile("" : "+v"((Fx).tid)); (Fx).lane = (Fx).tid & 63; (Fx).wave = __builtin_amdgcn_readfirstlane((Fx).tid >> 6); } while (0)
__global__ void __launch_bounds__(NWAVES * 64, 2) mk_fwd(Args args) {
    extern __shared__ __attribute__((aligned(16))) unsigned char lds[];
    {
        volatile LAS unsigned* MISC0 = (volatile LAS unsigned*)((LAS unsigned char*)lds + MISC_OFF);
        if (threadIdx.x < 32) MISC0[threadIdx.x] = 0u;
    }
    __syncthreads();
    const int lo = args.ph_lo, hi = args.ph_hi;
    XcdBarrier bar; bar.bar = (unsigned*)(args.ws + WS_CTL) + CW_BAR; bar.x = 0; bar.st = nullptr;
    if (hi - lo > 1) bar = xcd_barrier_post((unsigned*)(args.ws + WS_CTL) + CW_BAR, (volatile LAS unsigned*)((LAS unsigned char*)lds + MISC_OFF) + 8);

    for (int ph = lo; ph < hi; ++ph) {
      for (int rep = 0; rep < 2; ++rep) {
        if (rep == 1 && !(ph > 0 && ((MK_REP >> ((ph - 1) % PH_PER_LAYER)) & 1))) break;
        int tid = threadIdx.x; asm volatile("" : "+v"(tid));
        Frame F;
        F.kp = (const AS4 unsigned char*)__builtin_amdgcn_kernarg_segment_ptr(); asm volatile("" : "+s"(F.kp));
        F.lds = (LAS unsigned char*)lds;
        F.tid = tid; F.lane = tid & 63; F.wave = __builtin_amdgcn_readfirstlane(tid >> 6);
        F.G = gridDim.x; { const int bx = blockIdx.x; F.vcu = (F.G % 8 == 0) ? (bx % 8) * (F.G / 8) + bx / 8 : bx; }
        F.out = *(float* const AS4*)(F.kp + 168); F.ws = *(unsigned char* const AS4*)(F.kp + 176);
        bf16* HN = (bf16*)(F.ws + WS_HN); bf16* MIX = HN; bf16* P = (bf16*)(F.ws + WS_P); bf16* HFF = P;
        float* BA = (float*)(F.ws + WS_BA);
        if (ph == 0) {
            weights_phase(F);
            norm_phase<0>(F, F.inp(0), F.inp(1), HN, F.inp(2), BA, nullptr);
        } else {
#ifdef MK_ONLY_K
            const int l = (ph - 1) / PH_PER_LAYER, k = MK_ONLY_K;
#else
            const int l = (ph - 1) / PH_PER_LAYER, k = (ph - 1) % PH_PER_LAYER;
#endif
            const unsigned char* wb = F.ws + WS_W + (size_t)l * W_LAYER;
            if (k == 0) {
                pg8::Gemm g{(const pg8::bf16_t*)HN, (const pg8::bf16_t*)(wb + W_IN_OFF), M, NP, D}; pg8::StaticOrder S; S.init(M, NP, F.G, (int)blockIdx.x);
                pg8::EpiBf16<0> E{(pg8::bf16_t*)P, NP, nullptr, 0, 0, 1.f};
                pg8::gemm_phase<pg8::EpiBf16<0>, pg8::StaticOrder, true, true>(F.lds, g, S, E, tid);
            } else if (k == 1) {
                const int sub = rep ? MK_REPSUB : MK_SUB;
                if (sub & 1) for (int u = blockIdx.x; u < NCHUNK; u += F.G) { Frame Fu = F; RELAUNDER(Fu); dn_chunk_unit(Fu, l, u, P, BA); }
                if (sub & 2) for (int u = blockIdx.x; u < M / 128; u += F.G) { Frame Fu = F; RELAUNDER(Fu); gmlp_unit(Fu, l, u, P, MIX); }
                if (sub & 4) for (int u = blockIdx.x; u < M / 64; u += F.G) { Frame Fu = F; RELAUNDER(Fu); conv_unit(Fu, l, u, P, MIX); }
            } else if (k == 2) {
                for (int u = blockIdx.x; u < BATCH * 4; u += F.G) dn_scan(F, l, u);
            } else if (k == 3) {
                for (int u = blockIdx.x; u < NCHUNK; u += F.G) { Frame Fu = F; RELAUNDER(Fu); dn_finish_unit(Fu, l, u, P, MIX); }
            } else if (k == 4 || k == 7) {
                const float* base = (l == 0 && k == 4) ? F.inp(0) : F.out;
                pg8::Gemm g{(const pg8::bf16_t*)(k == 4 ? MIX : HFF), (const pg8::bf16_t*)(wb + (k == 4 ? W_O_OFF : W_D_OFF)), M, D, k == 4 ? D : DFF}; pg8::StaticOrder S; S.init(M, D, F.G, (int)blockIdx.x);
                pg8::EpiRes E{base, rep ? (float*)(F.ws + WS_REC) : F.out, D};
                pg8::gemm_phase<pg8::EpiRes, pg8::StaticOrder, true, true>(F.lds, g, S, E, tid);
            } else if (k == 5) {
                norm_phase<0>(F, F.out, F.inp(16) + l * D, HN, nullptr, nullptr, nullptr);
            } else if (k == 6) {
                pg8::Gemm g{(const pg8::bf16_t*)HN, (const pg8::bf16_t*)(wb + W_GU_OFF), M, 2 * DFF, D}; pg8::StaticOrder S; S.init(M, 2 * DFF, F.G, (int)blockIdx.x);
                pg8::EpiSwiGLU E{(pg8::bf16_t*)HFF, DFF};
                pg8::gemm_phase<pg8::EpiSwiGLU, pg8::StaticOrder, true, true>(F.lds, g, S, E, tid);
            } else {
                if (l + 1 < DEPTH) norm_phase<0>(F, F.out, F.inp(1) + (l + 1) * D, HN, F.inp(2) + (size_t)(l + 1) * D * DPROJ, BA, nullptr);
                else norm_phase<1>(F, F.out, F.inp(20), nullptr, nullptr, nullptr, F.out);
            }
        }
      }
        if (ph + 1 < hi) xcd_barrier(bar);
    }
}

#ifndef MK_SINGLE
#define MK_SINGLE 0
#endif

extern "C" void kernel_launch(void* const* d_in, const int* in_sizes, int n_in, void* d_out, int out_size, void* d_ws, size_t ws_size, hipStream_t stream) {
    static int grid = 0;
    if (grid == 0) {
        if (n_in != 21 || in_sizes[0] != M * D || out_size != M * D || ws_size < WS_END) { fprintf(stderr, "kernel_launch: unexpected shapes (n_in %d, in0 %d, out %d, ws %zu)\n", n_in, n_in > 0 ? in_sizes[0] : -1, out_size, ws_size); grid = -1; return; }
        int dev = 0, cus = 0, per_cu = 0;
        if (hipGetDevice(&dev) != hipSuccess || hipDeviceGetAttribute(&cus, hipDeviceAttributeMultiprocessorCount, dev) != hipSuccess) { grid = -1; return; }
        if (hipFuncSetAttribute((const void*)mk_fwd, hipFuncAttributeMaxDynamicSharedMemorySize, LDS_BYTES) != hipSuccess) { fprintf(stderr, "kernel_launch: hipFuncSetAttribute failed\n"); grid = -1; return; }
        if (hipOccupancyMaxActiveBlocksPerMultiprocessor(&per_cu, (const void*)mk_fwd, NWAVES * 64, LDS_BYTES) != hipSuccess || per_cu < 1) { fprintf(stderr, "kernel_launch: occupancy query says %d blocks per CU\n", per_cu); per_cu = 1; }
        (void)hipGetLastError();
        grid = cus;
        if (grid % 8 != 0 || grid < 32) fprintf(stderr, "kernel_launch: unexpected CU count %d\n", grid);
    }
    if (grid < 0) return;
    (void)hipMemsetAsync((char*)d_ws + WS_CTL, 0, CTL_ZERO_BYTES, stream);
    Args a{};
    for (int i = 0; i < 21; ++i) a.in[i] = (const float*)d_in[i];
    a.out = (float*)d_out; a.ws = (unsigned char*)d_ws;
#if MK_SINGLE
    a.ph_lo = 0; a.ph_hi = N_PHASES;
    hipLaunchKernelGGL(mk_fwd, dim3(grid), dim3(NWAVES * 64), LDS_BYTES, stream, a);
#else
    for (int ph = 0; ph < MK_PH_HI; ++ph) { a.ph_lo = ph; a.ph_hi = ph + 1; hipLaunchKernelGGL(mk_fwd, dim3(grid), dim3(NWAVES * 64), LDS_BYTES, stream, a); }
#endif
}
```

```cpp
#include <hip/hip_runtime.h>
#include <cstdio>
#include <cstdint>
#include <cmath>
#define MK_SINGLE 1
namespace pg8 {
#define PG8_LAS __attribute__((address_space(3)))
typedef unsigned short bf16_t;
typedef short bf16x8 __attribute__((ext_vector_type(8)));
typedef float f32x4 __attribute__((ext_vector_type(4)));
typedef unsigned u32x4 __attribute__((ext_vector_type(4)));
constexpr int BM = 256, BK = 64, HALF = 128, HTB = HALF * BK * 2  , STAGE_BYTES = 8 * HTB, NXCD = 8, WGM = 8;

__host__ __device__ __forceinline__ int lds_byte(int r, int c) { const int st = (r >> 4) * 2 + (c >> 5), rr = r & 15, cc = c & 31, ob = rr * 64 + cc * 2; return st * 1024 + (ob ^ (((ob >> 9) & 1) << 5)); }
__host__ __device__ __forceinline__ void stage_rc(int b, int& R, int& C) { const int st = b / 1024, sb = b % 1024, swz = sb ^ (((sb >> 9) & 1) << 5); R = (st >> 1) * 16 + swz / 64; C = (st & 1) * 32 + (swz % 64) / 2; }
__host__ __device__ __forceinline__ int perm32(int rho) { const int n = rho >> 4, i = rho & 15; return 8 * (i >> 2) + 4 * n + (i & 3); }

struct Unit { int pm, pn; };
struct Gemm { const bf16_t* A; const bf16_t* Bt; int M, N, K; };

struct StaticOrder {
    int nM, nN, nwg, G, c;
    __host__ __device__ void init(int M, int N, int G_, int c_) { nM = M / BM; nN = N / BM; nwg = nM * nN; G = G_; c = c_; }
    __host__ __device__ bool next(int i, Unit& u) const {
        const long L = (long)i * G + c; if (L >= nwg) return false;
        int wgid = (int)L; { const int q = nwg / NXCD, r = nwg % NXCD, xcd = wgid % NXCD, off = wgid / NXCD; wgid = (xcd < r ? xcd * (q + 1) : r * (q + 1) + (xcd - r) * q) + off; }
        const int nig = WGM * nN, gid = wgid / nig, fm = gid * WGM, gsz = (nM - fm) < WGM ? (nM - fm) : WGM;
        u.pm = fm + ((wgid % nig) % gsz); u.pn = (wgid % nig) / gsz; return true;
    }
    __device__ __forceinline__ void a_ready(const Unit&) const {}
    __device__ __forceinline__ void done(const Unit&) const {}
};

__device__ __forceinline__ unsigned cvt_pk_bf16(float lo, float hi) { unsigned r; asm volatile("v_cvt_pk_bf16_f32 %0, %1, %2" : "=v"(r) : "v"(lo), "v"(hi)); return r; }
typedef float f32x2 __attribute__((ext_vector_type(2)));
__device__ __forceinline__ f32x2 gelu_pk(f32x2 v) {
    const f32x2 av = __builtin_elementwise_abs(v), d = av * 0.2316418882f + 1.0f;
    f32x2 t; t.x = __builtin_amdgcn_rcpf(d.x); t.y = __builtin_amdgcn_rcpf(d.y);
    f32x2 q = t * 0.5307027145f + (-0.7265760135f); q = q * t + 0.7107068705f; q = q * t + (-0.142248368f); q = q * t + 0.127414796f; q = q * t;
    const f32x2 s = (v * v) * (-0.72134752044f);
    f32x2 e; e.x = __builtin_amdgcn_exp2f(s.x); e.y = __builtin_amdgcn_exp2f(s.y);
    const f32x2 m = v * (q * e), r = v - m;
    f32x2 o; o.x = v.x < 0.f ? m.x : r.x; o.y = v.y < 0.f ? m.y : r.y; return o;
}

template <int ACT  > struct EpiBf16 {
    static constexpr bool PERM = true, AFTER_DRAIN = false; static_assert(ACT == 0 || ACT == 1, "EpiBf16: ACT is 0 (none) or 1 (gelu_pk)");
    bf16_t* O; int ldc; const float* bias; int split_cols; size_t split_stride; float scale0;
    __device__ __forceinline__ void operator()(const f32x4 (&acc)[2][2][4][2], const Unit& u, int wr, int wc, int fr, int fq) const {
        const int row0 = u.pm * BM + wr * 64 + fr; int colt = u.pn * BM; bf16_t* base = O;
        float sc = 1.f; if (split_cols) { const int t = colt / split_cols; base += (size_t)t * split_stride; colt -= t * split_cols; if (t == 0) sc = scale0; }
        const int col0 = colt + wc * 32 + 8 * fq, bcol0 = u.pn * BM + wc * 32 + 8 * fq;
        f32x4 bv[2][2];
#pragma unroll
        for (int bj = 0; bj < 2; ++bj)
#pragma unroll
            for (int n = 0; n < 2; ++n) bv[bj][n] = bias ? *(const f32x4*)(bias + bcol0 + bj * HALF + 4 * n) : (f32x4){0.f, 0.f, 0.f, 0.f};
#pragma unroll
        for (int ai = 0; ai < 2; ++ai)
#pragma unroll
            for (int m = 0; m < 4; ++m) { bf16_t* rowp = base + (size_t)(row0 + ai * HALF + m * 16) * ldc + col0;
#pragma unroll
                for (int bj = 0; bj < 2; ++bj) { f32x4 v0 = acc[ai][bj][m][0] + bv[bj][0], v1 = acc[ai][bj][m][1] + bv[bj][1];
                    if (ACT == 1) { f32x2 a = gelu_pk((f32x2){v0[0], v0[1]}), b = gelu_pk((f32x2){v0[2], v0[3]}), c = gelu_pk((f32x2){v1[0], v1[1]}), d = gelu_pk((f32x2){v1[2], v1[3]});
                        v0 = (f32x4){a.x, a.y, b.x, b.y}; v1 = (f32x4){c.x, c.y, d.x, d.y}; }
                    v0 = v0 * sc; v1 = v1 * sc; u32x4 w; w.x = cvt_pk_bf16(v0[0], v0[1]); w.y = cvt_pk_bf16(v0[2], v0[3]); w.z = cvt_pk_bf16(v1[0], v1[1]); w.w = cvt_pk_bf16(v1[2], v1[3]);
                    *(u32x4*)(rowp + bj * HALF) = w; } }
    }
};
struct EpiRes {
    static constexpr bool PERM = false, AFTER_DRAIN = false;
    const float* base; float* out; int ldc;
    __device__ __forceinline__ void operator()(const f32x4 (&acc)[2][2][4][2], const Unit& u, int wr, int wc, int fr, int fq) const {
        const int row0 = u.pm * BM + wr * 64 + fr, col0 = u.pn * BM + wc * 32 + 4 * fq;
#pragma unroll
        for (int ai = 0; ai < 2; ++ai)
#pragma unroll
            for (int m = 0; m < 4; ++m) { const size_t off = (size_t)(row0 + ai * HALF + m * 16) * ldc + col0;
#pragma unroll
                for (int bj = 0; bj < 2; ++bj)
#pragma unroll
                    for (int n = 0; n < 2; ++n) { const f32x4 bs = *(const f32x4*)(base + off + bj * HALF + n * 16); *(f32x4*)(out + off + bj * HALF + n * 16) = bs + acc[ai][bj][m][n]; } }
    }
};
struct EpiSwiGLU {
    static constexpr bool PERM = true, AFTER_DRAIN = false;
    bf16_t* O; int ldo;
    __device__ __forceinline__ void operator()(const f32x4 (&acc)[2][2][4][2], const Unit& u, int wr, int wc, int fr, int fq) const {
        const int row0 = u.pm * BM + wr * 64 + fr, col0 = u.pn * HALF + wc * 32 + 8 * fq;
#pragma unroll
        for (int ai = 0; ai < 2; ++ai)
#pragma unroll
            for (int m = 0; m < 4; ++m) { bf16_t* rowp = O + (size_t)(row0 + ai * HALF + m * 16) * ldo + col0;
                float r[8];
#pragma unroll
                for (int n = 0; n < 2; ++n)
#pragma unroll
                    for (int e = 0; e < 4; ++e) { const float g = acc[ai][0][m][n][e], up = acc[ai][1][m][n][e]; r[4 * n + e] = g * __builtin_amdgcn_rcpf(1.0f + __expf(-g)) * up; }
                u32x4 w; w.x = cvt_pk_bf16(r[0], r[1]); w.y = cvt_pk_bf16(r[2], r[3]); w.z = cvt_pk_bf16(r[4], r[5]); w.w = cvt_pk_bf16(r[6], r[7]);
                *(u32x4*)rowp = w; }
    }
};
template <class Epi, class Sched, bool ALIGN_EPI = false, bool SP2 = false>
__device__ __forceinline__ void gemm_phase(PG8_LAS unsigned char* lds, const Gemm g, const Sched& S, const Epi& E, const int tid) {
    const int wid = __builtin_amdgcn_readfirstlane(tid >> 6), lane = tid & 63, wr = wid >> 2, wc = wid & 3, fr = lane & 15, fq = lane >> 4;
    const int K = g.K, nt = K / BK;
    unsigned voffA[2], voffB[2];
#pragma unroll
    for (int i = 0; i < 2; ++i) { int R, C; stage_rc(tid * 16 + i * 8192, R, C); const int Rb = Epi::PERM ? ((R & ~31) + perm32(R & 31)) : R;
        voffA[i] = (unsigned)(R * K + C) * 2u; voffB[i] = (unsigned)(Rb * K + C) * 2u; }
    const size_t kstep = (size_t)(BK * 2);
    const size_t hstep = (size_t)HALF * K * 2;
    const size_t tstep = 2 * hstep;
    const unsigned ldsw = (unsigned)wid * 1024u;
    const int aoff = lds_byte(wr * 64 + fr, fq * 8), boff = lds_byte(wc * 32 + fr, fq * 8);
#define PG8_SA(b, h) (((b) * 2 + (h)) * HTB)
#define PG8_SB(b, h) ((4 + (b) * 2 + (h)) * HTB)
#define PG8_STAGE(bufoff, gbase, voff) do { _Pragma("unroll") for (int _i = 0; _i < 2; ++_i) \
        __builtin_amdgcn_global_load_lds((const unsigned*)((const char*)(gbase) + (voff)[_i]), (PG8_LAS unsigned*)(lds + (bufoff) + ldsw + _i * 8192), 16, 0, 0); } while (0)
#define PG8_LDA(dst, b, h) do { _Pragma("unroll") for (int m = 0; m < 4; ++m) _Pragma("unroll") for (int k = 0; k < 2; ++k) dst[m][k] = *(const PG8_LAS bf16x8*)(lds + PG8_SA(b, h) + aoff + m * 2048 + k * 1024); } while (0)
#define PG8_LDB(dst, b, h) do { _Pragma("unroll") for (int n = 0; n < 2; ++n) _Pragma("unroll") for (int k = 0; k < 2; ++k) dst[n][k] = *(const PG8_LAS bf16x8*)(lds + PG8_SB(b, h) + boff + n * 2048 + k * 1024); } while (0)
#define PG8_MMA(ai, bj, At, Bt) do { __builtin_amdgcn_s_setprio(1); _Pragma("unroll") for (int m = 0; m < 4; ++m) _Pragma("unroll") for (int n = 0; n < 2; ++n) _Pragma("unroll") for (int k = 0; k < 2; ++k) \
        acc[ai][bj][m][n] = __builtin_amdgcn_mfma_f32_16x16x32_bf16(Bt[n][k], At[m][k], acc[ai][bj][m][n], 0, 0, 0); __builtin_amdgcn_s_setprio(0); } while (0)
#define PG8_WAIT_V(n) asm volatile("s_waitcnt vmcnt(" #n ")" ::: "memory")
#define PG8_WAIT_L(n) asm volatile("s_waitcnt lgkmcnt(" #n ")" ::: "memory")
#define PG8_BAR __builtin_amdgcn_s_barrier()
#define PG8_SCHED __builtin_amdgcn_sched_barrier(0)
    Unit cur, nxt; int ui = 0;
    if (!S.next(0, cur)) return;
    f32x4 acc[2][2][4][2];
#pragma unroll
    for (int a = 0; a < 2; ++a)
#pragma unroll
        for (int b = 0; b < 2; ++b)
#pragma unroll
            for (int m = 0; m < 4; ++m)
#pragma unroll
                for (int n = 0; n < 2; ++n) acc[a][b][m][n] = (f32x4){0.f, 0.f, 0.f, 0.f};
    bf16x8 At[4][2], B0[2][2], B1[2][2];
    const char* cA = (const char*)g.A + (size_t)cur.pm * tstep; const char* cB = (const char*)g.Bt + (size_t)cur.pn * tstep;
    S.a_ready(cur);
    if constexpr (SP2) {
        PG8_STAGE(PG8_SB(0, 0), cB, voffB); PG8_STAGE(PG8_SB(0, 1), cB + hstep, voffB); PG8_STAGE(PG8_SA(0, 0), cA, voffA); PG8_STAGE(PG8_SA(0, 1), cA + hstep, voffA);
        if (wr == 1) PG8_BAR;
        PG8_WAIT_V(2); PG8_BAR;
        PG8_STAGE(PG8_SB(1, 0), cB + kstep, voffB); PG8_STAGE(PG8_SA(1, 0), cA + kstep, voffA); PG8_STAGE(PG8_SB(1, 1), cB + hstep + kstep, voffB);
        PG8_WAIT_V(6); PG8_BAR;
    } else {
        PG8_STAGE(PG8_SB(0, 0), cB, voffB); PG8_STAGE(PG8_SA(0, 0), cA, voffA); PG8_STAGE(PG8_SB(0, 1), cB + hstep, voffB); PG8_STAGE(PG8_SA(0, 1), cA + hstep, voffA);
        if (wr == 1) PG8_BAR;
        PG8_WAIT_V(4); PG8_BAR;
        PG8_STAGE(PG8_SB(1, 0), cB + kstep, voffB); PG8_STAGE(PG8_SA(1, 0), cA + kstep, voffA); PG8_STAGE(PG8_SB(1, 1), cB + hstep + kstep, voffB);
        PG8_WAIT_V(6); PG8_BAR;
    }
    for (;;) {
        const bool has_next = S.next(ui + 1, nxt);
        const char* nA = has_next ? (const char*)g.A + (size_t)nxt.pm * tstep : cA; const char* nB = has_next ? (const char*)g.Bt + (size_t)nxt.pn * tstep : cB;
        for (int t = 0; t < nt; t += 2) {
            const bool last = (t == nt - 2);
            const char* a1 = cA + (size_t)(t + 1) * kstep;
            const char* a2 = last ? nA : cA + (size_t)(t + 2) * kstep; const char* b2 = last ? nB : cB + (size_t)(t + 2) * kstep;
            const char* a3 = a2 + kstep; const char* b3 = b2 + kstep;
            if (last && has_next) S.a_ready(nxt);
            if constexpr (SP2) {
            PG8_LDB(B0, 0, 0); PG8_LDB(B1, 0, 1); PG8_SCHED; PG8_LDA(At, 0, 0); PG8_STAGE(PG8_SA(1, 1), a1 + hstep, voffA);
            PG8_WAIT_V(8); PG8_WAIT_L(0); PG8_BAR; PG8_MMA(0, 0, At, B0); PG8_MMA(0, 1, At, B1); PG8_BAR; PG8_SCHED;
            PG8_LDA(At, 0, 1); PG8_STAGE(PG8_SB(0, 0), b2, voffB); PG8_STAGE(PG8_SB(0, 1), b2 + hstep, voffB); PG8_STAGE(PG8_SA(0, 0), a2, voffA);
            PG8_WAIT_V(8); PG8_WAIT_L(0); PG8_BAR; PG8_MMA(1, 0, At, B0); PG8_MMA(1, 1, At, B1); PG8_BAR; PG8_SCHED;
            PG8_LDB(B0, 1, 0); PG8_LDB(B1, 1, 1); PG8_SCHED; PG8_LDA(At, 1, 0); PG8_STAGE(PG8_SA(0, 1), a2 + hstep, voffA);
            PG8_WAIT_V(8); PG8_WAIT_L(0); PG8_BAR; PG8_MMA(0, 0, At, B0); PG8_MMA(0, 1, At, B1); PG8_BAR; PG8_SCHED;
            PG8_LDA(At, 1, 1); PG8_STAGE(PG8_SB(1, 0), b3, voffB); PG8_STAGE(PG8_SB(1, 1), b3 + hstep, voffB); PG8_STAGE(PG8_SA(1, 0), a3, voffA);
            PG8_WAIT_V(8); PG8_WAIT_L(0); PG8_BAR; PG8_MMA(1, 0, At, B0); PG8_MMA(1, 1, At, B1); PG8_BAR; PG8_SCHED;
            } else {
            PG8_LDB(B0, 0, 0); PG8_SCHED; PG8_LDA(At, 0, 0); PG8_STAGE(PG8_SA(1, 1), a1 + hstep, voffA);
            PG8_WAIT_L(8); PG8_BAR; PG8_WAIT_L(0); PG8_MMA(0, 0, At, B0); PG8_BAR; PG8_SCHED;
            PG8_LDB(B1, 0, 1); PG8_STAGE(PG8_SB(0, 0), b2, voffB);
            PG8_BAR; PG8_WAIT_L(0); PG8_MMA(0, 1, At, B1); PG8_BAR;
            PG8_LDA(At, 0, 1); PG8_STAGE(PG8_SA(0, 0), a2, voffA);
            PG8_BAR; PG8_WAIT_L(0); PG8_MMA(1, 0, At, B0); PG8_BAR; PG8_SCHED;
            PG8_STAGE(PG8_SB(0, 1), b2 + hstep, voffB);
            PG8_WAIT_V(6); PG8_BAR; PG8_MMA(1, 1, At, B1); PG8_BAR;
            PG8_LDB(B0, 1, 0); PG8_SCHED; PG8_LDA(At, 1, 0); PG8_STAGE(PG8_SA(0, 1), a2 + hstep, voffA);
            PG8_WAIT_L(8); PG8_BAR; PG8_WAIT_L(0); PG8_MMA(0, 0, At, B0); PG8_BAR; PG8_SCHED;
            PG8_LDB(B1, 1, 1); PG8_STAGE(PG8_SB(1, 0), b3, voffB);
            PG8_BAR; PG8_WAIT_L(0); PG8_MMA(0, 1, At, B1); PG8_BAR;
            PG8_LDA(At, 1, 1); PG8_STAGE(PG8_SA(1, 0), a3, voffA);
            PG8_BAR; PG8_WAIT_L(0); PG8_MMA(1, 0, At, B0); PG8_BAR; PG8_SCHED;
            PG8_STAGE(PG8_SB(1, 1), b3 + hstep, voffB);
            PG8_WAIT_V(6); PG8_BAR; PG8_MMA(1, 1, At, B1); PG8_BAR;
            }
        }
        if constexpr (ALIGN_EPI) { if (wr == 0) PG8_BAR; }
        if constexpr (!Epi::AFTER_DRAIN) { E(acc, cur, wr, wc, fr, fq); S.done(cur); }
        if (!has_next) break;
#pragma unroll
        for (int a = 0; a < 2; ++a)
#pragma unroll
            for (int b = 0; b < 2; ++b)
#pragma unroll
                for (int m = 0; m < 4; ++m)
#pragma unroll
                    for (int n = 0; n < 2; ++n) acc[a][b][m][n] = (f32x4){0.f, 0.f, 0.f, 0.f};
        cur = nxt; cA = nA; cB = nB; ++ui;
        if constexpr (ALIGN_EPI) { if (wr == 1) PG8_BAR; }
    }
    PG8_WAIT_V(0);
    if constexpr (!ALIGN_EPI) { if (wr == 0) PG8_BAR; }
    PG8_BAR;
    if constexpr (Epi::AFTER_DRAIN) { E.fused(acc, cur, wr, wc, fr, fq, lds, wid, lane); S.done(cur); }
#undef PG8_SA
#undef PG8_SB
#undef PG8_STAGE
#undef PG8_LDA
#undef PG8_LDB
#undef PG8_MMA
#undef PG8_WAIT_V
#undef PG8_WAIT_L
#undef PG8_BAR
#undef PG8_SCHED
}
}
#define GAS __attribute__((address_space(1)))
#define LAS __attribute__((address_space(3)))
typedef unsigned short bf16;
typedef unsigned v4u __attribute__((ext_vector_type(4)));
typedef float f32x4 __attribute__((ext_vector_type(4)));
typedef short bf16x8 __attribute__((ext_vector_type(8)));
typedef GAS unsigned gu32;
typedef GAS unsigned long long gu64;
#define RLX_AGENT __ATOMIC_RELAXED, __HIP_MEMORY_SCOPE_AGENT
#define LDS_WAIT() asm volatile("s_waitcnt lgkmcnt(0)" ::: "memory")
#define VM_WAIT() asm volatile("s_waitcnt vmcnt(0)" ::: "memory")
__device__ __forceinline__ unsigned long long rt() { return __builtin_amdgcn_s_memrealtime(); }
__device__ __forceinline__ unsigned f2bf(float f) { unsigned u = __builtin_bit_cast(unsigned, f); return (u + 0x7fffu + ((u >> 16) & 1u)) >> 16; }
typedef __bf16 bf16v2q __attribute__((ext_vector_type(2))); typedef float f32v2q __attribute__((ext_vector_type(2)));
__device__ __forceinline__ unsigned pk2(float lo, float hi) { const f32v2q v = {lo, hi}; return __builtin_bit_cast(unsigned, __builtin_convertvector(v, bf16v2q)); }

#define XB_TMO      128
#define XB_XCNT(j)  (256  + 64 * (j))
#define XB_XSUB(j)  (1280 + 64 * (j))
#define XB_XGEN(j)  (2304 + 64 * (j))
#define XB_TOP      3328
#define XB_TOPGEN   3392
#define XCD_BAR_WORDS 3456
#define XB_SPIN_CAP (1u << 18)

__device__ __forceinline__ unsigned xb_ld(unsigned* p)              { return __hip_atomic_load(p, __ATOMIC_RELAXED, __HIP_MEMORY_SCOPE_AGENT); }
__device__ __forceinline__ unsigned xb_add(unsigned* p, unsigned v) { return __hip_atomic_fetch_add(p, v, __ATOMIC_RELAXED, __HIP_MEMORY_SCOPE_AGENT); }
__device__ __forceinline__ unsigned xb_xcc_id() { return (unsigned)__builtin_amdgcn_s_getreg((3 << 11) | 20) & 0xFu; }
#define XB_SPIN(cond, bar) do { unsigned _sp = 0; while (cond) { __builtin_amdgcn_s_sleep(1); \
    if ((++_sp & 255u) == 0u) { if (xb_ld(&(bar)[XB_TMO])) break; if (_sp > XB_SPIN_CAP) { atomicAdd(&(bar)[XB_TMO], 1u); break; } } } } while (0)

struct XcdBarrier {
    unsigned* bar; unsigned x;
    volatile LAS unsigned* st;
};

__device__ __forceinline__ XcdBarrier xcd_barrier_post(unsigned* bar, volatile LAS unsigned* st) {
    XcdBarrier b; b.bar = bar; b.x = xb_xcc_id(); b.st = st;
    if (threadIdx.x == 0) (void)xb_add(&bar[XB_XCNT(b.x)], 1u);
    return b;
}
__device__ __forceinline__ void xcd_barrier_complete(unsigned* bar, unsigned x, unsigned& nloc, unsigned& nx) {
    const unsigned G = gridDim.x * gridDim.y * gridDim.z;
    unsigned sum, cnt, mine, sp = 0u;
    for (;;) {
        sum = 0u; cnt = 0u; mine = 0u;
#pragma unroll
        for (unsigned j = 0; j < 16; ++j) { const unsigned c = xb_ld(&bar[XB_XCNT(j)]); sum += c; cnt += (c > 0u) ? 1u : 0u; mine = (j == x) ? c : mine; }
        if (sum == G) break;
        __builtin_amdgcn_s_sleep(1);
        if ((++sp & 255u) == 0u) { if (xb_ld(&bar[XB_TMO])) break; if (sp > XB_SPIN_CAP) { atomicAdd(&bar[XB_TMO], 1u); break; } }
    }
    nloc = mine > 0u ? mine : 1u; nx = cnt > 0u ? cnt : 1u;
}

__device__ __forceinline__ void xcd_barrier(const XcdBarrier& b) {
    asm volatile("s_waitcnt vmcnt(0)" ::: "memory");
    __syncthreads();
    if (threadIdx.x == 0) {
        unsigned* bar = b.bar;
        __builtin_amdgcn_s_waitcnt(0);
        unsigned nloc = b.st[0], nx = b.st[1];
        if (nloc == 0u) { xcd_barrier_complete(bar, b.x, nloc, nx); b.st[0] = nloc; b.st[1] = nx; }
        const unsigned old = xb_add(&bar[XB_XSUB(b.x)], 1u);
        const unsigned gen = old / nloc;
        if (old + 1u == (gen + 1u) * nloc) {
            __builtin_amdgcn_fence(__ATOMIC_RELEASE, "agent");
            asm volatile("s_waitcnt vmcnt(0)" ::: "memory");
            const unsigned og = xb_add(&bar[XB_TOP], 1u);
            const unsigned tg = og / nx;
            if (og + 1u == (tg + 1u) * nx) xb_add(&bar[XB_TOPGEN], 1u);
            else XB_SPIN(xb_ld(&bar[XB_TOPGEN]) == tg, bar);
            __builtin_amdgcn_fence(__ATOMIC_ACQUIRE, "agent");
            xb_add(&bar[XB_XGEN(b.x)], 1u);
            asm volatile("s_waitcnt vmcnt(0)" ::: "memory");
        } else {
            XB_SPIN(xb_ld(&bar[XB_XGEN(b.x)]) == gen, bar);
            __builtin_amdgcn_fence(__ATOMIC_ACQUIRE, "agent");
            asm volatile("s_waitcnt vmcnt(0)" ::: "memory");
        }
    }
    __syncthreads();
}

#ifndef MK_PH_HI
#define MK_PH_HI 19
#endif
#ifndef MK_SUB
#define MK_SUB 7
#endif
#ifndef MK_DNSTEP
#define MK_DNSTEP 9
#endif
#ifndef MK_W6
#define MK_W6 1
#endif
#ifndef MK_CVSTEP
#define MK_CVSTEP 9
#endif
#ifndef MK_REP
#define MK_REP 0
#endif
#ifndef MK_REPSUB
#define MK_REPSUB 7
#endif
#ifndef MK_NEG
#define MK_NEG 1
#endif

constexpr int NWAVES = 8;
constexpr int D = 1024, BATCH = 8, SEQ = 4096, M = BATCH * SEQ, DEPTH = 2;
constexpr int DFF = 2816, DPROJ = 3080, NP = 3072;
constexpr int CVK = 31, DNCONV = 4;
constexpr float EPS = 1e-6f;
constexpr int NCHUNK = BATCH * 4 * 64;

constexpr size_t MiB = 1u << 20;
constexpr size_t WS_CTL = 0, CTL_ZERO_BYTES = 64 * 1024;
constexpr size_t WS_W = 2 * MiB;
constexpr size_t W_IN_OFF = 0, W_O_OFF = 6 * MiB, W_GU_OFF = 8 * MiB, W_D_OFF = 19 * MiB, W_LAYER = 25 * MiB;
constexpr size_t WS_BA = 53 * MiB;
constexpr size_t WS_CD = 54 * MiB + 512 * 1024;
constexpr size_t WS_HN = 64 * MiB;
constexpr size_t WS_P = 128 * MiB;
constexpr size_t WS_REC = 320 * MiB;
constexpr size_t REC_BYTES = 74752, REC_W = 0, REC_QD = 16384, REC_QK = 32768, REC_KDT = 40960, REC_U = 57344, REC_CD = 73728;
constexpr size_t WS_O = 468 * MiB, WS_END = 500 * MiB;
constexpr int CW_BAR = 4096;

constexpr int RING_BYTES = 131072;
constexpr int MISC_OFF = 163840 - 256;
constexpr int LDS_BYTES = 163840;

__device__ __forceinline__ float bf2f(unsigned short b) { return __uint_as_float(((unsigned)b) << 16); }
__device__ __forceinline__ float wave_sum(float v) {
#pragma unroll
    for (int o = 1; o < 64; o <<= 1) v += __shfl_xor(v, o);
    return v;
}
__device__ __forceinline__ float sigmoidf_(float x) { return __builtin_amdgcn_rcpf(1.0f + __builtin_amdgcn_exp2f(x * -1.4426950408889634f)); }
__device__ __forceinline__ float gelu_erf(float x) { return 0.5f * x * (1.0f + erff(x * 0.70710678118654752f)); }
typedef float f32x16 __attribute__((ext_vector_type(16)));
typedef unsigned u32x2 __attribute__((ext_vector_type(2)));
#define MFMA32(a, b, c) __builtin_amdgcn_mfma_f32_32x32x16_bf16((a), (b), (c), 0, 0, 0)
__device__ __forceinline__ int crow(int reg, int hh) { return (reg & 3) + 8 * (reg >> 2) + 4 * hh; }

#define AS4 __attribute__((address_space(4)))
struct Frame {
    LAS unsigned char* lds;
    int tid, lane, wave, vcu, G;
    const AS4 unsigned char* kp;
    float* out; unsigned char* ws;
    __device__ __forceinline__ const float* inp(int k) const { return *(const float* const AS4*)(kp + 8 * k); }
};

__device__ __forceinline__ void tr_item(const float* W, int ldw, int K, bf16* WT, int kb, int nsrc0, int ndst0, LAS float* scr, int lane) {
    const int k0 = 64 * kb;
#pragma unroll 8
    for (int i = 0; i < 32; ++i) { const int kk = 2 * i + (lane >> 5); scr[kk * 33 + (lane & 31)] = W[(size_t)(k0 + kk) * ldw + nsrc0 + (lane & 31)]; }
    LDS_WAIT(); asm volatile("" ::: "memory");
    const int c = lane & 7;
#pragma unroll
    for (int j = 0; j < 4; ++j) { const int n = (lane >> 3) + 8 * j; const LAS float* s = scr + (8 * c) * 33 + n;
        v4u o; o.x = pk2(s[0 * 33], s[1 * 33]); o.y = pk2(s[2 * 33], s[3 * 33]); o.z = pk2(s[4 * 33], s[5 * 33]); o.w = pk2(s[6 * 33], s[7 * 33]);
        *(GAS v4u*)(WT + (size_t)(ndst0 + n) * K + k0 + 8 * c) = o; }
    LDS_WAIT(); asm volatile("" ::: "memory");
}
__device__ __forceinline__ void weights_phase(Frame& F) {
    LAS float* scr = (LAS float*)(F.lds + F.wave * 16384);
    const int gw = F.vcu * NWAVES + F.wave, NGW = F.G * NWAVES;
    constexpr int I_IN = 16 * 96, I_O = 16 * 32, I_GU = 16 * 176, I_D = 44 * 32, I_L = I_IN + I_O + I_GU + I_D;
    for (int it = gw; it < DEPTH * I_L; it += NGW) {
        const int l = it / I_L; int r = it % I_L;
        bf16* wb = (bf16*)(F.ws + WS_W + (size_t)l * W_LAYER);
        if (r < I_IN) { const int kb = r / 96, nb = r % 96; tr_item(F.inp(2) + (size_t)l * D * DPROJ, DPROJ, D, (bf16*)((unsigned char*)wb + W_IN_OFF), kb, 32 * nb, 32 * nb, scr, F.lane); continue; } r -= I_IN;
        if (r < I_O) { const int kb = r / 32, nb = r % 32; tr_item(F.inp(15) + (size_t)l * D * D, D, D, (bf16*)((unsigned char*)wb + W_O_OFF), kb, 32 * nb, 32 * nb, scr, F.lane); continue; } r -= I_O;
        if (r < I_GU) { const int kb = r / 176, nb = r % 176; const int drow = 32 * nb, tile = drow >> 8, within = drow & 255;
            const float* src = (within < 128 ? F.inp(17) : F.inp(18)) + (size_t)l * D * DFF;
            tr_item(src, DFF, D, (bf16*)((unsigned char*)wb + W_GU_OFF), kb, tile * 128 + (within & 127), drow, scr, F.lane); continue; } r -= I_GU;
        { const int kb = r / 32, nb = r % 32; tr_item(F.inp(19) + (size_t)l * DFF * D, D, DFF, (bf16*)((unsigned char*)wb + W_D_OFF), kb, 32 * nb, 32 * nb, scr, F.lane); }
    }
}

template <int MODE>
__device__ __forceinline__ void norm_phase(Frame& F, const float* xin, const float* g, bf16* hn, const float* wlog, float* ba, float* fout) {
    const int gw = F.vcu * NWAVES + F.wave, NGW = F.G * NWAVES;
    f32x4 gv[4];
#pragma unroll
    for (int j = 0; j < 4; ++j) gv[j] = ((const f32x4*)g)[64 * j + F.lane];
    for (int m = gw; m < M; m += NGW) {
        const f32x4* xr = (const f32x4*)(xin + (size_t)m * D) + F.lane;
        f32x4 v[4]; float ss = 0.f;
#pragma unroll
        for (int j = 0; j < 4; ++j) { v[j] = xr[64 * j]; ss += (v[j].x * v[j].x + v[j].y * v[j].y) + (v[j].z * v[j].z + v[j].w * v[j].w); }
        const float rstd = 1.0f / sqrtf(wave_sum(ss) * (1.0f / D) + EPS);
#pragma unroll
        for (int j = 0; j < 4; ++j) v[j] = v[j] * rstd * gv[j];
        if (MODE == 0) {
            unsigned long long* o8 = (unsigned long long*)(hn + (size_t)m * D) + F.lane;
#pragma unroll
            for (int j = 0; j < 4; ++j) o8[64 * j] = (unsigned long long)pk2(v[j].x, v[j].y) | ((unsigned long long)pk2(v[j].z, v[j].w) << 32);
            if (wlog) {
                float acc[8];
#pragma unroll
                for (int t = 0; t < 8; ++t) acc[t] = 0.f;
#pragma unroll
                for (int j = 0; j < 4; ++j)
#pragma unroll
                    for (int e = 0; e < 4; ++e) { const int k = 256 * j + 4 * F.lane + e; const f32x4* wr = (const f32x4*)(wlog + (size_t)k * DPROJ + NP);
                        const f32x4 w0 = wr[0], w1 = wr[1]; const float y = v[j][e];
                        acc[0] += y * w0.x; acc[1] += y * w0.y; acc[2] += y * w0.z; acc[3] += y * w0.w; acc[4] += y * w1.x; acc[5] += y * w1.y; acc[6] += y * w1.z; acc[7] += y * w1.w; }
#pragma unroll
                for (int t = 0; t < 8; ++t) acc[t] = wave_sum(acc[t]);
                if (F.lane == 0) { *(f32x4*)(ba + (size_t)m * 8) = (f32x4){acc[0], acc[1], acc[2], acc[3]}; *(f32x4*)(ba + (size_t)m * 8 + 4) = (f32x4){acc[4], acc[5], acc[6], acc[7]}; }
            }
        } else {
            f32x4* o = (f32x4*)(fout + (size_t)m * D) + F.lane;
#pragma unroll
            for (int j = 0; j < 4; ++j) o[64 * j] = v[j];
        }
    }
}

__device__ __forceinline__ float gelu_as(float v) {
    const float d = fabsf(v) * 0.2316418882f + 1.0f, t = __builtin_amdgcn_rcpf(d);
    float q = t * 0.5307027145f + (-0.7265760135f); q = q * t + 0.7107068705f; q = q * t + (-0.142248368f); q = q * t + 0.127414796f; q = q * t;
    const float e = __builtin_amdgcn_exp2f((v * v) * (-0.72134752044f));
    const float m = v * (q * e), r = v - m;
    return v < 0.f ? m : r;
}
typedef __bf16 bf16v8m_t __attribute__((ext_vector_type(8)));
typedef float f32x8m_t __attribute__((ext_vector_type(8)));
__device__ __forceinline__ bf16x8 cvt8(float a0, float a1, float a2, float a3, float a4, float a5, float a6, float a7) { const f32x8m_t v = {a0, a1, a2, a3, a4, a5, a6, a7}; return __builtin_bit_cast(bf16x8, __builtin_convertvector(v, bf16v8m_t)); }
__device__ __forceinline__ void gmlp_unit(Frame& F, int l, int unit, const bf16* P, bf16* MIX) {
    const int m0 = unit * 128;
    LAS bf16* sVt = (LAS bf16*)F.lds;
    {
        float lg[4], lb[4];
#pragma unroll
        for (int e = 0; e < 4; ++e) { lg[e] = F.inp(3)[l * 256 + F.lane + 64 * e]; lb[e] = F.inp(4)[l * 256 + F.lane + 64 * e]; }
#pragma unroll 4
        for (int jj = 0; jj < 16; ++jj) {
            const int j = 16 * F.wave + jj;
            const bf16* pr = P + (size_t)(m0 + j) * NP + 256 + F.lane;
            float v[4];
#pragma unroll
            for (int e = 0; e < 4; ++e) v[e] = gelu_as(bf2f(pr[64 * e]));
            const float mean = wave_sum((v[0] + v[1]) + (v[2] + v[3])) * (1.0f / 256.0f);
#pragma unroll
            for (int e = 0; e < 4; ++e) v[e] -= mean;
            const float var = wave_sum((v[0] * v[0] + v[1] * v[1]) + (v[2] * v[2] + v[3] * v[3])) * (1.0f / 256.0f);
            const float r = 1.0f / sqrtf(var + EPS);
#pragma unroll
            for (int e = 0; e < 4; ++e) sVt[(F.lane + 64 * e) * 136 + j] = (bf16)(pk2(v[e] * r * lg[e] + lb[e], 0.f) & 0xffffu);
        }
    }
    __syncthreads();
    {
        const int r = F.lane & 31, hh = F.lane >> 5, h = F.wave >> 1, c = 32 * F.wave + r;
        const float* wsh = F.inp(5) + (size_t)(l * 4 + h) * 128 * 128;
        const float* bsh = F.inp(6) + (l * 4 + h) * 128;
        bf16x8 bfr[8];
#pragma unroll
        for (int s = 0; s < 8; ++s) bfr[s] = *(const LAS bf16x8*)(sVt + c * 136 + 16 * s + 8 * hh);
#pragma unroll
        for (int ti = 0; ti < 4; ++ti) {
            const int i = 32 * ti + r;
            f32x16 acc;
#pragma unroll
            for (int e = 0; e < 16; ++e) acc[e] = 0.f;
#pragma unroll
            for (int s = 0; s < 2 * ti + 2; ++s) {
                const float* ap = wsh + i * 128 + 16 * s + 8 * hh;
                f32x4 a0 = *(const f32x4*)ap, a1 = *(const f32x4*)(ap + 4);
                if (s >= 2 * ti) { const int j0 = 16 * s + 8 * hh;
                    a0.x = (j0 + 0 <= i) ? a0.x : 0.f; a0.y = (j0 + 1 <= i) ? a0.y : 0.f; a0.z = (j0 + 2 <= i) ? a0.z : 0.f; a0.w = (j0 + 3 <= i) ? a0.w : 0.f;
                    a1.x = (j0 + 4 <= i) ? a1.x : 0.f; a1.y = (j0 + 5 <= i) ? a1.y : 0.f; a1.z = (j0 + 6 <= i) ? a1.z : 0.f; a1.w = (j0 + 7 <= i) ? a1.w : 0.f; }
                acc = MFMA32(cvt8(a0.x, a0.y, a0.z, a0.w, a1.x, a1.y, a1.z, a1.w), bfr[s], acc);
            }
#pragma unroll
            for (int e = 0; e < 16; ++e) { const int io = 32 * ti + crow(e, hh);
                const float u = gelu_as(bf2f(P[(size_t)(m0 + io) * NP + c]));
                MIX[(size_t)(m0 + io) * D + c] = (bf16)(pk2(u * (acc[e] + bsh[io]), 0.f) & 0xffffu); }
        }
    }
    __syncthreads();
}

__device__ __forceinline__ void conv_unit(Frame& F, int l, int unit, const bf16* P, bf16* MIX) {
    const int b = unit >> 6, t0 = (unit & 63) * 64, m0 = b * SEQ + t0;
    LAS float* sY = (LAS float*)F.lds;
    for (int r = F.wave; r < 94; r += NWAVES) {
        const int t = t0 - 30 + r; f32x4 y = (f32x4){0.f, 0.f, 0.f, 0.f};
        if (t >= 0) {
            const bf16* pr = P + (size_t)(b * SEQ + t) * NP + 4 * F.lane;
            const u32x2 ra = *(const u32x2*)(pr + 512), rg = *(const u32x2*)(pr + 768);
            y.x = bf2f((unsigned short)(ra.x & 0xffffu)) * sigmoidf_(bf2f((unsigned short)(rg.x & 0xffffu)));
            y.y = bf2f((unsigned short)(ra.x >> 16)) * sigmoidf_(bf2f((unsigned short)(rg.x >> 16)));
            y.z = bf2f((unsigned short)(ra.y & 0xffffu)) * sigmoidf_(bf2f((unsigned short)(rg.y & 0xffffu)));
            y.w = bf2f((unsigned short)(ra.y >> 16)) * sigmoidf_(bf2f((unsigned short)(rg.y >> 16)));
        }
        *(LAS f32x4*)(sY + r * 256 + 4 * F.lane) = y;
    }
    __syncthreads();
    if (MK_CVSTEP < 2) return;
    const int c = F.tid & 255, hf = F.wave >> 2;
    float w[CVK];
#pragma unroll
    for (int k = 0; k < CVK; ++k) w[k] = F.inp(7)[(size_t)(l * CVK + k) * 256 + c];
    const float bias = F.inp(8)[l * 256 + c];
    float o[32];
#pragma unroll
    for (int g = 0; g < 4; ++g) {
        float y[38];
#pragma unroll
        for (int q = 0; q < 38; ++q) y[q] = sY[(hf * 32 + 8 * g + q) * 256 + c];
#pragma unroll
        for (int t8 = 0; t8 < 8; ++t8) {
            float a = bias;
#pragma unroll
            for (int k = 0; k < CVK; ++k) a += w[k] * y[t8 + k];
            o[8 * g + t8] = a;
        }
    }
    __syncthreads();
#pragma unroll
    for (int tt = 0; tt < 32; ++tt) sY[(hf * 32 + tt) * 256 + c] = o[tt];
    __syncthreads();
    if (MK_CVSTEP < 3) return;
    const f32x4 g4 = *(const f32x4*)(F.inp(9) + l * 256 + 4 * F.lane), b4 = *(const f32x4*)(F.inp(10) + l * 256 + 4 * F.lane);
    for (int i = F.wave; i < 64; i += NWAVES) {
        f32x4 v = *(LAS f32x4*)(sY + i * 256 + 4 * F.lane);
        const float mean = wave_sum((v.x + v.y) + (v.z + v.w)) * (1.0f / 256.0f);
        v = v - mean;
        const float var = wave_sum((v.x * v.x + v.y * v.y) + (v.z * v.z + v.w * v.w)) * (1.0f / 256.0f);
        const float r = 1.0f / sqrtf(var + EPS);
        v = v * r * g4 + b4;
        v.x *= sigmoidf_(v.x); v.y *= sigmoidf_(v.y); v.z *= sigmoidf_(v.z); v.w *= sigmoidf_(v.w);
        *(unsigned long long*)(MIX + (size_t)(m0 + i) * D + 256 + 4 * F.lane) = (unsigned long long)pk2(v.x, v.y) | ((unsigned long long)pk2(v.z, v.w) << 32);
    }
    __syncthreads();
}

#ifndef MK_TS
#define MK_TS 0
#endif
#ifndef MK_TK
#define MK_TK 4
#endif
#define TS_BEGIN(id) long long ts0_##id = 0; if (MK_TS == (id)) { asm volatile("s_waitcnt vmcnt(0) lgkmcnt(0)" ::: "memory"); ts0_##id = clock64(); }
#define TS_END(id) if (MK_TS == (id)) { asm volatile("s_waitcnt vmcnt(0) lgkmcnt(0)" ::: "memory"); const long long t1_ = clock64(), d_ = (t1_ - ts0_##id) * MK_TK; while (clock64() - t1_ < d_) __builtin_amdgcn_s_sleep(1); }
typedef __bf16 bf16v2_t __attribute__((ext_vector_type(2)));
typedef __bf16 bf16v8_t __attribute__((ext_vector_type(8)));
typedef float f32x2_t __attribute__((ext_vector_type(2)));
typedef float f32x8_t __attribute__((ext_vector_type(8)));
__device__ __forceinline__ unsigned cpk2(float lo, float hi) { const f32x2_t v = {lo, hi}; return __builtin_bit_cast(unsigned, __builtin_convertvector(v, bf16v2_t)); }
__device__ __forceinline__ v4u cpk8(float a0, float a1, float a2, float a3, float a4, float a5, float a6, float a7) { const f32x8_t v = {a0, a1, a2, a3, a4, a5, a6, a7}; return __builtin_bit_cast(v4u, __builtin_convertvector(v, bf16v8_t)); }
__device__ __forceinline__ bf16x8 pack_step(const f32x16& x, int s) { return __builtin_bit_cast(bf16x8, cpk8(x[8 * s], x[8 * s + 1], x[8 * s + 2], x[8 * s + 3], x[8 * s + 4], x[8 * s + 5], x[8 * s + 6], x[8 * s + 7])); }

template <int I> __device__ __forceinline__ void dn_solve_rows(float (&sol)[64], const LAS float* sA, const LAS float* sBeta, const LAS float* sEg, const LAS float* src, const bool isw) {
    if constexpr (I < 64) {
        float rv = sBeta[I] * src[I * 128] * (isw ? sEg[I] : 1.0f);
        const LAS float* arow = sA + I * 64;
        if constexpr (I >= 32) asm volatile("" : "+v"(arow) : "v"(sol[I - 1])); else if constexpr (I >= 2) asm volatile("" : "+v"(arow) : "v"(sol[I - 2]));
        float p0 = 0.f, p1 = 0.f, p2 = 0.f, p3 = 0.f;
#pragma unroll
        for (int j = 0; j + 3 < I; j += 4) { p0 += arow[j] * sol[j]; p1 += arow[j + 1] * sol[j + 1]; p2 += arow[j + 2] * sol[j + 2]; p3 += arow[j + 3] * sol[j + 3]; }
#pragma unroll
        for (int j = (I / 4) * 4; j < I; ++j) p0 += arow[j] * sol[j];
        rv -= (p0 + p1) + (p2 + p3);
        sol[I] = rv;
        dn_solve_rows<I + 1>(sol, sA, sBeta, sEg, src, isw);
    }
}

__device__ __forceinline__ void dn_load_raw(v4u (&raw)[7], const bf16* P, int cu, int tid) {
    const int b = cu >> 8, h = (cu >> 6) & 3, n = cu & 63, m0 = b * SEQ + n * 64;
    const bf16* pbase = P + 1024 + h * 128;
#pragma unroll
    for (int it = 0; it < 7; ++it) { int item = tid + 512 * it; item = item < 3 * 67 * 16 ? item : 3 * 67 * 16 - 1;
        const int sel = item / (67 * 16), rem = item - sel * (67 * 16), t = rem >> 4, pc = rem & 15;
        const int tr = (n > 0 || t >= 3) ? t : 3;
        raw[it] = *(const v4u*)(pbase + (long)(m0 - 3 + tr) * NP + sel * 512 + pc * 8);
        if (!(n > 0 || t >= 3)) raw[it] = (v4u){0u, 0u, 0u, 0u}; }
}
__device__ __forceinline__ void dn_chunk_units(Frame& F0, int l, int first, int stride, const bf16* P, const float* BA, const int stepmax) {
  if (stepmax < 1 || first >= NCHUNK) return;
  v4u rawn[7]; dn_load_raw(rawn, P, first, F0.tid);
  for (int cu = first; cu < NCHUNK; cu += stride) {
    Frame F = F0; asm volatile("" : "+v"(F.tid)); F.lane = F.tid & 63; F.wave = __builtin_amdgcn_readfirstlane(F.tid >> 6);
    const int b = cu >> 8, h = (cu >> 6) & 3, n = cu & 63, m0 = b * SEQ + n * 64;
    LAS float* sQ = (LAS float*)F.lds;
    LAS float* sK = (LAS float*)(F.lds + 32768);
    LAS float* sV = (LAS float*)(F.lds + 65536);
    LAS bf16* sQb = (LAS bf16*)(F.lds + 98304);
    LAS bf16* sKb = (LAS bf16*)(F.lds + 115712);
    LAS bf16* sRaw = (LAS bf16*)(F.lds + 98304);
    LAS float* sGam = (LAS float*)(F.lds + 149760);
    LAS float* sBeta = (LAS float*)(F.lds + 150016);
    LAS float* sEg = (LAS float*)(F.lds + 150272);
    LAS float* sEd = (LAS float*)(F.lds + 150528);
    LAS float* sA = sQ;
    bf16* rec = (bf16*)(F.ws + WS_REC + (size_t)cu * REC_BYTES);
    bf16* Uo = rec + REC_U / 2; float* CD = (float*)((unsigned char*)rec + REC_CD);
    TS_BEGIN(1)
    {
#pragma unroll
        for (int it = 0; it < 7; ++it) { const int item = F.tid + 512 * it; if (item < 3 * 67 * 16) *(LAS v4u*)(sRaw + item * 8) = rawn[it]; }
    }
    {
        const int cn = (cu + stride < NCHUNK) ? cu + stride : cu;
        dn_load_raw(rawn, P, cn, F.tid);
    }
    __syncthreads();
    TS_END(1)
#ifdef MK_X
    if (stepmax == 1) continue;
#endif
    TS_BEGIN(2)
#ifndef MK_Y
#define MK_Y 0
#endif
#ifndef MK_Z
#define MK_Z 0
#endif
    if (F.wave < 6 && !(stepmax == 1 && MK_Z)) {
        const int sel = F.wave >> 1, c = F.tid & 127;
        const int wch = sel * 512 + h * 128 + c;
        const float* cw = F.inp(11) + (size_t)l * DNCONV * 1536 + wch;
        const float w0 = cw[0], w1 = cw[1536], w2 = cw[2 * 1536], w3 = cw[3 * 1536];
        const LAS bf16* xc = sRaw + (sel * 67) * 128 + c;
        float x0 = bf2f(xc[0]), x1 = bf2f(xc[128]), x2 = bf2f(xc[256]);
        LAS float* dst = (sel == 0 ? sQ : (sel == 1 ? sK : sV)) + c;
#ifndef MK_DUP
#define MK_DUP 0
#endif
        for (int dup = 0; dup <= MK_DUP; ++dup) {
        asm volatile("" ::: "memory");
        x0 = bf2f(xc[0]); x1 = bf2f(xc[128]); x2 = bf2f(xc[256]);
#pragma unroll 16
        for (int i = 0; i < 64; ++i) {
            const float x3 = bf2f(xc[(i + 3) * 128]);
            const float y = (w0 * x0 + w1 * x1) + (w2 * x2 + w3 * x3);
            dst[i * 128] = y * sigmoidf_(y);
            x0 = x1; x1 = x2; x2 = x3;
        }
        }
    } else if (F.wave == 6) {
        const int i = F.lane;
        const float bl = BA[(size_t)(m0 + i) * 8 + h], al = BA[(size_t)(m0 + i) * 8 + 4 + h];
        const float beta = 1.0f / (1.0f + expf(-bl));
        const float z = al + F.inp(13)[l * 4 + h];
        const float sp = fmaxf(z, 0.f) + log1pf(expf(-fabsf(z)));
        float la = -expf(F.inp(12)[l * 4 + h]) * sp;
#pragma unroll
        for (int off = 1; off < 64; off <<= 1) { const float t = __shfl_up(la, off); if (i >= off) la += t; }
        const float glast = __shfl(la, 63);
        sGam[i] = la; sBeta[i] = beta; sEg[i] = expf(la); sEd[i] = expf(glast - la);
        if (i == 63) CD[0] = expf(la);
    }
    __syncthreads();
    TS_END(2)
    TS_BEGIN(3)
#pragma unroll
    for (int rr = 0; rr < 8; ++rr) {
        const int i = 8 * F.wave + rr;
        const float q0 = sQ[i * 128 + F.lane], q1 = sQ[i * 128 + 64 + F.lane], k0 = sK[i * 128 + F.lane], k1 = sK[i * 128 + 64 + F.lane];
        const float rq = (1.0f / sqrtf(wave_sum(q0 * q0 + q1 * q1) + EPS)) * 0.08838834764831845f;
        const float rk = 1.0f / sqrtf(wave_sum(k0 * k0 + k1 * k1) + EPS);
        sQ[i * 128 + F.lane] = q0 * rq; sQ[i * 128 + 64 + F.lane] = q1 * rq; sK[i * 128 + F.lane] = k0 * rk; sK[i * 128 + 64 + F.lane] = k1 * rk;
    }
    __syncthreads();
    TS_END(3)
    TS_BEGIN(4)
    {
        const int i = F.tid >> 3, cb = (F.tid & 7) * 16;
        f32x4 q[4], k[4];
#pragma unroll
        for (int t = 0; t < 4; ++t) { q[t] = *(LAS f32x4*)(sQ + i * 128 + cb + 4 * t); k[t] = *(LAS f32x4*)(sK + i * 128 + cb + 4 * t); }
        *(LAS v4u*)(sQb + i * 136 + cb) = cpk8(q[0].x, q[0].y, q[0].z, q[0].w, q[1].x, q[1].y, q[1].z, q[1].w);
        *(LAS v4u*)(sQb + i * 136 + cb + 8) = cpk8(q[2].x, q[2].y, q[2].z, q[2].w, q[3].x, q[3].y, q[3].z, q[3].w);
        *(LAS v4u*)(sKb + i * 136 + cb) = cpk8(k[0].x, k[0].y, k[0].z, k[0].w, k[1].x, k[1].y, k[1].z, k[1].w);
        *(LAS v4u*)(sKb + i * 136 + cb + 8) = cpk8(k[2].x, k[2].y, k[2].z, k[2].w, k[3].x, k[3].y, k[3].z, k[3].w);
    }
#pragma unroll
    for (int it = 0; it < 2; ++it) {
        const int item = F.tid + 512 * it, f = item >> 6, ln = item & 63, r = ln & 31, hh = ln >> 5;
        const int rt = f >> 3, kt = (f >> 1) & 3, s = f & 1, i = 32 * rt + r, d0 = 32 * kt + 16 * s + 4 * hh;
        const float eg = sEg[i];
        const f32x4 a = *(LAS f32x4*)(sQ + i * 128 + d0), c = *(LAS f32x4*)(sQ + i * 128 + d0 + 8);
        *(v4u*)(rec + REC_QD / 2 + f * 512 + ln * 8) = cpk8(a.x * eg, a.y * eg, a.z * eg, a.w * eg, c.x * eg, c.y * eg, c.z * eg, c.w * eg);
    }
#pragma unroll
    for (int it = 0; it < 2; ++it) {
        const int item = F.tid + 512 * it, f = item >> 6, ln = item & 63, r = ln & 31, hh = ln >> 5;
        const int a = f >> 2, t = (f >> 1) & 1, s = f & 1, dk = 32 * a + r, j0 = 32 * t + 16 * s + 4 * hh;
        float kv[8];
#pragma unroll
        for (int jj = 0; jj < 8; ++jj) { const int j = j0 + 8 * (jj >> 2) + (jj & 3); kv[jj] = sK[j * 128 + dk] * sEd[j]; }
        *(v4u*)(rec + REC_KDT / 2 + f * 512 + ln * 8) = cpk8(kv[0], kv[1], kv[2], kv[3], kv[4], kv[5], kv[6], kv[7]);
    }
    __syncthreads();
    TS_END(4)
    TS_BEGIN(5)
    {
        const int mat = F.wave >> 2, ti = (F.wave >> 1) & 1, tj = F.wave & 1, r = F.lane & 31, hh = F.lane >> 5;
        f32x16 acc;
#pragma unroll
        for (int e = 0; e < 16; ++e) acc[e] = 0.f;
        if (!(ti == 0 && tj == 1)) {
            const LAS bf16* Ab = sKb + (32 * (mat ? tj : ti) + r) * 136 + 8 * hh;
            const LAS bf16* Bb = (mat ? sQb + (32 * ti + r) * 136 : sKb + (32 * tj + r) * 136) + 8 * hh;
#pragma unroll
            for (int s = 0; s < 8; ++s) { const bf16x8 a = *(const LAS bf16x8*)(Ab + 16 * s), bb = *(const LAS bf16x8*)(Bb + 16 * s); acc = MFMA32(a, bb, acc); }
        }
        if (mat == 0) {
            const int j = 32 * tj + r; const float gj = sGam[j];
#pragma unroll
            for (int e = 0; e < 16; ++e) { const int i = 32 * ti + crow(e, hh); sA[i * 64 + j] = (j < i) ? sBeta[i] * acc[e] * expf(sGam[i] - gj) : 0.f; }
        } else {
            const int i = 32 * ti + r; const float gi = sGam[i];
            float v[16];
#pragma unroll
            for (int e = 0; e < 16; ++e) { const int j = 32 * tj + crow(e, hh); v[e] = (j <= i) ? acc[e] * expf(gi - sGam[j]) : 0.f; }
            bf16* qk = rec + REC_QK / 2 + ((ti * 2 + tj) * 2) * 512 + F.lane * 8;
            *(v4u*)qk = cpk8(v[0], v[1], v[2], v[3], v[4], v[5], v[6], v[7]);
            *(v4u*)(qk + 512) = cpk8(v[8], v[9], v[10], v[11], v[12], v[13], v[14], v[15]);
        }
    }
    __syncthreads();
    TS_END(5)
    TS_BEGIN(6)
    if (F.wave < 4) {
        const int col = F.tid & 127; const bool isw = F.wave >= 2;
        const LAS float* src = (isw ? sK : sV) + col;
        float sol[64];
        dn_solve_rows<0>(sol, sA, sBeta, sEg, src, isw);
        if (!isw) {
            bf16* ub = Uo + ((col >> 5) * 2) * 1024 + (col & 31) * 8;
#pragma unroll
            for (int t = 0; t < 2; ++t)
#pragma unroll
                for (int hh = 0; hh < 2; ++hh) { bf16* p = ub + t * 1024 + hh * 256;
                    *(v4u*)p = cpk8(sol[32 * t + 4 * hh + 0], sol[32 * t + 4 * hh + 1], sol[32 * t + 4 * hh + 2], sol[32 * t + 4 * hh + 3], sol[32 * t + 4 * hh + 8], sol[32 * t + 4 * hh + 9], sol[32 * t + 4 * hh + 10], sol[32 * t + 4 * hh + 11]);
                    *(v4u*)(p + 512) = cpk8(sol[32 * t + 4 * hh + 16], sol[32 * t + 4 * hh + 17], sol[32 * t + 4 * hh + 18], sol[32 * t + 4 * hh + 19], sol[32 * t + 4 * hh + 24], sol[32 * t + 4 * hh + 25], sol[32 * t + 4 * hh + 26], sol[32 * t + 4 * hh + 27]); }
        } else {
            LAS bf16* wrow = sQb + col;
#pragma unroll
            for (int i = 0; i < 64; ++i) wrow[i * 136] = (bf16)(cpk2(sol[i], 0.f) & 0xffffu);
        }
    }
    __syncthreads();
    TS_END(6)
    TS_BEGIN(7)
#pragma unroll
    for (int it = 0; it < 2; ++it) {
        const int item = F.tid + 512 * it, f = item >> 6, ln = item & 63, r = ln & 31, hh = ln >> 5;
        const int rt = f >> 3, kt = (f >> 1) & 3, s = f & 1;
        const LAS bf16* wp = sQb + (32 * rt + r) * 136 + 32 * kt + 16 * s + 4 * hh;
        const u32x2 lo = *(const LAS u32x2*)wp, hi = *(const LAS u32x2*)(wp + 8);
        v4u o; o.x = lo.x; o.y = lo.y; o.z = hi.x; o.w = hi.y;
        *(v4u*)(rec + REC_W / 2 + f * 512 + ln * 8) = o;
    }
    __syncthreads();
    TS_END(7)
  }
}

#define DN_BAR() do { asm volatile("s_waitcnt lgkmcnt(0)" ::: "memory"); __builtin_amdgcn_s_barrier(); asm volatile("" ::: "memory"); } while (0)
__device__ __forceinline__ void dn_scan(Frame& F, int l, int bh) {
    LAS unsigned char* ring = F.lds;
    const unsigned char* recs = F.ws + WS_REC + (size_t)(bh * 64) * REC_BYTES;
    if (F.wave >= 4) {
        const int v = F.wave - 4;
#define DN_DMA(n_) do { const unsigned char* src_ = recs + (size_t)(n_) * REC_BYTES + v * 1024 + F.lane * 16; LAS unsigned char* dst_ = ring + ((n_) & 1) * (int)REC_BYTES + v * 1024; \
        _Pragma("unroll") for (int q_ = 0; q_ < 19; ++q_) if (v + 4 * q_ < 73) __builtin_amdgcn_global_load_lds((const unsigned*)(src_ + q_ * 4096), (LAS unsigned*)(dst_ + q_ * 4096), 16, 0, 0); } while (0)
        DN_DMA(0);
        asm volatile("s_waitcnt vmcnt(0)" ::: "memory");
        DN_BAR();
        for (int n = 0; n < 64; ++n) {
            if (n + 1 < 64) DN_DMA(n + 1);
            asm volatile("s_waitcnt vmcnt(0)" ::: "memory");
            DN_BAR();
        }
#undef DN_DMA
    } else {
        const int w = F.wave;
        f32x16 S0, S1, S2, S3;
#pragma unroll
        for (int e = 0; e < 16; ++e) { S0[e] = 0.f; S1[e] = 0.f; S2[e] = 0.f; S3[e] = 0.f; }
        bf16* Ob = (bf16*)(F.ws + WS_O) + (size_t)(bh * 64) * 8192 + (w * 2) * 1024 + F.lane * 8;
        DN_BAR();
        for (int n = 0; n < 64; ++n) {
            const LAS unsigned char* buf = ring + (n & 1) * (int)REC_BYTES + F.lane * 16;
            const float cd = *(const LAS float*)(ring + (n & 1) * (int)REC_BYTES + REC_CD);
#define DN_A(off_, f_) (*(const LAS bf16x8*)(buf + (off_) + (f_) * 1024))
            f32x16 W0, W1, Q0, Q1;
#pragma unroll
            for (int e = 0; e < 16; ++e) { W0[e] = 0.f; W1[e] = 0.f; Q0[e] = 0.f; Q1[e] = 0.f; }
#define DN_KSTEP(Sa_, a_, s_) do { const bf16x8 sb_ = pack_step(Sa_, s_); \
                W0 = MFMA32(DN_A(REC_W, (0 * 4 + (a_)) * 2 + (s_)), sb_, W0); W1 = MFMA32(DN_A(REC_W, (1 * 4 + (a_)) * 2 + (s_)), sb_, W1); \
                Q0 = MFMA32(DN_A(REC_QD, (0 * 4 + (a_)) * 2 + (s_)), sb_, Q0); Q1 = MFMA32(DN_A(REC_QD, (1 * 4 + (a_)) * 2 + (s_)), sb_, Q1); } while (0)
            DN_KSTEP(S0, 0, 0); DN_KSTEP(S0, 0, 1); DN_KSTEP(S1, 1, 0); DN_KSTEP(S1, 1, 1); DN_KSTEP(S2, 2, 0); DN_KSTEP(S2, 2, 1); DN_KSTEP(S3, 3, 0); DN_KSTEP(S3, 3, 1);
#undef DN_KSTEP
            {
                const v4u u00 = *(const LAS v4u*)(buf + REC_U + (w * 2 + 0) * 2048), u01 = *(const LAS v4u*)(buf + REC_U + (w * 2 + 0) * 2048 + 1024);
                const v4u u10 = *(const LAS v4u*)(buf + REC_U + (w * 2 + 1) * 2048), u11 = *(const LAS v4u*)(buf + REC_U + (w * 2 + 1) * 2048 + 1024);
                const unsigned uu0[8] = {u00.x, u00.y, u00.z, u00.w, u01.x, u01.y, u01.z, u01.w}, uu1[8] = {u10.x, u10.y, u10.z, u10.w, u11.x, u11.y, u11.z, u11.w};
#pragma unroll
                for (int e = 0; e < 16; ++e) { const unsigned a0 = uu0[e >> 1], a1 = uu1[e >> 1];
                    W0[e] = ((e & 1) ? __uint_as_float(a0 & 0xffff0000u) : __uint_as_float(a0 << 16)) - W0[e];
                    W1[e] = ((e & 1) ? __uint_as_float(a1 & 0xffff0000u) : __uint_as_float(a1 << 16)) - W1[e]; }
            }
            const bf16x8 ub00 = pack_step(W0, 0), ub01 = pack_step(W0, 1), ub10 = pack_step(W1, 0), ub11 = pack_step(W1, 1);
            Q0 = MFMA32(DN_A(REC_QK, (0 * 2 + 0) * 2 + 0), ub00, Q0); Q0 = MFMA32(DN_A(REC_QK, (0 * 2 + 0) * 2 + 1), ub01, Q0); Q0 = MFMA32(DN_A(REC_QK, (0 * 2 + 1) * 2 + 0), ub10, Q0); Q0 = MFMA32(DN_A(REC_QK, (0 * 2 + 1) * 2 + 1), ub11, Q0);
            Q1 = MFMA32(DN_A(REC_QK, (1 * 2 + 0) * 2 + 0), ub00, Q1); Q1 = MFMA32(DN_A(REC_QK, (1 * 2 + 0) * 2 + 1), ub01, Q1); Q1 = MFMA32(DN_A(REC_QK, (1 * 2 + 1) * 2 + 0), ub10, Q1); Q1 = MFMA32(DN_A(REC_QK, (1 * 2 + 1) * 2 + 1), ub11, Q1);
            S0 = S0 * cd; S1 = S1 * cd; S2 = S2 * cd; S3 = S3 * cd;
#define DN_SUPD(Sa_, a_) do { Sa_ = MFMA32(DN_A(REC_KDT, ((a_) * 2 + 0) * 2 + 0), ub00, Sa_); Sa_ = MFMA32(DN_A(REC_KDT, ((a_) * 2 + 0) * 2 + 1), ub01, Sa_); \
                Sa_ = MFMA32(DN_A(REC_KDT, ((a_) * 2 + 1) * 2 + 0), ub10, Sa_); Sa_ = MFMA32(DN_A(REC_KDT, ((a_) * 2 + 1) * 2 + 1), ub11, Sa_); } while (0)
            DN_SUPD(S0, 0); DN_SUPD(S1, 1); DN_SUPD(S2, 2); DN_SUPD(S3, 3);
#undef DN_SUPD
#undef DN_A
            bf16* op = Ob + (size_t)n * 8192;
            *(v4u*)op = cpk8(Q0[0], Q0[1], Q0[2], Q0[3], Q0[4], Q0[5], Q0[6], Q0[7]); *(v4u*)(op + 512) = cpk8(Q0[8], Q0[9], Q0[10], Q0[11], Q0[12], Q0[13], Q0[14], Q0[15]);
            *(v4u*)(op + 1024) = cpk8(Q1[0], Q1[1], Q1[2], Q1[3], Q1[4], Q1[5], Q1[6], Q1[7]); *(v4u*)(op + 1536) = cpk8(Q1[8], Q1[9], Q1[10], Q1[11], Q1[12], Q1[13], Q1[14], Q1[15]);
            DN_BAR();
        }
    }
}
#undef DN_BAR

__device__ __forceinline__ void dn_finish_unit(Frame& F, int l, int cu, const bf16* P, bf16* MIX) {
    const int b = cu >> 8, h = (cu >> 6) & 3, n = cu & 63, m0 = b * SEQ + n * 64;
    LAS float* sO = (LAS float*)F.lds;
    {
        const int wt = F.wave, w = wt >> 1, t = wt & 1, r = F.lane & 31, hh = F.lane >> 5;
        const bf16* ip = (const bf16*)(F.ws + WS_O) + (size_t)cu * 8192 + wt * 1024 + F.lane * 8;
        const v4u a = *(const v4u*)ip, c = *(const v4u*)(ip + 512);
        const unsigned uu[8] = {a.x, a.y, a.z, a.w, c.x, c.y, c.z, c.w};
#pragma unroll
        for (int e = 0; e < 16; ++e) { const unsigned x = uu[e >> 1]; sO[(32 * t + crow(e, hh)) * 132 + 32 * w + r] = (e & 1) ? __uint_as_float(x & 0xffff0000u) : __uint_as_float(x << 16); }
    }
    __syncthreads();
    const float ng0 = F.inp(14)[l * 128 + 2 * F.lane], ng1 = F.inp(14)[l * 128 + 2 * F.lane + 1];
#pragma unroll
    for (int rr = 0; rr < 8; ++rr) {
        const int i = 8 * F.wave + rr;
        const f32x2_t o = *(const LAS f32x2_t*)(sO + i * 132 + 2 * F.lane);
        const unsigned g = *((const unsigned*)(P + (size_t)(m0 + i) * NP + 2560 + h * 128) + F.lane);
        const float rs = 1.0f / sqrtf(wave_sum(o.x * o.x + o.y * o.y) * (1.0f / 128.0f) + EPS);
        const float g0 = __uint_as_float(g << 16), g1 = __uint_as_float(g & 0xffff0000u);
        *((unsigned*)(MIX + (size_t)(m0 + i) * D + 512 + h * 128) + F.lane) = cpk2(o.x * rs * ng0 * (g0 * sigmoidf_(g0)), o.y * rs * ng1 * (g1 * sigmoidf_(g1)));
    }
    __syncthreads();
}
struct Args { const float* in[21]; float* out; unsigned char* ws; int ph_lo, ph_hi; };
constexpr int PH_PER_LAYER = 9, N_PHASES = 1 + PH_PER_LAYER * DEPTH;

#define RELAUNDER(Fx) do { asm volatile("" : "+v"((Fx).tid)); (Fx).lane = (Fx).tid & 63; (Fx).wave = __builtin_amdgcn_readfirstlane((Fx).tid >> 6); } while (0)
__global__ void __launch_bounds__(NWAVES * 64, 2) mk_fwd(Args args) {
    extern __shared__ __attribute__((aligned(16))) unsigned char lds[];
    {
        volatile LAS unsigned* MISC0 = (volatile LAS unsigned*)((LAS unsigned char*)lds + MISC_OFF);
        if (threadIdx.x < 32) MISC0[threadIdx.x] = 0u;
    }
    __syncthreads();
    const int lo = args.ph_lo, hi = args.ph_hi;
    XcdBarrier bar; bar.bar = (unsigned*)(args.ws + WS_CTL) + CW_BAR; bar.x = 0; bar.st = nullptr;
    if (hi - lo > 1) bar = xcd_barrier_post((unsigned*)(args.ws + WS_CTL) + CW_BAR, (volatile LAS unsigned*)((LAS unsigned char*)lds + MISC_OFF) + 8);

    for (int ph = lo; ph < hi; ++ph) {
      for (int rep = 0; rep < 2; ++rep) {
        if (rep == 1 && !(ph > 0 && ((MK_REP >> ((ph - 1) % PH_PER_LAYER)) & 1))) break;
        int tid = threadIdx.x; asm volatile("" : "+v"(tid));
        Frame F;
        F.kp = (const AS4 unsigned char*)__builtin_amdgcn_kernarg_segment_ptr(); asm volatile("" : "+s"(F.kp));
        F.lds = (LAS unsigned char*)lds;
        F.tid = tid; F.lane = tid & 63; F.wave = __builtin_amdgcn_readfirstlane(tid >> 6);
        F.G = gridDim.x; { const int bx = blockIdx.x; F.vcu = (F.G % 8 == 0) ? (bx % 8) * (F.G / 8) + bx / 8 : bx; }
        F.out = *(float* const AS4*)(F.kp + 168); F.ws = *(unsigned char* const AS4*)(F.kp + 176);
        bf16* HN = (bf16*)(F.ws + WS_HN); bf16* MIX = HN; bf16* P = (bf16*)(F.ws + WS_P); bf16* HFF = P;
        float* BA = (float*)(F.ws + WS_BA);
        if (ph == 0) {
            weights_phase(F);
            norm_phase<0>(F, F.inp(0), F.inp(1), HN, F.inp(2), BA, nullptr);
        } else {
#ifdef MK_ONLY_K
            const int l = (ph - 1) / PH_PER_LAYER, k = MK_ONLY_K;
#else
            const int l = (ph - 1) / PH_PER_LAYER, k = (ph - 1) % PH_PER_LAYER;
#endif
            const unsigned char* wb = F.ws + WS_W + (size_t)l * W_LAYER;
            if (k == 0) {
                pg8::Gemm g{(const pg8::bf16_t*)HN, (const pg8::bf16_t*)(wb + W_IN_OFF), M, NP, D}; pg8::StaticOrder S; S.init(M, NP, F.G, (int)blockIdx.x);
                pg8::EpiBf16<0> E{(pg8::bf16_t*)P, NP, nullptr, 0, 0, 1.f};
                pg8::gemm_phase<pg8::EpiBf16<0>, pg8::StaticOrder, true, true>(F.lds, g, S, E, tid);
            } else if (k == 1) {
                const int sub = rep ? MK_REPSUB : MK_SUB;
                if (sub & 1) dn_chunk_units(F, l, (int)blockIdx.x, F.G, P, BA, rep ? MK_DNSTEP : 9);
            } else if (k == 2) {
                if ((int)blockIdx.x < BATCH * 4) dn_scan(F, l, (int)blockIdx.x);
                else for (int v = (int)blockIdx.x - BATCH * 4; v < M / 128 + M / 64; v += F.G - BATCH * 4) { Frame Fu = F; RELAUNDER(Fu);
                    if (v < M / 128) gmlp_unit(Fu, l, v, P, MIX); else conv_unit(Fu, l, v - M / 128, P, MIX); }
            } else if (k == 3) {
                for (int u = blockIdx.x; u < NCHUNK; u += F.G) { Frame Fu = F; RELAUNDER(Fu); dn_finish_unit(Fu, l, u, P, MIX); }
            } else if (k == 4 || k == 7) {
                const float* base = (l == 0 && k == 4) ? F.inp(0) : F.out;
                pg8::Gemm g{(const pg8::bf16_t*)(k == 4 ? MIX : HFF), (const pg8::bf16_t*)(wb + (k == 4 ? W_O_OFF : W_D_OFF)), M, D, k == 4 ? D : DFF}; pg8::StaticOrder S; S.init(M, D, F.G, (int)blockIdx.x);
                pg8::EpiRes E{base, rep ? (float*)(F.ws + WS_REC) : F.out, D};
                pg8::gemm_phase<pg8::EpiRes, pg8::StaticOrder, true, true>(F.lds, g, S, E, tid);
            } else if (k == 5) {
                norm_phase<0>(F, F.out, F.inp(16) + l * D, HN, nullptr, nullptr, nullptr);
            } else if (k == 6) {
                pg8::Gemm g{(const pg8::bf16_t*)HN, (const pg8::bf16_t*)(wb + W_GU_OFF), M, 2 * DFF, D}; pg8::StaticOrder S; S.init(M, 2 * DFF, F.G, (int)blockIdx.x);
                pg8::EpiSwiGLU E{(pg8::bf16_t*)HFF, DFF};
                pg8::gemm_phase<pg8::EpiSwiGLU, pg8::StaticOrder, true, true>(F.lds, g, S, E, tid);
            } else {
                if (l + 1 < DEPTH) norm_phase<0>(F, F.out, F.inp(1) + (l + 1) * D, HN, F.inp(2) + (size_t)(l + 1) * D * DPROJ, BA, nullptr);
                else norm_phase<1>(F, F.out, F.inp(20), nullptr, nullptr, nullptr, F.out);
            }
        }
      }
        if (ph + 1 < hi) xcd_barrier(bar);
    }
}

#ifndef MK_SINGLE
#define MK_SINGLE 0
#endif

extern "C" void kernel_launch(void* const* d_in, const int* in_sizes, int n_in, void* d_out, int out_size, void* d_ws, size_t ws_size, hipStream_t stream) {
    static int grid = 0;
    if (grid == 0) {
        if (n_in != 21 || in_sizes[0] != M * D || out_size != M * D || ws_size < WS_END) { fprintf(stderr, "kernel_launch: unexpected shapes (n_in %d, in0 %d, out %d, ws %zu)\n", n_in, n_in > 0 ? in_sizes[0] : -1, out_size, ws_size); grid = -1; return; }
        int dev = 0, cus = 0, per_cu = 0;
        if (hipGetDevice(&dev) != hipSuccess || hipDeviceGetAttribute(&cus, hipDeviceAttributeMultiprocessorCount, dev) != hipSuccess) { grid = -1; return; }
        if (hipFuncSetAttribute((const void*)mk_fwd, hipFuncAttributeMaxDynamicSharedMemorySize, LDS_BYTES) != hipSuccess) { fprintf(stderr, "kernel_launch: hipFuncSetAttribute failed\n"); grid = -1; return; }
        if (hipOccupancyMaxActiveBlocksPerMultiprocessor(&per_cu, (const void*)mk_fwd, NWAVES * 64, LDS_BYTES) != hipSuccess || per_cu < 1) { fprintf(stderr, "kernel_launch: occupancy query says %d blocks per CU\n", per_cu); per_cu = 1; }
        (void)hipGetLastError();
        grid = cus;
        if (grid % 8 != 0 || grid < 32) fprintf(stderr, "kernel_launch: unexpected CU count %d\n", grid);
    }
    if (grid < 0) return;
    (void)hipMemsetAsync((char*)d_ws + WS_CTL, 0, CTL_ZERO_BYTES, stream);
    Args a{};
    for (int i = 0; i < 21; ++i) a.in[i] = (const float*)d_in[i];
    a.out = (float*)d_out; a.ws = (unsigned char*)d_ws;
#if MK_SINGLE
    a.ph_lo = 0; a.ph_hi = N_PHASES;
    hipLaunchKernelGGL(mk_fwd, dim3(grid), dim3(NWAVES * 64), LDS_BYTES, stream, a);
#else
    for (int ph = 0; ph < MK_PH_HI; ++ph) { a.ph_lo = ph; a.ph_hi = ph + 1; hipLaunchKernelGGL(mk_fwd, dim3(grid), dim3(NWAVES * 64), LDS_BYTES, stream, a); }
#endif
}
```

```cpp
#include <hip/hip_runtime.h>
#include <cstdio>
#include <cstdint>
#include <cmath>
#define MK_SINGLE 1
namespace pg8 {
#define PG8_LAS __attribute__((address_space(3)))
typedef unsigned short bf16_t;
typedef short bf16x8 __attribute__((ext_vector_type(8)));
typedef float f32x4 __attribute__((ext_vector_type(4)));
typedef unsigned u32x4 __attribute__((ext_vector_type(4)));
constexpr int BM = 256, BK = 64, HALF = 128, HTB = HALF * BK * 2  , STAGE_BYTES = 8 * HTB, NXCD = 8, WGM = 8;

__host__ __device__ __forceinline__ int lds_byte(int r, int c) { const int st = (r >> 4) * 2 + (c >> 5), rr = r & 15, cc = c & 31, ob = rr * 64 + cc * 2; return st * 1024 + (ob ^ (((ob >> 9) & 1) << 5)); }
__host__ __device__ __forceinline__ void stage_rc(int b, int& R, int& C) { const int st = b / 1024, sb = b % 1024, swz = sb ^ (((sb >> 9) & 1) << 5); R = (st >> 1) * 16 + swz / 64; C = (st & 1) * 32 + (swz % 64) / 2; }
__host__ __device__ __forceinline__ int perm32(int rho) { const int n = rho >> 4, i = rho & 15; return 8 * (i >> 2) + 4 * n + (i & 3); }

struct Unit { int pm, pn; };
struct Gemm { const bf16_t* A; const bf16_t* Bt; int M, N, K; };

struct StaticOrder {
    int nM, nN, nwg, G, c;
    __host__ __device__ void init(int M, int N, int G_, int c_) { nM = M / BM; nN = N / BM; nwg = nM * nN; G = G_; c = c_; }
    __host__ __device__ bool next(int i, Unit& u) const {
        const long L = (long)i * G + c; if (L >= nwg) return false;
        int wgid = (int)L; { const int q = nwg / NXCD, r = nwg % NXCD, xcd = wgid % NXCD, off = wgid / NXCD; wgid = (xcd < r ? xcd * (q + 1) : r * (q + 1) + (xcd - r) * q) + off; }
        const int nig = WGM * nN, gid = wgid / nig, fm = gid * WGM, gsz = (nM - fm) < WGM ? (nM - fm) : WGM;
        u.pm = fm + ((wgid % nig) % gsz); u.pn = (wgid % nig) / gsz; return true;
    }
    __device__ __forceinline__ void a_ready(const Unit&) const {}
    __device__ __forceinline__ void done(const Unit&) const {}
};

__device__ __forceinline__ unsigned cvt_pk_bf16(float lo, float hi) { unsigned r; asm volatile("v_cvt_pk_bf16_f32 %0, %1, %2" : "=v"(r) : "v"(lo), "v"(hi)); return r; }
typedef float f32x2 __attribute__((ext_vector_type(2)));
__device__ __forceinline__ f32x2 gelu_pk(f32x2 v) {
    const f32x2 av = __builtin_elementwise_abs(v), d = av * 0.2316418882f + 1.0f;
    f32x2 t; t.x = __builtin_amdgcn_rcpf(d.x); t.y = __builtin_amdgcn_rcpf(d.y);
    f32x2 q = t * 0.5307027145f + (-0.7265760135f); q = q * t + 0.7107068705f; q = q * t + (-0.142248368f); q = q * t + 0.127414796f; q = q * t;
    const f32x2 s = (v * v) * (-0.72134752044f);
    f32x2 e; e.x = __builtin_amdgcn_exp2f(s.x); e.y = __builtin_amdgcn_exp2f(s.y);
    const f32x2 m = v * (q * e), r = v - m;
    f32x2 o; o.x = v.x < 0.f ? m.x : r.x; o.y = v.y < 0.f ? m.y : r.y; return o;
}

template <int ACT  > struct EpiBf16 {
    static constexpr bool PERM = true, AFTER_DRAIN = false; static_assert(ACT == 0 || ACT == 1, "EpiBf16: ACT is 0 (none) or 1 (gelu_pk)");
    bf16_t* O; int ldc; const float* bias; int split_cols; size_t split_stride; float scale0;
    __device__ __forceinline__ void operator()(const f32x4 (&acc)[2][2][4][2], const Unit& u, int wr, int wc, int fr, int fq) const {
        const int row0 = u.pm * BM + wr * 64 + fr; int colt = u.pn * BM; bf16_t* base = O;
        float sc = 1.f; if (split_cols) { const int t = colt / split_cols; base += (size_t)t * split_stride; colt -= t * split_cols; if (t == 0) sc = scale0; }
        const int col0 = colt + wc * 32 + 8 * fq, bcol0 = u.pn * BM + wc * 32 + 8 * fq;
        f32x4 bv[2][2];
#pragma unroll
        for (int bj = 0; bj < 2; ++bj)
#pragma unroll
            for (int n = 0; n < 2; ++n) bv[bj][n] = bias ? *(const f32x4*)(bias + bcol0 + bj * HALF + 4 * n) : (f32x4){0.f, 0.f, 0.f, 0.f};
#pragma unroll
        for (int ai = 0; ai < 2; ++ai)
#pragma unroll
            for (int m = 0; m < 4; ++m) { bf16_t* rowp = base + (size_t)(row0 + ai * HALF + m * 16) * ldc + col0;
#pragma unroll
                for (int bj = 0; bj < 2; ++bj) { f32x4 v0 = acc[ai][bj][m][0] + bv[bj][0], v1 = acc[ai][bj][m][1] + bv[bj][1];
                    if (ACT == 1) { f32x2 a = gelu_pk((f32x2){v0[0], v0[1]}), b = gelu_pk((f32x2){v0[2], v0[3]}), c = gelu_pk((f32x2){v1[0], v1[1]}), d = gelu_pk((f32x2){v1[2], v1[3]});
                        v0 = (f32x4){a.x, a.y, b.x, b.y}; v1 = (f32x4){c.x, c.y, d.x, d.y}; }
                    v0 = v0 * sc; v1 = v1 * sc; u32x4 w; w.x = cvt_pk_bf16(v0[0], v0[1]); w.y = cvt_pk_bf16(v0[2], v0[3]); w.z = cvt_pk_bf16(v1[0], v1[1]); w.w = cvt_pk_bf16(v1[2], v1[3]);
                    *(u32x4*)(rowp + bj * HALF) = w; } }
    }
};
struct EpiRes {
    static constexpr bool PERM = false, AFTER_DRAIN = false;
    const float* base; float* out; int ldc;
    __device__ __forceinline__ void operator()(const f32x4 (&acc)[2][2][4][2], const Unit& u, int wr, int wc, int fr, int fq) const {
        const int row0 = u.pm * BM + wr * 64 + fr, col0 = u.pn * BM + wc * 32 + 4 * fq;
#pragma unroll
        for (int ai = 0; ai < 2; ++ai)
#pragma unroll
            for (int m = 0; m < 4; ++m) { const size_t off = (size_t)(row0 + ai * HALF + m * 16) * ldc + col0;
#pragma unroll
                for (int bj = 0; bj < 2; ++bj)
#pragma unroll
                    for (int n = 0; n < 2; ++n) { const f32x4 bs = *(const f32x4*)(base + off + bj * HALF + n * 16); *(f32x4*)(out + off + bj * HALF + n * 16) = bs + acc[ai][bj][m][n]; } }
    }
};
struct EpiSwiGLU {
    static constexpr bool PERM = true, AFTER_DRAIN = false;
    bf16_t* O; int ldo;
    __device__ __forceinline__ void operator()(const f32x4 (&acc)[2][2][4][2], const Unit& u, int wr, int wc, int fr, int fq) const {
        const int row0 = u.pm * BM + wr * 64 + fr, col0 = u.pn * HALF + wc * 32 + 8 * fq;
#pragma unroll
        for (int ai = 0; ai < 2; ++ai)
#pragma unroll
            for (int m = 0; m < 4; ++m) { bf16_t* rowp = O + (size_t)(row0 + ai * HALF + m * 16) * ldo + col0;
                float r[8];
#pragma unroll
                for (int n = 0; n < 2; ++n)
#pragma unroll
                    for (int e = 0; e < 4; ++e) { const float g = acc[ai][0][m][n][e], up = acc[ai][1][m][n][e]; r[4 * n + e] = g * __builtin_amdgcn_rcpf(1.0f + __expf(-g)) * up; }
                u32x4 w; w.x = cvt_pk_bf16(r[0], r[1]); w.y = cvt_pk_bf16(r[2], r[3]); w.z = cvt_pk_bf16(r[4], r[5]); w.w = cvt_pk_bf16(r[6], r[7]);
                *(u32x4*)rowp = w; }
    }
};
template <class Epi, class Sched, bool ALIGN_EPI = false, bool SP2 = false>
__device__ __forceinline__ void gemm_phase(PG8_LAS unsigned char* lds, const Gemm g, const Sched& S, const Epi& E, const int tid) {
    const int wid = __builtin_amdgcn_readfirstlane(tid >> 6), lane = tid & 63, wr = wid >> 2, wc = wid & 3, fr = lane & 15, fq = lane >> 4;
    const int K = g.K, nt = K / BK;
    unsigned voffA[2], voffB[2];
#pragma unroll
    for (int i = 0; i < 2; ++i) { int R, C; stage_rc(tid * 16 + i * 8192, R, C); const int Rb = Epi::PERM ? ((R & ~31) + perm32(R & 31)) : R;
        voffA[i] = (unsigned)(R * K + C) * 2u; voffB[i] = (unsigned)(Rb * K + C) * 2u; }
    const size_t kstep = (size_t)(BK * 2);
    const size_t hstep = (size_t)HALF * K * 2;
    const size_t tstep = 2 * hstep;
    const unsigned ldsw = (unsigned)wid * 1024u;
    const int aoff = lds_byte(wr * 64 + fr, fq * 8), boff = lds_byte(wc * 32 + fr, fq * 8);
#define PG8_SA(b, h) (((b) * 2 + (h)) * HTB)
#define PG8_SB(b, h) ((4 + (b) * 2 + (h)) * HTB)
#define PG8_STAGE(bufoff, gbase, voff) do { _Pragma("unroll") for (int _i = 0; _i < 2; ++_i) \
        __builtin_amdgcn_global_load_lds((const unsigned*)((const char*)(gbase) + (voff)[_i]), (PG8_LAS unsigned*)(lds + (bufoff) + ldsw + _i * 8192), 16, 0, 0); } while (0)
#define PG8_LDA(dst, b, h) do { _Pragma("unroll") for (int m = 0; m < 4; ++m) _Pragma("unroll") for (int k = 0; k < 2; ++k) dst[m][k] = *(const PG8_LAS bf16x8*)(lds + PG8_SA(b, h) + aoff + m * 2048 + k * 1024); } while (0)
#define PG8_LDB(dst, b, h) do { _Pragma("unroll") for (int n = 0; n < 2; ++n) _Pragma("unroll") for (int k = 0; k < 2; ++k) dst[n][k] = *(const PG8_LAS bf16x8*)(lds + PG8_SB(b, h) + boff + n * 2048 + k * 1024); } while (0)
#define PG8_MMA(ai, bj, At, Bt) do { __builtin_amdgcn_s_setprio(1); _Pragma("unroll") for (int m = 0; m < 4; ++m) _Pragma("unroll") for (int n = 0; n < 2; ++n) _Pragma("unroll") for (int k = 0; k < 2; ++k) \
        acc[ai][bj][m][n] = __builtin_amdgcn_mfma_f32_16x16x32_bf16(Bt[n][k], At[m][k], acc[ai][bj][m][n], 0, 0, 0); __builtin_amdgcn_s_setprio(0); } while (0)
#define PG8_WAIT_V(n) asm volatile("s_waitcnt vmcnt(" #n ")" ::: "memory")
#define PG8_WAIT_L(n) asm volatile("s_waitcnt lgkmcnt(" #n ")" ::: "memory")
#define PG8_BAR __builtin_amdgcn_s_barrier()
#define PG8_SCHED __builtin_amdgcn_sched_barrier(0)
    Unit cur, nxt; int ui = 0;
    if (!S.next(0, cur)) return;
    f32x4 acc[2][2][4][2];
#pragma unroll
    for (int a = 0; a < 2; ++a)
#pragma unroll
        for (int b = 0; b < 2; ++b)
#pragma unroll
            for (int m = 0; m < 4; ++m)
#pragma unroll
                for (int n = 0; n < 2; ++n) acc[a][b][m][n] = (f32x4){0.f, 0.f, 0.f, 0.f};
    bf16x8 At[4][2], B0[2][2], B1[2][2];
    const char* cA = (const char*)g.A + (size_t)cur.pm * tstep; const char* cB = (const char*)g.Bt + (size_t)cur.pn * tstep;
    S.a_ready(cur);
    if constexpr (SP2) {
        PG8_STAGE(PG8_SB(0, 0), cB, voffB); PG8_STAGE(PG8_SB(0, 1), cB + hstep, voffB); PG8_STAGE(PG8_SA(0, 0), cA, voffA); PG8_STAGE(PG8_SA(0, 1), cA + hstep, voffA);
        if (wr == 1) PG8_BAR;
        PG8_WAIT_V(2); PG8_BAR;
        PG8_STAGE(PG8_SB(1, 0), cB + kstep, voffB); PG8_STAGE(PG8_SA(1, 0), cA + kstep, voffA); PG8_STAGE(PG8_SB(1, 1), cB + hstep + kstep, voffB);
        PG8_WAIT_V(6); PG8_BAR;
    } else {
        PG8_STAGE(PG8_SB(0, 0), cB, voffB); PG8_STAGE(PG8_SA(0, 0), cA, voffA); PG8_STAGE(PG8_SB(0, 1), cB + hstep, voffB); PG8_STAGE(PG8_SA(0, 1), cA + hstep, voffA);
        if (wr == 1) PG8_BAR;
        PG8_WAIT_V(4); PG8_BAR;
        PG8_STAGE(PG8_SB(1, 0), cB + kstep, voffB); PG8_STAGE(PG8_SA(1, 0), cA + kstep, voffA); PG8_STAGE(PG8_SB(1, 1), cB + hstep + kstep, voffB);
        PG8_WAIT_V(6); PG8_BAR;
    }
    for (;;) {
        const bool has_next = S.next(ui + 1, nxt);
        const char* nA = has_next ? (const char*)g.A + (size_t)nxt.pm * tstep : cA; const char* nB = has_next ? (const char*)g.Bt + (size_t)nxt.pn * tstep : cB;
        for (int t = 0; t < nt; t += 2) {
            const bool last = (t == nt - 2);
            const char* a1 = cA + (size_t)(t + 1) * kstep;
            const char* a2 = last ? nA : cA + (size_t)(t + 2) * kstep; const char* b2 = last ? nB : cB + (size_t)(t + 2) * kstep;
            const char* a3 = a2 + kstep; const char* b3 = b2 + kstep;
            if (last && has_next) S.a_ready(nxt);
            if constexpr (SP2) {
            PG8_LDB(B0, 0, 0); PG8_LDB(B1, 0, 1); PG8_SCHED; PG8_LDA(At, 0, 0); PG8_STAGE(PG8_SA(1, 1), a1 + hstep, voffA);
            PG8_WAIT_V(8); PG8_WAIT_L(0); PG8_BAR; PG8_MMA(0, 0, At, B0); PG8_MMA(0, 1, At, B1); PG8_BAR; PG8_SCHED;
            PG8_LDA(At, 0, 1); PG8_STAGE(PG8_SB(0, 0), b2, voffB); PG8_STAGE(PG8_SB(0, 1), b2 + hstep, voffB); PG8_STAGE(PG8_SA(0, 0), a2, voffA);
            PG8_WAIT_V(8); PG8_WAIT_L(0); PG8_BAR; PG8_MMA(1, 0, At, B0); PG8_MMA(1, 1, At, B1); PG8_BAR; PG8_SCHED;
            PG8_LDB(B0, 1, 0); PG8_LDB(B1, 1, 1); PG8_SCHED; PG8_LDA(At, 1, 0); PG8_STAGE(PG8_SA(0, 1), a2 + hstep, voffA);
            PG8_WAIT_V(8); PG8_WAIT_L(0); PG8_BAR; PG8_MMA(0, 0, At, B0); PG8_MMA(0, 1, At, B1); PG8_BAR; PG8_SCHED;
            PG8_LDA(At, 1, 1); PG8_STAGE(PG8_SB(1, 0), b3, voffB); PG8_STAGE(PG8_SB(1, 1), b3 + hstep, voffB); PG8_STAGE(PG8_SA(1, 0), a3, voffA);
            PG8_WAIT_V(8); PG8_WAIT_L(0); PG8_BAR; PG8_MMA(1, 0, At, B0); PG8_MMA(1, 1, At, B1); PG8_BAR; PG8_SCHED;
            } else {
            PG8_LDB(B0, 0, 0); PG8_SCHED; PG8_LDA(At, 0, 0); PG8_STAGE(PG8_SA(1, 1), a1 + hstep, voffA);
            PG8_WAIT_L(8); PG8_BAR; PG8_WAIT_L(0); PG8_MMA(0, 0, At, B0); PG8_BAR; PG8_SCHED;
            PG8_LDB(B1, 0, 1); PG8_STAGE(PG8_SB(0, 0), b2, voffB);
            PG8_BAR; PG8_WAIT_L(0); PG8_MMA(0, 1, At, B1); PG8_BAR;
            PG8_LDA(At, 0, 1); PG8_STAGE(PG8_SA(0, 0), a2, voffA);
            PG8_BAR; PG8_WAIT_L(0); PG8_MMA(1, 0, At, B0); PG8_BAR; PG8_SCHED;
            PG8_STAGE(PG8_SB(0, 1), b2 + hstep, voffB);
            PG8_WAIT_V(6); PG8_BAR; PG8_MMA(1, 1, At, B1); PG8_BAR;
            PG8_LDB(B0, 1, 0); PG8_SCHED; PG8_LDA(At, 1, 0); PG8_STAGE(PG8_SA(0, 1), a2 + hstep, voffA);
            PG8_WAIT_L(8); PG8_BAR; PG8_WAIT_L(0); PG8_MMA(0, 0, At, B0); PG8_BAR; PG8_SCHED;
            PG8_LDB(B1, 1, 1); PG8_STAGE(PG8_SB(1, 0), b3, voffB);
            PG8_BAR; PG8_WAIT_L(0); PG8_MMA(0, 1, At, B1); PG8_BAR;
            PG8_LDA(At, 1, 1); PG8_STAGE(PG8_SA(1, 0), a3, voffA);
            PG8_BAR; PG8_WAIT_L(0); PG8_MMA(1, 0, At, B0); PG8_BAR; PG8_SCHED;
            PG8_STAGE(PG8_SB(1, 1), b3 + hstep, voffB);
            PG8_WAIT_V(6); PG8_BAR; PG8_MMA(1, 1, At, B1); PG8_BAR;
            }
        }
        if constexpr (ALIGN_EPI) { if (wr == 0) PG8_BAR; }
        if constexpr (!Epi::AFTER_DRAIN) { E(acc, cur, wr, wc, fr, fq); S.done(cur); }
        if (!has_next) break;
#pragma unroll
        for (int a = 0; a < 2; ++a)
#pragma unroll
            for (int b = 0; b < 2; ++b)
#pragma unroll
                for (int m = 0; m < 4; ++m)
#pragma unroll
                    for (int n = 0; n < 2; ++n) acc[a][b][m][n] = (f32x4){0.f, 0.f, 0.f, 0.f};
        cur = nxt; cA = nA; cB = nB; ++ui;
        if constexpr (ALIGN_EPI) { if (wr == 1) PG8_BAR; }
    }
    PG8_WAIT_V(0);
    if constexpr (!ALIGN_EPI) { if (wr == 0) PG8_BAR; }
    PG8_BAR;
    if constexpr (Epi::AFTER_DRAIN) { E.fused(acc, cur, wr, wc, fr, fq, lds, wid, lane); S.done(cur); }
#undef PG8_SA
#undef PG8_SB
#undef PG8_STAGE
#undef PG8_LDA
#undef PG8_LDB
#undef PG8_MMA
#undef PG8_WAIT_V
#undef PG8_WAIT_L
#undef PG8_BAR
#undef PG8_SCHED
}
}
#define GAS __attribute__((address_space(1)))
#define LAS __attribute__((address_space(3)))
typedef unsigned short bf16;
typedef unsigned v4u __attribute__((ext_vector_type(4)));
typedef float f32x4 __attribute__((ext_vector_type(4)));
typedef short bf16x8 __attribute__((ext_vector_type(8)));
typedef GAS unsigned gu32;
typedef GAS unsigned long long gu64;
#define RLX_AGENT __ATOMIC_RELAXED, __HIP_MEMORY_SCOPE_AGENT
#define LDS_WAIT() asm volatile("s_waitcnt lgkmcnt(0)" ::: "memory")
#define VM_WAIT() asm volatile("s_waitcnt vmcnt(0)" ::: "memory")
__device__ __forceinline__ unsigned long long rt() { return __builtin_amdgcn_s_memrealtime(); }
__device__ __forceinline__ unsigned f2bf(float f) { unsigned u = __builtin_bit_cast(unsigned, f); return (u + 0x7fffu + ((u >> 16) & 1u)) >> 16; }
typedef __bf16 bf16v2q __attribute__((ext_vector_type(2))); typedef float f32v2q __attribute__((ext_vector_type(2)));
__device__ __forceinline__ unsigned pk2(float lo, float hi) { const f32v2q v = {lo, hi}; return __builtin_bit_cast(unsigned, __builtin_convertvector(v, bf16v2q)); }

#define XB_TMO      128
#define XB_XCNT(j)  (256  + 64 * (j))
#define XB_XSUB(j)  (1280 + 64 * (j))
#define XB_XGEN(j)  (2304 + 64 * (j))
#define XB_TOP      3328
#define XB_TOPGEN   3392
#define XCD_BAR_WORDS 3456
#define XB_SPIN_CAP (1u << 18)

__device__ __forceinline__ unsigned xb_ld(unsigned* p)              { return __hip_atomic_load(p, __ATOMIC_RELAXED, __HIP_MEMORY_SCOPE_AGENT); }
__device__ __forceinline__ unsigned xb_add(unsigned* p, unsigned v) { return __hip_atomic_fetch_add(p, v, __ATOMIC_RELAXED, __HIP_MEMORY_SCOPE_AGENT); }
__device__ __forceinline__ unsigned xb_xcc_id() { return (unsigned)__builtin_amdgcn_s_getreg((3 << 11) | 20) & 0xFu; }
#define XB_SPIN(cond, bar) do { unsigned _sp = 0; while (cond) { __builtin_amdgcn_s_sleep(1); \
    if ((++_sp & 255u) == 0u) { if (xb_ld(&(bar)[XB_TMO])) break; if (_sp > XB_SPIN_CAP) { atomicAdd(&(bar)[XB_TMO], 1u); break; } } } } while (0)

struct XcdBarrier {
    unsigned* bar; unsigned x;
    volatile LAS unsigned* st;
};

__device__ __forceinline__ XcdBarrier xcd_barrier_post(unsigned* bar, volatile LAS unsigned* st) {
    XcdBarrier b; b.bar = bar; b.x = xb_xcc_id(); b.st = st;
    if (threadIdx.x == 0) (void)xb_add(&bar[XB_XCNT(b.x)], 1u);
    return b;
}
__device__ __forceinline__ void xcd_barrier_complete(unsigned* bar, unsigned x, unsigned& nloc, unsigned& nx) {
    const unsigned G = gridDim.x * gridDim.y * gridDim.z;
    unsigned sum, cnt, mine, sp = 0u;
    for (;;) {
        sum = 0u; cnt = 0u; mine = 0u;
#pragma unroll
        for (unsigned j = 0; j < 16; ++j) { const unsigned c = xb_ld(&bar[XB_XCNT(j)]); sum += c; cnt += (c > 0u) ? 1u : 0u; mine = (j == x) ? c : mine; }
        if (sum == G) break;
        __builtin_amdgcn_s_sleep(1);
        if ((++sp & 255u) == 0u) { if (xb_ld(&bar[XB_TMO])) break; if (sp > XB_SPIN_CAP) { atomicAdd(&bar[XB_TMO], 1u); break; } }
    }
    nloc = mine > 0u ? mine : 1u; nx = cnt > 0u ? cnt : 1u;
}

__device__ __forceinline__ void xcd_barrier(const XcdBarrier& b) {
    asm volatile("s_waitcnt vmcnt(0)" ::: "memory");
    __syncthreads();
    if (threadIdx.x == 0) {
        unsigned* bar = b.bar;
        __builtin_amdgcn_s_waitcnt(0);
        unsigned nloc = b.st[0], nx = b.st[1];
        if (nloc == 0u) { xcd_barrier_complete(bar, b.x, nloc, nx); b.st[0] = nloc; b.st[1] = nx; }
        const unsigned old = xb_add(&bar[XB_XSUB(b.x)], 1u);
        const unsigned gen = old / nloc;
        if (old + 1u == (gen + 1u) * nloc) {
            __builtin_amdgcn_fence(__ATOMIC_RELEASE, "agent");
            asm volatile("s_waitcnt vmcnt(0)" ::: "memory");
            const unsigned og = xb_add(&bar[XB_TOP], 1u);
            const unsigned tg = og / nx;
            if (og + 1u == (tg + 1u) * nx) xb_add(&bar[XB_TOPGEN], 1u);
            else XB_SPIN(xb_ld(&bar[XB_TOPGEN]) == tg, bar);
            __builtin_amdgcn_fence(__ATOMIC_ACQUIRE, "agent");
            xb_add(&bar[XB_XGEN(b.x)], 1u);
            asm volatile("s_waitcnt vmcnt(0)" ::: "memory");
        } else {
            XB_SPIN(xb_ld(&bar[XB_XGEN(b.x)]) == gen, bar);
            __builtin_amdgcn_fence(__ATOMIC_ACQUIRE, "agent");
            asm volatile("s_waitcnt vmcnt(0)" ::: "memory");
        }
    }
    __syncthreads();
}

#ifndef MK_PH_HI
#define MK_PH_HI 19
#endif
#ifndef MK_SUB
#define MK_SUB 7
#endif
#ifndef MK_DNSTEP
#define MK_DNSTEP 9
#endif
#ifndef MK_W6
#define MK_W6 1
#endif
#ifndef MK_CVSTEP
#define MK_CVSTEP 9
#endif
#ifndef MK_REP
#define MK_REP 0
#endif
#ifndef MK_REPSUB
#define MK_REPSUB 7
#endif
#ifndef MK_NEG
#define MK_NEG 1
#endif

constexpr int NWAVES = 8;
constexpr int D = 1024, BATCH = 8, SEQ = 4096, M = BATCH * SEQ, DEPTH = 2;
constexpr int DFF = 2816, DPROJ = 3080, NP = 3072;
constexpr int CVK = 31, DNCONV = 4;
constexpr float EPS = 1e-6f;
constexpr int NCHUNK = BATCH * 4 * 64;

constexpr size_t MiB = 1u << 20;
constexpr size_t WS_CTL = 0, CTL_ZERO_BYTES = 64 * 1024;
constexpr size_t WS_W = 2 * MiB;
constexpr size_t W_IN_OFF = 0, W_O_OFF = 6 * MiB, W_GU_OFF = 8 * MiB, W_D_OFF = 19 * MiB, W_LAYER = 25 * MiB;
constexpr size_t WS_BA = 53 * MiB;
constexpr size_t WS_CD = 54 * MiB + 512 * 1024;
constexpr size_t WS_HN = 64 * MiB;
constexpr size_t WS_P = 128 * MiB;
constexpr size_t WS_REC = 320 * MiB;
constexpr size_t REC_BYTES = 74752, REC_W = 0, REC_QD = 16384, REC_QK = 32768, REC_KDT = 40960, REC_U = 57344, REC_CD = 73728;
constexpr size_t WS_O = 468 * MiB, WS_END = 500 * MiB;
constexpr int CW_BAR = 4096;

constexpr int RING_BYTES = 131072;
constexpr int MISC_OFF = 163840 - 256;
constexpr int LDS_BYTES = 163840;

__device__ __forceinline__ float bf2f(unsigned short b) { return __uint_as_float(((unsigned)b) << 16); }
#define dpp_f(old, v, ctrl, row_mask, bound) __builtin_bit_cast(float, __builtin_amdgcn_update_dpp(__builtin_bit_cast(int, (float)(old)), __builtin_bit_cast(int, (float)(v)), (ctrl), (row_mask), 0xF, (bound)))
__device__ __forceinline__ float wave_sum(float v) {
    v += dpp_f(0.f, v, 0xB1, 0xF, true);
    v += dpp_f(0.f, v, 0x4E, 0xF, true);
    v += dpp_f(0.f, v, 0x141, 0xF, true);
    v += dpp_f(0.f, v, 0x140, 0xF, true);
    v += dpp_f(0.f, v, 0x142, 0xA, false);
    v += dpp_f(0.f, v, 0x143, 0xC, false);
    return __builtin_bit_cast(float, __builtin_amdgcn_readlane(__builtin_bit_cast(int, v), 63));
}
__device__ __forceinline__ float sigmoidf_(float x) { return __builtin_amdgcn_rcpf(1.0f + __builtin_amdgcn_exp2f(x * -1.4426950408889634f)); }
__device__ __forceinline__ float gelu_erf(float x) { return 0.5f * x * (1.0f + erff(x * 0.70710678118654752f)); }
typedef float f32x16 __attribute__((ext_vector_type(16)));
typedef unsigned u32x2 __attribute__((ext_vector_type(2)));
#define MFMA32(a, b, c) __builtin_amdgcn_mfma_f32_32x32x16_bf16((a), (b), (c), 0, 0, 0)
__device__ __forceinline__ int crow(int reg, int hh) { return (reg & 3) + 8 * (reg >> 2) + 4 * hh; }

#define AS4 __attribute__((address_space(4)))
struct Frame {
    LAS unsigned char* lds;
    int tid, lane, wave, vcu, G;
    const AS4 unsigned char* kp;
    float* out; unsigned char* ws;
    __device__ __forceinline__ const float* inp(int k) const { return *(const float* const AS4*)(kp + 8 * k); }
};

__device__ __forceinline__ void tr_item(const float* W, int ldw, int K, bf16* WT, int kb, int nsrc0, int ndst0, LAS float* scr, int lane) {
    const int k0 = 64 * kb;
#pragma unroll 8
    for (int i = 0; i < 32; ++i) { const int kk = 2 * i + (lane >> 5); scr[kk * 33 + (lane & 31)] = W[(size_t)(k0 + kk) * ldw + nsrc0 + (lane & 31)]; }
    LDS_WAIT(); asm volatile("" ::: "memory");
    const int c = lane & 7;
#pragma unroll
    for (int j = 0; j < 4; ++j) { const int n = (lane >> 3) + 8 * j; const LAS float* s = scr + (8 * c) * 33 + n;
        v4u o; o.x = pk2(s[0 * 33], s[1 * 33]); o.y = pk2(s[2 * 33], s[3 * 33]); o.z = pk2(s[4 * 33], s[5 * 33]); o.w = pk2(s[6 * 33], s[7 * 33]);
        *(GAS v4u*)(WT + (size_t)(ndst0 + n) * K + k0 + 8 * c) = o; }
    LDS_WAIT(); asm volatile("" ::: "memory");
}
__device__ __forceinline__ void weights_phase(Frame& F) {
    LAS float* scr = (LAS float*)(F.lds + F.wave * 16384);
    const int gw = F.vcu * NWAVES + F.wave, NGW = F.G * NWAVES;
    constexpr int I_IN = 16 * 96, I_O = 16 * 32, I_GU = 16 * 176, I_D = 44 * 32, I_L = I_IN + I_O + I_GU + I_D;
    for (int it = gw; it < DEPTH * I_L; it += NGW) {
        const int l = it / I_L; int r = it % I_L;
        bf16* wb = (bf16*)(F.ws + WS_W + (size_t)l * W_LAYER);
        if (r < I_IN) { const int kb = r / 96, nb = r % 96; tr_item(F.inp(2) + (size_t)l * D * DPROJ, DPROJ, D, (bf16*)((unsigned char*)wb + W_IN_OFF), kb, 32 * nb, 32 * nb, scr, F.lane); continue; } r -= I_IN;
        if (r < I_O) { const int kb = r / 32, nb = r % 32; tr_item(F.inp(15) + (size_t)l * D * D, D, D, (bf16*)((unsigned char*)wb + W_O_OFF), kb, 32 * nb, 32 * nb, scr, F.lane); continue; } r -= I_O;
        if (r < I_GU) { const int kb = r / 176, nb = r % 176; const int drow = 32 * nb, tile = drow >> 8, within = drow & 255;
            const float* src = (within < 128 ? F.inp(17) : F.inp(18)) + (size_t)l * D * DFF;
            tr_item(src, DFF, D, (bf16*)((unsigned char*)wb + W_GU_OFF), kb, tile * 128 + (within & 127), drow, scr, F.lane); continue; } r -= I_GU;
        { const int kb = r / 32, nb = r % 32; tr_item(F.inp(19) + (size_t)l * DFF * D, D, DFF, (bf16*)((unsigned char*)wb + W_D_OFF), kb, 32 * nb, 32 * nb, scr, F.lane); }
    }
}

template <int MODE>
__device__ __forceinline__ void norm_phase(Frame& F, const float* xin, const float* g, bf16* hn, const float* wlog, float* ba, float* fout) {
    const int gw = F.vcu * NWAVES + F.wave, NGW = F.G * NWAVES;
    f32x4 gv[4];
#pragma unroll
    for (int j = 0; j < 4; ++j) gv[j] = ((const f32x4*)g)[64 * j + F.lane];
    LAS float* sW = (LAS float*)F.lds;
    if (MODE == 0 && wlog) {
        __syncthreads();
#pragma unroll
        for (int q = 0; q < 2; ++q) { const int k = 2 * F.tid + q; const f32x4* wr = (const f32x4*)(wlog + (size_t)k * DPROJ + NP); const f32x4 w0 = wr[0], w1 = wr[1];
            sW[0 * 1024 + k] = w0.x; sW[1 * 1024 + k] = w0.y; sW[2 * 1024 + k] = w0.z; sW[3 * 1024 + k] = w0.w; sW[4 * 1024 + k] = w1.x; sW[5 * 1024 + k] = w1.y; sW[6 * 1024 + k] = w1.z; sW[7 * 1024 + k] = w1.w; }
        __syncthreads();
    }
    for (int m = gw; m < M; m += NGW) {
        const f32x4* xr = (const f32x4*)(xin + (size_t)m * D) + F.lane;
        f32x4 v[4]; float ss = 0.f;
#pragma unroll
        for (int j = 0; j < 4; ++j) { v[j] = xr[64 * j]; ss += (v[j].x * v[j].x + v[j].y * v[j].y) + (v[j].z * v[j].z + v[j].w * v[j].w); }
        const float rstd = 1.0f / sqrtf(wave_sum(ss) * (1.0f / D) + EPS);
#pragma unroll
        for (int j = 0; j < 4; ++j) v[j] = v[j] * rstd * gv[j];
        if (MODE == 0) {
            unsigned long long* o8 = (unsigned long long*)(hn + (size_t)m * D) + F.lane;
#pragma unroll
            for (int j = 0; j < 4; ++j) o8[64 * j] = (unsigned long long)pk2(v[j].x, v[j].y) | ((unsigned long long)pk2(v[j].z, v[j].w) << 32);
            if (wlog) {
                float acc[8];
#pragma unroll
                for (int t = 0; t < 8; ++t) { acc[t] = 0.f;
#pragma unroll
                    for (int j = 0; j < 4; ++j) { const f32x4 w = *(const LAS f32x4*)(sW + t * 1024 + 256 * j + 4 * F.lane); acc[t] += (v[j].x * w.x + v[j].y * w.y) + (v[j].z * w.z + v[j].w * w.w); } }
#pragma unroll
                for (int t = 0; t < 8; ++t) acc[t] = wave_sum(acc[t]);
                if (F.lane == 0) { *(f32x4*)(ba + (size_t)m * 8) = (f32x4){acc[0], acc[1], acc[2], acc[3]}; *(f32x4*)(ba + (size_t)m * 8 + 4) = (f32x4){acc[4], acc[5], acc[6], acc[7]}; }
            }
        } else {
            f32x4* o = (f32x4*)(fout + (size_t)m * D) + F.lane;
#pragma unroll
            for (int j = 0; j < 4; ++j) o[64 * j] = v[j];
        }
    }
}

__device__ __forceinline__ float gelu_as(float v) {
    const float d = fabsf(v) * 0.2316418882f + 1.0f, t = __builtin_amdgcn_rcpf(d);
    float q = t * 0.5307027145f + (-0.7265760135f); q = q * t + 0.7107068705f; q = q * t + (-0.142248368f); q = q * t + 0.127414796f; q = q * t;
    const float e = __builtin_amdgcn_exp2f((v * v) * (-0.72134752044f));
    const float m = v * (q * e), r = v - m;
    return v < 0.f ? m : r;
}
typedef __bf16 bf16v8m_t __attribute__((ext_vector_type(8)));
typedef float f32x8m_t __attribute__((ext_vector_type(8)));
__device__ __forceinline__ bf16x8 cvt8(float a0, float a1, float a2, float a3, float a4, float a5, float a6, float a7) { const f32x8m_t v = {a0, a1, a2, a3, a4, a5, a6, a7}; return __builtin_bit_cast(bf16x8, __builtin_convertvector(v, bf16v8m_t)); }
__device__ __forceinline__ void gmlp_unit(Frame& F, int l, int unit, const bf16* P, bf16* MIX) {
    const int m0 = unit * 128;
    LAS bf16* sVt = (LAS bf16*)F.lds;
    {
        float lg[4], lb[4];
#pragma unroll
        for (int e = 0; e < 4; ++e) { lg[e] = F.inp(3)[l * 256 + F.lane + 64 * e]; lb[e] = F.inp(4)[l * 256 + F.lane + 64 * e]; }
#pragma unroll 4
        for (int jj = 0; jj < 16; ++jj) {
            const int j = 16 * F.wave + jj;
            const bf16* pr = P + (size_t)(m0 + j) * NP + 256 + F.lane;
            float v[4];
#pragma unroll
            for (int e = 0; e < 4; ++e) v[e] = gelu_as(bf2f(pr[64 * e]));
            const float mean = wave_sum((v[0] + v[1]) + (v[2] + v[3])) * (1.0f / 256.0f);
#pragma unroll
            for (int e = 0; e < 4; ++e) v[e] -= mean;
            const float var = wave_sum((v[0] * v[0] + v[1] * v[1]) + (v[2] * v[2] + v[3] * v[3])) * (1.0f / 256.0f);
            const float r = 1.0f / sqrtf(var + EPS);
#pragma unroll
            for (int e = 0; e < 4; ++e) sVt[(F.lane + 64 * e) * 136 + j] = (bf16)(pk2(v[e] * r * lg[e] + lb[e], 0.f) & 0xffffu);
        }
    }
    __syncthreads();
    {
        const int r = F.lane & 31, hh = F.lane >> 5, h = F.wave >> 1, c = 32 * F.wave + r;
        const float* wsh = F.inp(5) + (size_t)(l * 4 + h) * 128 * 128;
        const float* bsh = F.inp(6) + (l * 4 + h) * 128;
        bf16x8 bfr[8];
#pragma unroll
        for (int s = 0; s < 8; ++s) bfr[s] = *(const LAS bf16x8*)(sVt + c * 136 + 16 * s + 8 * hh);
#pragma unroll
        for (int ti = 0; ti < 4; ++ti) {
            const int i = 32 * ti + r;
            f32x16 acc;
#pragma unroll
            for (int e = 0; e < 16; ++e) acc[e] = 0.f;
#pragma unroll
            for (int s = 0; s < 2 * ti + 2; ++s) {
                const float* ap = wsh + i * 128 + 16 * s + 8 * hh;
                f32x4 a0 = *(const f32x4*)ap, a1 = *(const f32x4*)(ap + 4);
                if (s >= 2 * ti) { const int j0 = 16 * s + 8 * hh;
                    a0.x = (j0 + 0 <= i) ? a0.x : 0.f; a0.y = (j0 + 1 <= i) ? a0.y : 0.f; a0.z = (j0 + 2 <= i) ? a0.z : 0.f; a0.w = (j0 + 3 <= i) ? a0.w : 0.f;
                    a1.x = (j0 + 4 <= i) ? a1.x : 0.f; a1.y = (j0 + 5 <= i) ? a1.y : 0.f; a1.z = (j0 + 6 <= i) ? a1.z : 0.f; a1.w = (j0 + 7 <= i) ? a1.w : 0.f; }
                acc = MFMA32(cvt8(a0.x, a0.y, a0.z, a0.w, a1.x, a1.y, a1.z, a1.w), bfr[s], acc);
            }
#pragma unroll
            for (int e = 0; e < 16; ++e) { const int io = 32 * ti + crow(e, hh);
                const float u = gelu_as(bf2f(P[(size_t)(m0 + io) * NP + c]));
                MIX[(size_t)(m0 + io) * D + c] = (bf16)(pk2(u * (acc[e] + bsh[io]), 0.f) & 0xffffu); }
        }
    }
    __syncthreads();
}

__device__ __forceinline__ void conv_unit(Frame& F, int l, int unit, const bf16* P, bf16* MIX) {
    const int b = unit >> 6, t0 = (unit & 63) * 64, m0 = b * SEQ + t0;
    LAS float* sY = (LAS float*)F.lds;
    for (int r = F.wave; r < 94; r += NWAVES) {
        const int t = t0 - 30 + r; f32x4 y = (f32x4){0.f, 0.f, 0.f, 0.f};
        if (t >= 0) {
            const bf16* pr = P + (size_t)(b * SEQ + t) * NP + 4 * F.lane;
            const u32x2 ra = *(const u32x2*)(pr + 512), rg = *(const u32x2*)(pr + 768);
            y.x = bf2f((unsigned short)(ra.x & 0xffffu)) * sigmoidf_(bf2f((unsigned short)(rg.x & 0xffffu)));
            y.y = bf2f((unsigned short)(ra.x >> 16)) * sigmoidf_(bf2f((unsigned short)(rg.x >> 16)));
            y.z = bf2f((unsigned short)(ra.y & 0xffffu)) * sigmoidf_(bf2f((unsigned short)(rg.y & 0xffffu)));
            y.w = bf2f((unsigned short)(ra.y >> 16)) * sigmoidf_(bf2f((unsigned short)(rg.y >> 16)));
        }
        *(LAS f32x4*)(sY + r * 256 + 4 * F.lane) = y;
    }
    __syncthreads();
    if (MK_CVSTEP < 2) return;
    const int c = F.tid & 255, hf = F.wave >> 2;
    float w[CVK];
#pragma unroll
    for (int k = 0; k < CVK; ++k) w[k] = F.inp(7)[(size_t)(l * CVK + k) * 256 + c];
    const float bias = F.inp(8)[l * 256 + c];
    float o[32];
#pragma unroll
    for (int g = 0; g < 4; ++g) {
        float y[38];
#pragma unroll
        for (int q = 0; q < 38; ++q) y[q] = sY[(hf * 32 + 8 * g + q) * 256 + c];
#pragma unroll
        for (int t8 = 0; t8 < 8; ++t8) {
            float a = bias;
#pragma unroll
            for (int k = 0; k < CVK; ++k) a += w[k] * y[t8 + k];
            o[8 * g + t8] = a;
        }
    }
    __syncthreads();
#pragma unroll
    for (int tt = 0; tt < 32; ++tt) sY[(hf * 32 + tt) * 256 + c] = o[tt];
    __syncthreads();
    if (MK_CVSTEP < 3) return;
    const f32x4 g4 = *(const f32x4*)(F.inp(9) + l * 256 + 4 * F.lane), b4 = *(const f32x4*)(F.inp(10) + l * 256 + 4 * F.lane);
    for (int i = F.wave; i < 64; i += NWAVES) {
        f32x4 v = *(LAS f32x4*)(sY + i * 256 + 4 * F.lane);
        const float mean = wave_sum((v.x + v.y) + (v.z + v.w)) * (1.0f / 256.0f);
        v = v - mean;
        const float var = wave_sum((v.x * v.x + v.y * v.y) + (v.z * v.z + v.w * v.w)) * (1.0f / 256.0f);
        const float r = 1.0f / sqrtf(var + EPS);
        v = v * r * g4 + b4;
        v.x *= sigmoidf_(v.x); v.y *= sigmoidf_(v.y); v.z *= sigmoidf_(v.z); v.w *= sigmoidf_(v.w);
        *(unsigned long long*)(MIX + (size_t)(m0 + i) * D + 256 + 4 * F.lane) = (unsigned long long)pk2(v.x, v.y) | ((unsigned long long)pk2(v.z, v.w) << 32);
    }
    __syncthreads();
}

#ifndef MK_TS
#define MK_TS 0
#endif
#ifndef MK_TK
#define MK_TK 4
#endif
#define TS_BEGIN(id) long long ts0_##id = 0; if (MK_TS == (id)) { asm volatile("s_waitcnt vmcnt(0) lgkmcnt(0)" ::: "memory"); ts0_##id = clock64(); }
#define TS_END(id) if (MK_TS == (id)) { asm volatile("s_waitcnt vmcnt(0) lgkmcnt(0)" ::: "memory"); const long long t1_ = clock64(), d_ = (t1_ - ts0_##id) * MK_TK; while (clock64() - t1_ < d_) __builtin_amdgcn_s_sleep(1); }
typedef __bf16 bf16v2_t __attribute__((ext_vector_type(2)));
typedef __bf16 bf16v8_t __attribute__((ext_vector_type(8)));
typedef float f32x2_t __attribute__((ext_vector_type(2)));
typedef float f32x8_t __attribute__((ext_vector_type(8)));
__device__ __forceinline__ unsigned cpk2(float lo, float hi) { const f32x2_t v = {lo, hi}; return __builtin_bit_cast(unsigned, __builtin_convertvector(v, bf16v2_t)); }
__device__ __forceinline__ v4u cpk8(float a0, float a1, float a2, float a3, float a4, float a5, float a6, float a7) { const f32x8_t v = {a0, a1, a2, a3, a4, a5, a6, a7}; return __builtin_bit_cast(v4u, __builtin_convertvector(v, bf16v8_t)); }
__device__ __forceinline__ bf16x8 pack_step(const f32x16& x, int s) { return __builtin_bit_cast(bf16x8, cpk8(x[8 * s], x[8 * s + 1], x[8 * s + 2], x[8 * s + 3], x[8 * s + 4], x[8 * s + 5], x[8 * s + 6], x[8 * s + 7])); }

template <int J> __device__ __forceinline__ void dn_solve_cols(f32x2_t (&acc)[32], const LAS float* sAt) {
    if constexpr (J < 63) {
        const LAS float* acol = sAt + J * 64;
        if constexpr (J >= 1) asm volatile("" : "+v"(acol) : "v"(acc[(J - 1) >> 1]));
        const float sj = (J & 1) ? acc[J >> 1].y : acc[J >> 1].x;
        if constexpr ((J & 1) == 0) acc[J >> 1].y -= acol[J + 1] * sj;
        const f32x2_t s2 = {sj, sj};
#pragma unroll
        for (int p = (J >> 1) + 1; p < 32; ++p) { const f32x2_t a2 = *(const LAS f32x2_t*)(acol + 2 * p); acc[p] -= a2 * s2; }
        dn_solve_cols<J + 1>(acc, sAt);
    }
}

__device__ __forceinline__ void dn_load_raw(v4u (&raw)[7], const bf16* P, int cu, int tid) {
    const int b = cu >> 8, h = (cu >> 6) & 3, n = cu & 63, m0 = b * SEQ + n * 64;
    const bf16* pbase = P + 1024 + h * 128;
#pragma unroll
    for (int it = 0; it < 7; ++it) { int item = tid + 512 * it; item = item < 3 * 67 * 16 ? item : 3 * 67 * 16 - 1;
        const int sel = item / (67 * 16), rem = item - sel * (67 * 16), t = rem >> 4, pc = rem & 15;
        const int tr = (n > 0 || t >= 3) ? t : 3;
        raw[it] = *(const v4u*)(pbase + (long)(m0 - 3 + tr) * NP + sel * 512 + pc * 8);
        if (!(n > 0 || t >= 3)) raw[it] = (v4u){0u, 0u, 0u, 0u}; }
}
__device__ __forceinline__ void dn_chunk_units(Frame& F0, int l, int first, int stride, const bf16* P, const float* BA, const int stepmax) {
  if (stepmax < 1 || first >= NCHUNK) return;
  v4u rawn[7]; dn_load_raw(rawn, P, first, F0.tid);
  for (int cu = first; cu < NCHUNK; cu += stride) {
    Frame F = F0; asm volatile("" : "+v"(F.tid)); F.lane = F.tid & 63; F.wave = __builtin_amdgcn_readfirstlane(F.tid >> 6);
    const int b = cu >> 8, h = (cu >> 6) & 3, n = cu & 63, m0 = b * SEQ + n * 64;
    LAS float* sQ = (LAS float*)F.lds;
    LAS float* sK = (LAS float*)(F.lds + 32768);
    LAS float* sV = (LAS float*)(F.lds + 65536);
    LAS bf16* sQb = (LAS bf16*)(F.lds + 98304);
    LAS bf16* sKb = (LAS bf16*)(F.lds + 115712);
    LAS bf16* sRaw = (LAS bf16*)(F.lds + 98304);
    LAS float* sGam = (LAS float*)(F.lds + 149760);
    LAS float* sBeta = (LAS float*)(F.lds + 150016);
    LAS float* sEg = (LAS float*)(F.lds + 150272);
    LAS float* sEd = (LAS float*)(F.lds + 150528);
    LAS float* sA = sQ;
    bf16* rec = (bf16*)(F.ws + WS_REC + (size_t)cu * REC_BYTES);
    bf16* Uo = rec + REC_U / 2; float* CD = (float*)((unsigned char*)rec + REC_CD);
    TS_BEGIN(1)
    {
#pragma unroll
        for (int it = 0; it < 7; ++it) { const int item = F.tid + 512 * it; if (item < 3 * 67 * 16) *(LAS v4u*)(sRaw + item * 8) = rawn[it]; }
    }
    {
        const int cn = (cu + stride < NCHUNK) ? cu + stride : cu;
        dn_load_raw(rawn, P, cn, F.tid);
    }
    __syncthreads();
    TS_END(1)
#ifdef MK_X
    if (stepmax == 1) continue;
#endif
    TS_BEGIN(2)
#ifndef MK_Y
#define MK_Y 0
#endif
#ifndef MK_Z
#define MK_Z 0
#endif
    if (F.wave < 6 && !(stepmax == 1 && MK_Z)) {
        const int sel = F.wave >> 1, c = F.tid & 127;
        const int wch = sel * 512 + h * 128 + c;
        const float* cw = F.inp(11) + (size_t)l * DNCONV * 1536 + wch;
        const float w0 = cw[0], w1 = cw[1536], w2 = cw[2 * 1536], w3 = cw[3 * 1536];
        const LAS bf16* xc = sRaw + (sel * 67) * 128 + c;
        float x0 = bf2f(xc[0]), x1 = bf2f(xc[128]), x2 = bf2f(xc[256]);
        LAS float* dst = (sel == 0 ? sQ : (sel == 1 ? sK : sV)) + c;
#ifndef MK_DUP
#define MK_DUP 0
#endif
        for (int dup = 0; dup <= MK_DUP; ++dup) {
        asm volatile("" ::: "memory");
        x0 = bf2f(xc[0]); x1 = bf2f(xc[128]); x2 = bf2f(xc[256]);
#pragma unroll 16
        for (int i = 0; i < 64; ++i) {
            const float x3 = bf2f(xc[(i + 3) * 128]);
            const float y = (w0 * x0 + w1 * x1) + (w2 * x2 + w3 * x3);
            dst[i * 128] = y * sigmoidf_(y);
            x0 = x1; x1 = x2; x2 = x3;
        }
        }
    } else if (F.wave == 6) {
        const int i = F.lane;
        const float bl = BA[(size_t)(m0 + i) * 8 + h], al = BA[(size_t)(m0 + i) * 8 + 4 + h];
        const float beta = 1.0f / (1.0f + expf(-bl));
        const float z = al + F.inp(13)[l * 4 + h];
        const float sp = fmaxf(z, 0.f) + log1pf(expf(-fabsf(z)));
        float la = -expf(F.inp(12)[l * 4 + h]) * sp;
#pragma unroll
        for (int off = 1; off < 64; off <<= 1) { const float t = __shfl_up(la, off); if (i >= off) la += t; }
        const float glast = __shfl(la, 63);
        sGam[i] = la; sBeta[i] = beta; sEg[i] = expf(la); sEd[i] = expf(glast - la);
        if (i == 63) CD[0] = expf(la);
    }
    __syncthreads();
    TS_END(2)
    TS_BEGIN(3)
    {
        float q0[8], q1[8], k0[8], k1[8], sq[8], sk[8];
#pragma unroll
        for (int rr = 0; rr < 8; ++rr) { const int i = 8 * F.wave + rr;
            q0[rr] = sQ[i * 128 + F.lane]; q1[rr] = sQ[i * 128 + 64 + F.lane]; k0[rr] = sK[i * 128 + F.lane]; k1[rr] = sK[i * 128 + 64 + F.lane];
            sq[rr] = q0[rr] * q0[rr] + q1[rr] * q1[rr]; sk[rr] = k0[rr] * k0[rr] + k1[rr] * k1[rr]; }
#pragma unroll
        for (int rr = 0; rr < 8; ++rr) { sq[rr] = wave_sum(sq[rr]); sk[rr] = wave_sum(sk[rr]); }
#pragma unroll
        for (int rr = 0; rr < 8; ++rr) { const int i = 8 * F.wave + rr;
            const float rq = (1.0f / sqrtf(sq[rr] + EPS)) * 0.08838834764831845f, rk = 1.0f / sqrtf(sk[rr] + EPS);
            sQ[i * 128 + F.lane] = q0[rr] * rq; sQ[i * 128 + 64 + F.lane] = q1[rr] * rq; sK[i * 128 + F.lane] = k0[rr] * rk; sK[i * 128 + 64 + F.lane] = k1[rr] * rk; }
    }
    __syncthreads();
    TS_END(3)
    TS_BEGIN(4)
    {
        const int i = F.tid >> 3, cb = (F.tid & 7) * 16;
        f32x4 q[4], k[4];
#pragma unroll
        for (int t = 0; t < 4; ++t) { q[t] = *(LAS f32x4*)(sQ + i * 128 + cb + 4 * t); k[t] = *(LAS f32x4*)(sK + i * 128 + cb + 4 * t); }
        *(LAS v4u*)(sQb + i * 136 + cb) = cpk8(q[0].x, q[0].y, q[0].z, q[0].w, q[1].x, q[1].y, q[1].z, q[1].w);
        *(LAS v4u*)(sQb + i * 136 + cb + 8) = cpk8(q[2].x, q[2].y, q[2].z, q[2].w, q[3].x, q[3].y, q[3].z, q[3].w);
        *(LAS v4u*)(sKb + i * 136 + cb) = cpk8(k[0].x, k[0].y, k[0].z, k[0].w, k[1].x, k[1].y, k[1].z, k[1].w);
        *(LAS v4u*)(sKb + i * 136 + cb + 8) = cpk8(k[2].x, k[2].y, k[2].z, k[2].w, k[3].x, k[3].y, k[3].z, k[3].w);
    }
#pragma unroll
    for (int it = 0; it < 2; ++it) {
        const int item = F.tid + 512 * it, f = item >> 6, ln = item & 63, r = ln & 31, hh = ln >> 5;
        const int rt = f >> 3, kt = (f >> 1) & 3, s = f & 1, i = 32 * rt + r, d0 = 32 * kt + 16 * s + 4 * hh;
        const float eg = sEg[i];
        const f32x4 a = *(LAS f32x4*)(sQ + i * 128 + d0), c = *(LAS f32x4*)(sQ + i * 128 + d0 + 8);
        *(v4u*)(rec + REC_QD / 2 + f * 512 + ln * 8) = cpk8(a.x * eg, a.y * eg, a.z * eg, a.w * eg, c.x * eg, c.y * eg, c.z * eg, c.w * eg);
    }
#pragma unroll
    for (int it = 0; it < 2; ++it) {
        const int item = F.tid + 512 * it, f = item >> 6, ln = item & 63, r = ln & 31, hh = ln >> 5;
        const int a = f >> 2, t = (f >> 1) & 1, s = f & 1, dk = 32 * a + r, j0 = 32 * t + 16 * s + 4 * hh;
        float kv[8];
#pragma unroll
        for (int jj = 0; jj < 8; ++jj) { const int j = j0 + 8 * (jj >> 2) + (jj & 3); kv[jj] = sK[j * 128 + dk] * sEd[j]; }
        *(v4u*)(rec + REC_KDT / 2 + f * 512 + ln * 8) = cpk8(kv[0], kv[1], kv[2], kv[3], kv[4], kv[5], kv[6], kv[7]);
    }
    __syncthreads();
    TS_END(4)
    TS_BEGIN(5)
    {
        const int mat = F.wave >> 2, ti = (F.wave >> 1) & 1, tj = F.wave & 1, r = F.lane & 31, hh = F.lane >> 5;
        f32x16 acc;
#pragma unroll
        for (int e = 0; e < 16; ++e) acc[e] = 0.f;
        if (!(ti == 0 && tj == 1)) {
            const LAS bf16* Ab = sKb + (32 * (mat ? tj : ti) + r) * 136 + 8 * hh;
            const LAS bf16* Bb = (mat ? sQb + (32 * ti + r) * 136 : sKb + (32 * tj + r) * 136) + 8 * hh;
#pragma unroll
            for (int s = 0; s < 8; ++s) { const bf16x8 a = *(const LAS bf16x8*)(Ab + 16 * s), bb = *(const LAS bf16x8*)(Bb + 16 * s); acc = MFMA32(a, bb, acc); }
        }
        if (mat == 0) {
            const int j = 32 * tj + r; const float gj = sGam[j];
#pragma unroll
            for (int g = 0; g < 4; ++g) { const int i0 = 32 * ti + 8 * g + 4 * hh; f32x4 o;
#pragma unroll
                for (int q = 0; q < 4; ++q) { const int i = i0 + q; o[q] = (j < i) ? sBeta[i] * acc[4 * g + q] * __expf(sGam[i] - gj) : 0.f; }
                *(LAS f32x4*)(sA + j * 64 + i0) = o; }
        } else {
            const int i = 32 * ti + r; const float gi = sGam[i];
            float v[16];
#pragma unroll
            for (int e = 0; e < 16; ++e) { const int j = 32 * tj + crow(e, hh); v[e] = (j <= i) ? acc[e] * expf(gi - sGam[j]) : 0.f; }
            bf16* qk = rec + REC_QK / 2 + ((ti * 2 + tj) * 2) * 512 + F.lane * 8;
            *(v4u*)qk = cpk8(v[0], v[1], v[2], v[3], v[4], v[5], v[6], v[7]);
            *(v4u*)(qk + 512) = cpk8(v[8], v[9], v[10], v[11], v[12], v[13], v[14], v[15]);
        }
    }
    __syncthreads();
    TS_END(5)
    TS_BEGIN(6)
    if (F.wave < 4) {
        const int col = F.tid & 127; const bool isw = F.wave >= 2;
        const LAS float* src = (isw ? sK : sV) + col;
        f32x2_t acc2[32];
        if (isw) {
#pragma unroll
            for (int p = 0; p < 32; ++p) { const f32x2_t bt = *(const LAS f32x2_t*)(sBeta + 2 * p), eg = *(const LAS f32x2_t*)(sEg + 2 * p); acc2[p].x = bt.x * eg.x * src[(2 * p) * 128]; acc2[p].y = bt.y * eg.y * src[(2 * p + 1) * 128]; }
        } else {
#pragma unroll
            for (int p = 0; p < 32; ++p) { const f32x2_t bt = *(const LAS f32x2_t*)(sBeta + 2 * p); acc2[p].x = bt.x * src[(2 * p) * 128]; acc2[p].y = bt.y * src[(2 * p + 1) * 128]; }
        }
        dn_solve_cols<0>(acc2, sA);
        float sol[64];
#pragma unroll
        for (int p = 0; p < 32; ++p) { sol[2 * p] = acc2[p].x; sol[2 * p + 1] = acc2[p].y; }
        if (!isw) {
            bf16* ub = Uo + ((col >> 5) * 2) * 1024 + (col & 31) * 8;
#pragma unroll
            for (int t = 0; t < 2; ++t)
#pragma unroll
                for (int hh = 0; hh < 2; ++hh) { bf16* p = ub + t * 1024 + hh * 256;
                    *(v4u*)p = cpk8(sol[32 * t + 4 * hh + 0], sol[32 * t + 4 * hh + 1], sol[32 * t + 4 * hh + 2], sol[32 * t + 4 * hh + 3], sol[32 * t + 4 * hh + 8], sol[32 * t + 4 * hh + 9], sol[32 * t + 4 * hh + 10], sol[32 * t + 4 * hh + 11]);
                    *(v4u*)(p + 512) = cpk8(sol[32 * t + 4 * hh + 16], sol[32 * t + 4 * hh + 17], sol[32 * t + 4 * hh + 18], sol[32 * t + 4 * hh + 19], sol[32 * t + 4 * hh + 24], sol[32 * t + 4 * hh + 25], sol[32 * t + 4 * hh + 26], sol[32 * t + 4 * hh + 27]); }
        } else {
            LAS bf16* wrow = sQb + col;
#pragma unroll
            for (int i = 0; i < 64; ++i) wrow[i * 136] = (bf16)(cpk2(sol[i], 0.f) & 0xffffu);
        }
    }
    __syncthreads();
    TS_END(6)
    TS_BEGIN(7)
#pragma unroll
    for (int it = 0; it < 2; ++it) {
        const int item = F.tid + 512 * it, f = item >> 6, ln = item & 63, r = ln & 31, hh = ln >> 5;
        const int rt = f >> 3, kt = (f >> 1) & 3, s = f & 1;
        const LAS bf16* wp = sQb + (32 * rt + r) * 136 + 32 * kt + 16 * s + 4 * hh;
        const u32x2 lo = *(const LAS u32x2*)wp, hi = *(const LAS u32x2*)(wp + 8);
        v4u o; o.x = lo.x; o.y = lo.y; o.z = hi.x; o.w = hi.y;
        *(v4u*)(rec + REC_W / 2 + f * 512 + ln * 8) = o;
    }
    __syncthreads();
    TS_END(7)
  }
}

#define DN_BAR() do { asm volatile("s_waitcnt lgkmcnt(0)" ::: "memory"); __builtin_amdgcn_s_barrier(); asm volatile("" ::: "memory"); } while (0)
__device__ __forceinline__ void dn_scan(Frame& F, int l, int bh) {
    LAS unsigned char* ring = F.lds;
    const unsigned char* recs = F.ws + WS_REC + (size_t)(bh * 64) * REC_BYTES;
    if (F.wave >= 4) {
        const int v = F.wave - 4;
#define DN_DMA(n_) do { const unsigned char* src_ = recs + (size_t)(n_) * REC_BYTES + v * 1024 + F.lane * 16; LAS unsigned char* dst_ = ring + ((n_) & 1) * (int)REC_BYTES + v * 1024; \
        _Pragma("unroll") for (int q_ = 0; q_ < 19; ++q_) if (v + 4 * q_ < 73) __builtin_amdgcn_global_load_lds((const unsigned*)(src_ + q_ * 4096), (LAS unsigned*)(dst_ + q_ * 4096), 16, 0, 0); } while (0)
        DN_DMA(0);
        asm volatile("s_waitcnt vmcnt(0)" ::: "memory");
        DN_BAR();
        for (int n = 0; n < 64; ++n) {
            if (n + 1 < 64) DN_DMA(n + 1);
            asm volatile("s_waitcnt vmcnt(0)" ::: "memory");
            DN_BAR();
        }
#undef DN_DMA
    } else {
        const int w = F.wave;
        f32x16 S0, S1, S2, S3;
#pragma unroll
        for (int e = 0; e < 16; ++e) { S0[e] = 0.f; S1[e] = 0.f; S2[e] = 0.f; S3[e] = 0.f; }
        bf16* Ob = (bf16*)(F.ws + WS_O) + (size_t)(bh * 64) * 8192 + (w * 2) * 1024 + F.lane * 8;
        DN_BAR();
        for (int n = 0; n < 64; ++n) {
            const LAS unsigned char* buf = ring + (n & 1) * (int)REC_BYTES + F.lane * 16;
            const float cd = *(const LAS float*)(ring + (n & 1) * (int)REC_BYTES + REC_CD);
#define DN_A(off_, f_) (*(const LAS bf16x8*)(buf + (off_) + (f_) * 1024))
            f32x16 W0, W1, Q0, Q1;
#pragma unroll
            for (int e = 0; e < 16; ++e) { W0[e] = 0.f; W1[e] = 0.f; Q0[e] = 0.f; Q1[e] = 0.f; }
#define DN_KSTEP(Sa_, a_, s_) do { const bf16x8 sb_ = pack_step(Sa_, s_); \
                W0 = MFMA32(DN_A(REC_W, (0 * 4 + (a_)) * 2 + (s_)), sb_, W0); W1 = MFMA32(DN_A(REC_W, (1 * 4 + (a_)) * 2 + (s_)), sb_, W1); \
                Q0 = MFMA32(DN_A(REC_QD, (0 * 4 + (a_)) * 2 + (s_)), sb_, Q0); Q1 = MFMA32(DN_A(REC_QD, (1 * 4 + (a_)) * 2 + (s_)), sb_, Q1); } while (0)
            DN_KSTEP(S0, 0, 0); DN_KSTEP(S0, 0, 1); DN_KSTEP(S1, 1, 0); DN_KSTEP(S1, 1, 1); DN_KSTEP(S2, 2, 0); DN_KSTEP(S2, 2, 1); DN_KSTEP(S3, 3, 0); DN_KSTEP(S3, 3, 1);
#undef DN_KSTEP
            {
                const v4u u00 = *(const LAS v4u*)(buf + REC_U + (w * 2 + 0) * 2048), u01 = *(const LAS v4u*)(buf + REC_U + (w * 2 + 0) * 2048 + 1024);
                const v4u u10 = *(const LAS v4u*)(buf + REC_U + (w * 2 + 1) * 2048), u11 = *(const LAS v4u*)(buf + REC_U + (w * 2 + 1) * 2048 + 1024);
                const unsigned uu0[8] = {u00.x, u00.y, u00.z, u00.w, u01.x, u01.y, u01.z, u01.w}, uu1[8] = {u10.x, u10.y, u10.z, u10.w, u11.x, u11.y, u11.z, u11.w};
#pragma unroll
                for (int e = 0; e < 16; ++e) { const unsigned a0 = uu0[e >> 1], a1 = uu1[e >> 1];
                    W0[e] = ((e & 1) ? __uint_as_float(a0 & 0xffff0000u) : __uint_as_float(a0 << 16)) - W0[e];
                    W1[e] = ((e & 1) ? __uint_as_float(a1 & 0xffff0000u) : __uint_as_float(a1 << 16)) - W1[e]; }
            }
            const bf16x8 ub00 = pack_step(W0, 0), ub01 = pack_step(W0, 1), ub10 = pack_step(W1, 0), ub11 = pack_step(W1, 1);
            Q0 = MFMA32(DN_A(REC_QK, (0 * 2 + 0) * 2 + 0), ub00, Q0); Q0 = MFMA32(DN_A(REC_QK, (0 * 2 + 0) * 2 + 1), ub01, Q0); Q0 = MFMA32(DN_A(REC_QK, (0 * 2 + 1) * 2 + 0), ub10, Q0); Q0 = MFMA32(DN_A(REC_QK, (0 * 2 + 1) * 2 + 1), ub11, Q0);
            Q1 = MFMA32(DN_A(REC_QK, (1 * 2 + 0) * 2 + 0), ub00, Q1); Q1 = MFMA32(DN_A(REC_QK, (1 * 2 + 0) * 2 + 1), ub01, Q1); Q1 = MFMA32(DN_A(REC_QK, (1 * 2 + 1) * 2 + 0), ub10, Q1); Q1 = MFMA32(DN_A(REC_QK, (1 * 2 + 1) * 2 + 1), ub11, Q1);
            S0 = S0 * cd; S1 = S1 * cd; S2 = S2 * cd; S3 = S3 * cd;
#define DN_SUPD(Sa_, a_) do { Sa_ = MFMA32(DN_A(REC_KDT, ((a_) * 2 + 0) * 2 + 0), ub00, Sa_); Sa_ = MFMA32(DN_A(REC_KDT, ((a_) * 2 + 0) * 2 + 1), ub01, Sa_); \
                Sa_ = MFMA32(DN_A(REC_KDT, ((a_) * 2 + 1) * 2 + 0), ub10, Sa_); Sa_ = MFMA32(DN_A(REC_KDT, ((a_) * 2 + 1) * 2 + 1), ub11, Sa_); } while (0)
            DN_SUPD(S0, 0); DN_SUPD(S1, 1); DN_SUPD(S2, 2); DN_SUPD(S3, 3);
#undef DN_SUPD
#undef DN_A
            bf16* op = Ob + (size_t)n * 8192;
            *(v4u*)op = cpk8(Q0[0], Q0[1], Q0[2], Q0[3], Q0[4], Q0[5], Q0[6], Q0[7]); *(v4u*)(op + 512) = cpk8(Q0[8], Q0[9], Q0[10], Q0[11], Q0[12], Q0[13], Q0[14], Q0[15]);
            *(v4u*)(op + 1024) = cpk8(Q1[0], Q1[1], Q1[2], Q1[3], Q1[4], Q1[5], Q1[6], Q1[7]); *(v4u*)(op + 1536) = cpk8(Q1[8], Q1[9], Q1[10], Q1[11], Q1[12], Q1[13], Q1[14], Q1[15]);
            DN_BAR();
        }
    }
}
#undef DN_BAR

__device__ __forceinline__ void dn_finish_unit(Frame& F, int l, int cu, const bf16* P, bf16* MIX) {
    const int b = cu >> 8, h = (cu >> 6) & 3, n = cu & 63, m0 = b * SEQ + n * 64;
    LAS float* sO = (LAS float*)F.lds;
    {
        const int wt = F.wave, w = wt >> 1, t = wt & 1, r = F.lane & 31, hh = F.lane >> 5;
        const bf16* ip = (const bf16*)(F.ws + WS_O) + (size_t)cu * 8192 + wt * 1024 + F.lane * 8;
        const v4u a = *(const v4u*)ip, c = *(const v4u*)(ip + 512);
        const unsigned uu[8] = {a.x, a.y, a.z, a.w, c.x, c.y, c.z, c.w};
#pragma unroll
        for (int e = 0; e < 16; ++e) { const unsigned x = uu[e >> 1]; sO[(32 * t + crow(e, hh)) * 132 + 32 * w + r] = (e & 1) ? __uint_as_float(x & 0xffff0000u) : __uint_as_float(x << 16); }
    }
    __syncthreads();
    const float ng0 = F.inp(14)[l * 128 + 2 * F.lane], ng1 = F.inp(14)[l * 128 + 2 * F.lane + 1];
#pragma unroll
    for (int rr = 0; rr < 8; ++rr) {
        const int i = 8 * F.wave + rr;
        const f32x2_t o = *(const LAS f32x2_t*)(sO + i * 132 + 2 * F.lane);
        const unsigned g = *((const unsigned*)(P + (size_t)(m0 + i) * NP + 2560 + h * 128) + F.lane);
        const float rs = 1.0f / sqrtf(wave_sum(o.x * o.x + o.y * o.y) * (1.0f / 128.0f) + EPS);
        const float g0 = __uint_as_float(g << 16), g1 = __uint_as_float(g & 0xffff0000u);
        *((unsigned*)(MIX + (size_t)(m0 + i) * D + 512 + h * 128) + F.lane) = cpk2(o.x * rs * ng0 * (g0 * sigmoidf_(g0)), o.y * rs * ng1 * (g1 * sigmoidf_(g1)));
    }
    __syncthreads();
}
struct Args { const float* in[21]; float* out; unsigned char* ws; int ph_lo, ph_hi; };
constexpr int PH_PER_LAYER = 9, N_PHASES = 1 + PH_PER_LAYER * DEPTH;

#define RELAUNDER(Fx) do { asm volatile("" : "+v"((Fx).tid)); (Fx).lane = (Fx).tid & 63; (Fx).wave = __builtin_amdgcn_readfirstlane((Fx).tid >> 6); } while (0)
__global__ void __launch_bounds__(NWAVES * 64, 2) mk_fwd(Args args) {
    extern __shared__ __attribute__((aligned(16))) unsigned char lds[];
    {
        volatile LAS unsigned* MISC0 = (volatile LAS unsigned*)((LAS unsigned char*)lds + MISC_OFF);
        if (threadIdx.x < 32) MISC0[threadIdx.x] = 0u;
    }
    __syncthreads();
    const int lo = args.ph_lo, hi = args.ph_hi;
    XcdBarrier bar; bar.bar = (unsigned*)(args.ws + WS_CTL) + CW_BAR; bar.x = 0; bar.st = nullptr;
    if (hi - lo > 1) bar = xcd_barrier_post((unsigned*)(args.ws + WS_CTL) + CW_BAR, (volatile LAS unsigned*)((LAS unsigned char*)lds + MISC_OFF) + 8);

    for (int ph = lo; ph < hi; ++ph) {
      for (int rep = 0; rep < 2; ++rep) {
        if (rep == 1 && !(ph > 0 && ((MK_REP >> ((ph - 1) % PH_PER_LAYER)) & 1))) break;
        int tid = threadIdx.x; asm volatile("" : "+v"(tid));
        Frame F;
        F.kp = (const AS4 unsigned char*)__builtin_amdgcn_kernarg_segment_ptr(); asm volatile("" : "+s"(F.kp));
        F.lds = (LAS unsigned char*)lds;
        F.tid = tid; F.lane = tid & 63; F.wave = __builtin_amdgcn_readfirstlane(tid >> 6);
        F.G = gridDim.x; { const int bx = blockIdx.x; F.vcu = (F.G % 8 == 0) ? (bx % 8) * (F.G / 8) + bx / 8 : bx; }
        F.out = *(float* const AS4*)(F.kp + 168); F.ws = *(unsigned char* const AS4*)(F.kp + 176);
        bf16* HN = (bf16*)(F.ws + WS_HN); bf16* MIX = HN; bf16* P = (bf16*)(F.ws + WS_P); bf16* HFF = P;
        float* BA = (float*)(F.ws + WS_BA);
        if (ph == 0) {
            weights_phase(F);
            norm_phase<0>(F, F.inp(0), F.inp(1), HN, F.inp(2), BA, nullptr);
        } else {
#ifdef MK_ONLY_K
            const int l = (ph - 1) / PH_PER_LAYER, k = MK_ONLY_K;
#else
            const int l = (ph - 1) / PH_PER_LAYER, k = (ph - 1) % PH_PER_LAYER;
#endif
            const unsigned char* wb = F.ws + WS_W + (size_t)l * W_LAYER;
            if (k == 0) {
                pg8::Gemm g{(const pg8::bf16_t*)HN, (const pg8::bf16_t*)(wb + W_IN_OFF), M, NP, D}; pg8::StaticOrder S; S.init(M, NP, F.G, (int)blockIdx.x);
                pg8::EpiBf16<0> E{(pg8::bf16_t*)P, NP, nullptr, 0, 0, 1.f};
                pg8::gemm_phase<pg8::EpiBf16<0>, pg8::StaticOrder, true, true>(F.lds, g, S, E, tid);
            } else if (k == 1) {
                const int sub = rep ? MK_REPSUB : MK_SUB;
                if (sub & 1) dn_chunk_units(F, l, (int)blockIdx.x, F.G, P, BA, rep ? MK_DNSTEP : 9);
            } else if (k == 2) {
                if ((int)blockIdx.x < BATCH * 4) dn_scan(F, l, (int)blockIdx.x);
                else for (int v = (int)blockIdx.x - BATCH * 4; v < M / 128 + M / 64; v += F.G - BATCH * 4) { Frame Fu = F; RELAUNDER(Fu);
                    if (v < M / 128) gmlp_unit(Fu, l, v, P, MIX); else conv_unit(Fu, l, v - M / 128, P, MIX); }
            } else if (k == 3) {
                for (int u = blockIdx.x; u < NCHUNK; u += F.G) { Frame Fu = F; RELAUNDER(Fu); dn_finish_unit(Fu, l, u, P, MIX); }
            } else if (k == 4 || k == 7) {
                const float* base = (l == 0 && k == 4) ? F.inp(0) : F.out;
                pg8::Gemm g{(const pg8::bf16_t*)(k == 4 ? MIX : HFF), (const pg8::bf16_t*)(wb + (k == 4 ? W_O_OFF : W_D_OFF)), M, D, k == 4 ? D : DFF}; pg8::StaticOrder S; S.init(M, D, F.G, (int)blockIdx.x);
                pg8::EpiRes E{base, rep ? (float*)(F.ws + WS_REC) : F.out, D};
                pg8::gemm_phase<pg8::EpiRes, pg8::StaticOrder, true, true>(F.lds, g, S, E, tid);
            } else if (k == 5) {
                norm_phase<0>(F, F.out, F.inp(16) + l * D, HN, nullptr, nullptr, nullptr);
            } else if (k == 6) {
                pg8::Gemm g{(const pg8::bf16_t*)HN, (const pg8::bf16_t*)(wb + W_GU_OFF), M, 2 * DFF, D}; pg8::StaticOrder S; S.init(M, 2 * DFF, F.G, (int)blockIdx.x);
                pg8::EpiSwiGLU E{(pg8::bf16_t*)HFF, DFF};
                pg8::gemm_phase<pg8::EpiSwiGLU, pg8::StaticOrder, true, true>(F.lds, g, S, E, tid);
            } else {
                if (l + 1 < DEPTH) norm_phase<0>(F, F.out, F.inp(1) + (l + 1) * D, HN, F.inp(2) + (size_t)(l + 1) * D * DPROJ, BA, nullptr);
                else norm_phase<1>(F, F.out, F.inp(20), nullptr, nullptr, nullptr, F.out);
            }
        }
      }
        if (ph + 1 < hi) xcd_barrier(bar);
    }
}

#ifndef MK_SINGLE
#define MK_SINGLE 0
#endif

extern "C" void kernel_launch(void* const* d_in, const int* in_sizes, int n_in, void* d_out, int out_size, void* d_ws, size_t ws_size, hipStream_t stream) {
    static int grid = 0;
    if (grid == 0) {
        if (n_in != 21 || in_sizes[0] != M * D || out_size != M * D || ws_size < WS_END) { fprintf(stderr, "kernel_launch: unexpected shapes (n_in %d, in0 %d, out %d, ws %zu)\n", n_in, n_in > 0 ? in_sizes[0] : -1, out_size, ws_size); grid = -1; return; }
        int dev = 0, cus = 0, per_cu = 0;
        if (hipGetDevice(&dev) != hipSuccess || hipDeviceGetAttribute(&cus, hipDeviceAttributeMultiprocessorCount, dev) != hipSuccess) { grid = -1; return; }
        if (hipFuncSetAttribute((const void*)mk_fwd, hipFuncAttributeMaxDynamicSharedMemorySize, LDS_BYTES) != hipSuccess) { fprintf(stderr, "kernel_launch: hipFuncSetAttribute failed\n"); grid = -1; return; }
        if (hipOccupancyMaxActiveBlocksPerMultiprocessor(&per_cu, (const void*)mk_fwd, NWAVES * 64, LDS_BYTES) != hipSuccess || per_cu < 1) { fprintf(stderr, "kernel_launch: occupancy query says %d blocks per CU\n", per_cu); per_cu = 1; }
        (void)hipGetLastError();
        grid = cus;
        if (grid % 8 != 0 || grid < 32) fprintf(stderr, "kernel_launch: unexpected CU count %d\n", grid);
    }
    if (grid < 0) return;
    (void)hipMemsetAsync((char*)d_ws + WS_CTL, 0, CTL_ZERO_BYTES, stream);
    Args a{};
    for (int i = 0; i < 21; ++i) a.in[i] = (const float*)d_in[i];
    a.out = (float*)d_out; a.ws = (unsigned char*)d_ws;
#if MK_SINGLE
    a.ph_lo = 0; a.ph_hi = N_PHASES;
    hipLaunchKernelGGL(mk_fwd, dim3(grid), dim3(NWAVES * 64), LDS_BYTES, stream, a);
#else
    for (int ph = 0; ph < MK_PH_HI; ++ph) { a.ph_lo = ph; a.ph_hi = ph + 1; hipLaunchKernelGGL(mk_fwd, dim3(grid), dim3(NWAVES * 64), LDS_BYTES, stream, a); }
#endif
}
```

```cpp
#include <hip/hip_runtime.h>
#include <cstdio>
#include <cstdint>
#include <cmath>
#define MK_SINGLE 1
namespace pg8 {
#define PG8_LAS __attribute__((address_space(3)))
typedef unsigned short bf16_t;
typedef short bf16x8 __attribute__((ext_vector_type(8)));
typedef float f32x4 __attribute__((ext_vector_type(4)));
typedef unsigned u32x4 __attribute__((ext_vector_type(4)));
constexpr int BM = 256, BK = 64, HALF = 128, HTB = HALF * BK * 2  , STAGE_BYTES = 8 * HTB, NXCD = 8, WGM = 8;

__host__ __device__ __forceinline__ int lds_byte(int r, int c) { const int st = (r >> 4) * 2 + (c >> 5), rr = r & 15, cc = c & 31, ob = rr * 64 + cc * 2; return st * 1024 + (ob ^ (((ob >> 9) & 1) << 5)); }
__host__ __device__ __forceinline__ void stage_rc(int b, int& R, int& C) { const int st = b / 1024, sb = b % 1024, swz = sb ^ (((sb >> 9) & 1) << 5); R = (st >> 1) * 16 + swz / 64; C = (st & 1) * 32 + (swz % 64) / 2; }
__host__ __device__ __forceinline__ int perm32(int rho) { const int n = rho >> 4, i = rho & 15; return 8 * (i >> 2) + 4 * n + (i & 3); }

struct Unit { int pm, pn; };
struct Gemm { const bf16_t* A; const bf16_t* Bt; int M, N, K; };

struct StaticOrder {
    int nM, nN, nwg, G, c;
    __host__ __device__ void init(int M, int N, int G_, int c_) { nM = M / BM; nN = N / BM; nwg = nM * nN; G = G_; c = c_; }
    __host__ __device__ bool next(int i, Unit& u) const {
        const long L = (long)i * G + c; if (L >= nwg) return false;
        int wgid = (int)L; { const int q = nwg / NXCD, r = nwg % NXCD, xcd = wgid % NXCD, off = wgid / NXCD; wgid = (xcd < r ? xcd * (q + 1) : r * (q + 1) + (xcd - r) * q) + off; }
        const int nig = WGM * nN, gid = wgid / nig, fm = gid * WGM, gsz = (nM - fm) < WGM ? (nM - fm) : WGM;
        u.pm = fm + ((wgid % nig) % gsz); u.pn = (wgid % nig) / gsz; return true;
    }
    __device__ __forceinline__ void a_ready(const Unit&) const {}
    __device__ __forceinline__ void done(const Unit&) const {}
};

typedef __bf16 bf16v2p __attribute__((ext_vector_type(2))); typedef float f32v2p __attribute__((ext_vector_type(2)));
__device__ __forceinline__ unsigned cvt_pk_bf16(float lo, float hi) { const f32v2p v = {lo, hi}; return __builtin_bit_cast(unsigned, __builtin_convertvector(v, bf16v2p)); }
typedef float f32x2 __attribute__((ext_vector_type(2)));
__device__ __forceinline__ f32x2 gelu_pk(f32x2 v) {
    const f32x2 av = __builtin_elementwise_abs(v), d = av * 0.2316418882f + 1.0f;
    f32x2 t; t.x = __builtin_amdgcn_rcpf(d.x); t.y = __builtin_amdgcn_rcpf(d.y);
    f32x2 q = t * 0.5307027145f + (-0.7265760135f); q = q * t + 0.7107068705f; q = q * t + (-0.142248368f); q = q * t + 0.127414796f; q = q * t;
    const f32x2 s = (v * v) * (-0.72134752044f);
    f32x2 e; e.x = __builtin_amdgcn_exp2f(s.x); e.y = __builtin_amdgcn_exp2f(s.y);
    const f32x2 m = v * (q * e), r = v - m;
    f32x2 o; o.x = v.x < 0.f ? m.x : r.x; o.y = v.y < 0.f ? m.y : r.y; return o;
}

template <int ACT  > struct EpiBf16 {
    static constexpr bool PERM = true, AFTER_DRAIN = false; static_assert(ACT == 0 || ACT == 1, "EpiBf16: ACT is 0 (none) or 1 (gelu_pk)");
    bf16_t* O; int ldc; const float* bias; int split_cols; size_t split_stride; float scale0;
    __device__ __forceinline__ void operator()(const f32x4 (&acc)[2][2][4][2], const Unit& u, int wr, int wc, int fr, int fq) const {
        const int row0 = u.pm * BM + wr * 64 + fr; int colt = u.pn * BM; bf16_t* base = O;
        float sc = 1.f; if (split_cols) { const int t = colt / split_cols; base += (size_t)t * split_stride; colt -= t * split_cols; if (t == 0) sc = scale0; }
        const int col0 = colt + wc * 32 + 8 * fq, bcol0 = u.pn * BM + wc * 32 + 8 * fq;
        f32x4 bv[2][2];
#pragma unroll
        for (int bj = 0; bj < 2; ++bj)
#pragma unroll
            for (int n = 0; n < 2; ++n) bv[bj][n] = bias ? *(const f32x4*)(bias + bcol0 + bj * HALF + 4 * n) : (f32x4){0.f, 0.f, 0.f, 0.f};
#pragma unroll
        for (int ai = 0; ai < 2; ++ai)
#pragma unroll
            for (int m = 0; m < 4; ++m) { bf16_t* rowp = base + (size_t)(row0 + ai * HALF + m * 16) * ldc + col0;
#pragma unroll
                for (int bj = 0; bj < 2; ++bj) { f32x4 v0 = acc[ai][bj][m][0] + bv[bj][0], v1 = acc[ai][bj][m][1] + bv[bj][1];
                    if (ACT == 1) { f32x2 a = gelu_pk((f32x2){v0[0], v0[1]}), b = gelu_pk((f32x2){v0[2], v0[3]}), c = gelu_pk((f32x2){v1[0], v1[1]}), d = gelu_pk((f32x2){v1[2], v1[3]});
                        v0 = (f32x4){a.x, a.y, b.x, b.y}; v1 = (f32x4){c.x, c.y, d.x, d.y}; }
                    v0 = v0 * sc; v1 = v1 * sc; u32x4 w; w.x = cvt_pk_bf16(v0[0], v0[1]); w.y = cvt_pk_bf16(v0[2], v0[3]); w.z = cvt_pk_bf16(v1[0], v1[1]); w.w = cvt_pk_bf16(v1[2], v1[3]);
                    *(u32x4*)(rowp + bj * HALF) = w; } }
    }
};
struct EpiRes {
    static constexpr bool PERM = false, AFTER_DRAIN = false;
    const float* base; float* out; int ldc; int noread;
    __device__ __forceinline__ void operator()(const f32x4 (&acc)[2][2][4][2], const Unit& u, int wr, int wc, int fr, int fq) const {
        const bool hi = fr >= 8;
        const int row0 = u.pm * BM + wr * 64 + (fr & 7), col0 = u.pn * BM + wc * 32 + 4 * fq + (hi ? 16 : 0);
#pragma unroll
        for (int ai = 0; ai < 2; ++ai)
#pragma unroll
            for (int m = 0; m < 4; ++m) { const size_t off = (size_t)(row0 + ai * HALF + m * 16) * ldc + col0;
#pragma unroll
                for (int bj = 0; bj < 2; ++bj) {
                    const f32x4 v0 = acc[ai][bj][m][0], v1 = acc[ai][bj][m][1];
                    f32x4 dA, dB;
#define EPI_XCH(e_) { const float s_ = hi ? v0[e_] : v1[e_]; const float r_ = __builtin_bit_cast(float, __builtin_amdgcn_update_dpp(0, __builtin_bit_cast(int, s_), 0x128  , 0xF, 0xF, false)); \
                        dA[e_] = hi ? r_ : v0[e_]; dB[e_] = hi ? v1[e_] : r_; }
                    EPI_XCH(0) EPI_XCH(1) EPI_XCH(2) EPI_XCH(3)
#undef EPI_XCH
                    const size_t oA = off + bj * HALF, oB = oA + (size_t)8 * ldc;
                    f32x4 bA = (f32x4){0.f, 0.f, 0.f, 0.f}, bB = bA; if (!noread) { bA = *(const f32x4*)(base + oA); bB = *(const f32x4*)(base + oB); }
                    *(f32x4*)(out + oA) = bA + dA; *(f32x4*)(out + oB) = bB + dB; } }
    }
};
struct EpiSwiGLU {
    static constexpr bool PERM = true, AFTER_DRAIN = false;
    bf16_t* O; int ldo;
    __device__ __forceinline__ void operator()(const f32x4 (&acc)[2][2][4][2], const Unit& u, int wr, int wc, int fr, int fq) const {
        const int row0 = u.pm * BM + wr * 64 + fr, col0 = u.pn * HALF + wc * 32 + 8 * fq;
#pragma unroll
        for (int ai = 0; ai < 2; ++ai)
#pragma unroll
            for (int m = 0; m < 4; ++m) { bf16_t* rowp = O + (size_t)(row0 + ai * HALF + m * 16) * ldo + col0;
                float r[8];
#pragma unroll
                for (int n = 0; n < 2; ++n)
#pragma unroll
                    for (int e = 0; e < 4; ++e) { const float g = acc[ai][0][m][n][e], up = acc[ai][1][m][n][e]; r[4 * n + e] = g * __builtin_amdgcn_rcpf(1.0f + __expf(-g)) * up; }
                u32x4 w; w.x = cvt_pk_bf16(r[0], r[1]); w.y = cvt_pk_bf16(r[2], r[3]); w.z = cvt_pk_bf16(r[4], r[5]); w.w = cvt_pk_bf16(r[6], r[7]);
                *(u32x4*)rowp = w; }
    }
};
struct EpiBf16FL {
    static constexpr bool PERM = true, AFTER_DRAIN = false;
    bf16_t* O; int ldc;
    __device__ __forceinline__ void operator()(const f32x4 (&acc)[2][2][4][2], const Unit& u, int wr, int wc, int fr, int fq) const {
        const bool hi = fr >= 8;
        const int row0 = u.pm * BM + wr * 64 + (fr & 7), col0 = u.pn * BM + wc * 64 + 8 * fq + (hi ? 32 : 0);
#pragma unroll
        for (int ai = 0; ai < 2; ++ai)
#pragma unroll
            for (int m = 0; m < 4; ++m) { bf16_t* rowp = O + (size_t)(row0 + ai * HALF + m * 16) * ldc + col0;
                unsigned w0[4], w1[4], dA[4], dB[4];
#pragma unroll
                for (int q = 0; q < 2; ++q) { w0[2 * q] = cvt_pk_bf16(acc[ai][0][m][q][0], acc[ai][0][m][q][1]); w0[2 * q + 1] = cvt_pk_bf16(acc[ai][0][m][q][2], acc[ai][0][m][q][3]);
                                              w1[2 * q] = cvt_pk_bf16(acc[ai][1][m][q][0], acc[ai][1][m][q][1]); w1[2 * q + 1] = cvt_pk_bf16(acc[ai][1][m][q][2], acc[ai][1][m][q][3]); }
#define EPI_XCH(e_) { const unsigned s_ = hi ? w0[e_] : w1[e_]; const unsigned r_ = (unsigned)__builtin_amdgcn_update_dpp(0, (int)s_, 0x128  , 0xF, 0xF, false); dA[e_] = hi ? r_ : w0[e_]; dB[e_] = hi ? w1[e_] : r_; }
                EPI_XCH(0) EPI_XCH(1) EPI_XCH(2) EPI_XCH(3)
#undef EPI_XCH
                *(u32x4*)rowp = (u32x4){dA[0], dA[1], dA[2], dA[3]}; *(u32x4*)(rowp + (size_t)8 * ldc) = (u32x4){dB[0], dB[1], dB[2], dB[3]}; }
    }
};
template <class Epi, class Sched, bool ALIGN_EPI = false, bool SP2 = false>
__device__ __forceinline__ void gemm_phase(PG8_LAS unsigned char* lds, const Gemm g, const Sched& S, const Epi& E, const int tid) {
    const int wid = __builtin_amdgcn_readfirstlane(tid >> 6), lane = tid & 63, wr = wid >> 2, wc = wid & 3, fr = lane & 15, fq = lane >> 4;
    const int K = g.K, nt = K / BK;
    unsigned voffA[2], voffB[2];
#pragma unroll
    for (int i = 0; i < 2; ++i) { int R, C; stage_rc(tid * 16 + i * 8192, R, C); const int Rb = Epi::PERM ? ((R & ~31) + perm32(R & 31)) : R;
        voffA[i] = (unsigned)(R * K + C) * 2u; voffB[i] = (unsigned)(Rb * K + C) * 2u; }
    const size_t kstep = (size_t)(BK * 2);
    const size_t hstep = (size_t)HALF * K * 2;
    const size_t tstep = 2 * hstep;
    const unsigned ldsw = (unsigned)wid * 1024u;
    const int aoff = lds_byte(wr * 64 + fr, fq * 8), boff = lds_byte(wc * 32 + fr, fq * 8);
#define PG8_SA(b, h) (((b) * 2 + (h)) * HTB)
#define PG8_SB(b, h) ((4 + (b) * 2 + (h)) * HTB)
#define PG8_STAGE(bufoff, gbase, voff) do { _Pragma("unroll") for (int _i = 0; _i < 2; ++_i) \
        __builtin_amdgcn_global_load_lds((const unsigned*)((const char*)(gbase) + (voff)[_i]), (PG8_LAS unsigned*)(lds + (bufoff) + ldsw + _i * 8192), 16, 0, 0); } while (0)
#define PG8_LDA(dst, b, h) do { _Pragma("unroll") for (int m = 0; m < 4; ++m) _Pragma("unroll") for (int k = 0; k < 2; ++k) dst[m][k] = *(const PG8_LAS bf16x8*)(lds + PG8_SA(b, h) + aoff + m * 2048 + k * 1024); } while (0)
#define PG8_LDB(dst, b, h) do { _Pragma("unroll") for (int n = 0; n < 2; ++n) _Pragma("unroll") for (int k = 0; k < 2; ++k) dst[n][k] = *(const PG8_LAS bf16x8*)(lds + PG8_SB(b, h) + boff + n * 2048 + k * 1024); } while (0)
#define PG8_MMA(ai, bj, At, Bt) do { __builtin_amdgcn_s_setprio(1); _Pragma("unroll") for (int m = 0; m < 4; ++m) _Pragma("unroll") for (int n = 0; n < 2; ++n) _Pragma("unroll") for (int k = 0; k < 2; ++k) \
        acc[ai][bj][m][n] = __builtin_amdgcn_mfma_f32_16x16x32_bf16(Bt[n][k], At[m][k], acc[ai][bj][m][n], 0, 0, 0); __builtin_amdgcn_s_setprio(0); } while (0)
#define PG8_WAIT_V(n) asm volatile("s_waitcnt vmcnt(" #n ")" ::: "memory")
#define PG8_WAIT_L(n) asm volatile("s_waitcnt lgkmcnt(" #n ")" ::: "memory")
#define PG8_BAR __builtin_amdgcn_s_barrier()
#define PG8_SCHED __builtin_amdgcn_sched_barrier(0)
    Unit cur, nxt; int ui = 0;
    if (!S.next(0, cur)) return;
    f32x4 acc[2][2][4][2];
#pragma unroll
    for (int a = 0; a < 2; ++a)
#pragma unroll
        for (int b = 0; b < 2; ++b)
#pragma unroll
            for (int m = 0; m < 4; ++m)
#pragma unroll
                for (int n = 0; n < 2; ++n) acc[a][b][m][n] = (f32x4){0.f, 0.f, 0.f, 0.f};
    bf16x8 At[4][2], B0[2][2], B1[2][2];
    const char* cA = (const char*)g.A + (size_t)cur.pm * tstep; const char* cB = (const char*)g.Bt + (size_t)cur.pn * tstep;
    S.a_ready(cur);
    if constexpr (SP2) {
        PG8_STAGE(PG8_SB(0, 0), cB, voffB); PG8_STAGE(PG8_SB(0, 1), cB + hstep, voffB); PG8_STAGE(PG8_SA(0, 0), cA, voffA); PG8_STAGE(PG8_SA(0, 1), cA + hstep, voffA);
        if (wr == 1) PG8_BAR;
        PG8_WAIT_V(2); PG8_BAR;
        PG8_STAGE(PG8_SB(1, 0), cB + kstep, voffB); PG8_STAGE(PG8_SA(1, 0), cA + kstep, voffA); PG8_STAGE(PG8_SB(1, 1), cB + hstep + kstep, voffB);
        PG8_WAIT_V(6); PG8_BAR;
    } else {
        PG8_STAGE(PG8_SB(0, 0), cB, voffB); PG8_STAGE(PG8_SA(0, 0), cA, voffA); PG8_STAGE(PG8_SB(0, 1), cB + hstep, voffB); PG8_STAGE(PG8_SA(0, 1), cA + hstep, voffA);
        if (wr == 1) PG8_BAR;
        PG8_WAIT_V(4); PG8_BAR;
        PG8_STAGE(PG8_SB(1, 0), cB + kstep, voffB); PG8_STAGE(PG8_SA(1, 0), cA + kstep, voffA); PG8_STAGE(PG8_SB(1, 1), cB + hstep + kstep, voffB);
        PG8_WAIT_V(6); PG8_BAR;
    }
    for (;;) {
        const bool has_next = S.next(ui + 1, nxt);
        const char* nA = has_next ? (const char*)g.A + (size_t)nxt.pm * tstep : cA; const char* nB = has_next ? (const char*)g.Bt + (size_t)nxt.pn * tstep : cB;
        for (int t = 0; t < nt; t += 2) {
            const bool last = (t == nt - 2);
            const char* a1 = cA + (size_t)(t + 1) * kstep;
            const char* a2 = last ? nA : cA + (size_t)(t + 2) * kstep; const char* b2 = last ? nB : cB + (size_t)(t + 2) * kstep;
            const char* a3 = a2 + kstep; const char* b3 = b2 + kstep;
            if (last && has_next) S.a_ready(nxt);
            if constexpr (SP2) {
            PG8_LDB(B0, 0, 0); PG8_LDB(B1, 0, 1); PG8_SCHED; PG8_LDA(At, 0, 0); PG8_STAGE(PG8_SA(1, 1), a1 + hstep, voffA);
            PG8_WAIT_V(8); PG8_WAIT_L(0); PG8_BAR; PG8_MMA(0, 0, At, B0); PG8_MMA(0, 1, At, B1); PG8_BAR; PG8_SCHED;
            PG8_LDA(At, 0, 1); PG8_STAGE(PG8_SB(0, 0), b2, voffB); PG8_STAGE(PG8_SB(0, 1), b2 + hstep, voffB); PG8_STAGE(PG8_SA(0, 0), a2, voffA);
            PG8_WAIT_V(8); PG8_WAIT_L(0); PG8_BAR; PG8_MMA(1, 0, At, B0); PG8_MMA(1, 1, At, B1); PG8_BAR; PG8_SCHED;
            PG8_LDB(B0, 1, 0); PG8_LDB(B1, 1, 1); PG8_SCHED; PG8_LDA(At, 1, 0); PG8_STAGE(PG8_SA(0, 1), a2 + hstep, voffA);
            PG8_WAIT_V(8); PG8_WAIT_L(0); PG8_BAR; PG8_MMA(0, 0, At, B0); PG8_MMA(0, 1, At, B1); PG8_BAR; PG8_SCHED;
            PG8_LDA(At, 1, 1); PG8_STAGE(PG8_SB(1, 0), b3, voffB); PG8_STAGE(PG8_SB(1, 1), b3 + hstep, voffB); PG8_STAGE(PG8_SA(1, 0), a3, voffA);
            PG8_WAIT_V(8); PG8_WAIT_L(0); PG8_BAR; PG8_MMA(1, 0, At, B0); PG8_MMA(1, 1, At, B1); PG8_BAR; PG8_SCHED;
            } else {
            PG8_LDB(B0, 0, 0); PG8_SCHED; PG8_LDA(At, 0, 0); PG8_STAGE(PG8_SA(1, 1), a1 + hstep, voffA);
            PG8_WAIT_L(8); PG8_BAR; PG8_WAIT_L(0); PG8_MMA(0, 0, At, B0); PG8_BAR; PG8_SCHED;
            PG8_LDB(B1, 0, 1); PG8_STAGE(PG8_SB(0, 0), b2, voffB);
            PG8_BAR; PG8_WAIT_L(0); PG8_MMA(0, 1, At, B1); PG8_BAR;
            PG8_LDA(At, 0, 1); PG8_STAGE(PG8_SA(0, 0), a2, voffA);
            PG8_BAR; PG8_WAIT_L(0); PG8_MMA(1, 0, At, B0); PG8_BAR; PG8_SCHED;
            PG8_STAGE(PG8_SB(0, 1), b2 + hstep, voffB);
            PG8_WAIT_V(6); PG8_BAR; PG8_MMA(1, 1, At, B1); PG8_BAR;
            PG8_LDB(B0, 1, 0); PG8_SCHED; PG8_LDA(At, 1, 0); PG8_STAGE(PG8_SA(0, 1), a2 + hstep, voffA);
            PG8_WAIT_L(8); PG8_BAR; PG8_WAIT_L(0); PG8_MMA(0, 0, At, B0); PG8_BAR; PG8_SCHED;
            PG8_LDB(B1, 1, 1); PG8_STAGE(PG8_SB(1, 0), b3, voffB);
            PG8_BAR; PG8_WAIT_L(0); PG8_MMA(0, 1, At, B1); PG8_BAR;
            PG8_LDA(At, 1, 1); PG8_STAGE(PG8_SA(1, 0), a3, voffA);
            PG8_BAR; PG8_WAIT_L(0); PG8_MMA(1, 0, At, B0); PG8_BAR; PG8_SCHED;
            PG8_STAGE(PG8_SB(1, 1), b3 + hstep, voffB);
            PG8_WAIT_V(6); PG8_BAR; PG8_MMA(1, 1, At, B1); PG8_BAR;
            }
        }
        if constexpr (ALIGN_EPI) { if (wr == 0) PG8_BAR; }
        if constexpr (!Epi::AFTER_DRAIN) { E(acc, cur, wr, wc, fr, fq); S.done(cur); }
        if (!has_next) break;
#pragma unroll
        for (int a = 0; a < 2; ++a)
#pragma unroll
            for (int b = 0; b < 2; ++b)
#pragma unroll
                for (int m = 0; m < 4; ++m)
#pragma unroll
                    for (int n = 0; n < 2; ++n) acc[a][b][m][n] = (f32x4){0.f, 0.f, 0.f, 0.f};
        cur = nxt; cA = nA; cB = nB; ++ui;
        if constexpr (ALIGN_EPI) { if (wr == 1) PG8_BAR; }
    }
    PG8_WAIT_V(0);
    if constexpr (!ALIGN_EPI) { if (wr == 0) PG8_BAR; }
    PG8_BAR;
    if constexpr (Epi::AFTER_DRAIN) { E.fused(acc, cur, wr, wc, fr, fq, lds, wid, lane); S.done(cur); }
#undef PG8_SA
#undef PG8_SB
#undef PG8_STAGE
#undef PG8_LDA
#undef PG8_LDB
#undef PG8_MMA
#undef PG8_WAIT_V
#undef PG8_WAIT_L
#undef PG8_BAR
#undef PG8_SCHED
}
}
#define GAS __attribute__((address_space(1)))
#define LAS __attribute__((address_space(3)))
typedef unsigned short bf16;
typedef unsigned v4u __attribute__((ext_vector_type(4)));
typedef float f32x4 __attribute__((ext_vector_type(4)));
typedef short bf16x8 __attribute__((ext_vector_type(8)));
typedef GAS unsigned gu32;
typedef GAS unsigned long long gu64;
#define RLX_AGENT __ATOMIC_RELAXED, __HIP_MEMORY_SCOPE_AGENT
#define LDS_WAIT() asm volatile("s_waitcnt lgkmcnt(0)" ::: "memory")
#define VM_WAIT() asm volatile("s_waitcnt vmcnt(0)" ::: "memory")
__device__ __forceinline__ unsigned long long rt() { return __builtin_amdgcn_s_memrealtime(); }
__device__ __forceinline__ unsigned f2bf(float f) { unsigned u = __builtin_bit_cast(unsigned, f); return (u + 0x7fffu + ((u >> 16) & 1u)) >> 16; }
typedef __bf16 bf16v2q __attribute__((ext_vector_type(2))); typedef float f32v2q __attribute__((ext_vector_type(2)));
__device__ __forceinline__ unsigned pk2(float lo, float hi) { const f32v2q v = {lo, hi}; return __builtin_bit_cast(unsigned, __builtin_convertvector(v, bf16v2q)); }

#define XB_TMO      128
#define XB_XCNT(j)  (256  + 64 * (j))
#define XB_XSUB(j)  (1280 + 64 * (j))
#define XB_XGEN(j)  (2304 + 64 * (j))
#define XB_TOP      3328
#define XB_TOPGEN   3392
#define XCD_BAR_WORDS 3456
#define XB_SPIN_CAP (1u << 18)

__device__ __forceinline__ unsigned xb_ld(unsigned* p)              { return __hip_atomic_load(p, __ATOMIC_RELAXED, __HIP_MEMORY_SCOPE_AGENT); }
__device__ __forceinline__ unsigned xb_add(unsigned* p, unsigned v) { return __hip_atomic_fetch_add(p, v, __ATOMIC_RELAXED, __HIP_MEMORY_SCOPE_AGENT); }
__device__ __forceinline__ unsigned xb_xcc_id() { return (unsigned)__builtin_amdgcn_s_getreg((3 << 11) | 20) & 0xFu; }
#define XB_SPIN(cond, bar) do { unsigned _sp = 0; while (cond) { __builtin_amdgcn_s_sleep(1); \
    if ((++_sp & 255u) == 0u) { if (xb_ld(&(bar)[XB_TMO])) break; if (_sp > XB_SPIN_CAP) { atomicAdd(&(bar)[XB_TMO], 1u); break; } } } } while (0)

struct XcdBarrier {
    unsigned* bar; unsigned x;
    volatile LAS unsigned* st;
};

__device__ __forceinline__ XcdBarrier xcd_barrier_post(unsigned* bar, volatile LAS unsigned* st) {
    XcdBarrier b; b.bar = bar; b.x = xb_xcc_id(); b.st = st;
    if (threadIdx.x == 0) (void)xb_add(&bar[XB_XCNT(b.x)], 1u);
    return b;
}
__device__ __forceinline__ void xcd_barrier_complete(unsigned* bar, unsigned x, unsigned& nloc, unsigned& nx) {
    const unsigned G = gridDim.x * gridDim.y * gridDim.z;
    unsigned sum, cnt, mine, sp = 0u;
    for (;;) {
        sum = 0u; cnt = 0u; mine = 0u;
#pragma unroll
        for (unsigned j = 0; j < 16; ++j) { const unsigned c = xb_ld(&bar[XB_XCNT(j)]); sum += c; cnt += (c > 0u) ? 1u : 0u; mine = (j == x) ? c : mine; }
        if (sum == G) break;
        __builtin_amdgcn_s_sleep(1);
        if ((++sp & 255u) == 0u) { if (xb_ld(&bar[XB_TMO])) break; if (sp > XB_SPIN_CAP) { atomicAdd(&bar[XB_TMO], 1u); break; } }
    }
    nloc = mine > 0u ? mine : 1u; nx = cnt > 0u ? cnt : 1u;
}

__device__ __forceinline__ void xcd_barrier(const XcdBarrier& b) {
    asm volatile("s_waitcnt vmcnt(0)" ::: "memory");
    __syncthreads();
    if (threadIdx.x == 0) {
        unsigned* bar = b.bar;
        __builtin_amdgcn_s_waitcnt(0);
        unsigned nloc = b.st[0], nx = b.st[1];
        if (nloc == 0u) { xcd_barrier_complete(bar, b.x, nloc, nx); b.st[0] = nloc; b.st[1] = nx; }
        const unsigned old = xb_add(&bar[XB_XSUB(b.x)], 1u);
        const unsigned gen = old / nloc;
        if (old + 1u == (gen + 1u) * nloc) {
            __builtin_amdgcn_fence(__ATOMIC_RELEASE, "agent");
            asm volatile("s_waitcnt vmcnt(0)" ::: "memory");
            const unsigned og = xb_add(&bar[XB_TOP], 1u);
            const unsigned tg = og / nx;
            if (og + 1u == (tg + 1u) * nx) xb_add(&bar[XB_TOPGEN], 1u);
            else XB_SPIN(xb_ld(&bar[XB_TOPGEN]) == tg, bar);
            __builtin_amdgcn_fence(__ATOMIC_ACQUIRE, "agent");
            xb_add(&bar[XB_XGEN(b.x)], 1u);
            asm volatile("s_waitcnt vmcnt(0)" ::: "memory");
        } else {
            XB_SPIN(xb_ld(&bar[XB_XGEN(b.x)]) == gen, bar);
            __builtin_amdgcn_fence(__ATOMIC_ACQUIRE, "agent");
            asm volatile("s_waitcnt vmcnt(0)" ::: "memory");
        }
    }
    __syncthreads();
}

#ifndef MK_PH_HI
#define MK_PH_HI 17
#endif
#ifndef MK_SUB
#define MK_SUB 3
#endif
#ifndef MK_DNSTEP
#define MK_DNSTEP 9
#endif
#ifndef MK_W6
#define MK_W6 1
#endif
#ifndef MK_CVSTEP
#define MK_CVSTEP 9
#endif
#ifndef MK_REP
#define MK_REP 0
#endif
#ifndef MK_REPSUB
#define MK_REPSUB 3
#endif
#ifndef MK_NOREAD
#define MK_NOREAD 0
#endif
#ifndef MK_STAG_A
#define MK_STAG_A 0
#endif
#ifndef MK_STAG_O
#define MK_STAG_O 0
#endif
#ifndef MK_STAG_GU
#define MK_STAG_GU 0
#endif
#ifndef MK_STAG_D
#define MK_STAG_D 0
#endif
#ifndef MK_REPSUB2
#define MK_REPSUB2 3
#endif
#ifndef MK_XBAR
#define MK_XBAR 0
#endif
#ifndef MK_NEG
#define MK_NEG 1
#endif

constexpr int NWAVES = 8;
constexpr int D = 1024, BATCH = 8, SEQ = 4096, M = BATCH * SEQ, DEPTH = 2;
constexpr int DFF = 2816, DPROJ = 3080, NP = 3072;
constexpr int CVK = 31, DNCONV = 4;
constexpr float EPS = 1e-6f;
constexpr int NCHUNK = BATCH * 4 * 64;

constexpr size_t MiB = 1u << 20;
constexpr size_t WS_CTL = 0, CTL_ZERO_BYTES = 64 * 1024;
constexpr size_t WS_W = 2 * MiB;
constexpr size_t W_IN_OFF = 0, W_O_OFF = 6 * MiB, W_GU_OFF = 8 * MiB, W_D_OFF = 19 * MiB, W_LAYER = 25 * MiB;
constexpr size_t WS_BA = 53 * MiB;
constexpr size_t WS_CD = 54 * MiB + 512 * 1024;
constexpr size_t WS_HN = 64 * MiB;
constexpr size_t WS_P = 128 * MiB;
constexpr size_t WS_REC = 320 * MiB;
constexpr size_t REC_BYTES = 74752, REC_W = 0, REC_QD = 16384, REC_QK = 32768, REC_KDT = 40960, REC_U = 57344, REC_CD = 73728;
constexpr size_t WS_O = 468 * MiB, WS_END = 500 * MiB;
constexpr int CW_BAR = 4096, CW_FLAGS = 8192;

constexpr int RING_BYTES = 131072;
constexpr int MISC_OFF = 163840 - 256;
constexpr int LDS_BYTES = 163840;

__device__ __forceinline__ float bf2f(unsigned short b) { return __uint_as_float(((unsigned)b) << 16); }
#define dpp_f(old, v, ctrl, row_mask, bound) __builtin_bit_cast(float, __builtin_amdgcn_update_dpp(__builtin_bit_cast(int, (float)(old)), __builtin_bit_cast(int, (float)(v)), (ctrl), (row_mask), 0xF, (bound)))
__device__ __forceinline__ float wave_sum(float v) {
    v += dpp_f(0.f, v, 0xB1, 0xF, true);
    v += dpp_f(0.f, v, 0x4E, 0xF, true);
    v += dpp_f(0.f, v, 0x141, 0xF, true);
    v += dpp_f(0.f, v, 0x140, 0xF, true);
    v += dpp_f(0.f, v, 0x142, 0xA, false);
    v += dpp_f(0.f, v, 0x143, 0xC, false);
    return __builtin_bit_cast(float, __builtin_amdgcn_readlane(__builtin_bit_cast(int, v), 63));
}
__device__ __forceinline__ float sigmoidf_(float x) { return __builtin_amdgcn_rcpf(1.0f + __builtin_amdgcn_exp2f(x * -1.4426950408889634f)); }
__device__ __forceinline__ float gelu_erf(float x) { return 0.5f * x * (1.0f + erff(x * 0.70710678118654752f)); }
typedef float f32x16 __attribute__((ext_vector_type(16)));
typedef unsigned u32x2 __attribute__((ext_vector_type(2)));
#define MFMA32(a, b, c) __builtin_amdgcn_mfma_f32_32x32x16_bf16((a), (b), (c), 0, 0, 0)
__device__ __forceinline__ int crow(int reg, int hh) { return (reg & 3) + 8 * (reg >> 2) + 4 * hh; }

#define AS4 __attribute__((address_space(4)))
struct Frame {
    LAS unsigned char* lds;
    int tid, lane, wave, vcu, G;
    const AS4 unsigned char* kp;
    float* out; unsigned char* ws;
    __device__ __forceinline__ const float* inp(int k) const { return *(const float* const AS4*)(kp + 8 * k); }
};

__device__ __forceinline__ void tr_item(const float* W, int ldw, int K, bf16* WT, int kb, int nsrc0, int ndst0, LAS float* scr, int lane) {
    const int k0 = 64 * kb;
#pragma unroll 8
    for (int i = 0; i < 32; ++i) { const int kk = 2 * i + (lane >> 5); scr[kk * 33 + (lane & 31)] = W[(size_t)(k0 + kk) * ldw + nsrc0 + (lane & 31)]; }
    LDS_WAIT(); asm volatile("" ::: "memory");
    const int c = lane & 7;
#pragma unroll
    for (int j = 0; j < 4; ++j) { const int n = (lane >> 3) + 8 * j; const LAS float* s = scr + (8 * c) * 33 + n;
        v4u o; o.x = pk2(s[0 * 33], s[1 * 33]); o.y = pk2(s[2 * 33], s[3 * 33]); o.z = pk2(s[4 * 33], s[5 * 33]); o.w = pk2(s[6 * 33], s[7 * 33]);
        *(GAS v4u*)(WT + (size_t)(ndst0 + n) * K + k0 + 8 * c) = o; }
    LDS_WAIT(); asm volatile("" ::: "memory");
}
__device__ __forceinline__ void weights_phase(Frame& F) {
    LAS float* scr = (LAS float*)(F.lds + F.wave * 16384);
    const int gw = F.vcu * NWAVES + F.wave, NGW = F.G * NWAVES;
    constexpr int I_IN = 16 * 96, I_O = 16 * 32, I_GU = 16 * 176, I_D = 44 * 32, I_L = I_IN + I_O + I_GU + I_D;
    for (int it = gw; it < DEPTH * I_L; it += NGW) {
        const int l = it / I_L; int r = it % I_L;
        bf16* wb = (bf16*)(F.ws + WS_W + (size_t)l * W_LAYER);
        if (r < I_IN) { const int kb = r / 96, nb = r % 96, q8 = nb & 7, nsrc = (nb & ~7) + (q8 & 3) * 2 + (q8 >> 2);
            tr_item(F.inp(2) + (size_t)l * D * DPROJ, DPROJ, D, (bf16*)((unsigned char*)wb + W_IN_OFF), kb, 32 * nsrc, 32 * nb, scr, F.lane); continue; } r -= I_IN;
        if (r < I_O) { const int kb = r / 32, nb = r % 32; tr_item(F.inp(15) + (size_t)l * D * D, D, D, (bf16*)((unsigned char*)wb + W_O_OFF), kb, 32 * nb, 32 * nb, scr, F.lane); continue; } r -= I_O;
        if (r < I_GU) { const int kb = r / 176, nb = r % 176; const int drow = 32 * nb, tile = drow >> 8, within = drow & 255;
            const float* src = (within < 128 ? F.inp(17) : F.inp(18)) + (size_t)l * D * DFF;
            tr_item(src, DFF, D, (bf16*)((unsigned char*)wb + W_GU_OFF), kb, tile * 128 + (within & 127), drow, scr, F.lane); continue; } r -= I_GU;
        { const int kb = r / 32, nb = r % 32; tr_item(F.inp(19) + (size_t)l * DFF * D, D, DFF, (bf16*)((unsigned char*)wb + W_D_OFF), kb, 32 * nb, 32 * nb, scr, F.lane); }
    }
}

template <int MODE>
__device__ __forceinline__ void norm_phase(Frame& F, const float* xin, const float* g, bf16* hn, const float* wlog, float* ba, float* fout) {
    const int gw = F.vcu * NWAVES + F.wave, NGW = F.G * NWAVES;
    f32x4 gv[4];
#pragma unroll
    for (int j = 0; j < 4; ++j) gv[j] = ((const f32x4*)g)[64 * j + F.lane];
    LAS float* sW = (LAS float*)F.lds;
    if (MODE == 0 && wlog) {
        __syncthreads();
#pragma unroll
        for (int q = 0; q < 2; ++q) { const int k = 2 * F.tid + q; const f32x4* wr = (const f32x4*)(wlog + (size_t)k * DPROJ + NP); const f32x4 w0 = wr[0], w1 = wr[1];
            sW[0 * 1024 + k] = w0.x; sW[1 * 1024 + k] = w0.y; sW[2 * 1024 + k] = w0.z; sW[3 * 1024 + k] = w0.w; sW[4 * 1024 + k] = w1.x; sW[5 * 1024 + k] = w1.y; sW[6 * 1024 + k] = w1.z; sW[7 * 1024 + k] = w1.w; }
        __syncthreads();
    }
    for (int m = gw; m < M; m += NGW) {
        const f32x4* xr = (const f32x4*)(xin + (size_t)m * D) + F.lane;
        f32x4 v[4]; float ss = 0.f;
#pragma unroll
        for (int j = 0; j < 4; ++j) { v[j] = xr[64 * j]; ss += (v[j].x * v[j].x + v[j].y * v[j].y) + (v[j].z * v[j].z + v[j].w * v[j].w); }
        const float rstd = 1.0f / sqrtf(wave_sum(ss) * (1.0f / D) + EPS);
#pragma unroll
        for (int j = 0; j < 4; ++j) v[j] = v[j] * rstd * gv[j];
        if (MODE == 0) {
            unsigned long long* o8 = (unsigned long long*)(hn + (size_t)m * D) + F.lane;
#pragma unroll
            for (int j = 0; j < 4; ++j) o8[64 * j] = (unsigned long long)pk2(v[j].x, v[j].y) | ((unsigned long long)pk2(v[j].z, v[j].w) << 32);
            if (wlog) {
                float acc[8];
#pragma unroll
                for (int t = 0; t < 8; ++t) { acc[t] = 0.f;
#pragma unroll
                    for (int j = 0; j < 4; ++j) { const f32x4 w = *(const LAS f32x4*)(sW + t * 1024 + 256 * j + 4 * F.lane); acc[t] += (v[j].x * w.x + v[j].y * w.y) + (v[j].z * w.z + v[j].w * w.w); } }
#pragma unroll
                for (int t = 0; t < 8; ++t) acc[t] = wave_sum(acc[t]);
                if (F.lane == 0) { *(f32x4*)(ba + (size_t)m * 8) = (f32x4){acc[0], acc[1], acc[2], acc[3]}; *(f32x4*)(ba + (size_t)m * 8 + 4) = (f32x4){acc[4], acc[5], acc[6], acc[7]}; }
            }
        } else {
            f32x4* o = (f32x4*)(fout + (size_t)m * D) + F.lane;
#pragma unroll
            for (int j = 0; j < 4; ++j) o[64 * j] = v[j];
        }
    }
}

__device__ __forceinline__ float gelu_as(float v) {
    const float d = fabsf(v) * 0.2316418882f + 1.0f, t = __builtin_amdgcn_rcpf(d);
    float q = t * 0.5307027145f + (-0.7265760135f); q = q * t + 0.7107068705f; q = q * t + (-0.142248368f); q = q * t + 0.127414796f; q = q * t;
    const float e = __builtin_amdgcn_exp2f((v * v) * (-0.72134752044f));
    const float m = v * (q * e), r = v - m;
    return v < 0.f ? m : r;
}
typedef __bf16 bf16v8m_t __attribute__((ext_vector_type(8)));
typedef float f32x8m_t __attribute__((ext_vector_type(8)));
__device__ __forceinline__ bf16x8 cvt8(float a0, float a1, float a2, float a3, float a4, float a5, float a6, float a7) { const f32x8m_t v = {a0, a1, a2, a3, a4, a5, a6, a7}; return __builtin_bit_cast(bf16x8, __builtin_convertvector(v, bf16v8m_t)); }
__device__ __forceinline__ void gmlp_unit(Frame& F, int l, int unit, const bf16* P, bf16* MIX) {
    const int m0 = unit * 128;
    LAS bf16* sVt = (LAS bf16*)F.lds;
    {
        float lg[4], lb[4];
#pragma unroll
        for (int e = 0; e < 4; ++e) { lg[e] = F.inp(3)[l * 256 + F.lane + 64 * e]; lb[e] = F.inp(4)[l * 256 + F.lane + 64 * e]; }
        unsigned short rv[16][4];
#pragma unroll
        for (int jj = 0; jj < 16; ++jj) { const bf16* pr = P + (size_t)(m0 + 16 * F.wave + jj) * NP + 256 + F.lane;
#pragma unroll
            for (int e = 0; e < 4; ++e) rv[jj][e] = pr[64 * e]; }
#pragma unroll
        for (int jj = 0; jj < 16; ++jj) {
            const int j = 16 * F.wave + jj;
            float v[4];
#pragma unroll
            for (int e = 0; e < 4; ++e) v[e] = gelu_as(bf2f(rv[jj][e]));
            const float mean = wave_sum((v[0] + v[1]) + (v[2] + v[3])) * (1.0f / 256.0f);
#pragma unroll
            for (int e = 0; e < 4; ++e) v[e] -= mean;
            const float var = wave_sum((v[0] * v[0] + v[1] * v[1]) + (v[2] * v[2] + v[3] * v[3])) * (1.0f / 256.0f);
            const float r = 1.0f / sqrtf(var + EPS);
#pragma unroll
            for (int e = 0; e < 4; ++e) sVt[(F.lane + 64 * e) * 136 + j] = (bf16)(pk2(v[e] * r * lg[e] + lb[e], 0.f) & 0xffffu);
        }
    }
    __syncthreads();
    {
        const int r = F.lane & 31, hh = F.lane >> 5, h = F.wave >> 1, c = 32 * F.wave + r;
        const float* wsh = F.inp(5) + (size_t)(l * 4 + h) * 128 * 128;
        const float* bsh = F.inp(6) + (l * 4 + h) * 128;
        bf16x8 bfr[8];
#pragma unroll
        for (int s = 0; s < 8; ++s) bfr[s] = *(const LAS bf16x8*)(sVt + c * 136 + 16 * s + 8 * hh);
#pragma unroll
        for (int ti = 0; ti < 4; ++ti) {
            const int i = 32 * ti + r;
            f32x16 acc;
#pragma unroll
            for (int e = 0; e < 16; ++e) acc[e] = 0.f;
            unsigned short ur[16]; float br[16];
#pragma unroll
            for (int e = 0; e < 16; ++e) { const int io = 32 * ti + crow(e, hh); ur[e] = P[(size_t)(m0 + io) * NP + c]; br[e] = bsh[io]; }
#pragma unroll
            for (int s = 0; s < 2 * ti + 2; ++s) {
                const float* ap = wsh + i * 128 + 16 * s + 8 * hh;
                f32x4 a0 = *(const f32x4*)ap, a1 = *(const f32x4*)(ap + 4);
                if (s >= 2 * ti) { const int j0 = 16 * s + 8 * hh;
                    a0.x = (j0 + 0 <= i) ? a0.x : 0.f; a0.y = (j0 + 1 <= i) ? a0.y : 0.f; a0.z = (j0 + 2 <= i) ? a0.z : 0.f; a0.w = (j0 + 3 <= i) ? a0.w : 0.f;
                    a1.x = (j0 + 4 <= i) ? a1.x : 0.f; a1.y = (j0 + 5 <= i) ? a1.y : 0.f; a1.z = (j0 + 6 <= i) ? a1.z : 0.f; a1.w = (j0 + 7 <= i) ? a1.w : 0.f; }
                acc = MFMA32(cvt8(a0.x, a0.y, a0.z, a0.w, a1.x, a1.y, a1.z, a1.w), bfr[s], acc);
            }
#pragma unroll
            for (int e = 0; e < 16; ++e) { const int io = 32 * ti + crow(e, hh);
                const float u = gelu_as(bf2f(ur[e]));
                MIX[(size_t)(m0 + io) * D + c] = (bf16)(pk2(u * (acc[e] + br[e]), 0.f) & 0xffffu); }
        }
    }
    __syncthreads();
}

__device__ __forceinline__ void conv_unit(Frame& F, int l, int unit, const bf16* P, bf16* MIX) {
    const int b = unit >> 6, t0 = (unit & 63) * 64, m0 = b * SEQ + t0;
    LAS float* sY = (LAS float*)F.lds;
    const int c = F.tid & 255, hf = F.wave >> 2;
    float w[CVK];
#pragma unroll
    for (int k = 0; k < CVK; ++k) w[k] = F.inp(7)[(size_t)(l * CVK + k) * 256 + c];
    const float bias = F.inp(8)[l * 256 + c];
    {
        u32x2 ra[12], rg[12];
#pragma unroll
        for (int q = 0; q < 12; ++q) { const int r = F.wave + 8 * q, rc = r < 94 ? r : 93; const int t = t0 - 30 + rc, tc = t >= 0 ? t : 0;
            const bf16* pr = P + (size_t)(b * SEQ + tc) * NP + 4 * F.lane; ra[q] = *(const u32x2*)(pr + 512); rg[q] = *(const u32x2*)(pr + 768); }
#pragma unroll
        for (int q = 0; q < 12; ++q) { const int r = F.wave + 8 * q; const int t = t0 - 30 + r;
            f32x4 y;
            y.x = bf2f((unsigned short)(ra[q].x & 0xffffu)) * sigmoidf_(bf2f((unsigned short)(rg[q].x & 0xffffu)));
            y.y = bf2f((unsigned short)(ra[q].x >> 16)) * sigmoidf_(bf2f((unsigned short)(rg[q].x >> 16)));
            y.z = bf2f((unsigned short)(ra[q].y & 0xffffu)) * sigmoidf_(bf2f((unsigned short)(rg[q].y & 0xffffu)));
            y.w = bf2f((unsigned short)(ra[q].y >> 16)) * sigmoidf_(bf2f((unsigned short)(rg[q].y >> 16)));
            if (t < 0) y = (f32x4){0.f, 0.f, 0.f, 0.f};
            if (r < 94) *(LAS f32x4*)(sY + r * 256 + 4 * F.lane) = y; }
    }
    __syncthreads();
    float o[32];
#pragma unroll
    for (int g = 0; g < 4; ++g) {
        float y[38];
#pragma unroll
        for (int q = 0; q < 38; ++q) y[q] = sY[(hf * 32 + 8 * g + q) * 256 + c];
#pragma unroll
        for (int t8 = 0; t8 < 8; ++t8) {
            float a = bias;
#pragma unroll
            for (int k = 0; k < CVK; ++k) a += w[k] * y[t8 + k];
            o[8 * g + t8] = a;
        }
    }
    __syncthreads();
#pragma unroll
    for (int tt = 0; tt < 32; ++tt) sY[(hf * 32 + tt) * 256 + c] = o[tt];
    __syncthreads();
    const f32x4 g4 = *(const f32x4*)(F.inp(9) + l * 256 + 4 * F.lane), b4 = *(const f32x4*)(F.inp(10) + l * 256 + 4 * F.lane);
    for (int i = F.wave; i < 64; i += NWAVES) {
        f32x4 v = *(LAS f32x4*)(sY + i * 256 + 4 * F.lane);
        const float mean = wave_sum((v.x + v.y) + (v.z + v.w)) * (1.0f / 256.0f);
        v = v - mean;
        const float var = wave_sum((v.x * v.x + v.y * v.y) + (v.z * v.z + v.w * v.w)) * (1.0f / 256.0f);
        const float r = 1.0f / sqrtf(var + EPS);
        v = v * r * g4 + b4;
        v.x *= sigmoidf_(v.x); v.y *= sigmoidf_(v.y); v.z *= sigmoidf_(v.z); v.w *= sigmoidf_(v.w);
        *(unsigned long long*)(MIX + (size_t)(m0 + i) * D + 256 + 4 * F.lane) = (unsigned long long)pk2(v.x, v.y) | ((unsigned long long)pk2(v.z, v.w) << 32);
    }
    __syncthreads();
}

#ifndef MK_TS
#define MK_TS 0
#endif
#ifndef MK_TK
#define MK_TK 4
#endif
#define TS_BEGIN(id) long long ts0_##id = 0; if (MK_TS == (id)) { asm volatile("s_waitcnt vmcnt(0) lgkmcnt(0)" ::: "memory"); ts0_##id = clock64(); }
#define TS_END(id) if (MK_TS == (id)) { asm volatile("s_waitcnt vmcnt(0) lgkmcnt(0)" ::: "memory"); const long long t1_ = clock64(), d_ = (t1_ - ts0_##id) * MK_TK; while (clock64() - t1_ < d_) __builtin_amdgcn_s_sleep(1); }
typedef __bf16 bf16v2_t __attribute__((ext_vector_type(2)));
typedef __bf16 bf16v8_t __attribute__((ext_vector_type(8)));
typedef float f32x2_t __attribute__((ext_vector_type(2)));
typedef float f32x8_t __attribute__((ext_vector_type(8)));
__device__ __forceinline__ unsigned cpk2(float lo, float hi) { const f32x2_t v = {lo, hi}; return __builtin_bit_cast(unsigned, __builtin_convertvector(v, bf16v2_t)); }
__device__ __forceinline__ v4u cpk8(float a0, float a1, float a2, float a3, float a4, float a5, float a6, float a7) { const f32x8_t v = {a0, a1, a2, a3, a4, a5, a6, a7}; return __builtin_bit_cast(v4u, __builtin_convertvector(v, bf16v8_t)); }
__device__ __forceinline__ bf16x8 pack_step(const f32x16& x, int s) { return __builtin_bit_cast(bf16x8, cpk8(x[8 * s], x[8 * s + 1], x[8 * s + 2], x[8 * s + 3], x[8 * s + 4], x[8 * s + 5], x[8 * s + 6], x[8 * s + 7])); }

template <int J> __device__ __forceinline__ void dn_load_col(f32x4 (&dst)[8], const LAS float* sAth, const f32x4& tie) {
    if constexpr (J < 63) {
        const LAS float* acol = sAth + J * 64;
        asm volatile("" : "+v"(acol) : "v"(tie.x));
#pragma unroll
        for (int q = (J >> 3); q < 8; ++q) dst[q] = *(const LAS f32x4*)(acol + 8 * q);
    }
}
template <int J> __device__ __forceinline__ void dn_solve_cols2(f32x4 (&acc)[8], const LAS float* sAth, const int h2, f32x4 (&cur)[8], f32x4 (&nxt)[8]) {
    if constexpr (J < 63) {
        constexpr int GJ = J >> 2, Q0 = GJ >> 1;
        f32x4 nn[8];
        dn_load_col<J + 2>(nn, sAth, acc[Q0]);
        const float mine = acc[Q0][J & 3];
        const float other = __builtin_bit_cast(float, __builtin_amdgcn_update_dpp(0, __builtin_bit_cast(int, mine), 0xB1, 0xF, 0xF, false));
        const float sj = (h2 == (GJ & 1)) ? mine : other;
#pragma unroll
        for (int q = Q0; q < 8; ++q) acc[q] -= cur[q] * sj;
        dn_solve_cols2<J + 1>(acc, sAth, h2, nxt, nn);
    }
}

__device__ __forceinline__ void dn_load_raw(v4u (&raw)[7], const bf16* P, int cu, int tid) {
    const int b = cu >> 8, h = (cu >> 6) & 3, n = cu & 63, m0 = b * SEQ + n * 64;
    const bf16* pbase = P + 1024 + h * 128;
#pragma unroll
    for (int it = 0; it < 7; ++it) { int item = tid + 512 * it; item = item < 3 * 67 * 16 ? item : 3 * 67 * 16 - 1;
        const int sel = item / (67 * 16), rem = item - sel * (67 * 16), t = rem >> 4, pc = rem & 15;
        const int tr = (n > 0 || t >= 3) ? t : 3;
        raw[it] = *(const v4u*)(pbase + (long)(m0 - 3 + tr) * NP + sel * 512 + pc * 8);
        if (!(n > 0 || t >= 3)) raw[it] = (v4u){0u, 0u, 0u, 0u}; }
}
#define DN_ST16(ptr_, val_) __builtin_amdgcn_raw_buffer_store_b128((val_), rsrc, (int)((const unsigned char*)(ptr_) - recbase), 0, 16)
#define DN_UNIT2CU(v_) ((((v_) & 31) << 6) | ((v_) >> 5))
__device__ __forceinline__ void dn_chunk_units(Frame& F0, int l, int first, int stride, const bf16* P, const float* BA, const int stepmax, unsigned* flags) {
  if (stepmax < 1 || first >= NCHUNK) return;
  v4u rawn[7]; dn_load_raw(rawn, P, DN_UNIT2CU(first), F0.tid);
  const unsigned char* recbase = F0.ws + WS_REC;
  const __amdgpu_buffer_rsrc_t rsrc = __builtin_amdgcn_make_buffer_rsrc((void*)recbase, 0, (int)(NCHUNK * REC_BYTES), 0x00020000);
  for (int vu = first; vu < NCHUNK; vu += stride) {
    const int cu = DN_UNIT2CU(vu);
    Frame F = F0; asm volatile("" : "+v"(F.tid)); F.lane = F.tid & 63; F.wave = __builtin_amdgcn_readfirstlane(F.tid >> 6);
    const int b = cu >> 8, h = (cu >> 6) & 3, n = cu & 63, m0 = b * SEQ + n * 64;
    LAS float* sQ = (LAS float*)F.lds;
    LAS float* sK = (LAS float*)(F.lds + 32768);
    LAS float* sV = (LAS float*)(F.lds + 65536);
    LAS bf16* sQb = (LAS bf16*)(F.lds + 98304);
    LAS bf16* sKb = (LAS bf16*)(F.lds + 115712);
    LAS bf16* sRaw = (LAS bf16*)(F.lds + 98304);
    LAS float* sGam = (LAS float*)(F.lds + 149760);
    LAS float* sBeta = (LAS float*)(F.lds + 150016);
    LAS float* sEg = (LAS float*)(F.lds + 150272);
    LAS float* sEd = (LAS float*)(F.lds + 150528);
    LAS float* sA = sQ;
    bf16* rec = (bf16*)(F.ws + WS_REC + (size_t)cu * REC_BYTES);
    bf16* Uo = rec + REC_U / 2; float* CD = (float*)((unsigned char*)rec + REC_CD);
    TS_BEGIN(1)
    {
#pragma unroll
        for (int it = 0; it < 7; ++it) { const int item = F.tid + 512 * it; if (item < 3 * 67 * 16) *(LAS v4u*)(sRaw + item * 8) = rawn[it]; }
    }
    {
        const int cn = (vu + stride < NCHUNK) ? DN_UNIT2CU(vu + stride) : cu;
        dn_load_raw(rawn, P, cn, F.tid);
    }
    __syncthreads();
    TS_END(1)
#ifdef MK_X
    if (stepmax == 1) continue;
#endif
    TS_BEGIN(2)
#ifndef MK_Y
#define MK_Y 0
#endif
#ifndef MK_Z
#define MK_Z 0
#endif
    if (F.wave < 6 && !(stepmax == 1 && MK_Z)) {
        const int sel = F.wave >> 1, c = F.tid & 127;
        const int wch = sel * 512 + h * 128 + c;
        const float* cw = F.inp(11) + (size_t)l * DNCONV * 1536 + wch;
        const float w0 = cw[0], w1 = cw[1536], w2 = cw[2 * 1536], w3 = cw[3 * 1536];
        const LAS bf16* xc = sRaw + (sel * 67) * 128 + c;
        float x0 = bf2f(xc[0]), x1 = bf2f(xc[128]), x2 = bf2f(xc[256]);
        LAS float* dst = (sel == 0 ? sQ : (sel == 1 ? sK : sV)) + c;
#ifndef MK_DUP
#define MK_DUP 0
#endif
        for (int dup = 0; dup <= MK_DUP; ++dup) {
        asm volatile("" ::: "memory");
        x0 = bf2f(xc[0]); x1 = bf2f(xc[128]); x2 = bf2f(xc[256]);
#pragma unroll 16
        for (int i = 0; i < 64; ++i) {
            const float x3 = bf2f(xc[(i + 3) * 128]);
            const float y = (w0 * x0 + w1 * x1) + (w2 * x2 + w3 * x3);
            dst[i * 128] = y * sigmoidf_(y);
            x0 = x1; x1 = x2; x2 = x3;
        }
        }
    } else if (F.wave == 6) {
        const int i = F.lane;
        const float bl = BA[(size_t)(m0 + i) * 8 + h], al = BA[(size_t)(m0 + i) * 8 + 4 + h];
        const float beta = 1.0f / (1.0f + expf(-bl));
        const float z = al + F.inp(13)[l * 4 + h];
        const float sp = fmaxf(z, 0.f) + log1pf(expf(-fabsf(z)));
        float la = -expf(F.inp(12)[l * 4 + h]) * sp;
#pragma unroll
        for (int off = 1; off < 64; off <<= 1) { const float t = __shfl_up(la, off); if (i >= off) la += t; }
        const float glast = __shfl(la, 63);
        sGam[i] = la; sBeta[i] = beta; sEg[i] = expf(la); sEd[i] = expf(glast - la);
        if (i == 63) __hip_atomic_store(CD, expf(la), __ATOMIC_RELAXED, __HIP_MEMORY_SCOPE_AGENT);
    }
    __syncthreads();
    TS_END(2)
    TS_BEGIN(3)
    {
        float q0[8], q1[8], k0[8], k1[8], sq[8], sk[8];
#pragma unroll
        for (int rr = 0; rr < 8; ++rr) { const int i = 8 * F.wave + rr;
            q0[rr] = sQ[i * 128 + F.lane]; q1[rr] = sQ[i * 128 + 64 + F.lane]; k0[rr] = sK[i * 128 + F.lane]; k1[rr] = sK[i * 128 + 64 + F.lane];
            sq[rr] = q0[rr] * q0[rr] + q1[rr] * q1[rr]; sk[rr] = k0[rr] * k0[rr] + k1[rr] * k1[rr]; }
#pragma unroll
        for (int rr = 0; rr < 8; ++rr) { sq[rr] = wave_sum(sq[rr]); sk[rr] = wave_sum(sk[rr]); }
#pragma unroll
        for (int rr = 0; rr < 8; ++rr) { const int i = 8 * F.wave + rr;
            const float rq = (1.0f / sqrtf(sq[rr] + EPS)) * 0.08838834764831845f, rk = 1.0f / sqrtf(sk[rr] + EPS);
            sQ[i * 128 + F.lane] = q0[rr] * rq; sQ[i * 128 + 64 + F.lane] = q1[rr] * rq; sK[i * 128 + F.lane] = k0[rr] * rk; sK[i * 128 + 64 + F.lane] = k1[rr] * rk; }
    }
    __syncthreads();
    TS_END(3)
    TS_BEGIN(4)
    {
        const int i = F.tid >> 3, cb = (F.tid & 7) * 16;
        f32x4 q[4], k[4];
#pragma unroll
        for (int t = 0; t < 4; ++t) { q[t] = *(LAS f32x4*)(sQ + i * 128 + cb + 4 * t); k[t] = *(LAS f32x4*)(sK + i * 128 + cb + 4 * t); }
        *(LAS v4u*)(sQb + i * 136 + cb) = cpk8(q[0].x, q[0].y, q[0].z, q[0].w, q[1].x, q[1].y, q[1].z, q[1].w);
        *(LAS v4u*)(sQb + i * 136 + cb + 8) = cpk8(q[2].x, q[2].y, q[2].z, q[2].w, q[3].x, q[3].y, q[3].z, q[3].w);
        *(LAS v4u*)(sKb + i * 136 + cb) = cpk8(k[0].x, k[0].y, k[0].z, k[0].w, k[1].x, k[1].y, k[1].z, k[1].w);
        *(LAS v4u*)(sKb + i * 136 + cb + 8) = cpk8(k[2].x, k[2].y, k[2].z, k[2].w, k[3].x, k[3].y, k[3].z, k[3].w);
    }
#pragma unroll
    for (int it = 0; it < 2; ++it) {
        const int item = F.tid + 512 * it, f = item >> 6, ln = item & 63, r = ln & 31, hh = ln >> 5;
        const int rt = f >> 3, kt = (f >> 1) & 3, s = f & 1, i = 32 * rt + r, d0 = 32 * kt + 16 * s + 4 * hh;
        const float eg = sEg[i];
        const f32x4 a = *(LAS f32x4*)(sQ + i * 128 + d0), c = *(LAS f32x4*)(sQ + i * 128 + d0 + 8);
        DN_ST16(rec + REC_QD / 2 + f * 512 + ln * 8, cpk8(a.x * eg, a.y * eg, a.z * eg, a.w * eg, c.x * eg, c.y * eg, c.z * eg, c.w * eg));
    }
#pragma unroll
    for (int it = 0; it < 2; ++it) {
        const int item = F.tid + 512 * it, f = item >> 6, ln = item & 63, r = ln & 31, hh = ln >> 5;
        const int a = f >> 2, t = (f >> 1) & 1, s = f & 1, dk = 32 * a + r, j0 = 32 * t + 16 * s + 4 * hh;
        float kv[8];
#pragma unroll
        for (int jj = 0; jj < 8; ++jj) { const int j = j0 + 8 * (jj >> 2) + (jj & 3); kv[jj] = sK[j * 128 + dk] * sEd[j]; }
        DN_ST16(rec + REC_KDT / 2 + f * 512 + ln * 8, cpk8(kv[0], kv[1], kv[2], kv[3], kv[4], kv[5], kv[6], kv[7]));
    }
    __syncthreads();
    TS_END(4)
    TS_BEGIN(5)
    {
        const int mat = F.wave >> 2, ti = (F.wave >> 1) & 1, tj = F.wave & 1, r = F.lane & 31, hh = F.lane >> 5;
        f32x16 acc;
#pragma unroll
        for (int e = 0; e < 16; ++e) acc[e] = 0.f;
        if (!(ti == 0 && tj == 1)) {
            const LAS bf16* Ab = sKb + (32 * (mat ? tj : ti) + r) * 136 + 8 * hh;
            const LAS bf16* Bb = (mat ? sQb + (32 * ti + r) * 136 : sKb + (32 * tj + r) * 136) + 8 * hh;
#pragma unroll
            for (int s = 0; s < 8; ++s) { const bf16x8 a = *(const LAS bf16x8*)(Ab + 16 * s), bb = *(const LAS bf16x8*)(Bb + 16 * s); acc = MFMA32(a, bb, acc); }
        }
        if (mat == 0) {
            const int j = 32 * tj + r; const float gj = sGam[j];
#pragma unroll
            for (int g = 0; g < 4; ++g) { const int i0 = 32 * ti + 8 * g + 4 * hh; f32x4 o;
#pragma unroll
                for (int q = 0; q < 4; ++q) { const int i = i0 + q; o[q] = (j < i) ? sBeta[i] * acc[4 * g + q] * __expf(sGam[i] - gj) : 0.f; }
                *(LAS f32x4*)(sA + j * 64 + i0) = o; }
        } else {
            const int i = 32 * ti + r; const float gi = sGam[i];
            float v[16];
#pragma unroll
            for (int e = 0; e < 16; ++e) { const int j = 32 * tj + crow(e, hh); v[e] = (j <= i) ? acc[e] * expf(gi - sGam[j]) : 0.f; }
            bf16* qk = rec + REC_QK / 2 + ((ti * 2 + tj) * 2) * 512 + F.lane * 8;
            DN_ST16(qk, cpk8(v[0], v[1], v[2], v[3], v[4], v[5], v[6], v[7]));
            DN_ST16(qk + 512, cpk8(v[8], v[9], v[10], v[11], v[12], v[13], v[14], v[15]));
        }
    }
    __syncthreads();
    TS_END(5)
    TS_BEGIN(6)
    {
        const int col = (F.tid >> 1) & 127, h2 = F.tid & 1; const bool isw = F.wave >= 4;
        const LAS float* src = (isw ? sK : sV) + col;
        f32x4 acc4[8];
#pragma unroll
        for (int q = 0; q < 8; ++q) { const int i0 = 8 * q + 4 * h2;
            f32x4 sc = *(const LAS f32x4*)(sBeta + i0);
            if (isw) sc = sc * *(const LAS f32x4*)(sEg + i0);
            acc4[q].x = sc.x * src[i0 * 128]; acc4[q].y = sc.y * src[(i0 + 1) * 128]; acc4[q].z = sc.z * src[(i0 + 2) * 128]; acc4[q].w = sc.w * src[(i0 + 3) * 128]; }
        { f32x4 c0[8], c1[8]; dn_load_col<0>(c0, sA + 4 * h2, acc4[0]); dn_load_col<1>(c1, sA + 4 * h2, acc4[0]); dn_solve_cols2<0>(acc4, sA + 4 * h2, h2, c0, c1); }
        LAS bf16* orow = (isw ? sQb : sKb) + col;
#pragma unroll
        for (int q = 0; q < 8; ++q) { const int i0 = 8 * q + 4 * h2;
#pragma unroll
            for (int e = 0; e < 4; ++e) orow[(i0 + e) * 136] = (bf16)(cpk2(acc4[q][e], 0.f) & 0xffffu); }
    }
    __syncthreads();
    TS_END(6)
    TS_BEGIN(7)
    {
        const int wt = F.wave, w = wt >> 1, t = wt & 1, c = F.lane & 31, hh = F.lane >> 5;
        float uv[16];
#pragma unroll
        for (int e = 0; e < 16; ++e) uv[e] = bf2f(sKb[(32 * t + crow(e, hh)) * 136 + 32 * w + c]);
        bf16* up = Uo + wt * 1024 + F.lane * 8;
        DN_ST16(up, cpk8(uv[0], uv[1], uv[2], uv[3], uv[4], uv[5], uv[6], uv[7])); DN_ST16(up + 512, cpk8(uv[8], uv[9], uv[10], uv[11], uv[12], uv[13], uv[14], uv[15]));
    }
#pragma unroll
    for (int it = 0; it < 2; ++it) {
        const int item = F.tid + 512 * it, f = item >> 6, ln = item & 63, r = ln & 31, hh = ln >> 5;
        const int rt = f >> 3, kt = (f >> 1) & 3, s = f & 1;
        const LAS bf16* wp = sQb + (32 * rt + r) * 136 + 32 * kt + 16 * s + 4 * hh;
        const u32x2 lo = *(const LAS u32x2*)wp, hi = *(const LAS u32x2*)(wp + 8);
        v4u o; o.x = lo.x; o.y = lo.y; o.z = hi.x; o.w = hi.y;
        DN_ST16(rec + REC_W / 2 + f * 512 + ln * 8, o);
    }
    asm volatile("s_waitcnt vmcnt(0)" ::: "memory");
    __syncthreads();
    if (F.tid == 0) __hip_atomic_store(flags + cu, 1u, __ATOMIC_RELAXED, __HIP_MEMORY_SCOPE_AGENT);
    TS_END(7)
  }
}

#define DN_BAR() do { asm volatile("s_waitcnt lgkmcnt(0)" ::: "memory"); __builtin_amdgcn_s_barrier(); asm volatile("" ::: "memory"); } while (0)
__device__ __forceinline__ void dn_scan(Frame& F, int l, int bh, unsigned* flags) {
    LAS unsigned char* ring = F.lds;
    const unsigned char* recs = F.ws + WS_REC + (size_t)(bh * 64) * REC_BYTES;
    if (F.wave >= 4) {
        const int v = F.wave - 4;
#define DN_DMA(n_) do { const unsigned char* src_ = recs + (size_t)(n_) * REC_BYTES + v * 1024 + F.lane * 16; LAS unsigned char* dst_ = ring + ((n_) & 1) * (int)REC_BYTES + v * 1024; \
        _Pragma("unroll") for (int q_ = 0; q_ < 19; ++q_) if (v + 4 * q_ < 73) __builtin_amdgcn_global_load_lds((const unsigned*)(src_ + q_ * 4096), (LAS unsigned*)(dst_ + q_ * 4096), 16, 0, 16  ); } while (0)
#define DN_WAITREC(n_) do { unsigned sp_ = 0; while (__builtin_amdgcn_readfirstlane(__hip_atomic_load(flags + bh * 64 + (n_), __ATOMIC_RELAXED, __HIP_MEMORY_SCOPE_AGENT)) == 0u) { \
            __builtin_amdgcn_s_sleep(2); if (++sp_ > (1u << 21)) break; } asm volatile("" ::: "memory"); } while (0)
        DN_WAITREC(0); DN_DMA(0);
        asm volatile("s_waitcnt vmcnt(0)" ::: "memory");
        DN_BAR();
        for (int n = 0; n < 64; ++n) {
            if (n + 1 < 64) { DN_WAITREC(n + 1); DN_DMA(n + 1); }
            asm volatile("s_waitcnt vmcnt(0)" ::: "memory");
            DN_BAR();
        }
#undef DN_DMA
#undef DN_WAITREC
    } else {
        const int w = F.wave;
        f32x16 S0, S1, S2, S3;
#pragma unroll
        for (int e = 0; e < 16; ++e) { S0[e] = 0.f; S1[e] = 0.f; S2[e] = 0.f; S3[e] = 0.f; }
        bf16* Ob = (bf16*)(F.ws + WS_O) + (size_t)(bh * 64) * 8192 + (w * 2) * 1024 + F.lane * 8;
        DN_BAR();
        for (int n = 0; n < 64; ++n) {
            const LAS unsigned char* buf = ring + (n & 1) * (int)REC_BYTES + F.lane * 16;
            const float cd = *(const LAS float*)(ring + (n & 1) * (int)REC_BYTES + REC_CD);
#define DN_A(off_, f_) (*(const LAS bf16x8*)(buf + (off_) + (f_) * 1024))
#define DN_FENCE() __builtin_amdgcn_sched_barrier(0)
            f32x16 W0, W1, Q0, Q1;
#pragma unroll
            for (int e = 0; e < 16; ++e) { W0[e] = 0.f; W1[e] = 0.f; Q0[e] = 0.f; Q1[e] = 0.f; }
            const v4u u00 = *(const LAS v4u*)(buf + REC_U + (w * 2 + 0) * 2048), u01 = *(const LAS v4u*)(buf + REC_U + (w * 2 + 0) * 2048 + 1024);
            const v4u u10 = *(const LAS v4u*)(buf + REC_U + (w * 2 + 1) * 2048), u11 = *(const LAS v4u*)(buf + REC_U + (w * 2 + 1) * 2048 + 1024);
            bf16x8 fa0, fa1, fa2, fa3, fb0, fb1, fb2, fb3;
#define DN_LDK(d0, d1, d2, d3, a_, s_) do { d0 = DN_A(REC_W, (0 * 4 + (a_)) * 2 + (s_)); d1 = DN_A(REC_W, (1 * 4 + (a_)) * 2 + (s_)); d2 = DN_A(REC_QD, (0 * 4 + (a_)) * 2 + (s_)); d3 = DN_A(REC_QD, (1 * 4 + (a_)) * 2 + (s_)); } while (0)
#define DN_MMK(d0, d1, d2, d3, Sa_, s_) do { const bf16x8 sb_ = pack_step(Sa_, s_); W0 = MFMA32(d0, sb_, W0); W1 = MFMA32(d1, sb_, W1); Q0 = MFMA32(d2, sb_, Q0); Q1 = MFMA32(d3, sb_, Q1); } while (0)
            DN_LDK(fa0, fa1, fa2, fa3, 0, 0); DN_FENCE();
            DN_LDK(fb0, fb1, fb2, fb3, 0, 1); DN_FENCE(); DN_MMK(fa0, fa1, fa2, fa3, S0, 0); DN_FENCE();
            DN_LDK(fa0, fa1, fa2, fa3, 1, 0); DN_FENCE(); DN_MMK(fb0, fb1, fb2, fb3, S0, 1); DN_FENCE();
            DN_LDK(fb0, fb1, fb2, fb3, 1, 1); DN_FENCE(); DN_MMK(fa0, fa1, fa2, fa3, S1, 0); DN_FENCE();
            DN_LDK(fa0, fa1, fa2, fa3, 2, 0); DN_FENCE(); DN_MMK(fb0, fb1, fb2, fb3, S1, 1); DN_FENCE();
            DN_LDK(fb0, fb1, fb2, fb3, 2, 1); DN_FENCE(); DN_MMK(fa0, fa1, fa2, fa3, S2, 0); DN_FENCE();
            DN_LDK(fa0, fa1, fa2, fa3, 3, 0); DN_FENCE(); DN_MMK(fb0, fb1, fb2, fb3, S2, 1); DN_FENCE();
            DN_LDK(fb0, fb1, fb2, fb3, 3, 1); DN_FENCE(); DN_MMK(fa0, fa1, fa2, fa3, S3, 0); DN_FENCE();
            fa0 = DN_A(REC_QK, (0 * 2 + 0) * 2 + 0); fa1 = DN_A(REC_QK, (0 * 2 + 0) * 2 + 1); fa2 = DN_A(REC_QK, (0 * 2 + 1) * 2 + 0); fa3 = DN_A(REC_QK, (0 * 2 + 1) * 2 + 1); DN_FENCE();
            DN_MMK(fb0, fb1, fb2, fb3, S3, 1); DN_FENCE();
#undef DN_LDK
#undef DN_MMK
            {
                const unsigned uu0[8] = {u00.x, u00.y, u00.z, u00.w, u01.x, u01.y, u01.z, u01.w}, uu1[8] = {u10.x, u10.y, u10.z, u10.w, u11.x, u11.y, u11.z, u11.w};
#pragma unroll
                for (int e = 0; e < 16; ++e) { const unsigned a0 = uu0[e >> 1], a1 = uu1[e >> 1];
                    W0[e] = ((e & 1) ? __uint_as_float(a0 & 0xffff0000u) : __uint_as_float(a0 << 16)) - W0[e];
                    W1[e] = ((e & 1) ? __uint_as_float(a1 & 0xffff0000u) : __uint_as_float(a1 << 16)) - W1[e]; }
            }
            const bf16x8 ub00 = pack_step(W0, 0), ub01 = pack_step(W0, 1), ub10 = pack_step(W1, 0), ub11 = pack_step(W1, 1);
            DN_FENCE();
            fb0 = DN_A(REC_QK, (1 * 2 + 0) * 2 + 0); fb1 = DN_A(REC_QK, (1 * 2 + 0) * 2 + 1); fb2 = DN_A(REC_QK, (1 * 2 + 1) * 2 + 0); fb3 = DN_A(REC_QK, (1 * 2 + 1) * 2 + 1); DN_FENCE();
            Q0 = MFMA32(fa0, ub00, Q0); Q0 = MFMA32(fa1, ub01, Q0); Q0 = MFMA32(fa2, ub10, Q0); Q0 = MFMA32(fa3, ub11, Q0); DN_FENCE();
#define DN_LDS_(d0, d1, d2, d3, a_) do { d0 = DN_A(REC_KDT, ((a_) * 2 + 0) * 2 + 0); d1 = DN_A(REC_KDT, ((a_) * 2 + 0) * 2 + 1); d2 = DN_A(REC_KDT, ((a_) * 2 + 1) * 2 + 0); d3 = DN_A(REC_KDT, ((a_) * 2 + 1) * 2 + 1); } while (0)
#define DN_SUPD(Sa_, d0, d1, d2, d3) do { Sa_ = MFMA32(d0, ub00, Sa_); Sa_ = MFMA32(d1, ub01, Sa_); Sa_ = MFMA32(d2, ub10, Sa_); Sa_ = MFMA32(d3, ub11, Sa_); } while (0)
            DN_LDS_(fa0, fa1, fa2, fa3, 0); DN_FENCE();
            Q1 = MFMA32(fb0, ub00, Q1); Q1 = MFMA32(fb1, ub01, Q1); Q1 = MFMA32(fb2, ub10, Q1); Q1 = MFMA32(fb3, ub11, Q1); DN_FENCE();
            S0 = S0 * cd; S1 = S1 * cd; S2 = S2 * cd; S3 = S3 * cd;
            DN_LDS_(fb0, fb1, fb2, fb3, 1); DN_FENCE(); DN_SUPD(S0, fa0, fa1, fa2, fa3); DN_FENCE();
            DN_LDS_(fa0, fa1, fa2, fa3, 2); DN_FENCE(); DN_SUPD(S1, fb0, fb1, fb2, fb3); DN_FENCE();
            DN_LDS_(fb0, fb1, fb2, fb3, 3); DN_FENCE(); DN_SUPD(S2, fa0, fa1, fa2, fa3); DN_FENCE();
            DN_SUPD(S3, fb0, fb1, fb2, fb3); DN_FENCE();
#undef DN_LDS_
#undef DN_SUPD
#undef DN_A
#undef DN_FENCE
            bf16* op = Ob + (size_t)n * 8192;
            *(v4u*)op = cpk8(Q0[0], Q0[1], Q0[2], Q0[3], Q0[4], Q0[5], Q0[6], Q0[7]); *(v4u*)(op + 512) = cpk8(Q0[8], Q0[9], Q0[10], Q0[11], Q0[12], Q0[13], Q0[14], Q0[15]);
            *(v4u*)(op + 1024) = cpk8(Q1[0], Q1[1], Q1[2], Q1[3], Q1[4], Q1[5], Q1[6], Q1[7]); *(v4u*)(op + 1536) = cpk8(Q1[8], Q1[9], Q1[10], Q1[11], Q1[12], Q1[13], Q1[14], Q1[15]);
            DN_BAR();
        }
    }
}
#undef DN_BAR

__device__ __forceinline__ void dn_finish_unit(Frame& F, int l, int cu, const bf16* P, bf16* MIX) {
    const int b = cu >> 8, h = (cu >> 6) & 3, n = cu & 63, m0 = b * SEQ + n * 64;
    LAS float* sO = (LAS float*)F.lds;
    {
        const int wt = F.wave, w = wt >> 1, t = wt & 1, r = F.lane & 31, hh = F.lane >> 5;
        const bf16* ip = (const bf16*)(F.ws + WS_O) + (size_t)cu * 8192 + wt * 1024 + F.lane * 8;
        const v4u a = *(const v4u*)ip, c = *(const v4u*)(ip + 512);
        const unsigned uu[8] = {a.x, a.y, a.z, a.w, c.x, c.y, c.z, c.w};
#pragma unroll
        for (int e = 0; e < 16; ++e) { const unsigned x = uu[e >> 1]; sO[(32 * t + crow(e, hh)) * 132 + 32 * w + r] = (e & 1) ? __uint_as_float(x & 0xffff0000u) : __uint_as_float(x << 16); }
    }
    __syncthreads();
    const float ng0 = F.inp(14)[l * 128 + 2 * F.lane], ng1 = F.inp(14)[l * 128 + 2 * F.lane + 1];
#pragma unroll
    for (int rr = 0; rr < 8; ++rr) {
        const int i = 8 * F.wave + rr;
        const f32x2_t o = *(const LAS f32x2_t*)(sO + i * 132 + 2 * F.lane);
        const unsigned g = *((const unsigned*)(P + (size_t)(m0 + i) * NP + 2560 + h * 128) + F.lane);
        const float rs = 1.0f / sqrtf(wave_sum(o.x * o.x + o.y * o.y) * (1.0f / 128.0f) + EPS);
        const float g0 = __uint_as_float(g << 16), g1 = __uint_as_float(g & 0xffff0000u);
        *((unsigned*)(MIX + (size_t)(m0 + i) * D + 512 + h * 128) + F.lane) = cpk2(o.x * rs * ng0 * (g0 * sigmoidf_(g0)), o.y * rs * ng1 * (g1 * sigmoidf_(g1)));
    }
    __syncthreads();
}
struct Args { const float* in[21]; float* out; unsigned char* ws; int ph_lo, ph_hi; };
constexpr int PH_PER_LAYER = 8, N_PHASES = 1 + PH_PER_LAYER * DEPTH;

#define RELAUNDER(Fx) do { asm volatile("" : "+v"((Fx).tid)); (Fx).lane = (Fx).tid & 63; (Fx).wave = __builtin_amdgcn_readfirstlane((Fx).tid >> 6); } while (0)
__device__ __forceinline__ void gemm_stagger(int us) {
    if (us > 0 && (blockIdx.x & 4)) { const unsigned long long t0 = __builtin_amdgcn_s_memrealtime(); while (__builtin_amdgcn_s_memrealtime() - t0 < (unsigned long long)us * 100ull) __builtin_amdgcn_s_sleep(8); }
}
__global__ void __launch_bounds__(NWAVES * 64, 2) mk_fwd(Args args) {
    extern __shared__ __attribute__((aligned(16))) unsigned char lds[];
    {
        volatile LAS unsigned* MISC0 = (volatile LAS unsigned*)((LAS unsigned char*)lds + MISC_OFF);
        if (threadIdx.x < 32) MISC0[threadIdx.x] = 0u;
    }
    __syncthreads();
    const int lo = args.ph_lo, hi = args.ph_hi;
    XcdBarrier bar; bar.bar = (unsigned*)(args.ws + WS_CTL) + CW_BAR; bar.x = 0; bar.st = nullptr;
    if (hi - lo > 1) bar = xcd_barrier_post((unsigned*)(args.ws + WS_CTL) + CW_BAR, (volatile LAS unsigned*)((LAS unsigned char*)lds + MISC_OFF) + 8);

    for (int ph = lo; ph < hi; ++ph) {
      for (int rep = 0; rep < 2; ++rep) {
        if (rep == 1 && !((ph > 0 && ((MK_REP >> ((ph - 1) % PH_PER_LAYER)) & 1) && !(((ph - 1) % PH_PER_LAYER) == 7 && ph > PH_PER_LAYER)) || (ph == 0 && (MK_REP & 512)))) break;
        int tid = threadIdx.x; asm volatile("" : "+v"(tid));
        Frame F;
        F.kp = (const AS4 unsigned char*)__builtin_amdgcn_kernarg_segment_ptr(); asm volatile("" : "+s"(F.kp));
        F.lds = (LAS unsigned char*)lds;
        F.tid = tid; F.lane = tid & 63; F.wave = __builtin_amdgcn_readfirstlane(tid >> 6);
        F.G = gridDim.x; { const int bx = blockIdx.x; F.vcu = (F.G % 8 == 0) ? (bx % 8) * (F.G / 8) + bx / 8 : bx; }
        F.out = *(float* const AS4*)(F.kp + 168); F.ws = *(unsigned char* const AS4*)(F.kp + 176);
        bf16* HN = (bf16*)(F.ws + WS_HN); bf16* MIX = HN; bf16* P = (bf16*)(F.ws + WS_P); bf16* HFF = P;
        float* BA = (float*)(F.ws + WS_BA);
        if (ph == 0) {
            weights_phase(F);
            norm_phase<0>(F, F.inp(0), F.inp(1), HN, F.inp(2), BA, nullptr);
        } else {
#ifdef MK_ONLY_K
            const int l = (ph - 1) / PH_PER_LAYER, k = MK_ONLY_K;
#else
            const int l = (ph - 1) / PH_PER_LAYER, k = (ph - 1) % PH_PER_LAYER;
#endif
            const unsigned char* wb = F.ws + WS_W + (size_t)l * W_LAYER;
            if (k == 0) {
                pg8::Gemm g{(const pg8::bf16_t*)HN, (const pg8::bf16_t*)(wb + W_IN_OFF), M, NP, D}; pg8::StaticOrder S; S.init(M, NP, F.G, (int)blockIdx.x);
                pg8::EpiBf16FL E{(pg8::bf16_t*)P, NP};
                pg8::gemm_phase<pg8::EpiBf16FL, pg8::StaticOrder, true, true>(F.lds, g, S, E, tid);
            } else if (k == 1) {
                unsigned* flags = (unsigned*)(F.ws + WS_CTL) + CW_FLAGS + l * NCHUNK;
                const int sub = rep ? MK_REPSUB : MK_SUB;
                if ((int)blockIdx.x < BATCH * 4) { if (sub & 1) dn_scan(F, l, (int)blockIdx.x, flags); }
                else {
                    if (sub & 1) dn_chunk_units(F, l, (int)blockIdx.x - BATCH * 4, F.G - BATCH * 4, P, BA, 9, flags);
                    if (sub & 2) for (int v = (int)blockIdx.x - BATCH * 4; v < M / 128 + M / 64; v += F.G - BATCH * 4) { Frame Fu = F; RELAUNDER(Fu);
                        if (v < M / 128) gmlp_unit(Fu, l, v, P, MIX); else conv_unit(Fu, l, v - M / 128, P, MIX); }
                }
            } else if (k == 2) {
                for (int u = blockIdx.x; u < NCHUNK; u += F.G) { Frame Fu = F; RELAUNDER(Fu); dn_finish_unit(Fu, l, u, P, MIX); }
            } else if (k == 3 || k == 6) {
                const float* base = (l == 0 && k == 3) ? F.inp(0) : F.out;
                pg8::Gemm g{(const pg8::bf16_t*)(k == 3 ? MIX : HFF), (const pg8::bf16_t*)(wb + (k == 3 ? W_O_OFF : W_D_OFF)), M, D, k == 3 ? D : DFF}; pg8::StaticOrder S; S.init(M, D, F.G, (int)blockIdx.x);
                gemm_stagger(k == 3 ? MK_STAG_O : MK_STAG_D);
                pg8::EpiRes E{base, rep ? (float*)(F.ws + WS_REC) : F.out, D, rep ? MK_NOREAD : 0};
                pg8::gemm_phase<pg8::EpiRes, pg8::StaticOrder, true, true>(F.lds, g, S, E, tid);
            } else if (k == 4) {
                norm_phase<0>(F, F.out, F.inp(16) + l * D, HN, nullptr, nullptr, nullptr);
            } else if (k == 5) {
                pg8::Gemm g{(const pg8::bf16_t*)HN, (const pg8::bf16_t*)(wb + W_GU_OFF), M, 2 * DFF, D}; pg8::StaticOrder S; S.init(M, 2 * DFF, F.G, (int)blockIdx.x);
                pg8::EpiSwiGLU E{(pg8::bf16_t*)HFF, DFF};
                gemm_stagger(MK_STAG_GU);
                pg8::gemm_phase<pg8::EpiSwiGLU, pg8::StaticOrder, true, true>(F.lds, g, S, E, tid);
            } else {
                if (l + 1 < DEPTH) norm_phase<0>(F, F.out, F.inp(1) + (l + 1) * D, HN, F.inp(2) + (size_t)(l + 1) * D * DPROJ, BA, nullptr);
                else norm_phase<1>(F, F.out, F.inp(20), nullptr, nullptr, nullptr, F.out);
            }
        }
      }
        if (ph + 1 < hi) { xcd_barrier(bar); for (int xb = 0; xb < MK_XBAR; ++xb) xcd_barrier(bar); }
    }
}

#ifndef MK_SINGLE
#define MK_SINGLE 0
#endif

extern "C" void kernel_launch(void* const* d_in, const int* in_sizes, int n_in, void* d_out, int out_size, void* d_ws, size_t ws_size, hipStream_t stream) {
    static int grid = 0;
    if (grid == 0) {
        if (n_in != 21 || in_sizes[0] != M * D || out_size != M * D || ws_size < WS_END) { fprintf(stderr, "kernel_launch: unexpected shapes (n_in %d, in0 %d, out %d, ws %zu)\n", n_in, n_in > 0 ? in_sizes[0] : -1, out_size, ws_size); grid = -1; return; }
        int dev = 0, cus = 0, per_cu = 0;
        if (hipGetDevice(&dev) != hipSuccess || hipDeviceGetAttribute(&cus, hipDeviceAttributeMultiprocessorCount, dev) != hipSuccess) { grid = -1; return; }
        if (hipFuncSetAttribute((const void*)mk_fwd, hipFuncAttributeMaxDynamicSharedMemorySize, LDS_BYTES) != hipSuccess) { fprintf(stderr, "kernel_launch: hipFuncSetAttribute failed\n"); grid = -1; return; }
        if (hipOccupancyMaxActiveBlocksPerMultiprocessor(&per_cu, (const void*)mk_fwd, NWAVES * 64, LDS_BYTES) != hipSuccess || per_cu < 1) { fprintf(stderr, "kernel_launch: occupancy query says %d blocks per CU\n", per_cu); per_cu = 1; }
        (void)hipGetLastError();
        grid = cus;
        if (grid % 8 != 0 || grid < 32) fprintf(stderr, "kernel_launch: unexpected CU count %d\n", grid);
    }
    if (grid < 0) return;
    (void)hipMemsetAsync((char*)d_ws + WS_CTL, 0, CTL_ZERO_BYTES, stream);
    Args a{};
    for (int i = 0; i < 21; ++i) a.in[i] = (const float*)d_in[i];
    a.out = (float*)d_out; a.ws = (unsigned char*)d_ws;
#if MK_SINGLE
    a.ph_lo = 0; a.ph_hi = N_PHASES;
    hipLaunchKernelGGL(mk_fwd, dim3(grid), dim3(NWAVES * 64), LDS_BYTES, stream, a);
#else
    for (int ph = 0; ph < MK_PH_HI; ++ph) { a.ph_lo = ph; a.ph_hi = ph + 1; hipLaunchKernelGGL(mk_fwd, dim3(grid), dim3(NWAVES * 64), LDS_BYTES, stream, a); }
#endif
}
```

```cpp
#include <hip/hip_runtime.h>
#include <cstdio>
#include <cstdint>
#include <cmath>
#define MK_SINGLE 1
namespace pg8 {
#define PG8_LAS __attribute__((address_space(3)))
typedef unsigned short bf16_t;
typedef short bf16x8 __attribute__((ext_vector_type(8)));
typedef float f32x4 __attribute__((ext_vector_type(4)));
typedef unsigned u32x4 __attribute__((ext_vector_type(4)));
constexpr int BM = 256, BK = 64, HALF = 128, HTB = HALF * BK * 2  , STAGE_BYTES = 8 * HTB, NXCD = 8, WGM = 8;

__host__ __device__ __forceinline__ int lds_byte(int r, int c) { const int st = (r >> 4) * 2 + (c >> 5), rr = r & 15, cc = c & 31, ob = rr * 64 + cc * 2; return st * 1024 + (ob ^ (((ob >> 9) & 1) << 5)); }
__host__ __device__ __forceinline__ void stage_rc(int b, int& R, int& C) { const int st = b / 1024, sb = b % 1024, swz = sb ^ (((sb >> 9) & 1) << 5); R = (st >> 1) * 16 + swz / 64; C = (st & 1) * 32 + (swz % 64) / 2; }
__host__ __device__ __forceinline__ int perm32(int rho) { const int n = rho >> 4, i = rho & 15; return 8 * (i >> 2) + 4 * n + (i & 3); }

struct Unit { int pm, pn; };
struct Gemm { const bf16_t* A; const bf16_t* Bt; int M, N, K; };

struct StaticOrder {
    int nM, nN, nwg, G, c;
    __host__ __device__ void init(int M, int N, int G_, int c_) { nM = M / BM; nN = N / BM; nwg = nM * nN; G = G_; c = c_; }
    __host__ __device__ bool next(int i, Unit& u) const {
        const long L = (long)i * G + c; if (L >= nwg) return false;
        int wgid = (int)L; { const int q = nwg / NXCD, r = nwg % NXCD, xcd = wgid % NXCD, off = wgid / NXCD; wgid = (xcd < r ? xcd * (q + 1) : r * (q + 1) + (xcd - r) * q) + off; }
        const int nig = WGM * nN, gid = wgid / nig, fm = gid * WGM, gsz = (nM - fm) < WGM ? (nM - fm) : WGM;
        u.pm = fm + ((wgid % nig) % gsz); u.pn = (wgid % nig) / gsz; return true;
    }
    __device__ __forceinline__ void a_ready(const Unit&) const {}
    __device__ __forceinline__ void done(const Unit&) const {}
};

typedef __bf16 bf16v2p __attribute__((ext_vector_type(2))); typedef float f32v2p __attribute__((ext_vector_type(2)));
__device__ __forceinline__ unsigned cvt_pk_bf16(float lo, float hi) { const f32v2p v = {lo, hi}; return __builtin_bit_cast(unsigned, __builtin_convertvector(v, bf16v2p)); }
typedef float f32x2 __attribute__((ext_vector_type(2)));
__device__ __forceinline__ f32x2 gelu_pk(f32x2 v) {
    const f32x2 av = __builtin_elementwise_abs(v), d = av * 0.2316418882f + 1.0f;
    f32x2 t; t.x = __builtin_amdgcn_rcpf(d.x); t.y = __builtin_amdgcn_rcpf(d.y);
    f32x2 q = t * 0.5307027145f + (-0.7265760135f); q = q * t + 0.7107068705f; q = q * t + (-0.142248368f); q = q * t + 0.127414796f; q = q * t;
    const f32x2 s = (v * v) * (-0.72134752044f);
    f32x2 e; e.x = __builtin_amdgcn_exp2f(s.x); e.y = __builtin_amdgcn_exp2f(s.y);
    const f32x2 m = v * (q * e), r = v - m;
    f32x2 o; o.x = v.x < 0.f ? m.x : r.x; o.y = v.y < 0.f ? m.y : r.y; return o;
}

template <int ACT  > struct EpiBf16 {
    static constexpr bool PERM = true, AFTER_DRAIN = false; static_assert(ACT == 0 || ACT == 1, "EpiBf16: ACT is 0 (none) or 1 (gelu_pk)");
    bf16_t* O; int ldc; const float* bias; int split_cols; size_t split_stride; float scale0;
    __device__ __forceinline__ void operator()(const f32x4 (&acc)[2][2][4][2], const Unit& u, int wr, int wc, int fr, int fq) const {
        const int row0 = u.pm * BM + wr * 64 + fr; int colt = u.pn * BM; bf16_t* base = O;
        float sc = 1.f; if (split_cols) { const int t = colt / split_cols; base += (size_t)t * split_stride; colt -= t * split_cols; if (t == 0) sc = scale0; }
        const int col0 = colt + wc * 32 + 8 * fq, bcol0 = u.pn * BM + wc * 32 + 8 * fq;
        f32x4 bv[2][2];
#pragma unroll
        for (int bj = 0; bj < 2; ++bj)
#pragma unroll
            for (int n = 0; n < 2; ++n) bv[bj][n] = bias ? *(const f32x4*)(bias + bcol0 + bj * HALF + 4 * n) : (f32x4){0.f, 0.f, 0.f, 0.f};
#pragma unroll
        for (int ai = 0; ai < 2; ++ai)
#pragma unroll
            for (int m = 0; m < 4; ++m) { bf16_t* rowp = base + (size_t)(row0 + ai * HALF + m * 16) * ldc + col0;
#pragma unroll
                for (int bj = 0; bj < 2; ++bj) { f32x4 v0 = acc[ai][bj][m][0] + bv[bj][0], v1 = acc[ai][bj][m][1] + bv[bj][1];
                    if (ACT == 1) { f32x2 a = gelu_pk((f32x2){v0[0], v0[1]}), b = gelu_pk((f32x2){v0[2], v0[3]}), c = gelu_pk((f32x2){v1[0], v1[1]}), d = gelu_pk((f32x2){v1[2], v1[3]});
                        v0 = (f32x4){a.x, a.y, b.x, b.y}; v1 = (f32x4){c.x, c.y, d.x, d.y}; }
                    v0 = v0 * sc; v1 = v1 * sc; u32x4 w; w.x = cvt_pk_bf16(v0[0], v0[1]); w.y = cvt_pk_bf16(v0[2], v0[3]); w.z = cvt_pk_bf16(v1[0], v1[1]); w.w = cvt_pk_bf16(v1[2], v1[3]);
                    *(u32x4*)(rowp + bj * HALF) = w; } }
    }
};
struct EpiRes {
    static constexpr bool PERM = false, AFTER_DRAIN = false;
    const float* base; float* out; int ldc; int noread;
    __device__ __forceinline__ void operator()(const f32x4 (&acc)[2][2][4][2], const Unit& u, int wr, int wc, int fr, int fq) const {
        const bool hi = fr >= 8;
        const int row0 = u.pm * BM + wr * 64 + (fr & 7), col0 = u.pn * BM + wc * 32 + 4 * fq + (hi ? 16 : 0);
#pragma unroll
        for (int ai = 0; ai < 2; ++ai)
#pragma unroll
            for (int m = 0; m < 4; ++m) { const size_t off = (size_t)(row0 + ai * HALF + m * 16) * ldc + col0;
#pragma unroll
                for (int bj = 0; bj < 2; ++bj) {
                    const f32x4 v0 = acc[ai][bj][m][0], v1 = acc[ai][bj][m][1];
                    f32x4 dA, dB;
#define EPI_XCH(e_) { const float s_ = hi ? v0[e_] : v1[e_]; const float r_ = __builtin_bit_cast(float, __builtin_amdgcn_update_dpp(0, __builtin_bit_cast(int, s_), 0x128  , 0xF, 0xF, false)); \
                        dA[e_] = hi ? r_ : v0[e_]; dB[e_] = hi ? v1[e_] : r_; }
                    EPI_XCH(0) EPI_XCH(1) EPI_XCH(2) EPI_XCH(3)
#undef EPI_XCH
                    const size_t oA = off + bj * HALF, oB = oA + (size_t)8 * ldc;
                    f32x4 bA = (f32x4){0.f, 0.f, 0.f, 0.f}, bB = bA; if (!noread) { bA = *(const f32x4*)(base + oA); bB = *(const f32x4*)(base + oB); }
                    *(f32x4*)(out + oA) = bA + dA; *(f32x4*)(out + oB) = bB + dB; } }
    }
};
struct EpiSwiGLU {
    static constexpr bool PERM = true, AFTER_DRAIN = false;
    bf16_t* O; int ldo;
    __device__ __forceinline__ void operator()(const f32x4 (&acc)[2][2][4][2], const Unit& u, int wr, int wc, int fr, int fq) const {
        const int row0 = u.pm * BM + wr * 64 + fr, col0 = u.pn * HALF + wc * 32 + 8 * fq;
#pragma unroll
        for (int ai = 0; ai < 2; ++ai)
#pragma unroll
            for (int m = 0; m < 4; ++m) { bf16_t* rowp = O + (size_t)(row0 + ai * HALF + m * 16) * ldo + col0;
                float r[8];
#pragma unroll
                for (int n = 0; n < 2; ++n)
#pragma unroll
                    for (int e = 0; e < 4; ++e) { const float g = acc[ai][0][m][n][e], up = acc[ai][1][m][n][e]; r[4 * n + e] = g * __builtin_amdgcn_rcpf(1.0f + __expf(-g)) * up; }
                u32x4 w; w.x = cvt_pk_bf16(r[0], r[1]); w.y = cvt_pk_bf16(r[2], r[3]); w.z = cvt_pk_bf16(r[4], r[5]); w.w = cvt_pk_bf16(r[6], r[7]);
                *(u32x4*)rowp = w; }
    }
};
struct EpiBf16FL {
    static constexpr bool PERM = true, AFTER_DRAIN = false;
    bf16_t* O; int ldc; int nostore;
    __device__ __forceinline__ void operator()(const f32x4 (&acc)[2][2][4][2], const Unit& u, int wr, int wc, int fr, int fq) const {
        const bool hi = fr >= 8;
        const int row0 = u.pm * BM + wr * 64 + (fr & 7), col0 = u.pn * BM + wc * 64 + 8 * fq + (hi ? 32 : 0);
#pragma unroll
        for (int ai = 0; ai < 2; ++ai)
#pragma unroll
            for (int m = 0; m < 4; ++m) { bf16_t* rowp = O + (size_t)(row0 + ai * HALF + m * 16) * ldc + col0;
                unsigned w0[4], w1[4], dA[4], dB[4];
#pragma unroll
                for (int q = 0; q < 2; ++q) { w0[2 * q] = cvt_pk_bf16(acc[ai][0][m][q][0], acc[ai][0][m][q][1]); w0[2 * q + 1] = cvt_pk_bf16(acc[ai][0][m][q][2], acc[ai][0][m][q][3]);
                                              w1[2 * q] = cvt_pk_bf16(acc[ai][1][m][q][0], acc[ai][1][m][q][1]); w1[2 * q + 1] = cvt_pk_bf16(acc[ai][1][m][q][2], acc[ai][1][m][q][3]); }
#define EPI_XCH(e_) { const unsigned s_ = hi ? w0[e_] : w1[e_]; const unsigned r_ = (unsigned)__builtin_amdgcn_update_dpp(0, (int)s_, 0x128  , 0xF, 0xF, false); dA[e_] = hi ? r_ : w0[e_]; dB[e_] = hi ? w1[e_] : r_; }
                EPI_XCH(0) EPI_XCH(1) EPI_XCH(2) EPI_XCH(3)
#undef EPI_XCH
                if (!nostore) { *(u32x4*)rowp = (u32x4){dA[0], dA[1], dA[2], dA[3]}; *(u32x4*)(rowp + (size_t)8 * ldc) = (u32x4){dB[0], dB[1], dB[2], dB[3]}; }
                else asm volatile("" :: "v"(dA[0]), "v"(dA[1]), "v"(dA[2]), "v"(dA[3]), "v"(dB[0]), "v"(dB[1]), "v"(dB[2]), "v"(dB[3])); }
    }
};
template <class Epi, class Sched, bool ALIGN_EPI = false, bool SP2 = false>
__device__ __forceinline__ void gemm_phase(PG8_LAS unsigned char* lds, const Gemm g, const Sched& S, const Epi& E, const int tid) {
    const int wid = __builtin_amdgcn_readfirstlane(tid >> 6), lane = tid & 63, wr = wid >> 2, wc = wid & 3, fr = lane & 15, fq = lane >> 4;
    const int K = g.K, nt = K / BK;
    unsigned voffA[2], voffB[2];
#pragma unroll
    for (int i = 0; i < 2; ++i) { int R, C; stage_rc(tid * 16 + i * 8192, R, C); const int Rb = Epi::PERM ? ((R & ~31) + perm32(R & 31)) : R;
        voffA[i] = (unsigned)(R * K + C) * 2u; voffB[i] = (unsigned)(Rb * K + C) * 2u; }
    const size_t kstep = (size_t)(BK * 2);
    const size_t hstep = (size_t)HALF * K * 2;
    const size_t tstep = 2 * hstep;
    const unsigned ldsw = (unsigned)wid * 1024u;
    const int aoff = lds_byte(wr * 64 + fr, fq * 8), boff = lds_byte(wc * 32 + fr, fq * 8);
#define PG8_SA(b, h) (((b) * 2 + (h)) * HTB)
#define PG8_SB(b, h) ((4 + (b) * 2 + (h)) * HTB)
#define PG8_STAGE(bufoff, gbase, voff) do { _Pragma("unroll") for (int _i = 0; _i < 2; ++_i) \
        __builtin_amdgcn_global_load_lds((const unsigned*)((const char*)(gbase) + (voff)[_i]), (PG8_LAS unsigned*)(lds + (bufoff) + ldsw + _i * 8192), 16, 0, 0); } while (0)
#define PG8_LDA(dst, b, h) do { _Pragma("unroll") for (int m = 0; m < 4; ++m) _Pragma("unroll") for (int k = 0; k < 2; ++k) dst[m][k] = *(const PG8_LAS bf16x8*)(lds + PG8_SA(b, h) + aoff + m * 2048 + k * 1024); } while (0)
#define PG8_LDB(dst, b, h) do { _Pragma("unroll") for (int n = 0; n < 2; ++n) _Pragma("unroll") for (int k = 0; k < 2; ++k) dst[n][k] = *(const PG8_LAS bf16x8*)(lds + PG8_SB(b, h) + boff + n * 2048 + k * 1024); } while (0)
#define PG8_MMA(ai, bj, At, Bt) do { __builtin_amdgcn_s_setprio(1); _Pragma("unroll") for (int m = 0; m < 4; ++m) _Pragma("unroll") for (int n = 0; n < 2; ++n) _Pragma("unroll") for (int k = 0; k < 2; ++k) \
        acc[ai][bj][m][n] = __builtin_amdgcn_mfma_f32_16x16x32_bf16(Bt[n][k], At[m][k], acc[ai][bj][m][n], 0, 0, 0); __builtin_amdgcn_s_setprio(0); } while (0)
#define PG8_WAIT_V(n) asm volatile("s_waitcnt vmcnt(" #n ")" ::: "memory")
#define PG8_WAIT_L(n) asm volatile("s_waitcnt lgkmcnt(" #n ")" ::: "memory")
#define PG8_BAR __builtin_amdgcn_s_barrier()
#define PG8_SCHED __builtin_amdgcn_sched_barrier(0)
    Unit cur, nxt; int ui = 0;
    if (!S.next(0, cur)) return;
    f32x4 acc[2][2][4][2];
#pragma unroll
    for (int a = 0; a < 2; ++a)
#pragma unroll
        for (int b = 0; b < 2; ++b)
#pragma unroll
            for (int m = 0; m < 4; ++m)
#pragma unroll
                for (int n = 0; n < 2; ++n) acc[a][b][m][n] = (f32x4){0.f, 0.f, 0.f, 0.f};
    bf16x8 At[4][2], B0[2][2], B1[2][2];
    const char* cA = (const char*)g.A + (size_t)cur.pm * tstep; const char* cB = (const char*)g.Bt + (size_t)cur.pn * tstep;
    S.a_ready(cur);
    if constexpr (SP2) {
        PG8_STAGE(PG8_SB(0, 0), cB, voffB); PG8_STAGE(PG8_SB(0, 1), cB + hstep, voffB); PG8_STAGE(PG8_SA(0, 0), cA, voffA); PG8_STAGE(PG8_SA(0, 1), cA + hstep, voffA);
        if (wr == 1) PG8_BAR;
        PG8_WAIT_V(2); PG8_BAR;
        PG8_STAGE(PG8_SB(1, 0), cB + kstep, voffB); PG8_STAGE(PG8_SA(1, 0), cA + kstep, voffA); PG8_STAGE(PG8_SB(1, 1), cB + hstep + kstep, voffB);
        PG8_WAIT_V(6); PG8_BAR;
    } else {
        PG8_STAGE(PG8_SB(0, 0), cB, voffB); PG8_STAGE(PG8_SA(0, 0), cA, voffA); PG8_STAGE(PG8_SB(0, 1), cB + hstep, voffB); PG8_STAGE(PG8_SA(0, 1), cA + hstep, voffA);
        if (wr == 1) PG8_BAR;
        PG8_WAIT_V(4); PG8_BAR;
        PG8_STAGE(PG8_SB(1, 0), cB + kstep, voffB); PG8_STAGE(PG8_SA(1, 0), cA + kstep, voffA); PG8_STAGE(PG8_SB(1, 1), cB + hstep + kstep, voffB);
        PG8_WAIT_V(6); PG8_BAR;
    }
    for (;;) {
        const bool has_next = S.next(ui + 1, nxt);
        const char* nA = has_next ? (const char*)g.A + (size_t)nxt.pm * tstep : cA; const char* nB = has_next ? (const char*)g.Bt + (size_t)nxt.pn * tstep : cB;
        for (int t = 0; t < nt; t += 2) {
            const bool last = (t == nt - 2);
            const char* a1 = cA + (size_t)(t + 1) * kstep;
            const char* a2 = last ? nA : cA + (size_t)(t + 2) * kstep; const char* b2 = last ? nB : cB + (size_t)(t + 2) * kstep;
            const char* a3 = a2 + kstep; const char* b3 = b2 + kstep;
            if (last && has_next) S.a_ready(nxt);
            if constexpr (SP2) {
            PG8_LDB(B0, 0, 0); PG8_LDB(B1, 0, 1); PG8_SCHED; PG8_LDA(At, 0, 0); PG8_STAGE(PG8_SA(1, 1), a1 + hstep, voffA);
            PG8_WAIT_V(8); PG8_WAIT_L(0); PG8_BAR; PG8_MMA(0, 0, At, B0); PG8_MMA(0, 1, At, B1); PG8_BAR; PG8_SCHED;
            PG8_LDA(At, 0, 1); PG8_STAGE(PG8_SB(0, 0), b2, voffB); PG8_STAGE(PG8_SB(0, 1), b2 + hstep, voffB); PG8_STAGE(PG8_SA(0, 0), a2, voffA);
            PG8_WAIT_V(8); PG8_WAIT_L(0); PG8_BAR; PG8_MMA(1, 0, At, B0); PG8_MMA(1, 1, At, B1); PG8_BAR; PG8_SCHED;
            PG8_LDB(B0, 1, 0); PG8_LDB(B1, 1, 1); PG8_SCHED; PG8_LDA(At, 1, 0); PG8_STAGE(PG8_SA(0, 1), a2 + hstep, voffA);
            PG8_WAIT_V(8); PG8_WAIT_L(0); PG8_BAR; PG8_MMA(0, 0, At, B0); PG8_MMA(0, 1, At, B1); PG8_BAR; PG8_SCHED;
            PG8_LDA(At, 1, 1); PG8_STAGE(PG8_SB(1, 0), b3, voffB); PG8_STAGE(PG8_SB(1, 1), b3 + hstep, voffB); PG8_STAGE(PG8_SA(1, 0), a3, voffA);
            PG8_WAIT_V(8); PG8_WAIT_L(0); PG8_BAR; PG8_MMA(1, 0, At, B0); PG8_MMA(1, 1, At, B1); PG8_BAR; PG8_SCHED;
            } else {
            PG8_LDB(B0, 0, 0); PG8_SCHED; PG8_LDA(At, 0, 0); PG8_STAGE(PG8_SA(1, 1), a1 + hstep, voffA);
            PG8_WAIT_L(8); PG8_BAR; PG8_WAIT_L(0); PG8_MMA(0, 0, At, B0); PG8_BAR; PG8_SCHED;
            PG8_LDB(B1, 0, 1); PG8_STAGE(PG8_SB(0, 0), b2, voffB);
            PG8_BAR; PG8_WAIT_L(0); PG8_MMA(0, 1, At, B1); PG8_BAR;
            PG8_LDA(At, 0, 1); PG8_STAGE(PG8_SA(0, 0), a2, voffA);
            PG8_BAR; PG8_WAIT_L(0); PG8_MMA(1, 0, At, B0); PG8_BAR; PG8_SCHED;
            PG8_STAGE(PG8_SB(0, 1), b2 + hstep, voffB);
            PG8_WAIT_V(6); PG8_BAR; PG8_MMA(1, 1, At, B1); PG8_BAR;
            PG8_LDB(B0, 1, 0); PG8_SCHED; PG8_LDA(At, 1, 0); PG8_STAGE(PG8_SA(0, 1), a2 + hstep, voffA);
            PG8_WAIT_L(8); PG8_BAR; PG8_WAIT_L(0); PG8_MMA(0, 0, At, B0); PG8_BAR; PG8_SCHED;
            PG8_LDB(B1, 1, 1); PG8_STAGE(PG8_SB(1, 0), b3, voffB);
            PG8_BAR; PG8_WAIT_L(0); PG8_MMA(0, 1, At, B1); PG8_BAR;
            PG8_LDA(At, 1, 1); PG8_STAGE(PG8_SA(1, 0), a3, voffA);
            PG8_BAR; PG8_WAIT_L(0); PG8_MMA(1, 0, At, B0); PG8_BAR; PG8_SCHED;
            PG8_STAGE(PG8_SB(1, 1), b3 + hstep, voffB);
            PG8_WAIT_V(6); PG8_BAR; PG8_MMA(1, 1, At, B1); PG8_BAR;
            }
        }
        if constexpr (ALIGN_EPI) { if (wr == 0) PG8_BAR; }
        if constexpr (!Epi::AFTER_DRAIN) { E(acc, cur, wr, wc, fr, fq); S.done(cur); }
        if (!has_next) break;
#pragma unroll
        for (int a = 0; a < 2; ++a)
#pragma unroll
            for (int b = 0; b < 2; ++b)
#pragma unroll
                for (int m = 0; m < 4; ++m)
#pragma unroll
                    for (int n = 0; n < 2; ++n) acc[a][b][m][n] = (f32x4){0.f, 0.f, 0.f, 0.f};
        cur = nxt; cA = nA; cB = nB; ++ui;
        if constexpr (ALIGN_EPI) { if (wr == 1) PG8_BAR; }
    }
    PG8_WAIT_V(0);
    if constexpr (!ALIGN_EPI) { if (wr == 0) PG8_BAR; }
    PG8_BAR;
    if constexpr (Epi::AFTER_DRAIN) { E.fused(acc, cur, wr, wc, fr, fq, lds, wid, lane); S.done(cur); }
#undef PG8_SA
#undef PG8_SB
#undef PG8_STAGE
#undef PG8_LDA
#undef PG8_LDB
#undef PG8_MMA
#undef PG8_WAIT_V
#undef PG8_WAIT_L
#undef PG8_BAR
#undef PG8_SCHED
}
}
#define GAS __attribute__((address_space(1)))
#define LAS __attribute__((address_space(3)))
typedef unsigned short bf16;
typedef unsigned v4u __attribute__((ext_vector_type(4)));
typedef float f32x4 __attribute__((ext_vector_type(4)));
typedef short bf16x8 __attribute__((ext_vector_type(8)));
typedef GAS unsigned gu32;
typedef GAS unsigned long long gu64;
#define RLX_AGENT __ATOMIC_RELAXED, __HIP_MEMORY_SCOPE_AGENT
#define LDS_WAIT() asm volatile("s_waitcnt lgkmcnt(0)" ::: "memory")
#define VM_WAIT() asm volatile("s_waitcnt vmcnt(0)" ::: "memory")
__device__ __forceinline__ unsigned long long rt() { return __builtin_amdgcn_s_memrealtime(); }
__device__ __forceinline__ unsigned f2bf(float f) { unsigned u = __builtin_bit_cast(unsigned, f); return (u + 0x7fffu + ((u >> 16) & 1u)) >> 16; }
typedef __bf16 bf16v2q __attribute__((ext_vector_type(2))); typedef float f32v2q __attribute__((ext_vector_type(2)));
__device__ __forceinline__ unsigned pk2(float lo, float hi) { const f32v2q v = {lo, hi}; return __builtin_bit_cast(unsigned, __builtin_convertvector(v, bf16v2q)); }

#define XB_TMO      128
#define XB_XCNT(j)  (256  + 64 * (j))
#define XB_XSUB(j)  (1280 + 64 * (j))
#define XB_XGEN(j)  (2304 + 64 * (j))
#define XB_TOP      3328
#define XB_TOPGEN   3392
#define XCD_BAR_WORDS 3456
#define XB_SPIN_CAP (1u << 18)

__device__ __forceinline__ unsigned xb_ld(unsigned* p)              { return __hip_atomic_load(p, __ATOMIC_RELAXED, __HIP_MEMORY_SCOPE_AGENT); }
__device__ __forceinline__ unsigned xb_add(unsigned* p, unsigned v) { return __hip_atomic_fetch_add(p, v, __ATOMIC_RELAXED, __HIP_MEMORY_SCOPE_AGENT); }
__device__ __forceinline__ unsigned xb_xcc_id() { return (unsigned)__builtin_amdgcn_s_getreg((3 << 11) | 20) & 0xFu; }
#define XB_SPIN(cond, bar) do { unsigned _sp = 0; while (cond) { __builtin_amdgcn_s_sleep(1); \
    if ((++_sp & 255u) == 0u) { if (xb_ld(&(bar)[XB_TMO])) break; if (_sp > XB_SPIN_CAP) { atomicAdd(&(bar)[XB_TMO], 1u); break; } } } } while (0)

struct XcdBarrier {
    unsigned* bar; unsigned x;
    volatile LAS unsigned* st;
};

__device__ __forceinline__ XcdBarrier xcd_barrier_post(unsigned* bar, volatile LAS unsigned* st) {
    XcdBarrier b; b.bar = bar; b.x = xb_xcc_id(); b.st = st;
    if (threadIdx.x == 0) (void)xb_add(&bar[XB_XCNT(b.x)], 1u);
    return b;
}
__device__ __forceinline__ void xcd_barrier_complete(unsigned* bar, unsigned x, unsigned& nloc, unsigned& nx) {
    const unsigned G = gridDim.x * gridDim.y * gridDim.z;
    unsigned sum, cnt, mine, sp = 0u;
    for (;;) {
        sum = 0u; cnt = 0u; mine = 0u;
#pragma unroll
        for (unsigned j = 0; j < 16; ++j) { const unsigned c = xb_ld(&bar[XB_XCNT(j)]); sum += c; cnt += (c > 0u) ? 1u : 0u; mine = (j == x) ? c : mine; }
        if (sum == G) break;
        __builtin_amdgcn_s_sleep(1);
        if ((++sp & 255u) == 0u) { if (xb_ld(&bar[XB_TMO])) break; if (sp > XB_SPIN_CAP) { atomicAdd(&bar[XB_TMO], 1u); break; } }
    }
    nloc = mine > 0u ? mine : 1u; nx = cnt > 0u ? cnt : 1u;
}

__device__ __forceinline__ void xcd_barrier(const XcdBarrier& b) {
    asm volatile("s_waitcnt vmcnt(0)" ::: "memory");
    __syncthreads();
    if (threadIdx.x == 0) {
        unsigned* bar = b.bar;
        __builtin_amdgcn_s_waitcnt(0);
        unsigned nloc = b.st[0], nx = b.st[1];
        if (nloc == 0u) { xcd_barrier_complete(bar, b.x, nloc, nx); b.st[0] = nloc; b.st[1] = nx; }
        const unsigned old = xb_add(&bar[XB_XSUB(b.x)], 1u);
        const unsigned gen = old / nloc;
        if (old + 1u == (gen + 1u) * nloc) {
            __builtin_amdgcn_fence(__ATOMIC_RELEASE, "agent");
            asm volatile("s_waitcnt vmcnt(0)" ::: "memory");
            const unsigned og = xb_add(&bar[XB_TOP], 1u);
            const unsigned tg = og / nx;
            if (og + 1u == (tg + 1u) * nx) xb_add(&bar[XB_TOPGEN], 1u);
            else XB_SPIN(xb_ld(&bar[XB_TOPGEN]) == tg, bar);
            __builtin_amdgcn_fence(__ATOMIC_ACQUIRE, "agent");
            xb_add(&bar[XB_XGEN(b.x)], 1u);
            asm volatile("s_waitcnt vmcnt(0)" ::: "memory");
        } else {
            XB_SPIN(xb_ld(&bar[XB_XGEN(b.x)]) == gen, bar);
            __builtin_amdgcn_fence(__ATOMIC_ACQUIRE, "agent");
            asm volatile("s_waitcnt vmcnt(0)" ::: "memory");
        }
    }
    __syncthreads();
}

#ifndef MK_PH_HI
#define MK_PH_HI 17
#endif
#ifndef MK_SUB
#define MK_SUB 3
#endif
#ifndef MK_DNSTEP
#define MK_DNSTEP 9
#endif
#ifndef MK_W6
#define MK_W6 1
#endif
#ifndef MK_CVSTEP
#define MK_CVSTEP 9
#endif
#ifndef MK_REP
#define MK_REP 0
#endif
#ifndef MK_REPSUB
#define MK_REPSUB 3
#endif
#ifndef MK_NOREAD
#define MK_NOREAD 0
#endif
#ifndef MK_STAG_A
#define MK_STAG_A 0
#endif
#ifndef MK_STAG_O
#define MK_STAG_O 0
#endif
#ifndef MK_STAG_GU
#define MK_STAG_GU 0
#endif
#ifndef MK_STAG_D
#define MK_STAG_D 0
#endif
#ifndef MK_REPSUB2
#define MK_REPSUB2 3
#endif
#ifndef MK_XBAR
#define MK_XBAR 0
#endif
#ifndef MK_NOSTORE
#define MK_NOSTORE 0
#endif
#ifndef MK_NEG
#define MK_NEG 1
#endif

constexpr int NWAVES = 8;
constexpr int D = 1024, BATCH = 8, SEQ = 4096, M = BATCH * SEQ, DEPTH = 2;
constexpr int DFF = 2816, DPROJ = 3080, NP = 3072;
constexpr int CVK = 31, DNCONV = 4;
constexpr float EPS = 1e-6f;
constexpr int NCHUNK = BATCH * 4 * 64;

constexpr size_t MiB = 1u << 20;
constexpr size_t WS_CTL = 0, CTL_ZERO_BYTES = 64 * 1024;
constexpr size_t WS_W = 2 * MiB;
constexpr size_t W_IN_OFF = 0, W_O_OFF = 6 * MiB, W_GU_OFF = 8 * MiB, W_D_OFF = 19 * MiB, W_LAYER = 25 * MiB;
constexpr size_t WS_BA = 53 * MiB;
constexpr size_t WS_CD = 54 * MiB + 512 * 1024;
constexpr size_t WS_HN = 64 * MiB;
constexpr size_t WS_P = 128 * MiB;
constexpr size_t WS_REC = 320 * MiB;
constexpr size_t REC_BYTES = 74752, REC_W = 0, REC_QD = 16384, REC_QK = 32768, REC_KDT = 40960, REC_U = 57344, REC_CD = 73728;
constexpr size_t WS_O = 468 * MiB, WS_END = 500 * MiB;
constexpr int CW_BAR = 4096, CW_FLAGS = 8192;

constexpr int RING_BYTES = 131072;
constexpr int MISC_OFF = 163840 - 256;
constexpr int LDS_BYTES = 163840;

__device__ __forceinline__ float bf2f(unsigned short b) { return __uint_as_float(((unsigned)b) << 16); }
#define dpp_f(old, v, ctrl, row_mask, bound) __builtin_bit_cast(float, __builtin_amdgcn_update_dpp(__builtin_bit_cast(int, (float)(old)), __builtin_bit_cast(int, (float)(v)), (ctrl), (row_mask), 0xF, (bound)))
__device__ __forceinline__ float wave_sum(float v) {
    v += dpp_f(0.f, v, 0xB1, 0xF, true);
    v += dpp_f(0.f, v, 0x4E, 0xF, true);
    v += dpp_f(0.f, v, 0x141, 0xF, true);
    v += dpp_f(0.f, v, 0x140, 0xF, true);
    v += dpp_f(0.f, v, 0x142, 0xA, false);
    v += dpp_f(0.f, v, 0x143, 0xC, false);
    return __builtin_bit_cast(float, __builtin_amdgcn_readlane(__builtin_bit_cast(int, v), 63));
}
__device__ __forceinline__ float sigmoidf_(float x) { return __builtin_amdgcn_rcpf(1.0f + __builtin_amdgcn_exp2f(x * -1.4426950408889634f)); }
__device__ __forceinline__ float gelu_erf(float x) { return 0.5f * x * (1.0f + erff(x * 0.70710678118654752f)); }
typedef float f32x16 __attribute__((ext_vector_type(16)));
typedef unsigned u32x2 __attribute__((ext_vector_type(2)));
#define MFMA32(a, b, c) __builtin_amdgcn_mfma_f32_32x32x16_bf16((a), (b), (c), 0, 0, 0)
__device__ __forceinline__ int crow(int reg, int hh) { return (reg & 3) + 8 * (reg >> 2) + 4 * hh; }

#define AS4 __attribute__((address_space(4)))
struct Frame {
    LAS unsigned char* lds;
    int tid, lane, wave, vcu, G;
    const AS4 unsigned char* kp;
    float* out; unsigned char* ws;
    __device__ __forceinline__ const float* inp(int k) const { return *(const float* const AS4*)(kp + 8 * k); }
};

__device__ __forceinline__ void tr_item(const float* W, int ldw, int K, bf16* WT, int kb, int nsrc0, int ndst0, LAS float* scr, int lane) {
    const int k0 = 64 * kb;
#pragma unroll 8
    for (int i = 0; i < 32; ++i) { const int kk = 2 * i + (lane >> 5); scr[kk * 33 + (lane & 31)] = W[(size_t)(k0 + kk) * ldw + nsrc0 + (lane & 31)]; }
    LDS_WAIT(); asm volatile("" ::: "memory");
    const int c = lane & 7;
#pragma unroll
    for (int j = 0; j < 4; ++j) { const int n = (lane >> 3) + 8 * j; const LAS float* s = scr + (8 * c) * 33 + n;
        v4u o; o.x = pk2(s[0 * 33], s[1 * 33]); o.y = pk2(s[2 * 33], s[3 * 33]); o.z = pk2(s[4 * 33], s[5 * 33]); o.w = pk2(s[6 * 33], s[7 * 33]);
        *(GAS v4u*)(WT + (size_t)(ndst0 + n) * K + k0 + 8 * c) = o; }
    LDS_WAIT(); asm volatile("" ::: "memory");
}
__device__ __forceinline__ void weights_phase(Frame& F) {
    LAS float* scr = (LAS float*)(F.lds + F.wave * 16384);
    const int gw = F.vcu * NWAVES + F.wave, NGW = F.G * NWAVES;
    constexpr int I_IN = 16 * 96, I_O = 16 * 32, I_GU = 16 * 176, I_D = 44 * 32, I_L = I_IN + I_O + I_GU + I_D;
    for (int it = gw; it < DEPTH * I_L; it += NGW) {
        const int l = it / I_L; int r = it % I_L;
        bf16* wb = (bf16*)(F.ws + WS_W + (size_t)l * W_LAYER);
        if (r < I_IN) { const int kb = r / 96, nb = r % 96, q8 = nb & 7, nsrc = (nb & ~7) + (q8 & 3) * 2 + (q8 >> 2);
            tr_item(F.inp(2) + (size_t)l * D * DPROJ, DPROJ, D, (bf16*)((unsigned char*)wb + W_IN_OFF), kb, 32 * nsrc, 32 * nb, scr, F.lane); continue; } r -= I_IN;
        if (r < I_O) { const int kb = r / 32, nb = r % 32; tr_item(F.inp(15) + (size_t)l * D * D, D, D, (bf16*)((unsigned char*)wb + W_O_OFF), kb, 32 * nb, 32 * nb, scr, F.lane); continue; } r -= I_O;
        if (r < I_GU) { const int kb = r / 176, nb = r % 176; const int drow = 32 * nb, tile = drow >> 8, within = drow & 255;
            const float* src = (within < 128 ? F.inp(17) : F.inp(18)) + (size_t)l * D * DFF;
            tr_item(src, DFF, D, (bf16*)((unsigned char*)wb + W_GU_OFF), kb, tile * 128 + (within & 127), drow, scr, F.lane); continue; } r -= I_GU;
        { const int kb = r / 32, nb = r % 32; tr_item(F.inp(19) + (size_t)l * DFF * D, D, DFF, (bf16*)((unsigned char*)wb + W_D_OFF), kb, 32 * nb, 32 * nb, scr, F.lane); }
    }
}

template <int MODE>
__device__ __forceinline__ void norm_phase(Frame& F, const float* xin, const float* g, bf16* hn, const float* wlog, float* ba, float* fout) {
    const int gw = F.vcu * NWAVES + F.wave, NGW = F.G * NWAVES;
    f32x4 gv[4];
#pragma unroll
    for (int j = 0; j < 4; ++j) gv[j] = ((const f32x4*)g)[64 * j + F.lane];
    LAS float* sW = (LAS float*)F.lds;
    if (MODE == 0 && wlog) {
        __syncthreads();
#pragma unroll
        for (int q = 0; q < 2; ++q) { const int k = 2 * F.tid + q; const f32x4* wr = (const f32x4*)(wlog + (size_t)k * DPROJ + NP); const f32x4 w0 = wr[0], w1 = wr[1];
            sW[0 * 1024 + k] = w0.x; sW[1 * 1024 + k] = w0.y; sW[2 * 1024 + k] = w0.z; sW[3 * 1024 + k] = w0.w; sW[4 * 1024 + k] = w1.x; sW[5 * 1024 + k] = w1.y; sW[6 * 1024 + k] = w1.z; sW[7 * 1024 + k] = w1.w; }
        __syncthreads();
    }
    for (int m = gw; m < M; m += NGW) {
        const f32x4* xr = (const f32x4*)(xin + (size_t)m * D) + F.lane;
        f32x4 v[4]; float ss = 0.f;
#pragma unroll
        for (int j = 0; j < 4; ++j) { v[j] = xr[64 * j]; ss += (v[j].x * v[j].x + v[j].y * v[j].y) + (v[j].z * v[j].z + v[j].w * v[j].w); }
        const float rstd = __builtin_amdgcn_rsqf(wave_sum(ss) * (1.0f / D) + EPS);
#pragma unroll
        for (int j = 0; j < 4; ++j) v[j] = v[j] * rstd * gv[j];
        if (MODE == 0) {
            unsigned long long* o8 = (unsigned long long*)(hn + (size_t)m * D) + F.lane;
#pragma unroll
            for (int j = 0; j < 4; ++j) o8[64 * j] = (unsigned long long)pk2(v[j].x, v[j].y) | ((unsigned long long)pk2(v[j].z, v[j].w) << 32);
            if (wlog) {
                float acc[8];
#pragma unroll
                for (int t = 0; t < 8; ++t) { acc[t] = 0.f;
#pragma unroll
                    for (int j = 0; j < 4; ++j) { const f32x4 w = *(const LAS f32x4*)(sW + t * 1024 + 256 * j + 4 * F.lane); acc[t] += (v[j].x * w.x + v[j].y * w.y) + (v[j].z * w.z + v[j].w * w.w); } }
#pragma unroll
                for (int t = 0; t < 8; ++t) acc[t] = wave_sum(acc[t]);
                if (F.lane == 0) { *(f32x4*)(ba + (size_t)m * 8) = (f32x4){acc[0], acc[1], acc[2], acc[3]}; *(f32x4*)(ba + (size_t)m * 8 + 4) = (f32x4){acc[4], acc[5], acc[6], acc[7]}; }
            }
        } else {
            f32x4* o = (f32x4*)(fout + (size_t)m * D) + F.lane;
#pragma unroll
            for (int j = 0; j < 4; ++j) o[64 * j] = v[j];
        }
    }
}

__device__ __forceinline__ float gelu_as(float v) {
    const float d = fabsf(v) * 0.2316418882f + 1.0f, t = __builtin_amdgcn_rcpf(d);
    float q = t * 0.5307027145f + (-0.7265760135f); q = q * t + 0.7107068705f; q = q * t + (-0.142248368f); q = q * t + 0.127414796f; q = q * t;
    const float e = __builtin_amdgcn_exp2f((v * v) * (-0.72134752044f));
    const float m = v * (q * e), r = v - m;
    return v < 0.f ? m : r;
}
typedef __bf16 bf16v8m_t __attribute__((ext_vector_type(8)));
typedef float f32x8m_t __attribute__((ext_vector_type(8)));
__device__ __forceinline__ bf16x8 cvt8(float a0, float a1, float a2, float a3, float a4, float a5, float a6, float a7) { const f32x8m_t v = {a0, a1, a2, a3, a4, a5, a6, a7}; return __builtin_bit_cast(bf16x8, __builtin_convertvector(v, bf16v8m_t)); }
__device__ __forceinline__ void gmlp_unit(Frame& F, int l, int unit, const bf16* P, bf16* MIX) {
    const int m0 = unit * 128;
    LAS bf16* sVt = (LAS bf16*)F.lds;
    {
        float lg[4], lb[4];
#pragma unroll
        for (int e = 0; e < 4; ++e) { lg[e] = F.inp(3)[l * 256 + F.lane + 64 * e]; lb[e] = F.inp(4)[l * 256 + F.lane + 64 * e]; }
        unsigned short rv[16][4];
#pragma unroll
        for (int jj = 0; jj < 16; ++jj) { const bf16* pr = P + (size_t)(m0 + 16 * F.wave + jj) * NP + 256 + F.lane;
#pragma unroll
            for (int e = 0; e < 4; ++e) rv[jj][e] = pr[64 * e]; }
#pragma unroll
        for (int jj = 0; jj < 16; ++jj) {
            const int j = 16 * F.wave + jj;
            float v[4];
#pragma unroll
            for (int e = 0; e < 4; ++e) v[e] = gelu_as(bf2f(rv[jj][e]));
            const float mean = wave_sum((v[0] + v[1]) + (v[2] + v[3])) * (1.0f / 256.0f);
#pragma unroll
            for (int e = 0; e < 4; ++e) v[e] -= mean;
            const float var = wave_sum((v[0] * v[0] + v[1] * v[1]) + (v[2] * v[2] + v[3] * v[3])) * (1.0f / 256.0f);
            const float r = __builtin_amdgcn_rsqf(var + EPS);
#pragma unroll
            for (int e = 0; e < 4; ++e) sVt[(F.lane + 64 * e) * 136 + j] = (bf16)(pk2(v[e] * r * lg[e] + lb[e], 0.f) & 0xffffu);
        }
    }
    __syncthreads();
    {
        const int r = F.lane & 31, hh = F.lane >> 5, h = F.wave >> 1, c = 32 * F.wave + r;
        const float* wsh = F.inp(5) + (size_t)(l * 4 + h) * 128 * 128;
        const float* bsh = F.inp(6) + (l * 4 + h) * 128;
        bf16x8 bfr[8];
#pragma unroll
        for (int s = 0; s < 8; ++s) bfr[s] = *(const LAS bf16x8*)(sVt + c * 136 + 16 * s + 8 * hh);
#pragma unroll
        for (int ti = 0; ti < 4; ++ti) {
            const int i = 32 * ti + r;
            f32x16 acc;
#pragma unroll
            for (int e = 0; e < 16; ++e) acc[e] = 0.f;
            unsigned short ur[16]; float br[16];
#pragma unroll
            for (int e = 0; e < 16; ++e) { const int io = 32 * ti + crow(e, hh); ur[e] = P[(size_t)(m0 + io) * NP + c]; br[e] = bsh[io]; }
#pragma unroll
            for (int s = 0; s < 2 * ti + 2; ++s) {
                const float* ap = wsh + i * 128 + 16 * s + 8 * hh;
                f32x4 a0 = *(const f32x4*)ap, a1 = *(const f32x4*)(ap + 4);
                if (s >= 2 * ti) { const int j0 = 16 * s + 8 * hh;
                    a0.x = (j0 + 0 <= i) ? a0.x : 0.f; a0.y = (j0 + 1 <= i) ? a0.y : 0.f; a0.z = (j0 + 2 <= i) ? a0.z : 0.f; a0.w = (j0 + 3 <= i) ? a0.w : 0.f;
                    a1.x = (j0 + 4 <= i) ? a1.x : 0.f; a1.y = (j0 + 5 <= i) ? a1.y : 0.f; a1.z = (j0 + 6 <= i) ? a1.z : 0.f; a1.w = (j0 + 7 <= i) ? a1.w : 0.f; }
                acc = MFMA32(cvt8(a0.x, a0.y, a0.z, a0.w, a1.x, a1.y, a1.z, a1.w), bfr[s], acc);
            }
#pragma unroll
            for (int e = 0; e < 16; ++e) { const int io = 32 * ti + crow(e, hh);
                const float u = gelu_as(bf2f(ur[e]));
                MIX[(size_t)(m0 + io) * D + c] = (bf16)(pk2(u * (acc[e] + br[e]), 0.f) & 0xffffu); }
        }
    }
    __syncthreads();
}

__device__ __forceinline__ void conv_unit(Frame& F, int l, int unit, const bf16* P, bf16* MIX) {
    const int b = unit >> 6, t0 = (unit & 63) * 64, m0 = b * SEQ + t0;
    LAS float* sY = (LAS float*)F.lds;
    const int c = F.tid & 255, hf = F.wave >> 2;
    float w[CVK];
#pragma unroll
    for (int k = 0; k < CVK; ++k) w[k] = F.inp(7)[(size_t)(l * CVK + k) * 256 + c];
    const float bias = F.inp(8)[l * 256 + c];
    {
        u32x2 ra[12], rg[12];
#pragma unroll
        for (int q = 0; q < 12; ++q) { const int r = F.wave + 8 * q, rc = r < 94 ? r : 93; const int t = t0 - 30 + rc, tc = t >= 0 ? t : 0;
            const bf16* pr = P + (size_t)(b * SEQ + tc) * NP + 4 * F.lane; ra[q] = *(const u32x2*)(pr + 512); rg[q] = *(const u32x2*)(pr + 768); }
#pragma unroll
        for (int q = 0; q < 12; ++q) { const int r = F.wave + 8 * q; const int t = t0 - 30 + r;
            f32x4 y;
            y.x = bf2f((unsigned short)(ra[q].x & 0xffffu)) * sigmoidf_(bf2f((unsigned short)(rg[q].x & 0xffffu)));
            y.y = bf2f((unsigned short)(ra[q].x >> 16)) * sigmoidf_(bf2f((unsigned short)(rg[q].x >> 16)));
            y.z = bf2f((unsigned short)(ra[q].y & 0xffffu)) * sigmoidf_(bf2f((unsigned short)(rg[q].y & 0xffffu)));
            y.w = bf2f((unsigned short)(ra[q].y >> 16)) * sigmoidf_(bf2f((unsigned short)(rg[q].y >> 16)));
            if (t < 0) y = (f32x4){0.f, 0.f, 0.f, 0.f};
            if (r < 94) *(LAS f32x4*)(sY + r * 256 + 4 * F.lane) = y; }
    }
    __syncthreads();
    float o[32];
#pragma unroll
    for (int g = 0; g < 4; ++g) {
        float y[38];
#pragma unroll
        for (int q = 0; q < 38; ++q) y[q] = sY[(hf * 32 + 8 * g + q) * 256 + c];
#pragma unroll
        for (int t8 = 0; t8 < 8; ++t8) {
            float a = bias;
#pragma unroll
            for (int k = 0; k < CVK; ++k) a += w[k] * y[t8 + k];
            o[8 * g + t8] = a;
        }
    }
    __syncthreads();
#pragma unroll
    for (int tt = 0; tt < 32; ++tt) sY[(hf * 32 + tt) * 256 + c] = o[tt];
    __syncthreads();
    const f32x4 g4 = *(const f32x4*)(F.inp(9) + l * 256 + 4 * F.lane), b4 = *(const f32x4*)(F.inp(10) + l * 256 + 4 * F.lane);
    for (int i = F.wave; i < 64; i += NWAVES) {
        f32x4 v = *(LAS f32x4*)(sY + i * 256 + 4 * F.lane);
        const float mean = wave_sum((v.x + v.y) + (v.z + v.w)) * (1.0f / 256.0f);
        v = v - mean;
        const float var = wave_sum((v.x * v.x + v.y * v.y) + (v.z * v.z + v.w * v.w)) * (1.0f / 256.0f);
        const float r = __builtin_amdgcn_rsqf(var + EPS);
        v = v * r * g4 + b4;
        v.x *= sigmoidf_(v.x); v.y *= sigmoidf_(v.y); v.z *= sigmoidf_(v.z); v.w *= sigmoidf_(v.w);
        *(unsigned long long*)(MIX + (size_t)(m0 + i) * D + 256 + 4 * F.lane) = (unsigned long long)pk2(v.x, v.y) | ((unsigned long long)pk2(v.z, v.w) << 32);
    }
    __syncthreads();
}

#ifndef MK_TS
#define MK_TS 0
#endif
#ifndef MK_TK
#define MK_TK 4
#endif
#define TS_BEGIN(id) long long ts0_##id = 0; if (MK_TS == (id)) { asm volatile("s_waitcnt vmcnt(0) lgkmcnt(0)" ::: "memory"); ts0_##id = clock64(); }
#define TS_END(id) if (MK_TS == (id)) { asm volatile("s_waitcnt vmcnt(0) lgkmcnt(0)" ::: "memory"); const long long t1_ = clock64(), d_ = (t1_ - ts0_##id) * MK_TK; while (clock64() - t1_ < d_) __builtin_amdgcn_s_sleep(1); }
typedef __bf16 bf16v2_t __attribute__((ext_vector_type(2)));
typedef __bf16 bf16v8_t __attribute__((ext_vector_type(8)));
typedef float f32x2_t __attribute__((ext_vector_type(2)));
typedef float f32x8_t __attribute__((ext_vector_type(8)));
__device__ __forceinline__ unsigned cpk2(float lo, float hi) { const f32x2_t v = {lo, hi}; return __builtin_bit_cast(unsigned, __builtin_convertvector(v, bf16v2_t)); }
__device__ __forceinline__ v4u cpk8(float a0, float a1, float a2, float a3, float a4, float a5, float a6, float a7) { const f32x8_t v = {a0, a1, a2, a3, a4, a5, a6, a7}; return __builtin_bit_cast(v4u, __builtin_convertvector(v, bf16v8_t)); }
__device__ __forceinline__ bf16x8 pack_step(const f32x16& x, int s) { return __builtin_bit_cast(bf16x8, cpk8(x[8 * s], x[8 * s + 1], x[8 * s + 2], x[8 * s + 3], x[8 * s + 4], x[8 * s + 5], x[8 * s + 6], x[8 * s + 7])); }

template <int J> __device__ __forceinline__ void dn_load_col(f32x4 (&dst)[4], const LAS float* sAth, const f32x4& tie) {
    if constexpr (J < 63) {
        const LAS float* acol = sAth + J * 64;
        asm volatile("" : "+v"(acol) : "v"(tie.x));
#pragma unroll
        for (int q = (J >> 4); q < 4; ++q) dst[q] = *(const LAS f32x4*)(acol + 16 * q);
    }
}
template <int J> __device__ __forceinline__ void dn_solve_cols2(f32x4 (&au)[4], f32x4 (&aw)[4], const LAS float* sAth, f32x4 (&cur)[4], f32x4 (&nxt)[4]) {
    if constexpr (J < 63) {
        constexpr int GJ = J >> 2, Q0 = GJ >> 2, OWN = GJ & 3, BC = OWN * 0x55;
        f32x4 nn[4];
        dn_load_col<J + 2>(nn, sAth, au[Q0]);
        float mu = au[Q0][J & 3], mw = aw[Q0][J & 3];
        asm volatile("" : "+v"(mu), "+v"(mw));
        const float su = __builtin_bit_cast(float, __builtin_amdgcn_update_dpp(0, __builtin_bit_cast(int, mu), BC, 0xF, 0xF, false));
        const float sw = __builtin_bit_cast(float, __builtin_amdgcn_update_dpp(0, __builtin_bit_cast(int, mw), BC, 0xF, 0xF, false));
        const float nsu = -su, nsw = -sw;
#pragma unroll
        for (int q = Q0; q < 4; ++q) { au[q] = __builtin_elementwise_fma(cur[q], (f32x4){nsu, nsu, nsu, nsu}, au[q]); aw[q] = __builtin_elementwise_fma(cur[q], (f32x4){nsw, nsw, nsw, nsw}, aw[q]); }
        dn_solve_cols2<J + 1>(au, aw, sAth, nxt, nn);
    }
}

template <int J> __device__ __forceinline__ void dn_solve_cols1(f32x4 (&au)[4], const LAS float* sAth, f32x4 (&cur)[4], f32x4 (&nxt)[4]) {
    if constexpr (J < 63) {
        constexpr int GJ = J >> 2, Q0 = GJ >> 2, OWN = GJ & 3, BC = OWN * 0x55;
        f32x4 nn[4];
        dn_load_col<J + 2>(nn, sAth, au[Q0]);
        float mu = au[Q0][J & 3];
        asm volatile("" : "+v"(mu));
        const float su = __builtin_bit_cast(float, __builtin_amdgcn_update_dpp(0, __builtin_bit_cast(int, mu), BC, 0xF, 0xF, false));
        const float nsu = -su;
#pragma unroll
        for (int q = Q0; q < 4; ++q) au[q] = __builtin_elementwise_fma(cur[q], (f32x4){nsu, nsu, nsu, nsu}, au[q]);
        dn_solve_cols1<J + 1>(au, sAth, nxt, nn);
    }
}

__device__ __forceinline__ void dn_load_raw(v4u (&raw)[7], const bf16* P, int cu, int tid) {
    const int b = cu >> 8, h = (cu >> 6) & 3, n = cu & 63, m0 = b * SEQ + n * 64;
    const bf16* pbase = P + 1024 + h * 128;
#pragma unroll
    for (int it = 0; it < 7; ++it) { int item = tid + 512 * it; item = item < 3 * 67 * 16 ? item : 3 * 67 * 16 - 1;
        const int sel = item / (67 * 16), rem = item - sel * (67 * 16), t = rem >> 4, pc = rem & 15;
        const int tr = (n > 0 || t >= 3) ? t : 3;
        raw[it] = *(const v4u*)(pbase + (long)(m0 - 3 + tr) * NP + sel * 512 + pc * 8);
        if (!(n > 0 || t >= 3)) raw[it] = (v4u){0u, 0u, 0u, 0u}; }
}
#define DN_ST16(ptr_, val_) __builtin_amdgcn_raw_buffer_store_b128((val_), rsrc, (int)((const unsigned char*)(ptr_) - recbase), 0, 16)
#define DN_UNIT2CU(v_) ((((v_) & 31) << 6) | ((v_) >> 5))
__device__ __forceinline__ void dn_chunk_units(Frame& F0, int l, int first, int stride, const bf16* P, const float* BA, const int stepmax, unsigned* flags) {
  if (stepmax < 1 || first >= NCHUNK) return;
  v4u rawn[7]; dn_load_raw(rawn, P, DN_UNIT2CU(first), F0.tid);
  const unsigned char* recbase = F0.ws + WS_REC;
  const __amdgpu_buffer_rsrc_t rsrc = __builtin_amdgcn_make_buffer_rsrc((void*)recbase, 0, (int)(NCHUNK * REC_BYTES), 0x00020000);
  for (int vu = first; vu < NCHUNK; vu += stride) {
    const int cu = DN_UNIT2CU(vu);
    Frame F = F0; asm volatile("" : "+v"(F.tid)); F.lane = F.tid & 63; F.wave = __builtin_amdgcn_readfirstlane(F.tid >> 6);
    const int b = cu >> 8, h = (cu >> 6) & 3, n = cu & 63, m0 = b * SEQ + n * 64;
    LAS float* sQ = (LAS float*)F.lds;
    LAS float* sK = (LAS float*)(F.lds + 32768);
    LAS float* sV = (LAS float*)(F.lds + 65536);
    LAS bf16* sQb = (LAS bf16*)(F.lds + 98304);
    LAS bf16* sKb = (LAS bf16*)(F.lds + 115712);
    LAS bf16* sVt = (LAS bf16*)(F.lds + 65536);
    LAS bf16* sKt = (LAS bf16*)(F.lds + 65536 + 16384);
    LAS bf16* sTu = (LAS bf16*)(F.lds + 98304);
    LAS bf16* sTw = (LAS bf16*)(F.lds + 98304 + 9216);
#define DN_CM(row_, j_) ((row_) * 64 + ((((j_) >> 3) ^ ((row_) & 7)) << 3) + ((j_) & 7))
    LAS bf16* sRaw = (LAS bf16*)(F.lds + 98304);
    LAS float* sGam = (LAS float*)(F.lds + 149760);
    LAS float* sBeta = (LAS float*)(F.lds + 150016);
    LAS float* sEg = (LAS float*)(F.lds + 150272);
    LAS float* sEd = (LAS float*)(F.lds + 150528);
    LAS float* sA = (LAS float*)(F.lds + 133120);
    bf16* rec = (bf16*)(F.ws + WS_REC + (size_t)cu * REC_BYTES);
    bf16* Uo = rec + REC_U / 2; float* CD = (float*)((unsigned char*)rec + REC_CD);
    TS_BEGIN(1)
    {
#pragma unroll
        for (int it = 0; it < 7; ++it) { const int item = F.tid + 512 * it; if (item < 3 * 67 * 16) *(LAS v4u*)(sRaw + item * 8) = rawn[it]; }
    }
    {
        const int cn = (vu + stride < NCHUNK) ? DN_UNIT2CU(vu + stride) : cu;
        dn_load_raw(rawn, P, cn, F.tid);
    }
    __syncthreads();
    TS_END(1)
#ifdef MK_X
    if (stepmax == 1) continue;
#endif
    TS_BEGIN(2)
#ifndef MK_Y
#define MK_Y 0
#endif
#ifndef MK_Z
#define MK_Z 0
#endif
    if (F.wave < 6 && !(stepmax == 1 && MK_Z)) {
        const int sel = F.wave >> 1, c = F.tid & 127;
        const int wch = sel * 512 + h * 128 + c;
        const float* cw = F.inp(11) + (size_t)l * DNCONV * 1536 + wch;
        const float w0 = cw[0], w1 = cw[1536], w2 = cw[2 * 1536], w3 = cw[3 * 1536];
        const LAS bf16* xc = sRaw + (sel * 67) * 128 + c;
        float x0 = bf2f(xc[0]), x1 = bf2f(xc[128]), x2 = bf2f(xc[256]);
        LAS float* dst = (sel == 0 ? sQ : sK) + c;
#ifndef MK_DUP
#define MK_DUP 0
#endif
        if (sel < 2) {
#pragma unroll 16
            for (int i = 0; i < 64; ++i) {
                const float x3 = bf2f(xc[(i + 3) * 128]);
                const float y = __builtin_fmaf(w3, x3, __builtin_fmaf(w2, x2, __builtin_fmaf(w1, x1, w0 * x0)));
                dst[i * 128] = y * sigmoidf_(y);
                x0 = x1; x1 = x2; x2 = x3;
            }
        } else {
#pragma unroll 2
            for (int i8 = 0; i8 < 8; ++i8) {
                float yv[8];
#pragma unroll
                for (int e = 0; e < 8; ++e) { const float x3 = bf2f(xc[(8 * i8 + e + 3) * 128]);
                    const float y = __builtin_fmaf(w3, x3, __builtin_fmaf(w2, x2, __builtin_fmaf(w1, x1, w0 * x0)));
                    yv[e] = y * sigmoidf_(y); x0 = x1; x1 = x2; x2 = x3; }
                *(LAS v4u*)(sVt + DN_CM(c, 8 * i8)) = cpk8(yv[0], yv[1], yv[2], yv[3], yv[4], yv[5], yv[6], yv[7]);
            }
        }
    } else if (F.wave == 6) {
        const int i = F.lane;
        const float bl = BA[(size_t)(m0 + i) * 8 + h], al = BA[(size_t)(m0 + i) * 8 + 4 + h];
        const float beta = sigmoidf_(bl);
        const float z = al + F.inp(13)[l * 4 + h];
        const float sp = fmaxf(z, 0.f) + log1pf(expf(-fabsf(z)));
        float la = -expf(F.inp(12)[l * 4 + h]) * sp;
#pragma unroll
        for (int off = 1; off < 64; off <<= 1) { const float t = __shfl_up(la, off); if (i >= off) la += t; }
        const float glast = __shfl(la, 63);
        sGam[i] = la; sBeta[i] = beta; sEg[i] = expf(la); sEd[i] = expf(glast - la);
        if (i == 63) __hip_atomic_store(CD, expf(la), __ATOMIC_RELAXED, __HIP_MEMORY_SCOPE_AGENT);
    }
    __syncthreads();
    TS_END(2)
    TS_BEGIN(3)
    {
        float q0[8], q1[8], k0[8], k1[8], sq[8], sk[8];
#pragma unroll
        for (int rr = 0; rr < 8; ++rr) { const int i = 8 * F.wave + rr;
            q0[rr] = sQ[i * 128 + F.lane]; q1[rr] = sQ[i * 128 + 64 + F.lane]; k0[rr] = sK[i * 128 + F.lane]; k1[rr] = sK[i * 128 + 64 + F.lane];
            sq[rr] = q0[rr] * q0[rr] + q1[rr] * q1[rr]; sk[rr] = k0[rr] * k0[rr] + k1[rr] * k1[rr]; }
#pragma unroll
        for (int rr = 0; rr < 8; ++rr) { sq[rr] = wave_sum(sq[rr]); sk[rr] = wave_sum(sk[rr]); }
#pragma unroll
        for (int rr = 0; rr < 8; ++rr) { const int i = 8 * F.wave + rr;
            const float rq = __builtin_amdgcn_rsqf(sq[rr] + EPS) * 0.08838834764831845f, rk = __builtin_amdgcn_rsqf(sk[rr] + EPS);
            sQ[i * 128 + F.lane] = q0[rr] * rq; sQ[i * 128 + 64 + F.lane] = q1[rr] * rq; sK[i * 128 + F.lane] = k0[rr] * rk; sK[i * 128 + 64 + F.lane] = k1[rr] * rk; }
    }
    __syncthreads();
    TS_END(3)
    TS_BEGIN(4)
    {
        const int i = F.tid >> 3, cb = (F.tid & 7) * 16;
        f32x4 q[4], k[4];
#pragma unroll
        for (int t = 0; t < 4; ++t) { q[t] = *(LAS f32x4*)(sQ + i * 128 + cb + 4 * t); k[t] = *(LAS f32x4*)(sK + i * 128 + cb + 4 * t); }
        *(LAS v4u*)(sQb + i * 136 + cb) = cpk8(q[0].x, q[0].y, q[0].z, q[0].w, q[1].x, q[1].y, q[1].z, q[1].w);
        *(LAS v4u*)(sQb + i * 136 + cb + 8) = cpk8(q[2].x, q[2].y, q[2].z, q[2].w, q[3].x, q[3].y, q[3].z, q[3].w);
        *(LAS v4u*)(sKb + i * 136 + cb) = cpk8(k[0].x, k[0].y, k[0].z, k[0].w, k[1].x, k[1].y, k[1].z, k[1].w);
        *(LAS v4u*)(sKb + i * 136 + cb + 8) = cpk8(k[2].x, k[2].y, k[2].z, k[2].w, k[3].x, k[3].y, k[3].z, k[3].w);
    }
#pragma unroll
    for (int it = 0; it < 2; ++it) {
        const int item = F.tid + 512 * it, dk = item & 127, jb = item >> 7;
        float kv[8];
#pragma unroll
        for (int jj = 0; jj < 8; ++jj) kv[jj] = sK[(8 * jb + jj) * 128 + dk];
        *(LAS v4u*)(sKt + DN_CM(dk, 8 * jb)) = cpk8(kv[0], kv[1], kv[2], kv[3], kv[4], kv[5], kv[6], kv[7]);
    }
    __syncthreads();
    TS_END(4)
    TS_BEGIN(5)
    {
        const int mat = F.wave >> 2, ti = (F.wave >> 1) & 1, tj = F.wave & 1, r = F.lane & 31, hh = F.lane >> 5;
        f32x16 acc;
#pragma unroll
        for (int e = 0; e < 16; ++e) acc[e] = 0.f;
        if (!(ti == 0 && tj == 1)) {
            const LAS bf16* Ab = sKb + (32 * (mat ? tj : ti) + r) * 136 + 8 * hh;
            const LAS bf16* Bb = (mat ? sQb + (32 * ti + r) * 136 : sKb + (32 * tj + r) * 136) + 8 * hh;
#pragma unroll
            for (int s = 0; s < 8; ++s) { const bf16x8 a = *(const LAS bf16x8*)(Ab + 16 * s), bb = *(const LAS bf16x8*)(Bb + 16 * s); acc = MFMA32(a, bb, acc); }
        }
        if (mat == 0) {
            const int j = 32 * tj + r; const float gj = sGam[j];
#pragma unroll
            for (int g = 0; g < 4; ++g) { const int i0 = 32 * ti + 8 * g + 4 * hh; f32x4 o;
#pragma unroll
                for (int q = 0; q < 4; ++q) { const int i = i0 + q; o[q] = (j < i) ? sBeta[i] * acc[4 * g + q] * __expf(sGam[i] - gj) : 0.f; }
                *(LAS f32x4*)(sA + j * 64 + i0) = o; }
        } else {
            const int i = 32 * ti + r; const float gi = sGam[i];
            float v[16];
#pragma unroll
            for (int e = 0; e < 16; ++e) { const int j = 32 * tj + crow(e, hh); v[e] = (j <= i) ? acc[e] * __expf(gi - sGam[j]) : 0.f; }
            bf16* qk = rec + REC_QK / 2 + ((ti * 2 + tj) * 2) * 512 + F.lane * 8;
            DN_ST16(qk, cpk8(v[0], v[1], v[2], v[3], v[4], v[5], v[6], v[7]));
            DN_ST16(qk + 512, cpk8(v[8], v[9], v[10], v[11], v[12], v[13], v[14], v[15]));
        }
    }
    __syncthreads();
    TS_END(5)
    TS_BEGIN(6)
    if (F.wave < 4) {
        const int g = F.tid >> 2, h4 = F.tid & 3;
        f32x4 au[4];
#pragma unroll
        for (int q = 0; q < 4; ++q)
#pragma unroll
            for (int e = 0; e < 4; ++e) au[q][e] = (16 * q + 4 * h4 + e == g) ? 1.0f : 0.0f;
        { f32x4 c0[4], c1[4]; dn_load_col<0>(c0, sA + 4 * h4, au[0]); dn_load_col<1>(c1, sA + 4 * h4, au[0]); dn_solve_cols1<0>(au, sA + 4 * h4, c0, c1); }
        const float bu = sBeta[g], eu = bu * sEg[g];
#pragma unroll
        for (int q = 0; q < 4; ++q)
#pragma unroll
            for (int e = 0; e < 4; ++e) { const int i = 16 * q + 4 * h4 + e;
                sTu[i * 72 + g] = (bf16)(cpk2(au[q][e] * bu, 0.f) & 0xffffu); sTw[i * 72 + g] = (bf16)(cpk2(au[q][e] * eu, 0.f) & 0xffffu); }
    } else {
        for (int item = F.tid - 256; item < 2048; item += 256) {
            const int f = (item >> 6) & 15, ln = item & 63, r = ln & 31, hh = ln >> 5;
            if (item < 1024) {
                const int rt = f >> 3, kt = (f >> 1) & 3, s_ = f & 1, i = 32 * rt + r, d0 = 32 * kt + 16 * s_ + 4 * hh;
                const float eg = sEg[i];
                const f32x4 a = *(LAS f32x4*)(sQ + i * 128 + d0), c = *(LAS f32x4*)(sQ + i * 128 + d0 + 8);
                DN_ST16(rec + REC_QD / 2 + f * 512 + ln * 8, cpk8(a.x * eg, a.y * eg, a.z * eg, a.w * eg, c.x * eg, c.y * eg, c.z * eg, c.w * eg));
            } else {
                const int a = f >> 2, t = (f >> 1) & 1, s_ = f & 1, dk = 32 * a + r, j0 = 32 * t + 16 * s_ + 4 * hh;
                float kv[8];
#pragma unroll
                for (int jj = 0; jj < 8; ++jj) { const int j = j0 + 8 * (jj >> 2) + (jj & 3); kv[jj] = sK[j * 128 + dk] * sEd[j]; }
                DN_ST16(rec + REC_KDT / 2 + f * 512 + ln * 8, cpk8(kv[0], kv[1], kv[2], kv[3], kv[4], kv[5], kv[6], kv[7]));
            }
        }
    }
    __syncthreads();
    TS_END(6)
    TS_BEGIN(7)
    {
        const int r = F.lane & 31, hh = F.lane >> 5;
        {
            const int t = F.wave & 1, wv = F.wave >> 1;
            f32x16 acc;
#pragma unroll
            for (int e = 0; e < 16; ++e) acc[e] = 0.f;
#pragma unroll
            for (int ks = 0; ks < 4; ++ks) { const bf16x8 a = *(const LAS bf16x8*)(sTu + (32 * t + r) * 72 + 16 * ks + 8 * hh), bb = *(const LAS bf16x8*)(sVt + DN_CM(32 * wv + r, 16 * ks + 8 * hh)); acc = MFMA32(a, bb, acc); }
            bf16* up = Uo + (wv * 2 + t) * 1024 + F.lane * 8;
            DN_ST16(up, cpk8(acc[0], acc[1], acc[2], acc[3], acc[4], acc[5], acc[6], acc[7])); DN_ST16(up + 512, cpk8(acc[8], acc[9], acc[10], acc[11], acc[12], acc[13], acc[14], acc[15]));
        }
        {
            const int a = F.wave >> 1, ti = F.wave & 1;
            f32x16 acc;
#pragma unroll
            for (int e = 0; e < 16; ++e) acc[e] = 0.f;
#pragma unroll
            for (int ks = 0; ks < 4; ++ks) { const bf16x8 ka = *(const LAS bf16x8*)(sKt + DN_CM(32 * a + r, 16 * ks + 8 * hh)), tb = *(const LAS bf16x8*)(sTw + (32 * ti + r) * 72 + 16 * ks + 8 * hh); acc = MFMA32(ka, tb, acc); }
            bf16* wp = rec + REC_W / 2 + ((ti * 4 + a) * 2) * 512 + F.lane * 8;
            DN_ST16(wp, cpk8(acc[0], acc[1], acc[2], acc[3], acc[4], acc[5], acc[6], acc[7])); DN_ST16(wp + 512, cpk8(acc[8], acc[9], acc[10], acc[11], acc[12], acc[13], acc[14], acc[15]));
        }
    }
    asm volatile("s_waitcnt vmcnt(0)" ::: "memory");
    __syncthreads();
    if (F.tid == 0) __hip_atomic_store(flags + cu, 1u, __ATOMIC_RELAXED, __HIP_MEMORY_SCOPE_AGENT);
    TS_END(7)
  }
}

#define DN_BAR() do { asm volatile("s_waitcnt lgkmcnt(0)" ::: "memory"); __builtin_amdgcn_s_barrier(); asm volatile("" ::: "memory"); } while (0)
__device__ __forceinline__ void dn_scan(Frame& F, int l, int bh, unsigned* flags) {
    LAS unsigned char* ring = F.lds;
    const unsigned char* recs = F.ws + WS_REC + (size_t)(bh * 64) * REC_BYTES;
    if (F.wave >= 4) {
        const int v = F.wave - 4;
#define DN_DMA(n_) do { const unsigned char* src_ = recs + (size_t)(n_) * REC_BYTES + v * 1024 + F.lane * 16; LAS unsigned char* dst_ = ring + ((n_) & 1) * (int)REC_BYTES + v * 1024; \
        _Pragma("unroll") for (int q_ = 0; q_ < 19; ++q_) if (v + 4 * q_ < 73) __builtin_amdgcn_global_load_lds((const unsigned*)(src_ + q_ * 4096), (LAS unsigned*)(dst_ + q_ * 4096), 16, 0, 16  ); } while (0)
#define DN_WAITREC(n_) do { unsigned sp_ = 0; while (__builtin_amdgcn_readfirstlane(__hip_atomic_load(flags + bh * 64 + (n_), __ATOMIC_RELAXED, __HIP_MEMORY_SCOPE_AGENT)) == 0u) { \
            __builtin_amdgcn_s_sleep(2); if (++sp_ > (1u << 21)) break; } asm volatile("" ::: "memory"); } while (0)
        DN_WAITREC(0); DN_DMA(0);
        asm volatile("s_waitcnt vmcnt(0)" ::: "memory");
        DN_BAR();
        for (int n = 0; n < 64; ++n) {
            if (n + 1 < 64) { DN_WAITREC(n + 1); DN_DMA(n + 1); }
            asm volatile("s_waitcnt vmcnt(0)" ::: "memory");
            DN_BAR();
        }
#undef DN_DMA
#undef DN_WAITREC
    } else {
        const int w = F.wave;
        f32x16 S0, S1, S2, S3;
#pragma unroll
        for (int e = 0; e < 16; ++e) { S0[e] = 0.f; S1[e] = 0.f; S2[e] = 0.f; S3[e] = 0.f; }
        bf16* Ob = (bf16*)(F.ws + WS_O) + (size_t)(bh * 64) * 8192 + (w * 2) * 1024 + F.lane * 8;
        DN_BAR();
        for (int n = 0; n < 64; ++n) {
            const LAS unsigned char* buf = ring + (n & 1) * (int)REC_BYTES + F.lane * 16;
            const float cd = *(const LAS float*)(ring + (n & 1) * (int)REC_BYTES + REC_CD);
#define DN_A(off_, f_) (*(const LAS bf16x8*)(buf + (off_) + (f_) * 1024))
#define DN_FENCE() __builtin_amdgcn_sched_barrier(0)
            f32x16 W0, W1, Q0, Q1;
#pragma unroll
            for (int e = 0; e < 16; ++e) { W0[e] = 0.f; W1[e] = 0.f; Q0[e] = 0.f; Q1[e] = 0.f; }
            const v4u u00 = *(const LAS v4u*)(buf + REC_U + (w * 2 + 0) * 2048), u01 = *(const LAS v4u*)(buf + REC_U + (w * 2 + 0) * 2048 + 1024);
            const v4u u10 = *(const LAS v4u*)(buf + REC_U + (w * 2 + 1) * 2048), u11 = *(const LAS v4u*)(buf + REC_U + (w * 2 + 1) * 2048 + 1024);
            bf16x8 fa0, fa1, fa2, fa3, fb0, fb1, fb2, fb3;
#define DN_LDK(d0, d1, d2, d3, a_, s_) do { d0 = DN_A(REC_W, (0 * 4 + (a_)) * 2 + (s_)); d1 = DN_A(REC_W, (1 * 4 + (a_)) * 2 + (s_)); d2 = DN_A(REC_QD, (0 * 4 + (a_)) * 2 + (s_)); d3 = DN_A(REC_QD, (1 * 4 + (a_)) * 2 + (s_)); } while (0)
#define DN_MMK(d0, d1, d2, d3, Sa_, s_) do { const bf16x8 sb_ = pack_step(Sa_, s_); W0 = MFMA32(d0, sb_, W0); W1 = MFMA32(d1, sb_, W1); Q0 = MFMA32(d2, sb_, Q0); Q1 = MFMA32(d3, sb_, Q1); } while (0)
            DN_LDK(fa0, fa1, fa2, fa3, 0, 0); DN_FENCE();
            DN_LDK(fb0, fb1, fb2, fb3, 0, 1); DN_FENCE(); DN_MMK(fa0, fa1, fa2, fa3, S0, 0); DN_FENCE();
            DN_LDK(fa0, fa1, fa2, fa3, 1, 0); DN_FENCE(); DN_MMK(fb0, fb1, fb2, fb3, S0, 1); DN_FENCE();
            DN_LDK(fb0, fb1, fb2, fb3, 1, 1); DN_FENCE(); DN_MMK(fa0, fa1, fa2, fa3, S1, 0); DN_FENCE();
            DN_LDK(fa0, fa1, fa2, fa3, 2, 0); DN_FENCE(); DN_MMK(fb0, fb1, fb2, fb3, S1, 1); DN_FENCE();
            DN_LDK(fb0, fb1, fb2, fb3, 2, 1); DN_FENCE(); DN_MMK(fa0, fa1, fa2, fa3, S2, 0); DN_FENCE();
            DN_LDK(fa0, fa1, fa2, fa3, 3, 0); DN_FENCE(); DN_MMK(fb0, fb1, fb2, fb3, S2, 1); DN_FENCE();
            DN_LDK(fb0, fb1, fb2, fb3, 3, 1); DN_FENCE(); DN_MMK(fa0, fa1, fa2, fa3, S3, 0); DN_FENCE();
            fa0 = DN_A(REC_QK, (0 * 2 + 0) * 2 + 0); fa1 = DN_A(REC_QK, (0 * 2 + 0) * 2 + 1); fa2 = DN_A(REC_QK, (0 * 2 + 1) * 2 + 0); fa3 = DN_A(REC_QK, (0 * 2 + 1) * 2 + 1); DN_FENCE();
            DN_MMK(fb0, fb1, fb2, fb3, S3, 1); DN_FENCE();
#undef DN_LDK
#undef DN_MMK
            {
                const unsigned uu0[8] = {u00.x, u00.y, u00.z, u00.w, u01.x, u01.y, u01.z, u01.w}, uu1[8] = {u10.x, u10.y, u10.z, u10.w, u11.x, u11.y, u11.z, u11.w};
#pragma unroll
                for (int e = 0; e < 16; ++e) { const unsigned a0 = uu0[e >> 1], a1 = uu1[e >> 1];
                    W0[e] = ((e & 1) ? __uint_as_float(a0 & 0xffff0000u) : __uint_as_float(a0 << 16)) - W0[e];
                    W1[e] = ((e & 1) ? __uint_as_float(a1 & 0xffff0000u) : __uint_as_float(a1 << 16)) - W1[e]; }
            }
            const bf16x8 ub00 = pack_step(W0, 0), ub01 = pack_step(W0, 1), ub10 = pack_step(W1, 0), ub11 = pack_step(W1, 1);
            DN_FENCE();
            fb0 = DN_A(REC_QK, (1 * 2 + 0) * 2 + 0); fb1 = DN_A(REC_QK, (1 * 2 + 0) * 2 + 1); fb2 = DN_A(REC_QK, (1 * 2 + 1) * 2 + 0); fb3 = DN_A(REC_QK, (1 * 2 + 1) * 2 + 1); DN_FENCE();
            Q0 = MFMA32(fa0, ub00, Q0); Q0 = MFMA32(fa1, ub01, Q0); Q0 = MFMA32(fa2, ub10, Q0); Q0 = MFMA32(fa3, ub11, Q0); DN_FENCE();
#define DN_LDS_(d0, d1, d2, d3, a_) do { d0 = DN_A(REC_KDT, ((a_) * 2 + 0) * 2 + 0); d1 = DN_A(REC_KDT, ((a_) * 2 + 0) * 2 + 1); d2 = DN_A(REC_KDT, ((a_) * 2 + 1) * 2 + 0); d3 = DN_A(REC_KDT, ((a_) * 2 + 1) * 2 + 1); } while (0)
#define DN_SUPD(Sa_, d0, d1, d2, d3) do { Sa_ = MFMA32(d0, ub00, Sa_); Sa_ = MFMA32(d1, ub01, Sa_); Sa_ = MFMA32(d2, ub10, Sa_); Sa_ = MFMA32(d3, ub11, Sa_); } while (0)
            DN_LDS_(fa0, fa1, fa2, fa3, 0); DN_FENCE();
            Q1 = MFMA32(fb0, ub00, Q1); Q1 = MFMA32(fb1, ub01, Q1); Q1 = MFMA32(fb2, ub10, Q1); Q1 = MFMA32(fb3, ub11, Q1); DN_FENCE();
            S0 = S0 * cd; S1 = S1 * cd; S2 = S2 * cd; S3 = S3 * cd;
            DN_LDS_(fb0, fb1, fb2, fb3, 1); DN_FENCE(); DN_SUPD(S0, fa0, fa1, fa2, fa3); DN_FENCE();
            DN_LDS_(fa0, fa1, fa2, fa3, 2); DN_FENCE(); DN_SUPD(S1, fb0, fb1, fb2, fb3); DN_FENCE();
            DN_LDS_(fb0, fb1, fb2, fb3, 3); DN_FENCE(); DN_SUPD(S2, fa0, fa1, fa2, fa3); DN_FENCE();
            DN_SUPD(S3, fb0, fb1, fb2, fb3); DN_FENCE();
#undef DN_LDS_
#undef DN_SUPD
#undef DN_A
#undef DN_FENCE
            bf16* op = Ob + (size_t)n * 8192;
            *(v4u*)op = cpk8(Q0[0], Q0[1], Q0[2], Q0[3], Q0[4], Q0[5], Q0[6], Q0[7]); *(v4u*)(op + 512) = cpk8(Q0[8], Q0[9], Q0[10], Q0[11], Q0[12], Q0[13], Q0[14], Q0[15]);
            *(v4u*)(op + 1024) = cpk8(Q1[0], Q1[1], Q1[2], Q1[3], Q1[4], Q1[5], Q1[6], Q1[7]); *(v4u*)(op + 1536) = cpk8(Q1[8], Q1[9], Q1[10], Q1[11], Q1[12], Q1[13], Q1[14], Q1[15]);
            DN_BAR();
        }
    }
}
#undef DN_BAR

__device__ __forceinline__ void dn_finish_unit(Frame& F, int l, int cu, const bf16* P, bf16* MIX) {
    const int b = cu >> 8, h = (cu >> 6) & 3, n = cu & 63, m0 = b * SEQ + n * 64;
    LAS float* sO = (LAS float*)F.lds;
    {
        const int wt = F.wave, w = wt >> 1, t = wt & 1, r = F.lane & 31, hh = F.lane >> 5;
        const bf16* ip = (const bf16*)(F.ws + WS_O) + (size_t)cu * 8192 + wt * 1024 + F.lane * 8;
        const v4u a = *(const v4u*)ip, c = *(const v4u*)(ip + 512);
        const unsigned uu[8] = {a.x, a.y, a.z, a.w, c.x, c.y, c.z, c.w};
#pragma unroll
        for (int e = 0; e < 16; ++e) { const unsigned x = uu[e >> 1]; sO[(32 * t + crow(e, hh)) * 132 + 32 * w + r] = (e & 1) ? __uint_as_float(x & 0xffff0000u) : __uint_as_float(x << 16); }
    }
    __syncthreads();
    const float ng0 = F.inp(14)[l * 128 + 2 * F.lane], ng1 = F.inp(14)[l * 128 + 2 * F.lane + 1];
#pragma unroll
    for (int rr = 0; rr < 8; ++rr) {
        const int i = 8 * F.wave + rr;
        const f32x2_t o = *(const LAS f32x2_t*)(sO + i * 132 + 2 * F.lane);
        const unsigned g = *((const unsigned*)(P + (size_t)(m0 + i) * NP + 2560 + h * 128) + F.lane);
        const float rs = __builtin_amdgcn_rsqf(wave_sum(o.x * o.x + o.y * o.y) * (1.0f / 128.0f) + EPS);
        const float g0 = __uint_as_float(g << 16), g1 = __uint_as_float(g & 0xffff0000u);
        *((unsigned*)(MIX + (size_t)(m0 + i) * D + 512 + h * 128) + F.lane) = cpk2(o.x * rs * ng0 * (g0 * sigmoidf_(g0)), o.y * rs * ng1 * (g1 * sigmoidf_(g1)));
    }
    __syncthreads();
}
struct Args { const float* in[21]; float* out; unsigned char* ws; int ph_lo, ph_hi; };
constexpr int PH_PER_LAYER = 8, N_PHASES = 1 + PH_PER_LAYER * DEPTH;

#define RELAUNDER(Fx) do { asm volatile("" : "+v"((Fx).tid)); (Fx).lane = (Fx).tid & 63; (Fx).wave = __builtin_amdgcn_readfirstlane((Fx).tid >> 6); } while (0)
__device__ __forceinline__ void gemm_stagger(int us) {
    if (us > 0 && (blockIdx.x & 4)) { const unsigned long long t0 = __builtin_amdgcn_s_memrealtime(); while (__builtin_amdgcn_s_memrealtime() - t0 < (unsigned long long)us * 100ull) __builtin_amdgcn_s_sleep(8); }
}
__global__ void __launch_bounds__(NWAVES * 64, 2) mk_fwd(Args args) {
    extern __shared__ __attribute__((aligned(16))) unsigned char lds[];
    {
        volatile LAS unsigned* MISC0 = (volatile LAS unsigned*)((LAS unsigned char*)lds + MISC_OFF);
        if (threadIdx.x < 32) MISC0[threadIdx.x] = 0u;
    }
    __syncthreads();
    const int lo = args.ph_lo, hi = args.ph_hi;
    XcdBarrier bar; bar.bar = (unsigned*)(args.ws + WS_CTL) + CW_BAR; bar.x = 0; bar.st = nullptr;
    if (hi - lo > 1) bar = xcd_barrier_post((unsigned*)(args.ws + WS_CTL) + CW_BAR, (volatile LAS unsigned*)((LAS unsigned char*)lds + MISC_OFF) + 8);

    for (int ph = lo; ph < hi; ++ph) {
      for (int rep = 0; rep < 2; ++rep) {
        if (rep == 1 && !((ph > 0 && ((MK_REP >> ((ph - 1) % PH_PER_LAYER)) & 1) && !(((ph - 1) % PH_PER_LAYER) == 7 && ph > PH_PER_LAYER)) || (ph == 0 && (MK_REP & 512)))) break;
        int tid = threadIdx.x; asm volatile("" : "+v"(tid));
        Frame F;
        F.kp = (const AS4 unsigned char*)__builtin_amdgcn_kernarg_segment_ptr(); asm volatile("" : "+s"(F.kp));
        F.lds = (LAS unsigned char*)lds;
        F.tid = tid; F.lane = tid & 63; F.wave = __builtin_amdgcn_readfirstlane(tid >> 6);
        F.G = gridDim.x; { const int bx = blockIdx.x; F.vcu = (F.G % 8 == 0) ? (bx % 8) * (F.G / 8) + bx / 8 : bx; }
        F.out = *(float* const AS4*)(F.kp + 168); F.ws = *(unsigned char* const AS4*)(F.kp + 176);
        bf16* HN = (bf16*)(F.ws + WS_HN); bf16* MIX = HN; bf16* P = (bf16*)(F.ws + WS_P); bf16* HFF = P;
        float* BA = (float*)(F.ws + WS_BA);
        if (ph == 0) {
            weights_phase(F);
            norm_phase<0>(F, F.inp(0), F.inp(1), HN, F.inp(2), BA, nullptr);
        } else {
#ifdef MK_ONLY_K
            const int l = (ph - 1) / PH_PER_LAYER, k = MK_ONLY_K;
#else
            const int l = (ph - 1) / PH_PER_LAYER, k = (ph - 1) % PH_PER_LAYER;
#endif
            const unsigned char* wb = F.ws + WS_W + (size_t)l * W_LAYER;
            if (k == 0) {
                pg8::Gemm g{(const pg8::bf16_t*)HN, (const pg8::bf16_t*)(wb + W_IN_OFF), M, NP, D}; pg8::StaticOrder S; S.init(M, NP, F.G, (int)blockIdx.x);
                pg8::EpiBf16FL E{(pg8::bf16_t*)P, NP, rep ? MK_NOSTORE : 0};
                pg8::gemm_phase<pg8::EpiBf16FL, pg8::StaticOrder, true, true>(F.lds, g, S, E, tid);
            } else if (k == 1) {
                unsigned* flags = (unsigned*)(F.ws + WS_CTL) + CW_FLAGS + l * NCHUNK;
                const int sub = rep ? MK_REPSUB : MK_SUB;
                if ((int)blockIdx.x < BATCH * 4) { if (sub & 1) dn_scan(F, l, (int)blockIdx.x, flags); }
                else {
                    if (sub & 1) dn_chunk_units(F, l, (int)blockIdx.x - BATCH * 4, F.G - BATCH * 4, P, BA, 9, flags);
                    const int gq = (int)blockIdx.x - BATCH * 4, nq = F.G - BATCH * 4, extra = NCHUNK - (NCHUNK / nq) * nq;
                    if ((sub & 2) && gq >= extra) for (int v = gq - extra; v < M / 128 + M / 64; v += nq - extra) { Frame Fu = F; RELAUNDER(Fu);
                        if (v < M / 128) gmlp_unit(Fu, l, v, P, MIX); else conv_unit(Fu, l, v - M / 128, P, MIX); }
                }
            } else if (k == 2) {
                for (int u = blockIdx.x; u < NCHUNK; u += F.G) { Frame Fu = F; RELAUNDER(Fu); dn_finish_unit(Fu, l, u, P, MIX); }
            } else if (k == 3 || k == 6) {
                const float* base = (l == 0 && k == 3) ? F.inp(0) : F.out;
                pg8::Gemm g{(const pg8::bf16_t*)(k == 3 ? MIX : HFF), (const pg8::bf16_t*)(wb + (k == 3 ? W_O_OFF : W_D_OFF)), M, D, k == 3 ? D : DFF}; pg8::StaticOrder S; S.init(M, D, F.G, (int)blockIdx.x);
                gemm_stagger(k == 3 ? MK_STAG_O : MK_STAG_D);
                pg8::EpiRes E{base, rep ? (float*)(F.ws + WS_REC) : F.out, D, rep ? MK_NOREAD : 0};
                pg8::gemm_phase<pg8::EpiRes, pg8::StaticOrder, true, true>(F.lds, g, S, E, tid);
            } else if (k == 4) {
                norm_phase<0>(F, F.out, F.inp(16) + l * D, HN, nullptr, nullptr, nullptr);
            } else if (k == 5) {
                pg8::Gemm g{(const pg8::bf16_t*)HN, (const pg8::bf16_t*)(wb + W_GU_OFF), M, 2 * DFF, D}; pg8::StaticOrder S; S.init(M, 2 * DFF, F.G, (int)blockIdx.x);
                pg8::EpiSwiGLU E{(pg8::bf16_t*)HFF, DFF};
                gemm_stagger(MK_STAG_GU);
                pg8::gemm_phase<pg8::EpiSwiGLU, pg8::StaticOrder, true, true>(F.lds, g, S, E, tid);
            } else {
                if (l + 1 < DEPTH) norm_phase<0>(F, F.out, F.inp(1) + (l + 1) * D, HN, F.inp(2) + (size_t)(l + 1) * D * DPROJ, BA, nullptr);
                else norm_phase<1>(F, F.out, F.inp(20), nullptr, nullptr, nullptr, F.out);
            }
        }
      }
        if (ph + 1 < hi) { xcd_barrier(bar); for (int xb = 0; xb < MK_XBAR; ++xb) xcd_barrier(bar); }
    }
}

#ifndef MK_SINGLE
#define MK_SINGLE 0
#endif

extern "C" void kernel_launch(void* const* d_in, const int* in_sizes, int n_in, void* d_out, int out_size, void* d_ws, size_t ws_size, hipStream_t stream) {
    static int grid = 0;
    if (grid == 0) {
        if (n_in != 21 || in_sizes[0] != M * D || out_size != M * D || ws_size < WS_END) { fprintf(stderr, "kernel_launch: unexpected shapes (n_in %d, in0 %d, out %d, ws %zu)\n", n_in, n_in > 0 ? in_sizes[0] : -1, out_size, ws_size); grid = -1; return; }
        int dev = 0, cus = 0, per_cu = 0;
        if (hipGetDevice(&dev) != hipSuccess || hipDeviceGetAttribute(&cus, hipDeviceAttributeMultiprocessorCount, dev) != hipSuccess) { grid = -1; return; }
        if (hipFuncSetAttribute((const void*)mk_fwd, hipFuncAttributeMaxDynamicSharedMemorySize, LDS_BYTES) != hipSuccess) { fprintf(stderr, "kernel_launch: hipFuncSetAttribute failed\n"); grid = -1; return; }
        if (hipOccupancyMaxActiveBlocksPerMultiprocessor(&per_cu, (const void*)mk_fwd, NWAVES * 64, LDS_BYTES) != hipSuccess || per_cu < 1) { fprintf(stderr, "kernel_launch: occupancy query says %d blocks per CU\n", per_cu); per_cu = 1; }
        (void)hipGetLastError();
        grid = cus;
        if (grid % 8 != 0 || grid < 32) fprintf(stderr, "kernel_launch: unexpected CU count %d\n", grid);
    }
    if (grid < 0) return;
    (void)hipMemsetAsync((char*)d_ws + WS_CTL, 0, CTL_ZERO_BYTES, stream);
    Args a{};
    for (int i = 0; i < 21; ++i) a.in[i] = (const float*)d_in[i];
    a.out = (float*)d_out; a.ws = (unsigned char*)d_ws;
#if MK_SINGLE
    a.ph_lo = 0; a.ph_hi = N_PHASES;
    hipLaunchKernelGGL(mk_fwd, dim3(grid), dim3(NWAVES * 64), LDS_BYTES, stream, a);
#else
    for (int ph = 0; ph < MK_PH_HI; ++ph) { a.ph_lo = ph; a.ph_hi = ph + 1; hipLaunchKernelGGL(mk_fwd, dim3(grid), dim3(NWAVES * 64), LDS_BYTES, stream, a); }
#endif
}
```

```cpp
#include <hip/hip_runtime.h>
#include <cstdio>
#include <cstdint>
#include <cmath>
#define MK_SINGLE 1
namespace pg8 {
#define PG8_LAS __attribute__((address_space(3)))
typedef unsigned short bf16_t;
typedef short bf16x8 __attribute__((ext_vector_type(8)));
typedef float f32x4 __attribute__((ext_vector_type(4)));
typedef unsigned u32x4 __attribute__((ext_vector_type(4)));
constexpr int BM = 256, BK = 64, HALF = 128, HTB = HALF * BK * 2  , STAGE_BYTES = 8 * HTB, NXCD = 8, WGM = 8;

__host__ __device__ __forceinline__ int lds_byte(int r, int c) { const int st = (r >> 4) * 2 + (c >> 5), rr = r & 15, cc = c & 31, ob = rr * 64 + cc * 2; return st * 1024 + (ob ^ (((ob >> 9) & 1) << 5)); }
__host__ __device__ __forceinline__ void stage_rc(int b, int& R, int& C) { const int st = b / 1024, sb = b % 1024, swz = sb ^ (((sb >> 9) & 1) << 5); R = (st >> 1) * 16 + swz / 64; C = (st & 1) * 32 + (swz % 64) / 2; }
__host__ __device__ __forceinline__ int perm32(int rho) { const int n = rho >> 4, i = rho & 15; return 8 * (i >> 2) + 4 * n + (i & 3); }

struct Unit { int pm, pn; };
struct Gemm { const bf16_t* A; const bf16_t* Bt; int M, N, K; };

struct StaticOrder {
    int nM, nN, nwg, G, c;
    __host__ __device__ void init(int M, int N, int G_, int c_) { nM = M / BM; nN = N / BM; nwg = nM * nN; G = G_; c = c_; }
    __host__ __device__ bool next(int i, Unit& u) const {
        const long L = (long)i * G + c; if (L >= nwg) return false;
        int wgid = (int)L; { const int q = nwg / NXCD, r = nwg % NXCD, xcd = wgid % NXCD, off = wgid / NXCD; wgid = (xcd < r ? xcd * (q + 1) : r * (q + 1) + (xcd - r) * q) + off; }
        const int nig = WGM * nN, gid = wgid / nig, fm = gid * WGM, gsz = (nM - fm) < WGM ? (nM - fm) : WGM;
        u.pm = fm + ((wgid % nig) % gsz); u.pn = (wgid % nig) / gsz; return true;
    }
    __device__ __forceinline__ void a_ready(const Unit&) const {}
    __device__ __forceinline__ void done(const Unit&) const {}
};

typedef __bf16 bf16v2p __attribute__((ext_vector_type(2))); typedef float f32v2p __attribute__((ext_vector_type(2)));
__device__ __forceinline__ unsigned cvt_pk_bf16(float lo, float hi) { const f32v2p v = {lo, hi}; return __builtin_bit_cast(unsigned, __builtin_convertvector(v, bf16v2p)); }
typedef float f32x2 __attribute__((ext_vector_type(2)));
__device__ __forceinline__ f32x2 gelu_pk(f32x2 v) {
    const f32x2 av = __builtin_elementwise_abs(v), d = av * 0.2316418882f + 1.0f;
    f32x2 t; t.x = __builtin_amdgcn_rcpf(d.x); t.y = __builtin_amdgcn_rcpf(d.y);
    f32x2 q = t * 0.5307027145f + (-0.7265760135f); q = q * t + 0.7107068705f; q = q * t + (-0.142248368f); q = q * t + 0.127414796f; q = q * t;
    const f32x2 s = (v * v) * (-0.72134752044f);
    f32x2 e; e.x = __builtin_amdgcn_exp2f(s.x); e.y = __builtin_amdgcn_exp2f(s.y);
    const f32x2 m = v * (q * e), r = v - m;
    f32x2 o; o.x = v.x < 0.f ? m.x : r.x; o.y = v.y < 0.f ? m.y : r.y; return o;
}

template <int ACT  > struct EpiBf16 {
    static constexpr bool PERM = true, AFTER_DRAIN = false; static_assert(ACT == 0 || ACT == 1, "EpiBf16: ACT is 0 (none) or 1 (gelu_pk)");
    bf16_t* O; int ldc; const float* bias; int split_cols; size_t split_stride; float scale0;
    __device__ __forceinline__ void operator()(const f32x4 (&acc)[2][2][4][2], const Unit& u, int wr, int wc, int fr, int fq) const {
        const int row0 = u.pm * BM + wr * 64 + fr; int colt = u.pn * BM; bf16_t* base = O;
        float sc = 1.f; if (split_cols) { const int t = colt / split_cols; base += (size_t)t * split_stride; colt -= t * split_cols; if (t == 0) sc = scale0; }
        const int col0 = colt + wc * 32 + 8 * fq, bcol0 = u.pn * BM + wc * 32 + 8 * fq;
        f32x4 bv[2][2];
#pragma unroll
        for (int bj = 0; bj < 2; ++bj)
#pragma unroll
            for (int n = 0; n < 2; ++n) bv[bj][n] = bias ? *(const f32x4*)(bias + bcol0 + bj * HALF + 4 * n) : (f32x4){0.f, 0.f, 0.f, 0.f};
#pragma unroll
        for (int ai = 0; ai < 2; ++ai)
#pragma unroll
            for (int m = 0; m < 4; ++m) { bf16_t* rowp = base + (size_t)(row0 + ai * HALF + m * 16) * ldc + col0;
#pragma unroll
                for (int bj = 0; bj < 2; ++bj) { f32x4 v0 = acc[ai][bj][m][0] + bv[bj][0], v1 = acc[ai][bj][m][1] + bv[bj][1];
                    if (ACT == 1) { f32x2 a = gelu_pk((f32x2){v0[0], v0[1]}), b = gelu_pk((f32x2){v0[2], v0[3]}), c = gelu_pk((f32x2){v1[0], v1[1]}), d = gelu_pk((f32x2){v1[2], v1[3]});
                        v0 = (f32x4){a.x, a.y, b.x, b.y}; v1 = (f32x4){c.x, c.y, d.x, d.y}; }
                    v0 = v0 * sc; v1 = v1 * sc; u32x4 w; w.x = cvt_pk_bf16(v0[0], v0[1]); w.y = cvt_pk_bf16(v0[2], v0[3]); w.z = cvt_pk_bf16(v1[0], v1[1]); w.w = cvt_pk_bf16(v1[2], v1[3]);
                    *(u32x4*)(rowp + bj * HALF) = w; } }
    }
};
struct EpiRes {
    static constexpr bool PERM = false, AFTER_DRAIN = false;
    const float* base; float* out; int ldc; int noread;
    __device__ __forceinline__ void operator()(const f32x4 (&acc)[2][2][4][2], const Unit& u, int wr, int wc, int fr, int fq) const {
        const bool hi = fr >= 8;
        const int row0 = u.pm * BM + wr * 64 + (fr & 7), col0 = u.pn * BM + wc * 32 + 4 * fq + (hi ? 16 : 0);
#pragma unroll
        for (int ai = 0; ai < 2; ++ai) {
            f32x4 bA[4][2], bB[4][2];
#pragma unroll
            for (int m = 0; m < 4; ++m)
#pragma unroll
                for (int bj = 0; bj < 2; ++bj) { const size_t oA = (size_t)(row0 + ai * HALF + m * 16) * ldc + col0 + bj * HALF, oB = oA + (size_t)8 * ldc;
                    bA[m][bj] = (f32x4){0.f, 0.f, 0.f, 0.f}; bB[m][bj] = bA[m][bj]; if (!noread) { bA[m][bj] = *(const f32x4*)(base + oA); bB[m][bj] = *(const f32x4*)(base + oB); } }
            asm volatile("" ::: "memory");
#pragma unroll
            for (int m = 0; m < 4; ++m)
#pragma unroll
                for (int bj = 0; bj < 2; ++bj) { const size_t oA = (size_t)(row0 + ai * HALF + m * 16) * ldc + col0 + bj * HALF, oB = oA + (size_t)8 * ldc;
                    const f32x4 v0 = acc[ai][bj][m][0], v1 = acc[ai][bj][m][1];
                    f32x4 dA, dB;
#define EPI_XCH(e_) { const float s_ = hi ? v0[e_] : v1[e_]; const float r_ = __builtin_bit_cast(float, __builtin_amdgcn_update_dpp(0, __builtin_bit_cast(int, s_), 0x128  , 0xF, 0xF, false)); \
                        dA[e_] = hi ? r_ : v0[e_]; dB[e_] = hi ? v1[e_] : r_; }
                    EPI_XCH(0) EPI_XCH(1) EPI_XCH(2) EPI_XCH(3)
#undef EPI_XCH
                    *(f32x4*)(out + oA) = bA[m][bj] + dA; *(f32x4*)(out + oB) = bB[m][bj] + dB; }
            asm volatile("" ::: "memory");
        }
    }
};
struct EpiSwiGLU {
    static constexpr bool PERM = true, AFTER_DRAIN = false;
    bf16_t* O; int ldo;
    __device__ __forceinline__ void operator()(const f32x4 (&acc)[2][2][4][2], const Unit& u, int wr, int wc, int fr, int fq) const {
        const int row0 = u.pm * BM + wr * 64 + fr, col0 = u.pn * HALF + wc * 32 + 8 * fq;
#pragma unroll
        for (int ai = 0; ai < 2; ++ai)
#pragma unroll
            for (int m = 0; m < 4; ++m) { bf16_t* rowp = O + (size_t)(row0 + ai * HALF + m * 16) * ldo + col0;
                float r[8];
#pragma unroll
                for (int n = 0; n < 2; ++n)
#pragma unroll
                    for (int e = 0; e < 4; ++e) { const float g = acc[ai][0][m][n][e], up = acc[ai][1][m][n][e]; r[4 * n + e] = g * __builtin_amdgcn_rcpf(1.0f + __expf(-g)) * up; }
                u32x4 w; w.x = cvt_pk_bf16(r[0], r[1]); w.y = cvt_pk_bf16(r[2], r[3]); w.z = cvt_pk_bf16(r[4], r[5]); w.w = cvt_pk_bf16(r[6], r[7]);
                *(u32x4*)rowp = w; }
    }
};
struct EpiBf16FL {
    static constexpr bool PERM = true, AFTER_DRAIN = false;
    bf16_t* O; int ldc; int nostore;
    __device__ __forceinline__ void operator()(const f32x4 (&acc)[2][2][4][2], const Unit& u, int wr, int wc, int fr, int fq) const {
        const bool hi = fr >= 8;
        const int row0 = u.pm * BM + wr * 64 + (fr & 7), col0 = u.pn * BM + wc * 64 + 8 * fq + (hi ? 32 : 0);
#pragma unroll
        for (int ai = 0; ai < 2; ++ai)
#pragma unroll
            for (int m = 0; m < 4; ++m) { bf16_t* rowp = O + (size_t)(row0 + ai * HALF + m * 16) * ldc + col0;
                unsigned w0[4], w1[4], dA[4], dB[4];
#pragma unroll
                for (int q = 0; q < 2; ++q) { w0[2 * q] = cvt_pk_bf16(acc[ai][0][m][q][0], acc[ai][0][m][q][1]); w0[2 * q + 1] = cvt_pk_bf16(acc[ai][0][m][q][2], acc[ai][0][m][q][3]);
                                              w1[2 * q] = cvt_pk_bf16(acc[ai][1][m][q][0], acc[ai][1][m][q][1]); w1[2 * q + 1] = cvt_pk_bf16(acc[ai][1][m][q][2], acc[ai][1][m][q][3]); }
#define EPI_XCH(e_) { const unsigned s_ = hi ? w0[e_] : w1[e_]; const unsigned r_ = (unsigned)__builtin_amdgcn_update_dpp(0, (int)s_, 0x128  , 0xF, 0xF, false); dA[e_] = hi ? r_ : w0[e_]; dB[e_] = hi ? w1[e_] : r_; }
                EPI_XCH(0) EPI_XCH(1) EPI_XCH(2) EPI_XCH(3)
#undef EPI_XCH
                if (!nostore) { *(u32x4*)rowp = (u32x4){dA[0], dA[1], dA[2], dA[3]}; *(u32x4*)(rowp + (size_t)8 * ldc) = (u32x4){dB[0], dB[1], dB[2], dB[3]}; }
                else asm volatile("" :: "v"(dA[0]), "v"(dA[1]), "v"(dA[2]), "v"(dA[3]), "v"(dB[0]), "v"(dB[1]), "v"(dB[2]), "v"(dB[3])); }
    }
};
struct EpiResB {
    static constexpr bool PERM = true, AFTER_DRAIN = false;
    const bf16_t* base; bf16_t* out; int ldc;
    __device__ __forceinline__ void operator()(const f32x4 (&acc)[2][2][4][2], const Unit& u, int wr, int wc, int fr, int fq) const {
        const bool hi = fr >= 8;
        const int row0 = u.pm * BM + wr * 64 + (fr & 7), col0 = u.pn * BM + wc * 64 + 8 * fq + (hi ? 32 : 0);
#pragma unroll
        for (int ai = 0; ai < 2; ++ai) {
            u32x4 bA[4], bB[4];
#pragma unroll
            for (int m = 0; m < 4; ++m) { const bf16_t* rp = base + (size_t)(row0 + ai * HALF + m * 16) * ldc + col0; bA[m] = *(const u32x4*)rp; bB[m] = *(const u32x4*)(rp + (size_t)8 * ldc); }
            asm volatile("" ::: "memory");
#pragma unroll
            for (int m = 0; m < 4; ++m) {
                float sA[8], sB[8];
#define EPI_XCH(e_, n_, j_) { const float v0_ = acc[ai][0][m][n_][j_], v1_ = acc[ai][1][m][n_][j_]; const float s_ = hi ? v0_ : v1_; \
                    const float r_ = __builtin_bit_cast(float, __builtin_amdgcn_update_dpp(0, __builtin_bit_cast(int, s_), 0x128  , 0xF, 0xF, false)); sA[e_] = hi ? r_ : v0_; sB[e_] = hi ? v1_ : r_; }
                EPI_XCH(0, 0, 0) EPI_XCH(1, 0, 1) EPI_XCH(2, 0, 2) EPI_XCH(3, 0, 3) EPI_XCH(4, 1, 0) EPI_XCH(5, 1, 1) EPI_XCH(6, 1, 2) EPI_XCH(7, 1, 3)
#undef EPI_XCH
                u32x4 oA, oB;
#pragma unroll
                for (int q = 0; q < 4; ++q) {
                    oA[q] = cvt_pk_bf16(__builtin_bit_cast(float, bA[m][q] << 16) + sA[2 * q], __builtin_bit_cast(float, bA[m][q] & 0xffff0000u) + sA[2 * q + 1]);
                    oB[q] = cvt_pk_bf16(__builtin_bit_cast(float, bB[m][q] << 16) + sB[2 * q], __builtin_bit_cast(float, bB[m][q] & 0xffff0000u) + sB[2 * q + 1]); }
                bf16_t* wp = out + (size_t)(row0 + ai * HALF + m * 16) * ldc + col0;
                *(u32x4*)wp = oA; *(u32x4*)(wp + (size_t)8 * ldc) = oB; }
            asm volatile("" ::: "memory");
        }
    }
};
template <class Epi, class Sched, bool ALIGN_EPI = false, bool SP2 = false>
__device__ __forceinline__ void gemm_phase(PG8_LAS unsigned char* lds, const Gemm g, const Sched& S, const Epi& E, const int tid) {
    const int wid = __builtin_amdgcn_readfirstlane(tid >> 6), lane = tid & 63, wr = wid >> 2, wc = wid & 3, fr = lane & 15, fq = lane >> 4;
    const int K = g.K, nt = K / BK;
    unsigned voffA[2], voffB[2];
#pragma unroll
    for (int i = 0; i < 2; ++i) { int R, C; stage_rc(tid * 16 + i * 8192, R, C); const int Rb = Epi::PERM ? ((R & ~31) + perm32(R & 31)) : R;
        voffA[i] = (unsigned)(R * K + C) * 2u; voffB[i] = (unsigned)(Rb * K + C) * 2u; }
    const size_t kstep = (size_t)(BK * 2);
    const size_t hstep = (size_t)HALF * K * 2;
    const size_t tstep = 2 * hstep;
    const unsigned ldsw = (unsigned)wid * 1024u;
    const int aoff = lds_byte(wr * 64 + fr, fq * 8), boff = lds_byte(wc * 32 + fr, fq * 8);
#define PG8_SA(b, h) (((b) * 2 + (h)) * HTB)
#define PG8_SB(b, h) ((4 + (b) * 2 + (h)) * HTB)
#define PG8_STAGE(bufoff, gbase, voff) do { _Pragma("unroll") for (int _i = 0; _i < 2; ++_i) \
        __builtin_amdgcn_global_load_lds((const unsigned*)((const char*)(gbase) + (voff)[_i]), (PG8_LAS unsigned*)(lds + (bufoff) + ldsw + _i * 8192), 16, 0, 0); } while (0)
#define PG8_LDA(dst, b, h) do { _Pragma("unroll") for (int m = 0; m < 4; ++m) _Pragma("unroll") for (int k = 0; k < 2; ++k) dst[m][k] = *(const PG8_LAS bf16x8*)(lds + PG8_SA(b, h) + aoff + m * 2048 + k * 1024); } while (0)
#define PG8_LDB(dst, b, h) do { _Pragma("unroll") for (int n = 0; n < 2; ++n) _Pragma("unroll") for (int k = 0; k < 2; ++k) dst[n][k] = *(const PG8_LAS bf16x8*)(lds + PG8_SB(b, h) + boff + n * 2048 + k * 1024); } while (0)
#define PG8_MMA(ai, bj, At, Bt) do { __builtin_amdgcn_s_setprio(1); _Pragma("unroll") for (int m = 0; m < 4; ++m) _Pragma("unroll") for (int n = 0; n < 2; ++n) _Pragma("unroll") for (int k = 0; k < 2; ++k) \
        acc[ai][bj][m][n] = __builtin_amdgcn_mfma_f32_16x16x32_bf16(Bt[n][k], At[m][k], acc[ai][bj][m][n], 0, 0, 0); __builtin_amdgcn_s_setprio(0); } while (0)
#define PG8_WAIT_V(n) asm volatile("s_waitcnt vmcnt(" #n ")" ::: "memory")
#define PG8_WAIT_L(n) asm volatile("s_waitcnt lgkmcnt(" #n ")" ::: "memory")
#define PG8_BAR __builtin_amdgcn_s_barrier()
#define PG8_SCHED __builtin_amdgcn_sched_barrier(0)
    Unit cur, nxt; int ui = 0;
    if (!S.next(0, cur)) return;
    f32x4 acc[2][2][4][2];
#pragma unroll
    for (int a = 0; a < 2; ++a)
#pragma unroll
        for (int b = 0; b < 2; ++b)
#pragma unroll
            for (int m = 0; m < 4; ++m)
#pragma unroll
                for (int n = 0; n < 2; ++n) acc[a][b][m][n] = (f32x4){0.f, 0.f, 0.f, 0.f};
    bf16x8 At[4][2], B0[2][2], B1[2][2];
    const char* cA = (const char*)g.A + (size_t)cur.pm * tstep; const char* cB = (const char*)g.Bt + (size_t)cur.pn * tstep;
    S.a_ready(cur);
    if constexpr (SP2) {
        PG8_STAGE(PG8_SB(0, 0), cB, voffB); PG8_STAGE(PG8_SB(0, 1), cB + hstep, voffB); PG8_STAGE(PG8_SA(0, 0), cA, voffA); PG8_STAGE(PG8_SA(0, 1), cA + hstep, voffA);
        if (wr == 1) PG8_BAR;
        PG8_WAIT_V(2); PG8_BAR;
        PG8_STAGE(PG8_SB(1, 0), cB + kstep, voffB); PG8_STAGE(PG8_SA(1, 0), cA + kstep, voffA); PG8_STAGE(PG8_SB(1, 1), cB + hstep + kstep, voffB);
        PG8_WAIT_V(6); PG8_BAR;
    } else {
        PG8_STAGE(PG8_SB(0, 0), cB, voffB); PG8_STAGE(PG8_SA(0, 0), cA, voffA); PG8_STAGE(PG8_SB(0, 1), cB + hstep, voffB); PG8_STAGE(PG8_SA(0, 1), cA + hstep, voffA);
        if (wr == 1) PG8_BAR;
        PG8_WAIT_V(4); PG8_BAR;
        PG8_STAGE(PG8_SB(1, 0), cB + kstep, voffB); PG8_STAGE(PG8_SA(1, 0), cA + kstep, voffA); PG8_STAGE(PG8_SB(1, 1), cB + hstep + kstep, voffB);
        PG8_WAIT_V(6); PG8_BAR;
    }
    for (;;) {
        const bool has_next = S.next(ui + 1, nxt);
        const char* nA = has_next ? (const char*)g.A + (size_t)nxt.pm * tstep : cA; const char* nB = has_next ? (const char*)g.Bt + (size_t)nxt.pn * tstep : cB;
        for (int t = 0; t < nt; t += 2) {
            const bool last = (t == nt - 2);
            const char* a1 = cA + (size_t)(t + 1) * kstep;
            const char* a2 = last ? nA : cA + (size_t)(t + 2) * kstep; const char* b2 = last ? nB : cB + (size_t)(t + 2) * kstep;
            const char* a3 = a2 + kstep; const char* b3 = b2 + kstep;
            if (last && has_next) S.a_ready(nxt);
            if constexpr (SP2) {
            PG8_LDB(B0, 0, 0); PG8_LDB(B1, 0, 1); PG8_SCHED; PG8_LDA(At, 0, 0); PG8_STAGE(PG8_SA(1, 1), a1 + hstep, voffA);
            PG8_WAIT_V(8); PG8_WAIT_L(0); PG8_BAR; PG8_MMA(0, 0, At, B0); PG8_MMA(0, 1, At, B1); PG8_BAR; PG8_SCHED;
            PG8_LDA(At, 0, 1); PG8_STAGE(PG8_SB(0, 0), b2, voffB); PG8_STAGE(PG8_SB(0, 1), b2 + hstep, voffB); PG8_STAGE(PG8_SA(0, 0), a2, voffA);
            PG8_WAIT_V(8); PG8_WAIT_L(0); PG8_BAR; PG8_MMA(1, 0, At, B0); PG8_MMA(1, 1, At, B1); PG8_BAR; PG8_SCHED;
            PG8_LDB(B0, 1, 0); PG8_LDB(B1, 1, 1); PG8_SCHED; PG8_LDA(At, 1, 0); PG8_STAGE(PG8_SA(0, 1), a2 + hstep, voffA);
            PG8_WAIT_V(8); PG8_WAIT_L(0); PG8_BAR; PG8_MMA(0, 0, At, B0); PG8_MMA(0, 1, At, B1); PG8_BAR; PG8_SCHED;
            PG8_LDA(At, 1, 1); PG8_STAGE(PG8_SB(1, 0), b3, voffB); PG8_STAGE(PG8_SB(1, 1), b3 + hstep, voffB); PG8_STAGE(PG8_SA(1, 0), a3, voffA);
            PG8_WAIT_V(8); PG8_WAIT_L(0); PG8_BAR; PG8_MMA(1, 0, At, B0); PG8_MMA(1, 1, At, B1); PG8_BAR; PG8_SCHED;
            } else {
            PG8_LDB(B0, 0, 0); PG8_SCHED; PG8_LDA(At, 0, 0); PG8_STAGE(PG8_SA(1, 1), a1 + hstep, voffA);
            PG8_WAIT_L(8); PG8_BAR; PG8_WAIT_L(0); PG8_MMA(0, 0, At, B0); PG8_BAR; PG8_SCHED;
            PG8_LDB(B1, 0, 1); PG8_STAGE(PG8_SB(0, 0), b2, voffB);
            PG8_BAR; PG8_WAIT_L(0); PG8_MMA(0, 1, At, B1); PG8_BAR;
            PG8_LDA(At, 0, 1); PG8_STAGE(PG8_SA(0, 0), a2, voffA);
            PG8_BAR; PG8_WAIT_L(0); PG8_MMA(1, 0, At, B0); PG8_BAR; PG8_SCHED;
            PG8_STAGE(PG8_SB(0, 1), b2 + hstep, voffB);
            PG8_WAIT_V(6); PG8_BAR; PG8_MMA(1, 1, At, B1); PG8_BAR;
            PG8_LDB(B0, 1, 0); PG8_SCHED; PG8_LDA(At, 1, 0); PG8_STAGE(PG8_SA(0, 1), a2 + hstep, voffA);
            PG8_WAIT_L(8); PG8_BAR; PG8_WAIT_L(0); PG8_MMA(0, 0, At, B0); PG8_BAR; PG8_SCHED;
            PG8_LDB(B1, 1, 1); PG8_STAGE(PG8_SB(1, 0), b3, voffB);
            PG8_BAR; PG8_WAIT_L(0); PG8_MMA(0, 1, At, B1); PG8_BAR;
            PG8_LDA(At, 1, 1); PG8_STAGE(PG8_SA(1, 0), a3, voffA);
            PG8_BAR; PG8_WAIT_L(0); PG8_MMA(1, 0, At, B0); PG8_BAR; PG8_SCHED;
            PG8_STAGE(PG8_SB(1, 1), b3 + hstep, voffB);
            PG8_WAIT_V(6); PG8_BAR; PG8_MMA(1, 1, At, B1); PG8_BAR;
            }
        }
        if constexpr (ALIGN_EPI) { if (wr == 0) PG8_BAR; }
        if constexpr (!Epi::AFTER_DRAIN) { E(acc, cur, wr, wc, fr, fq); S.done(cur); }
        if (!has_next) break;
#pragma unroll
        for (int a = 0; a < 2; ++a)
#pragma unroll
            for (int b = 0; b < 2; ++b)
#pragma unroll
                for (int m = 0; m < 4; ++m)
#pragma unroll
                    for (int n = 0; n < 2; ++n) acc[a][b][m][n] = (f32x4){0.f, 0.f, 0.f, 0.f};
        cur = nxt; cA = nA; cB = nB; ++ui;
        if constexpr (ALIGN_EPI) { if (wr == 1) PG8_BAR; }
    }
    PG8_WAIT_V(0);
    if constexpr (!ALIGN_EPI) { if (wr == 0) PG8_BAR; }
    PG8_BAR;
    if constexpr (Epi::AFTER_DRAIN) { E.fused(acc, cur, wr, wc, fr, fq, lds, wid, lane); S.done(cur); }
#undef PG8_SA
#undef PG8_SB
#undef PG8_STAGE
#undef PG8_LDA
#undef PG8_LDB
#undef PG8_MMA
#undef PG8_WAIT_V
#undef PG8_WAIT_L
#undef PG8_BAR
#undef PG8_SCHED
}
}
#define GAS __attribute__((address_space(1)))
#define LAS __attribute__((address_space(3)))
typedef unsigned short bf16;
typedef unsigned v4u __attribute__((ext_vector_type(4)));
typedef float f32x4 __attribute__((ext_vector_type(4)));
typedef short bf16x8 __attribute__((ext_vector_type(8)));
typedef GAS unsigned gu32;
typedef GAS unsigned long long gu64;
#define RLX_AGENT __ATOMIC_RELAXED, __HIP_MEMORY_SCOPE_AGENT
#define LDS_WAIT() asm volatile("s_waitcnt lgkmcnt(0)" ::: "memory")
#define VM_WAIT() asm volatile("s_waitcnt vmcnt(0)" ::: "memory")
__device__ __forceinline__ unsigned long long rt() { return __builtin_amdgcn_s_memrealtime(); }
__device__ __forceinline__ unsigned f2bf(float f) { unsigned u = __builtin_bit_cast(unsigned, f); return (u + 0x7fffu + ((u >> 16) & 1u)) >> 16; }
typedef __bf16 bf16v2q __attribute__((ext_vector_type(2))); typedef float f32v2q __attribute__((ext_vector_type(2)));
__device__ __forceinline__ unsigned pk2(float lo, float hi) { const f32v2q v = {lo, hi}; return __builtin_bit_cast(unsigned, __builtin_convertvector(v, bf16v2q)); }

#define XB_TMO      128
#define XB_XCNT(j)  (256  + 64 * (j))
#define XB_XSUB(j)  (1280 + 64 * (j))
#define XB_XGEN(j)  (2304 + 64 * (j))
#define XB_TOP      3328
#define XB_TOPGEN   3392
#define XCD_BAR_WORDS 3456
#define XB_SPIN_CAP (1u << 18)

__device__ __forceinline__ unsigned xb_ld(unsigned* p)              { return __hip_atomic_load(p, __ATOMIC_RELAXED, __HIP_MEMORY_SCOPE_AGENT); }
__device__ __forceinline__ unsigned xb_add(unsigned* p, unsigned v) { return __hip_atomic_fetch_add(p, v, __ATOMIC_RELAXED, __HIP_MEMORY_SCOPE_AGENT); }
__device__ __forceinline__ unsigned xb_xcc_id() { return (unsigned)__builtin_amdgcn_s_getreg((3 << 11) | 20) & 0xFu; }
#define XB_SPIN(cond, bar) do { unsigned _sp = 0; while (cond) { __builtin_amdgcn_s_sleep(1); \
    if ((++_sp & 255u) == 0u) { if (xb_ld(&(bar)[XB_TMO])) break; if (_sp > XB_SPIN_CAP) { atomicAdd(&(bar)[XB_TMO], 1u); break; } } } } while (0)

struct XcdBarrier {
    unsigned* bar; unsigned x;
    volatile LAS unsigned* st;
};

__device__ __forceinline__ XcdBarrier xcd_barrier_post(unsigned* bar, volatile LAS unsigned* st) {
    XcdBarrier b; b.bar = bar; b.x = xb_xcc_id(); b.st = st;
    if (threadIdx.x == 0) (void)xb_add(&bar[XB_XCNT(b.x)], 1u);
    return b;
}
__device__ __forceinline__ void xcd_barrier_complete(unsigned* bar, unsigned x, unsigned& nloc, unsigned& nx) {
    const unsigned G = gridDim.x * gridDim.y * gridDim.z;
    unsigned sum, cnt, mine, sp = 0u;
    for (;;) {
        sum = 0u; cnt = 0u; mine = 0u;
#pragma unroll
        for (unsigned j = 0; j < 16; ++j) { const unsigned c = xb_ld(&bar[XB_XCNT(j)]); sum += c; cnt += (c > 0u) ? 1u : 0u; mine = (j == x) ? c : mine; }
        if (sum == G) break;
        __builtin_amdgcn_s_sleep(1);
        if ((++sp & 255u) == 0u) { if (xb_ld(&bar[XB_TMO])) break; if (sp > XB_SPIN_CAP) { atomicAdd(&bar[XB_TMO], 1u); break; } }
    }
    nloc = mine > 0u ? mine : 1u; nx = cnt > 0u ? cnt : 1u;
}

__device__ __forceinline__ void xcd_barrier(const XcdBarrier& b) {
    asm volatile("s_waitcnt vmcnt(0)" ::: "memory");
    __syncthreads();
    if (threadIdx.x == 0) {
        unsigned* bar = b.bar;
        __builtin_amdgcn_s_waitcnt(0);
        unsigned nloc = b.st[0], nx = b.st[1];
        if (nloc == 0u) { xcd_barrier_complete(bar, b.x, nloc, nx); b.st[0] = nloc; b.st[1] = nx; }
        const unsigned old = xb_add(&bar[XB_XSUB(b.x)], 1u);
        const unsigned gen = old / nloc;
        if (old + 1u == (gen + 1u) * nloc) {
            __builtin_amdgcn_fence(__ATOMIC_RELEASE, "agent");
            asm volatile("s_waitcnt vmcnt(0)" ::: "memory");
            const unsigned og = xb_add(&bar[XB_TOP], 1u);
            const unsigned tg = og / nx;
            if (og + 1u == (tg + 1u) * nx) xb_add(&bar[XB_TOPGEN], 1u);
            else XB_SPIN(xb_ld(&bar[XB_TOPGEN]) == tg, bar);
            __builtin_amdgcn_fence(__ATOMIC_ACQUIRE, "agent");
            xb_add(&bar[XB_XGEN(b.x)], 1u);
            asm volatile("s_waitcnt vmcnt(0)" ::: "memory");
        } else {
            XB_SPIN(xb_ld(&bar[XB_XGEN(b.x)]) == gen, bar);
            __builtin_amdgcn_fence(__ATOMIC_ACQUIRE, "agent");
            asm volatile("s_waitcnt vmcnt(0)" ::: "memory");
        }
    }
    __syncthreads();
}

#ifndef MK_PH_HI
#define MK_PH_HI 17
#endif
#ifndef MK_SUB
#define MK_SUB 3
#endif
#ifndef MK_DNSTEP
#define MK_DNSTEP 9
#endif
#ifndef MK_W6
#define MK_W6 1
#endif
#ifndef MK_CVSTEP
#define MK_CVSTEP 9
#endif
#ifndef MK_REP
#define MK_REP 0
#endif
#ifndef MK_REPSUB
#define MK_REPSUB 3
#endif
#ifndef MK_NOREAD
#define MK_NOREAD 0
#endif
#ifndef MK_STAG_A
#define MK_STAG_A 0
#endif
#ifndef MK_STAG_O
#define MK_STAG_O 0
#endif
#ifndef MK_STAG_GU
#define MK_STAG_GU 0
#endif
#ifndef MK_STAG_D
#define MK_STAG_D 0
#endif
#ifndef MK_REPSUB2
#define MK_REPSUB2 3
#endif
#ifndef MK_XBAR
#define MK_XBAR 0
#endif
#ifndef MK_NOSTORE
#define MK_NOSTORE 0
#endif
#ifndef MK_NEG
#define MK_NEG 1
#endif

constexpr int NWAVES = 8;
constexpr int D = 1024, BATCH = 8, SEQ = 4096, M = BATCH * SEQ, DEPTH = 2;
constexpr int DFF = 2816, DPROJ = 3080, NP = 3072;
constexpr int CVK = 31, DNCONV = 4;
constexpr float EPS = 1e-6f;
constexpr int NCHUNK = BATCH * 4 * 64;

constexpr size_t MiB = 1u << 20;
constexpr size_t WS_CTL = 0, CTL_ZERO_BYTES = 64 * 1024;
constexpr size_t WS_W = 2 * MiB;
constexpr size_t W_IN_OFF = 0, W_O_OFF = 6 * MiB, W_GU_OFF = 8 * MiB, W_D_OFF = 19 * MiB, W_LAYER = 25 * MiB;
constexpr size_t WS_BA = 53 * MiB;
constexpr size_t WS_CD = 54 * MiB + 512 * 1024;
constexpr size_t WS_XB = 64 * MiB;
constexpr size_t WS_P = 128 * MiB;
constexpr size_t WS_REC = 320 * MiB;
constexpr size_t REC_BYTES = 74752, REC_W = 0, REC_QD = 16384, REC_QK = 32768, REC_KDT = 40960, REC_U = 57344, REC_CD = 73728;
constexpr size_t WS_O = 468 * MiB, WS_END = 500 * MiB;
constexpr int CW_BAR = 4096, CW_FLAGS = 8192;

constexpr int RING_BYTES = 131072;
constexpr int MISC_OFF = 163840 - 256;
constexpr int LDS_BYTES = 163840;

__device__ __forceinline__ float bf2f(unsigned short b) { return __uint_as_float(((unsigned)b) << 16); }
#define dpp_f(old, v, ctrl, row_mask, bound) __builtin_bit_cast(float, __builtin_amdgcn_update_dpp(__builtin_bit_cast(int, (float)(old)), __builtin_bit_cast(int, (float)(v)), (ctrl), (row_mask), 0xF, (bound)))
__device__ __forceinline__ float wave_sum(float v) {
    v += dpp_f(0.f, v, 0xB1, 0xF, true);
    v += dpp_f(0.f, v, 0x4E, 0xF, true);
    v += dpp_f(0.f, v, 0x141, 0xF, true);
    v += dpp_f(0.f, v, 0x140, 0xF, true);
    v += dpp_f(0.f, v, 0x142, 0xA, false);
    v += dpp_f(0.f, v, 0x143, 0xC, false);
    return __builtin_bit_cast(float, __builtin_amdgcn_readlane(__builtin_bit_cast(int, v), 63));
}
__device__ __forceinline__ float sigmoidf_(float x) { return __builtin_amdgcn_rcpf(1.0f + __builtin_amdgcn_exp2f(x * -1.4426950408889634f)); }
__device__ __forceinline__ float gelu_erf(float x) { return 0.5f * x * (1.0f + erff(x * 0.70710678118654752f)); }
typedef float f32x16 __attribute__((ext_vector_type(16)));
typedef unsigned u32x2 __attribute__((ext_vector_type(2)));
#define MFMA32(a, b, c) __builtin_amdgcn_mfma_f32_32x32x16_bf16((a), (b), (c), 0, 0, 0)
__device__ __forceinline__ int crow(int reg, int hh) { return (reg & 3) + 8 * (reg >> 2) + 4 * hh; }

#define AS4 __attribute__((address_space(4)))
struct Frame {
    LAS unsigned char* lds;
    int tid, lane, wave, vcu, G;
    const AS4 unsigned char* kp;
    float* out; unsigned char* ws;
    __device__ __forceinline__ const float* inp(int k) const { return *(const float* const AS4*)(kp + 8 * k); }
};

__device__ __forceinline__ void tr_item(const float* W, int ldw, int K, bf16* WT, int kb, int nsrc0, int ndst0, LAS float* scr, int lane) {
    const int k0 = 64 * kb;
#pragma unroll 8
    for (int i = 0; i < 32; ++i) { const int kk = 2 * i + (lane >> 5); scr[kk * 33 + (lane & 31)] = W[(size_t)(k0 + kk) * ldw + nsrc0 + (lane & 31)]; }
    LDS_WAIT(); asm volatile("" ::: "memory");
    const int c = lane & 7;
#pragma unroll
    for (int j = 0; j < 4; ++j) { const int n = (lane >> 3) + 8 * j; const LAS float* s = scr + (8 * c) * 33 + n;
        v4u o; o.x = pk2(s[0 * 33], s[1 * 33]); o.y = pk2(s[2 * 33], s[3 * 33]); o.z = pk2(s[4 * 33], s[5 * 33]); o.w = pk2(s[6 * 33], s[7 * 33]);
        *(GAS v4u*)(WT + (size_t)(ndst0 + n) * K + k0 + 8 * c) = o; }
    LDS_WAIT(); asm volatile("" ::: "memory");
}
__device__ __forceinline__ void weights_phase(Frame& F) {
    LAS float* scr = (LAS float*)(F.lds + F.wave * 16384);
    const int gw = F.vcu * NWAVES + F.wave, NGW = F.G * NWAVES;
    constexpr int I_IN = 16 * 96, I_O = 16 * 32, I_GU = 16 * 176, I_D = 44 * 32, I_L = I_IN + I_O + I_GU + I_D;
    for (int it = gw; it < DEPTH * I_L; it += NGW) {
        const int l = it / I_L; int r = it % I_L;
        bf16* wb = (bf16*)(F.ws + WS_W + (size_t)l * W_LAYER);
        if (r < I_IN) { const int kb = r / 96, nb = r % 96, q8 = nb & 7, nsrc = (nb & ~7) + (q8 & 3) * 2 + (q8 >> 2);
            tr_item(F.inp(2) + (size_t)l * D * DPROJ, DPROJ, D, (bf16*)((unsigned char*)wb + W_IN_OFF), kb, 32 * nsrc, 32 * nb, scr, F.lane); continue; } r -= I_IN;
        if (r < I_O) { const int kb = r / 32, nb = r % 32, q8 = nb & 7, nsrc = (nb & ~7) + (q8 & 3) * 2 + (q8 >> 2); tr_item(F.inp(15) + (size_t)l * D * D, D, D, (bf16*)((unsigned char*)wb + W_O_OFF), kb, 32 * nsrc, 32 * nb, scr, F.lane); continue; } r -= I_O;
        if (r < I_GU) { const int kb = r / 176, nb = r % 176; const int drow = 32 * nb, tile = drow >> 8, within = drow & 255;
            const float* src = (within < 128 ? F.inp(17) : F.inp(18)) + (size_t)l * D * DFF;
            tr_item(src, DFF, D, (bf16*)((unsigned char*)wb + W_GU_OFF), kb, tile * 128 + (within & 127), drow, scr, F.lane); continue; } r -= I_GU;
        { const int kb = r / 32, nb = r % 32, q8 = nb & 7, nsrc = (nb & ~7) + (q8 & 3) * 2 + (q8 >> 2); tr_item(F.inp(19) + (size_t)l * DFF * D, D, DFF, (bf16*)((unsigned char*)wb + W_D_OFF), kb, 32 * nsrc, 32 * nb, scr, F.lane); }
    }
}

template <int MODE, bool XBF>
__device__ __forceinline__ void norm_phase(Frame& F, const void* xin_, const float* g, bf16* hn, const float* wlog, float* ba, float* fout, bf16* xb_out) {
    const int gw = F.vcu * NWAVES + F.wave, NGW = F.G * NWAVES;
    f32x4 gv[4];
#pragma unroll
    for (int j = 0; j < 4; ++j) gv[j] = ((const f32x4*)g)[64 * j + F.lane];
    LAS float* sW = (LAS float*)F.lds;
    if (MODE == 0 && wlog) {
        __syncthreads();
#pragma unroll
        for (int q = 0; q < 2; ++q) { const int k = 2 * F.tid + q; const f32x4* wr = (const f32x4*)(wlog + (size_t)k * DPROJ + NP); const f32x4 w0 = wr[0], w1 = wr[1];
            sW[0 * 1024 + k] = w0.x; sW[1 * 1024 + k] = w0.y; sW[2 * 1024 + k] = w0.z; sW[3 * 1024 + k] = w0.w; sW[4 * 1024 + k] = w1.x; sW[5 * 1024 + k] = w1.y; sW[6 * 1024 + k] = w1.z; sW[7 * 1024 + k] = w1.w; }
        __syncthreads();
    }
    for (int m = gw; m < M; m += NGW) {
        f32x4 v[4]; float ss = 0.f;
        if (XBF) { const u32x2* xr = (const u32x2*)((const bf16*)xin_ + (size_t)m * D) + F.lane;
#pragma unroll
            for (int j = 0; j < 4; ++j) { const u32x2 r2 = xr[64 * j]; v[j].x = __uint_as_float(r2.x << 16); v[j].y = __uint_as_float(r2.x & 0xffff0000u); v[j].z = __uint_as_float(r2.y << 16); v[j].w = __uint_as_float(r2.y & 0xffff0000u); }
        } else { const f32x4* xr = (const f32x4*)((const float*)xin_ + (size_t)m * D) + F.lane;
#pragma unroll
            for (int j = 0; j < 4; ++j) v[j] = xr[64 * j];
            if (xb_out) { unsigned long long* o8 = (unsigned long long*)(xb_out + (size_t)m * D) + F.lane;
#pragma unroll
                for (int j = 0; j < 4; ++j) o8[64 * j] = (unsigned long long)pk2(v[j].x, v[j].y) | ((unsigned long long)pk2(v[j].z, v[j].w) << 32); } }
#pragma unroll
        for (int j = 0; j < 4; ++j) ss += (v[j].x * v[j].x + v[j].y * v[j].y) + (v[j].z * v[j].z + v[j].w * v[j].w);
        const float rstd = __builtin_amdgcn_rsqf(wave_sum(ss) * (1.0f / D) + EPS);
#pragma unroll
        for (int j = 0; j < 4; ++j) v[j] = v[j] * rstd * gv[j];
        if (MODE == 0) {
            unsigned long long* o8 = (unsigned long long*)(hn + (size_t)m * D) + F.lane;
#pragma unroll
            for (int j = 0; j < 4; ++j) o8[64 * j] = (unsigned long long)pk2(v[j].x, v[j].y) | ((unsigned long long)pk2(v[j].z, v[j].w) << 32);
            if (wlog) {
                float acc[8];
#pragma unroll
                for (int t = 0; t < 8; ++t) { acc[t] = 0.f;
#pragma unroll
                    for (int j = 0; j < 4; ++j) { const f32x4 w = *(const LAS f32x4*)(sW + t * 1024 + 256 * j + 4 * F.lane); acc[t] += (v[j].x * w.x + v[j].y * w.y) + (v[j].z * w.z + v[j].w * w.w); } }
#pragma unroll
                for (int t = 0; t < 8; ++t) acc[t] = wave_sum(acc[t]);
                if (F.lane == 0) { *(f32x4*)(ba + (size_t)m * 8) = (f32x4){acc[0], acc[1], acc[2], acc[3]}; *(f32x4*)(ba + (size_t)m * 8 + 4) = (f32x4){acc[4], acc[5], acc[6], acc[7]}; }
            }
        } else {
            f32x4* o = (f32x4*)(fout + (size_t)m * D) + F.lane;
#pragma unroll
            for (int j = 0; j < 4; ++j) o[64 * j] = v[j];
        }
    }
}

__device__ __forceinline__ float gelu_as(float v) {
    const float d = fabsf(v) * 0.2316418882f + 1.0f, t = __builtin_amdgcn_rcpf(d);
    float q = t * 0.5307027145f + (-0.7265760135f); q = q * t + 0.7107068705f; q = q * t + (-0.142248368f); q = q * t + 0.127414796f; q = q * t;
    const float e = __builtin_amdgcn_exp2f((v * v) * (-0.72134752044f));
    const float m = v * (q * e), r = v - m;
    return v < 0.f ? m : r;
}
typedef __bf16 bf16v8m_t __attribute__((ext_vector_type(8)));
typedef float f32x8m_t __attribute__((ext_vector_type(8)));
__device__ __forceinline__ bf16x8 cvt8(float a0, float a1, float a2, float a3, float a4, float a5, float a6, float a7) { const f32x8m_t v = {a0, a1, a2, a3, a4, a5, a6, a7}; return __builtin_bit_cast(bf16x8, __builtin_convertvector(v, bf16v8m_t)); }
__device__ __forceinline__ void gmlp_unit(Frame& F, int l, int unit, const bf16* P, bf16* MIX) {
    const int m0 = unit * 128;
    LAS bf16* sVt = (LAS bf16*)F.lds;
    {
        float lg[4], lb[4];
#pragma unroll
        for (int e = 0; e < 4; ++e) { lg[e] = F.inp(3)[l * 256 + F.lane + 64 * e]; lb[e] = F.inp(4)[l * 256 + F.lane + 64 * e]; }
        unsigned short rv[16][4];
#pragma unroll
        for (int jj = 0; jj < 16; ++jj) { const bf16* pr = P + (size_t)(m0 + 16 * F.wave + jj) * NP + 256 + F.lane;
#pragma unroll
            for (int e = 0; e < 4; ++e) rv[jj][e] = pr[64 * e]; }
#pragma unroll
        for (int jj = 0; jj < 16; ++jj) {
            const int j = 16 * F.wave + jj;
            float v[4];
#pragma unroll
            for (int e = 0; e < 4; ++e) v[e] = gelu_as(bf2f(rv[jj][e]));
            const float mean = wave_sum((v[0] + v[1]) + (v[2] + v[3])) * (1.0f / 256.0f);
#pragma unroll
            for (int e = 0; e < 4; ++e) v[e] -= mean;
            const float var = wave_sum((v[0] * v[0] + v[1] * v[1]) + (v[2] * v[2] + v[3] * v[3])) * (1.0f / 256.0f);
            const float r = __builtin_amdgcn_rsqf(var + EPS);
#pragma unroll
            for (int e = 0; e < 4; ++e) sVt[(F.lane + 64 * e) * 136 + j] = (bf16)(pk2(v[e] * r * lg[e] + lb[e], 0.f) & 0xffffu);
        }
    }
    __syncthreads();
    {
        const int r = F.lane & 31, hh = F.lane >> 5, h = F.wave >> 1, c = 32 * F.wave + r;
        const float* wsh = F.inp(5) + (size_t)(l * 4 + h) * 128 * 128;
        const float* bsh = F.inp(6) + (l * 4 + h) * 128;
        bf16x8 bfr[8];
#pragma unroll
        for (int s = 0; s < 8; ++s) bfr[s] = *(const LAS bf16x8*)(sVt + c * 136 + 16 * s + 8 * hh);
#pragma unroll
        for (int ti = 0; ti < 4; ++ti) {
            const int i = 32 * ti + r;
            f32x16 acc;
#pragma unroll
            for (int e = 0; e < 16; ++e) acc[e] = 0.f;
            unsigned short ur[16]; float br[16];
#pragma unroll
            for (int e = 0; e < 16; ++e) { const int io = 32 * ti + crow(e, hh); ur[e] = P[(size_t)(m0 + io) * NP + c]; br[e] = bsh[io]; }
#pragma unroll
            for (int s = 0; s < 2 * ti + 2; ++s) {
                const float* ap = wsh + i * 128 + 16 * s + 8 * hh;
                f32x4 a0 = *(const f32x4*)ap, a1 = *(const f32x4*)(ap + 4);
                if (s >= 2 * ti) { const int j0 = 16 * s + 8 * hh;
                    a0.x = (j0 + 0 <= i) ? a0.x : 0.f; a0.y = (j0 + 1 <= i) ? a0.y : 0.f; a0.z = (j0 + 2 <= i) ? a0.z : 0.f; a0.w = (j0 + 3 <= i) ? a0.w : 0.f;
                    a1.x = (j0 + 4 <= i) ? a1.x : 0.f; a1.y = (j0 + 5 <= i) ? a1.y : 0.f; a1.z = (j0 + 6 <= i) ? a1.z : 0.f; a1.w = (j0 + 7 <= i) ? a1.w : 0.f; }
                acc = MFMA32(cvt8(a0.x, a0.y, a0.z, a0.w, a1.x, a1.y, a1.z, a1.w), bfr[s], acc);
            }
#pragma unroll
            for (int e = 0; e < 16; ++e) { const int io = 32 * ti + crow(e, hh);
                const float u = gelu_as(bf2f(ur[e]));
                MIX[(size_t)(m0 + io) * D + c] = (bf16)(pk2(u * (acc[e] + br[e]), 0.f) & 0xffffu); }
        }
    }
    __syncthreads();
}

__device__ __forceinline__ void conv_unit(Frame& F, int l, int unit, const bf16* P, bf16* MIX) {
    const int b = unit >> 6, t0 = (unit & 63) * 64, m0 = b * SEQ + t0;
    LAS float* sY = (LAS float*)F.lds;
    const int c = F.tid & 255, hf = F.wave >> 2;
    float w[CVK];
#pragma unroll
    for (int k = 0; k < CVK; ++k) w[k] = F.inp(7)[(size_t)(l * CVK + k) * 256 + c];
    const float bias = F.inp(8)[l * 256 + c];
    {
        u32x2 ra[12], rg[12];
#pragma unroll
        for (int q = 0; q < 12; ++q) { const int r = F.wave + 8 * q, rc = r < 94 ? r : 93; const int t = t0 - 30 + rc, tc = t >= 0 ? t : 0;
            const bf16* pr = P + (size_t)(b * SEQ + tc) * NP + 4 * F.lane; ra[q] = *(const u32x2*)(pr + 512); rg[q] = *(const u32x2*)(pr + 768); }
#pragma unroll
        for (int q = 0; q < 12; ++q) { const int r = F.wave + 8 * q; const int t = t0 - 30 + r;
            f32x4 y;
            y.x = bf2f((unsigned short)(ra[q].x & 0xffffu)) * sigmoidf_(bf2f((unsigned short)(rg[q].x & 0xffffu)));
            y.y = bf2f((unsigned short)(ra[q].x >> 16)) * sigmoidf_(bf2f((unsigned short)(rg[q].x >> 16)));
            y.z = bf2f((unsigned short)(ra[q].y & 0xffffu)) * sigmoidf_(bf2f((unsigned short)(rg[q].y & 0xffffu)));
            y.w = bf2f((unsigned short)(ra[q].y >> 16)) * sigmoidf_(bf2f((unsigned short)(rg[q].y >> 16)));
            if (t < 0) y = (f32x4){0.f, 0.f, 0.f, 0.f};
            if (r < 94) *(LAS f32x4*)(sY + r * 256 + 4 * F.lane) = y; }
    }
    __syncthreads();
    float o[32];
#pragma unroll
    for (int g = 0; g < 4; ++g) {
        float y[38];
#pragma unroll
        for (int q = 0; q < 38; ++q) y[q] = sY[(hf * 32 + 8 * g + q) * 256 + c];
#pragma unroll
        for (int t8 = 0; t8 < 8; ++t8) {
            float a = bias;
#pragma unroll
            for (int k = 0; k < CVK; ++k) a += w[k] * y[t8 + k];
            o[8 * g + t8] = a;
        }
    }
    __syncthreads();
#pragma unroll
    for (int tt = 0; tt < 32; ++tt) sY[(hf * 32 + tt) * 256 + c] = o[tt];
    __syncthreads();
    const f32x4 g4 = *(const f32x4*)(F.inp(9) + l * 256 + 4 * F.lane), b4 = *(const f32x4*)(F.inp(10) + l * 256 + 4 * F.lane);
    for (int i = F.wave; i < 64; i += NWAVES) {
        f32x4 v = *(LAS f32x4*)(sY + i * 256 + 4 * F.lane);
        const float mean = wave_sum((v.x + v.y) + (v.z + v.w)) * (1.0f / 256.0f);
        v = v - mean;
        const float var = wave_sum((v.x * v.x + v.y * v.y) + (v.z * v.z + v.w * v.w)) * (1.0f / 256.0f);
        const float r = __builtin_amdgcn_rsqf(var + EPS);
        v = v * r * g4 + b4;
        v.x *= sigmoidf_(v.x); v.y *= sigmoidf_(v.y); v.z *= sigmoidf_(v.z); v.w *= sigmoidf_(v.w);
        *(unsigned long long*)(MIX + (size_t)(m0 + i) * D + 256 + 4 * F.lane) = (unsigned long long)pk2(v.x, v.y) | ((unsigned long long)pk2(v.z, v.w) << 32);
    }
    __syncthreads();
}

#ifndef MK_TS
#define MK_TS 0
#endif
#ifndef MK_TK
#define MK_TK 4
#endif
#define TS_BEGIN(id) long long ts0_##id = 0; if (MK_TS == (id)) { asm volatile("s_waitcnt vmcnt(0) lgkmcnt(0)" ::: "memory"); ts0_##id = clock64(); }
#define TS_END(id) if (MK_TS == (id)) { asm volatile("s_waitcnt vmcnt(0) lgkmcnt(0)" ::: "memory"); const long long t1_ = clock64(), d_ = (t1_ - ts0_##id) * MK_TK; while (clock64() - t1_ < d_) __builtin_amdgcn_s_sleep(1); }
typedef __bf16 bf16v2_t __attribute__((ext_vector_type(2)));
typedef __bf16 bf16v8_t __attribute__((ext_vector_type(8)));
typedef float f32x2_t __attribute__((ext_vector_type(2)));
typedef float f32x8_t __attribute__((ext_vector_type(8)));
__device__ __forceinline__ unsigned cpk2(float lo, float hi) { const f32x2_t v = {lo, hi}; return __builtin_bit_cast(unsigned, __builtin_convertvector(v, bf16v2_t)); }
__device__ __forceinline__ v4u cpk8(float a0, float a1, float a2, float a3, float a4, float a5, float a6, float a7) { const f32x8_t v = {a0, a1, a2, a3, a4, a5, a6, a7}; return __builtin_bit_cast(v4u, __builtin_convertvector(v, bf16v8_t)); }
__device__ __forceinline__ bf16x8 pack_step(const f32x16& x, int s) { return __builtin_bit_cast(bf16x8, cpk8(x[8 * s], x[8 * s + 1], x[8 * s + 2], x[8 * s + 3], x[8 * s + 4], x[8 * s + 5], x[8 * s + 6], x[8 * s + 7])); }

template <int J> __device__ __forceinline__ void dn_load_col(f32x4 (&dst)[4], const LAS float* sAth, const f32x4& tie) {
    if constexpr (J < 63) {
        const LAS float* acol = sAth + J * 64;
        asm volatile("" : "+v"(acol) : "v"(tie.x));
#pragma unroll
        for (int q = (J >> 4); q < 4; ++q) dst[q] = *(const LAS f32x4*)(acol + 16 * q);
    }
}
template <int J> __device__ __forceinline__ void dn_solve_cols2(f32x4 (&au)[4], f32x4 (&aw)[4], const LAS float* sAth, f32x4 (&cur)[4], f32x4 (&nxt)[4]) {
    if constexpr (J < 63) {
        constexpr int GJ = J >> 2, Q0 = GJ >> 2, OWN = GJ & 3, BC = OWN * 0x55;
        f32x4 nn[4];
        dn_load_col<J + 2>(nn, sAth, au[Q0]);
        float mu = au[Q0][J & 3], mw = aw[Q0][J & 3];
        asm volatile("" : "+v"(mu), "+v"(mw));
        const float su = __builtin_bit_cast(float, __builtin_amdgcn_update_dpp(0, __builtin_bit_cast(int, mu), BC, 0xF, 0xF, false));
        const float sw = __builtin_bit_cast(float, __builtin_amdgcn_update_dpp(0, __builtin_bit_cast(int, mw), BC, 0xF, 0xF, false));
        const float nsu = -su, nsw = -sw;
#pragma unroll
        for (int q = Q0; q < 4; ++q) { au[q] = __builtin_elementwise_fma(cur[q], (f32x4){nsu, nsu, nsu, nsu}, au[q]); aw[q] = __builtin_elementwise_fma(cur[q], (f32x4){nsw, nsw, nsw, nsw}, aw[q]); }
        dn_solve_cols2<J + 1>(au, aw, sAth, nxt, nn);
    }
}

template <int J> __device__ __forceinline__ void dn_solve_cols1(f32x4 (&au)[4], const LAS float* sAth, f32x4 (&cur)[4], f32x4 (&nxt)[4]) {
    if constexpr (J < 63) {
        constexpr int GJ = J >> 2, Q0 = GJ >> 2, OWN = GJ & 3, BC = OWN * 0x55;
        f32x4 nn[4];
        dn_load_col<J + 2>(nn, sAth, au[Q0]);
        float mu = au[Q0][J & 3];
        asm volatile("" : "+v"(mu));
        const float su = __builtin_bit_cast(float, __builtin_amdgcn_update_dpp(0, __builtin_bit_cast(int, mu), BC, 0xF, 0xF, false));
        const float nsu = -su;
#pragma unroll
        for (int q = Q0; q < 4; ++q) au[q] = __builtin_elementwise_fma(cur[q], (f32x4){nsu, nsu, nsu, nsu}, au[q]);
        dn_solve_cols1<J + 1>(au, sAth, nxt, nn);
    }
}

__device__ __forceinline__ void dn_load_raw(v4u (&raw)[7], const bf16* P, int cu, int tid) {
    const int b = cu >> 8, h = (cu >> 6) & 3, n = cu & 63, m0 = b * SEQ + n * 64;
    const bf16* pbase = P + 1024 + h * 128;
#pragma unroll
    for (int it = 0; it < 7; ++it) { int item = tid + 512 * it; item = item < 3 * 67 * 16 ? item : 3 * 67 * 16 - 1;
        const int sel = item / (67 * 16), rem = item - sel * (67 * 16), t = rem >> 4, pc = rem & 15;
        const int tr = (n > 0 || t >= 3) ? t : 3;
        raw[it] = *(const v4u*)(pbase + (long)(m0 - 3 + tr) * NP + sel * 512 + pc * 8);
        if (!(n > 0 || t >= 3)) raw[it] = (v4u){0u, 0u, 0u, 0u}; }
}
#define DN_ST16(ptr_, val_) __builtin_amdgcn_raw_buffer_store_b128((val_), rsrc, (int)((const unsigned char*)(ptr_) - recbase), 0, 16)
#define DN_UNIT2CU(v_) ((((v_) & 31) << 6) | ((v_) >> 5))
__device__ __forceinline__ void dn_chunk_units(Frame& F0, int l, int first, int stride, const bf16* P, const float* BA, const int stepmax, unsigned* flags) {
  if (stepmax < 1 || first >= NCHUNK) return;
  v4u rawn[7]; dn_load_raw(rawn, P, DN_UNIT2CU(first), F0.tid);
  const unsigned char* recbase = F0.ws + WS_REC;
  const __amdgpu_buffer_rsrc_t rsrc = __builtin_amdgcn_make_buffer_rsrc((void*)recbase, 0, (int)(NCHUNK * REC_BYTES), 0x00020000);
  for (int vu = first; vu < NCHUNK; vu += stride) {
    const int cu = DN_UNIT2CU(vu);
    Frame F = F0; asm volatile("" : "+v"(F.tid)); F.lane = F.tid & 63; F.wave = __builtin_amdgcn_readfirstlane(F.tid >> 6);
    const int b = cu >> 8, h = (cu >> 6) & 3, n = cu & 63, m0 = b * SEQ + n * 64;
    LAS float* sQ = (LAS float*)F.lds;
    LAS float* sK = (LAS float*)(F.lds + 32768);
    LAS float* sV = (LAS float*)(F.lds + 65536);
    LAS bf16* sQb = (LAS bf16*)(F.lds + 98304);
    LAS bf16* sKb = (LAS bf16*)(F.lds + 115712);
    LAS bf16* sVt = (LAS bf16*)(F.lds + 65536);
    LAS bf16* sKt = (LAS bf16*)(F.lds + 65536 + 16384);
    LAS bf16* sTu = (LAS bf16*)(F.lds + 98304);
    LAS bf16* sTw = (LAS bf16*)(F.lds + 98304 + 9216);
#define DN_CM(row_, j_) ((row_) * 64 + ((((j_) >> 3) ^ ((row_) & 7)) << 3) + ((j_) & 7))
    LAS bf16* sRaw = (LAS bf16*)(F.lds + 98304);
    LAS float* sGam = (LAS float*)(F.lds + 149760);
    LAS float* sBeta = (LAS float*)(F.lds + 150016);
    LAS float* sEg = (LAS float*)(F.lds + 150272);
    LAS float* sEd = (LAS float*)(F.lds + 150528);
    LAS float* sA = (LAS float*)(F.lds + 133120);
    bf16* rec = (bf16*)(F.ws + WS_REC + (size_t)cu * REC_BYTES);
    bf16* Uo = rec + REC_U / 2; float* CD = (float*)((unsigned char*)rec + REC_CD);
    TS_BEGIN(1)
    {
#pragma unroll
        for (int it = 0; it < 7; ++it) { const int item = F.tid + 512 * it; if (item < 3 * 67 * 16) *(LAS v4u*)(sRaw + item * 8) = rawn[it]; }
    }
    {
        const int cn = (vu + stride < NCHUNK) ? DN_UNIT2CU(vu + stride) : cu;
        dn_load_raw(rawn, P, cn, F.tid);
    }
    __syncthreads();
    TS_END(1)
#ifdef MK_X
    if (stepmax == 1) continue;
#endif
    TS_BEGIN(2)
#ifndef MK_Y
#define MK_Y 0
#endif
#ifndef MK_Z
#define MK_Z 0
#endif
    if (F.wave < 6 && !(stepmax == 1 && MK_Z)) {
        const int sel = F.wave >> 1, c = F.tid & 127;
        const int wch = sel * 512 + h * 128 + c;
        const float* cw = F.inp(11) + (size_t)l * DNCONV * 1536 + wch;
        const float w0 = cw[0], w1 = cw[1536], w2 = cw[2 * 1536], w3 = cw[3 * 1536];
        const LAS bf16* xc = sRaw + (sel * 67) * 128 + c;
        float x0 = bf2f(xc[0]), x1 = bf2f(xc[128]), x2 = bf2f(xc[256]);
        LAS float* dst = (sel == 0 ? sQ : sK) + c;
#ifndef MK_DUP
#define MK_DUP 0
#endif
        if (sel < 2) {
#pragma unroll 16
            for (int i = 0; i < 64; ++i) {
                const float x3 = bf2f(xc[(i + 3) * 128]);
                const float y = __builtin_fmaf(w3, x3, __builtin_fmaf(w2, x2, __builtin_fmaf(w1, x1, w0 * x0)));
                dst[i * 128] = y * sigmoidf_(y);
                x0 = x1; x1 = x2; x2 = x3;
            }
        } else {
#pragma unroll 2
            for (int i8 = 0; i8 < 8; ++i8) {
                float yv[8];
#pragma unroll
                for (int e = 0; e < 8; ++e) { const float x3 = bf2f(xc[(8 * i8 + e + 3) * 128]);
                    const float y = __builtin_fmaf(w3, x3, __builtin_fmaf(w2, x2, __builtin_fmaf(w1, x1, w0 * x0)));
                    yv[e] = y * sigmoidf_(y); x0 = x1; x1 = x2; x2 = x3; }
                *(LAS v4u*)(sVt + DN_CM(c, 8 * i8)) = cpk8(yv[0], yv[1], yv[2], yv[3], yv[4], yv[5], yv[6], yv[7]);
            }
        }
    } else if (F.wave == 6) {
        const int i = F.lane;
        const float bl = BA[(size_t)(m0 + i) * 8 + h], al = BA[(size_t)(m0 + i) * 8 + 4 + h];
        const float beta = sigmoidf_(bl);
        const float z = al + F.inp(13)[l * 4 + h];
        const float sp = fmaxf(z, 0.f) + log1pf(expf(-fabsf(z)));
        float la = -expf(F.inp(12)[l * 4 + h]) * sp;
#pragma unroll
        for (int off = 1; off < 64; off <<= 1) { const float t = __shfl_up(la, off); if (i >= off) la += t; }
        const float glast = __shfl(la, 63);
        sGam[i] = la; sBeta[i] = beta; sEg[i] = expf(la); sEd[i] = expf(glast - la);
        if (i == 63) __hip_atomic_store(CD, expf(la), __ATOMIC_RELAXED, __HIP_MEMORY_SCOPE_AGENT);
    }
    __syncthreads();
    TS_END(2)
    TS_BEGIN(3)
    {
        float q0[8], q1[8], k0[8], k1[8], sq[8], sk[8];
#pragma unroll
        for (int rr = 0; rr < 8; ++rr) { const int i = 8 * F.wave + rr;
            q0[rr] = sQ[i * 128 + F.lane]; q1[rr] = sQ[i * 128 + 64 + F.lane]; k0[rr] = sK[i * 128 + F.lane]; k1[rr] = sK[i * 128 + 64 + F.lane];
            sq[rr] = q0[rr] * q0[rr] + q1[rr] * q1[rr]; sk[rr] = k0[rr] * k0[rr] + k1[rr] * k1[rr]; }
#pragma unroll
        for (int rr = 0; rr < 8; ++rr) { sq[rr] = wave_sum(sq[rr]); sk[rr] = wave_sum(sk[rr]); }
#pragma unroll
        for (int rr = 0; rr < 8; ++rr) { const int i = 8 * F.wave + rr;
            const float rq = __builtin_amdgcn_rsqf(sq[rr] + EPS) * 0.08838834764831845f, rk = __builtin_amdgcn_rsqf(sk[rr] + EPS);
            sQ[i * 128 + F.lane] = q0[rr] * rq; sQ[i * 128 + 64 + F.lane] = q1[rr] * rq; sK[i * 128 + F.lane] = k0[rr] * rk; sK[i * 128 + 64 + F.lane] = k1[rr] * rk; }
    }
    __syncthreads();
    TS_END(3)
    TS_BEGIN(4)
    {
        const int i = F.tid >> 3, cb = (F.tid & 7) * 16;
        f32x4 q[4], k[4];
#pragma unroll
        for (int t = 0; t < 4; ++t) { q[t] = *(LAS f32x4*)(sQ + i * 128 + cb + 4 * t); k[t] = *(LAS f32x4*)(sK + i * 128 + cb + 4 * t); }
        *(LAS v4u*)(sQb + i * 136 + cb) = cpk8(q[0].x, q[0].y, q[0].z, q[0].w, q[1].x, q[1].y, q[1].z, q[1].w);
        *(LAS v4u*)(sQb + i * 136 + cb + 8) = cpk8(q[2].x, q[2].y, q[2].z, q[2].w, q[3].x, q[3].y, q[3].z, q[3].w);
        *(LAS v4u*)(sKb + i * 136 + cb) = cpk8(k[0].x, k[0].y, k[0].z, k[0].w, k[1].x, k[1].y, k[1].z, k[1].w);
        *(LAS v4u*)(sKb + i * 136 + cb + 8) = cpk8(k[2].x, k[2].y, k[2].z, k[2].w, k[3].x, k[3].y, k[3].z, k[3].w);
    }
#pragma unroll
    for (int it = 0; it < 2; ++it) {
        const int item = F.tid + 512 * it, dk = item & 127, jb = item >> 7;
        float kv[8];
#pragma unroll
        for (int jj = 0; jj < 8; ++jj) kv[jj] = sK[(8 * jb + jj) * 128 + dk];
        *(LAS v4u*)(sKt + DN_CM(dk, 8 * jb)) = cpk8(kv[0], kv[1], kv[2], kv[3], kv[4], kv[5], kv[6], kv[7]);
    }
    __syncthreads();
    TS_END(4)
    TS_BEGIN(5)
    {
        const int mat = F.wave >> 2, ti = (F.wave >> 1) & 1, tj = F.wave & 1, r = F.lane & 31, hh = F.lane >> 5;
        f32x16 acc;
#pragma unroll
        for (int e = 0; e < 16; ++e) acc[e] = 0.f;
        if (!(ti == 0 && tj == 1)) {
            const LAS bf16* Ab = sKb + (32 * (mat ? tj : ti) + r) * 136 + 8 * hh;
            const LAS bf16* Bb = (mat ? sQb + (32 * ti + r) * 136 : sKb + (32 * tj + r) * 136) + 8 * hh;
#pragma unroll
            for (int s = 0; s < 8; ++s) { const bf16x8 a = *(const LAS bf16x8*)(Ab + 16 * s), bb = *(const LAS bf16x8*)(Bb + 16 * s); acc = MFMA32(a, bb, acc); }
        }
        if (mat == 0) {
            const int j = 32 * tj + r; const float gj = sGam[j];
#pragma unroll
            for (int g = 0; g < 4; ++g) { const int i0 = 32 * ti + 8 * g + 4 * hh; f32x4 o;
#pragma unroll
                for (int q = 0; q < 4; ++q) { const int i = i0 + q; o[q] = (j < i) ? sBeta[i] * acc[4 * g + q] * __expf(sGam[i] - gj) : 0.f; }
                *(LAS f32x4*)(sA + j * 64 + i0) = o; }
        } else {
            const int i = 32 * ti + r; const float gi = sGam[i];
            float v[16];
#pragma unroll
            for (int e = 0; e < 16; ++e) { const int j = 32 * tj + crow(e, hh); v[e] = (j <= i) ? acc[e] * __expf(gi - sGam[j]) : 0.f; }
            bf16* qk = rec + REC_QK / 2 + ((ti * 2 + tj) * 2) * 512 + F.lane * 8;
            DN_ST16(qk, cpk8(v[0], v[1], v[2], v[3], v[4], v[5], v[6], v[7]));
            DN_ST16(qk + 512, cpk8(v[8], v[9], v[10], v[11], v[12], v[13], v[14], v[15]));
        }
    }
    __syncthreads();
    TS_END(5)
    TS_BEGIN(6)
    if (F.wave < 4) {
        const int g = F.tid >> 2, h4 = F.tid & 3;
        f32x4 au[4];
#pragma unroll
        for (int q = 0; q < 4; ++q)
#pragma unroll
            for (int e = 0; e < 4; ++e) au[q][e] = (16 * q + 4 * h4 + e == g) ? 1.0f : 0.0f;
        { f32x4 c0[4], c1[4]; dn_load_col<0>(c0, sA + 4 * h4, au[0]); dn_load_col<1>(c1, sA + 4 * h4, au[0]); dn_solve_cols1<0>(au, sA + 4 * h4, c0, c1); }
        const float bu = sBeta[g], eu = bu * sEg[g];
#pragma unroll
        for (int q = 0; q < 4; ++q)
#pragma unroll
            for (int e = 0; e < 4; ++e) { const int i = 16 * q + 4 * h4 + e;
                sTu[i * 72 + g] = (bf16)(cpk2(au[q][e] * bu, 0.f) & 0xffffu); sTw[i * 72 + g] = (bf16)(cpk2(au[q][e] * eu, 0.f) & 0xffffu); }
    } else {
        for (int item = F.tid - 256; item < 2048; item += 256) {
            const int f = (item >> 6) & 15, ln = item & 63, r = ln & 31, hh = ln >> 5;
            if (item < 1024) {
                const int rt = f >> 3, kt = (f >> 1) & 3, s_ = f & 1, i = 32 * rt + r, d0 = 32 * kt + 16 * s_ + 4 * hh;
                const float eg = sEg[i];
                const f32x4 a = *(LAS f32x4*)(sQ + i * 128 + d0), c = *(LAS f32x4*)(sQ + i * 128 + d0 + 8);
                DN_ST16(rec + REC_QD / 2 + f * 512 + ln * 8, cpk8(a.x * eg, a.y * eg, a.z * eg, a.w * eg, c.x * eg, c.y * eg, c.z * eg, c.w * eg));
            } else {
                const int a = f >> 2, t = (f >> 1) & 1, s_ = f & 1, dk = 32 * a + r, j0 = 32 * t + 16 * s_ + 4 * hh;
                float kv[8];
#pragma unroll
                for (int jj = 0; jj < 8; ++jj) { const int j = j0 + 8 * (jj >> 2) + (jj & 3); kv[jj] = sK[j * 128 + dk] * sEd[j]; }
                DN_ST16(rec + REC_KDT / 2 + f * 512 + ln * 8, cpk8(kv[0], kv[1], kv[2], kv[3], kv[4], kv[5], kv[6], kv[7]));
            }
        }
    }
    __syncthreads();
    TS_END(6)
    TS_BEGIN(7)
    {
        const int r = F.lane & 31, hh = F.lane >> 5;
        {
            const int t = F.wave & 1, wv = F.wave >> 1;
            f32x16 acc;
#pragma unroll
            for (int e = 0; e < 16; ++e) acc[e] = 0.f;
#pragma unroll
            for (int ks = 0; ks < 4; ++ks) { const bf16x8 a = *(const LAS bf16x8*)(sTu + (32 * t + r) * 72 + 16 * ks + 8 * hh), bb = *(const LAS bf16x8*)(sVt + DN_CM(32 * wv + r, 16 * ks + 8 * hh)); acc = MFMA32(a, bb, acc); }
            bf16* up = Uo + (wv * 2 + t) * 1024 + F.lane * 8;
            DN_ST16(up, cpk8(acc[0], acc[1], acc[2], acc[3], acc[4], acc[5], acc[6], acc[7])); DN_ST16(up + 512, cpk8(acc[8], acc[9], acc[10], acc[11], acc[12], acc[13], acc[14], acc[15]));
        }
        {
            const int a = F.wave >> 1, ti = F.wave & 1;
            f32x16 acc;
#pragma unroll
            for (int e = 0; e < 16; ++e) acc[e] = 0.f;
#pragma unroll
            for (int ks = 0; ks < 4; ++ks) { const bf16x8 ka = *(const LAS bf16x8*)(sKt + DN_CM(32 * a + r, 16 * ks + 8 * hh)), tb = *(const LAS bf16x8*)(sTw + (32 * ti + r) * 72 + 16 * ks + 8 * hh); acc = MFMA32(ka, tb, acc); }
            bf16* wp = rec + REC_W / 2 + ((ti * 4 + a) * 2) * 512 + F.lane * 8;
            DN_ST16(wp, cpk8(acc[0], acc[1], acc[2], acc[3], acc[4], acc[5], acc[6], acc[7])); DN_ST16(wp + 512, cpk8(acc[8], acc[9], acc[10], acc[11], acc[12], acc[13], acc[14], acc[15]));
        }
    }
    asm volatile("s_waitcnt vmcnt(0)" ::: "memory");
    __syncthreads();
    if (F.tid == 0) __hip_atomic_store(flags + cu, 1u, __ATOMIC_RELAXED, __HIP_MEMORY_SCOPE_AGENT);
    TS_END(7)
  }
}

#define DN_BAR() do { asm volatile("s_waitcnt lgkmcnt(0)" ::: "memory"); __builtin_amdgcn_s_barrier(); asm volatile("" ::: "memory"); } while (0)
__device__ __forceinline__ void dn_scan(Frame& F, int l, int bh, unsigned* flags) {
    LAS unsigned char* ring = F.lds;
    const unsigned char* recs = F.ws + WS_REC + (size_t)(bh * 64) * REC_BYTES;
    if (F.wave >= 4) {
        const int v = F.wave - 4;
#define DN_DMA(n_) do { const unsigned char* src_ = recs + (size_t)(n_) * REC_BYTES + v * 1024 + F.lane * 16; LAS unsigned char* dst_ = ring + ((n_) & 1) * (int)REC_BYTES + v * 1024; \
        _Pragma("unroll") for (int q_ = 0; q_ < 19; ++q_) if (v + 4 * q_ < 73) __builtin_amdgcn_global_load_lds((const unsigned*)(src_ + q_ * 4096), (LAS unsigned*)(dst_ + q_ * 4096), 16, 0, 16  ); } while (0)
#define DN_WAITREC(n_) do { unsigned sp_ = 0; while (__builtin_amdgcn_readfirstlane(__hip_atomic_load(flags + bh * 64 + (n_), __ATOMIC_RELAXED, __HIP_MEMORY_SCOPE_AGENT)) == 0u) { \
            __builtin_amdgcn_s_sleep(2); if (++sp_ > (1u << 21)) break; } asm volatile("" ::: "memory"); } while (0)
        DN_WAITREC(0); DN_DMA(0);
        asm volatile("s_waitcnt vmcnt(0)" ::: "memory");
        DN_BAR();
        for (int n = 0; n < 64; ++n) {
            if (n + 1 < 64) { DN_WAITREC(n + 1); DN_DMA(n + 1); }
            asm volatile("s_waitcnt vmcnt(0)" ::: "memory");
            DN_BAR();
        }
#undef DN_DMA
#undef DN_WAITREC
    } else {
        const int w = F.wave;
        f32x16 S0, S1, S2, S3;
#pragma unroll
        for (int e = 0; e < 16; ++e) { S0[e] = 0.f; S1[e] = 0.f; S2[e] = 0.f; S3[e] = 0.f; }
        bf16* Ob = (bf16*)(F.ws + WS_O) + (size_t)(bh * 64) * 8192 + (w * 2) * 1024 + F.lane * 8;
        DN_BAR();
        for (int n = 0; n < 64; ++n) {
            const LAS unsigned char* buf = ring + (n & 1) * (int)REC_BYTES + F.lane * 16;
            const float cd = *(const LAS float*)(ring + (n & 1) * (int)REC_BYTES + REC_CD);
#define DN_A(off_, f_) (*(const LAS bf16x8*)(buf + (off_) + (f_) * 1024))
#define DN_FENCE() __builtin_amdgcn_sched_barrier(0)
            f32x16 W0, W1, Q0, Q1;
#pragma unroll
            for (int e = 0; e < 16; ++e) { W0[e] = 0.f; W1[e] = 0.f; Q0[e] = 0.f; Q1[e] = 0.f; }
            const v4u u00 = *(const LAS v4u*)(buf + REC_U + (w * 2 + 0) * 2048), u01 = *(const LAS v4u*)(buf + REC_U + (w * 2 + 0) * 2048 + 1024);
            const v4u u10 = *(const LAS v4u*)(buf + REC_U + (w * 2 + 1) * 2048), u11 = *(const LAS v4u*)(buf + REC_U + (w * 2 + 1) * 2048 + 1024);
            bf16x8 fa0, fa1, fa2, fa3, fb0, fb1, fb2, fb3;
#define DN_LDK(d0, d1, d2, d3, a_, s_) do { d0 = DN_A(REC_W, (0 * 4 + (a_)) * 2 + (s_)); d1 = DN_A(REC_W, (1 * 4 + (a_)) * 2 + (s_)); d2 = DN_A(REC_QD, (0 * 4 + (a_)) * 2 + (s_)); d3 = DN_A(REC_QD, (1 * 4 + (a_)) * 2 + (s_)); } while (0)
#define DN_MMK(d0, d1, d2, d3, Sa_, s_) do { const bf16x8 sb_ = pack_step(Sa_, s_); W0 = MFMA32(d0, sb_, W0); W1 = MFMA32(d1, sb_, W1); Q0 = MFMA32(d2, sb_, Q0); Q1 = MFMA32(d3, sb_, Q1); } while (0)
            DN_LDK(fa0, fa1, fa2, fa3, 0, 0); DN_FENCE();
            DN_LDK(fb0, fb1, fb2, fb3, 0, 1); DN_FENCE(); DN_MMK(fa0, fa1, fa2, fa3, S0, 0); DN_FENCE();
            DN_LDK(fa0, fa1, fa2, fa3, 1, 0); DN_FENCE(); DN_MMK(fb0, fb1, fb2, fb3, S0, 1); DN_FENCE();
            DN_LDK(fb0, fb1, fb2, fb3, 1, 1); DN_FENCE(); DN_MMK(fa0, fa1, fa2, fa3, S1, 0); DN_FENCE();
            DN_LDK(fa0, fa1, fa2, fa3, 2, 0); DN_FENCE(); DN_MMK(fb0, fb1, fb2, fb3, S1, 1); DN_FENCE();
            DN_LDK(fb0, fb1, fb2, fb3, 2, 1); DN_FENCE(); DN_MMK(fa0, fa1, fa2, fa3, S2, 0); DN_FENCE();
            DN_LDK(fa0, fa1, fa2, fa3, 3, 0); DN_FENCE(); DN_MMK(fb0, fb1, fb2, fb3, S2, 1); DN_FENCE();
            DN_LDK(fb0, fb1, fb2, fb3, 3, 1); DN_FENCE(); DN_MMK(fa0, fa1, fa2, fa3, S3, 0); DN_FENCE();
            fa0 = DN_A(REC_QK, (0 * 2 + 0) * 2 + 0); fa1 = DN_A(REC_QK, (0 * 2 + 0) * 2 + 1); fa2 = DN_A(REC_QK, (0 * 2 + 1) * 2 + 0); fa3 = DN_A(REC_QK, (0 * 2 + 1) * 2 + 1); DN_FENCE();
            DN_MMK(fb0, fb1, fb2, fb3, S3, 1); DN_FENCE();
#undef DN_LDK
#undef DN_MMK
            {
                const unsigned uu0[8] = {u00.x, u00.y, u00.z, u00.w, u01.x, u01.y, u01.z, u01.w}, uu1[8] = {u10.x, u10.y, u10.z, u10.w, u11.x, u11.y, u11.z, u11.w};
#pragma unroll
                for (int e = 0; e < 16; ++e) { const unsigned a0 = uu0[e >> 1], a1 = uu1[e >> 1];
                    W0[e] = ((e & 1) ? __uint_as_float(a0 & 0xffff0000u) : __uint_as_float(a0 << 16)) - W0[e];
                    W1[e] = ((e & 1) ? __uint_as_float(a1 & 0xffff0000u) : __uint_as_float(a1 << 16)) - W1[e]; }
            }
            const bf16x8 ub00 = pack_step(W0, 0), ub01 = pack_step(W0, 1), ub10 = pack_step(W1, 0), ub11 = pack_step(W1, 1);
            DN_FENCE();
            fb0 = DN_A(REC_QK, (1 * 2 + 0) * 2 + 0); fb1 = DN_A(REC_QK, (1 * 2 + 0) * 2 + 1); fb2 = DN_A(REC_QK, (1 * 2 + 1) * 2 + 0); fb3 = DN_A(REC_QK, (1 * 2 + 1) * 2 + 1); DN_FENCE();
            Q0 = MFMA32(fa0, ub00, Q0); Q0 = MFMA32(fa1, ub01, Q0); Q0 = MFMA32(fa2, ub10, Q0); Q0 = MFMA32(fa3, ub11, Q0); DN_FENCE();
#define DN_LDS_(d0, d1, d2, d3, a_) do { d0 = DN_A(REC_KDT, ((a_) * 2 + 0) * 2 + 0); d1 = DN_A(REC_KDT, ((a_) * 2 + 0) * 2 + 1); d2 = DN_A(REC_KDT, ((a_) * 2 + 1) * 2 + 0); d3 = DN_A(REC_KDT, ((a_) * 2 + 1) * 2 + 1); } while (0)
#define DN_SUPD(Sa_, d0, d1, d2, d3) do { Sa_ = MFMA32(d0, ub00, Sa_); Sa_ = MFMA32(d1, ub01, Sa_); Sa_ = MFMA32(d2, ub10, Sa_); Sa_ = MFMA32(d3, ub11, Sa_); } while (0)
            DN_LDS_(fa0, fa1, fa2, fa3, 0); DN_FENCE();
            Q1 = MFMA32(fb0, ub00, Q1); Q1 = MFMA32(fb1, ub01, Q1); Q1 = MFMA32(fb2, ub10, Q1); Q1 = MFMA32(fb3, ub11, Q1); DN_FENCE();
            S0 = S0 * cd; S1 = S1 * cd; S2 = S2 * cd; S3 = S3 * cd;
            DN_LDS_(fb0, fb1, fb2, fb3, 1); DN_FENCE(); DN_SUPD(S0, fa0, fa1, fa2, fa3); DN_FENCE();
            DN_LDS_(fa0, fa1, fa2, fa3, 2); DN_FENCE(); DN_SUPD(S1, fb0, fb1, fb2, fb3); DN_FENCE();
            DN_LDS_(fb0, fb1, fb2, fb3, 3); DN_FENCE(); DN_SUPD(S2, fa0, fa1, fa2, fa3); DN_FENCE();
            DN_SUPD(S3, fb0, fb1, fb2, fb3); DN_FENCE();
#undef DN_LDS_
#undef DN_SUPD
#undef DN_A
#undef DN_FENCE
            bf16* op = Ob + (size_t)n * 8192;
            *(v4u*)op = cpk8(Q0[0], Q0[1], Q0[2], Q0[3], Q0[4], Q0[5], Q0[6], Q0[7]); *(v4u*)(op + 512) = cpk8(Q0[8], Q0[9], Q0[10], Q0[11], Q0[12], Q0[13], Q0[14], Q0[15]);
            *(v4u*)(op + 1024) = cpk8(Q1[0], Q1[1], Q1[2], Q1[3], Q1[4], Q1[5], Q1[6], Q1[7]); *(v4u*)(op + 1536) = cpk8(Q1[8], Q1[9], Q1[10], Q1[11], Q1[12], Q1[13], Q1[14], Q1[15]);
            DN_BAR();
        }
    }
}
#undef DN_BAR

__device__ __forceinline__ void dn_finish_unit(Frame& F, int l, int cu, const bf16* P, bf16* MIX) {
    const int b = cu >> 8, h = (cu >> 6) & 3, n = cu & 63, m0 = b * SEQ + n * 64;
    LAS float* sO = (LAS float*)F.lds;
    {
        const int wt = F.wave, w = wt >> 1, t = wt & 1, r = F.lane & 31, hh = F.lane >> 5;
        const bf16* ip = (const bf16*)(F.ws + WS_O) + (size_t)cu * 8192 + wt * 1024 + F.lane * 8;
        const v4u a = *(const v4u*)ip, c = *(const v4u*)(ip + 512);
        const unsigned uu[8] = {a.x, a.y, a.z, a.w, c.x, c.y, c.z, c.w};
#pragma unroll
        for (int e = 0; e < 16; ++e) { const unsigned x = uu[e >> 1]; sO[(32 * t + crow(e, hh)) * 132 + 32 * w + r] = (e & 1) ? __uint_as_float(x & 0xffff0000u) : __uint_as_float(x << 16); }
    }
    __syncthreads();
    const float ng0 = F.inp(14)[l * 128 + 2 * F.lane], ng1 = F.inp(14)[l * 128 + 2 * F.lane + 1];
#pragma unroll
    for (int rr = 0; rr < 8; ++rr) {
        const int i = 8 * F.wave + rr;
        const f32x2_t o = *(const LAS f32x2_t*)(sO + i * 132 + 2 * F.lane);
        const unsigned g = *((const unsigned*)(P + (size_t)(m0 + i) * NP + 2560 + h * 128) + F.lane);
        const float rs = __builtin_amdgcn_rsqf(wave_sum(o.x * o.x + o.y * o.y) * (1.0f / 128.0f) + EPS);
        const float g0 = __uint_as_float(g << 16), g1 = __uint_as_float(g & 0xffff0000u);
        *((unsigned*)(MIX + (size_t)(m0 + i) * D + 512 + h * 128) + F.lane) = cpk2(o.x * rs * ng0 * (g0 * sigmoidf_(g0)), o.y * rs * ng1 * (g1 * sigmoidf_(g1)));
    }
    __syncthreads();
}
struct Args { const float* in[21]; float* out; unsigned char* ws; int ph_lo, ph_hi; };
constexpr int PH_PER_LAYER = 8, N_PHASES = 1 + PH_PER_LAYER * DEPTH;

#define RELAUNDER(Fx) do { asm volatile("" : "+v"((Fx).tid)); (Fx).lane = (Fx).tid & 63; (Fx).wave = __builtin_amdgcn_readfirstlane((Fx).tid >> 6); } while (0)
__device__ __forceinline__ void gemm_stagger(int us) {
    if (us > 0 && (blockIdx.x & 4)) { const unsigned long long t0 = __builtin_amdgcn_s_memrealtime(); while (__builtin_amdgcn_s_memrealtime() - t0 < (unsigned long long)us * 100ull) __builtin_amdgcn_s_sleep(8); }
}
__global__ void __launch_bounds__(NWAVES * 64, 2) mk_fwd(Args args) {
    extern __shared__ __attribute__((aligned(16))) unsigned char lds[];
    {
        volatile LAS unsigned* MISC0 = (volatile LAS unsigned*)((LAS unsigned char*)lds + MISC_OFF);
        if (threadIdx.x < 32) MISC0[threadIdx.x] = 0u;
    }
    __syncthreads();
    const int lo = args.ph_lo, hi = args.ph_hi;
    XcdBarrier bar; bar.bar = (unsigned*)(args.ws + WS_CTL) + CW_BAR; bar.x = 0; bar.st = nullptr;
    if (hi - lo > 1) bar = xcd_barrier_post((unsigned*)(args.ws + WS_CTL) + CW_BAR, (volatile LAS unsigned*)((LAS unsigned char*)lds + MISC_OFF) + 8);

    for (int ph = lo; ph < hi; ++ph) {
      for (int rep = 0; rep < 2; ++rep) {
        if (rep == 1 && !((ph > 0 && ((MK_REP >> ((ph - 1) % PH_PER_LAYER)) & 1) && !(((ph - 1) % PH_PER_LAYER) == 7 && ph > PH_PER_LAYER)) || (ph == 0 && (MK_REP & 512)))) break;
        int tid = threadIdx.x; asm volatile("" : "+v"(tid));
        Frame F;
        F.kp = (const AS4 unsigned char*)__builtin_amdgcn_kernarg_segment_ptr(); asm volatile("" : "+s"(F.kp));
        F.lds = (LAS unsigned char*)lds;
        F.tid = tid; F.lane = tid & 63; F.wave = __builtin_amdgcn_readfirstlane(tid >> 6);
        F.G = gridDim.x; { const int bx = blockIdx.x; F.vcu = (F.G % 8 == 0) ? (bx % 8) * (F.G / 8) + bx / 8 : bx; }
        F.out = *(float* const AS4*)(F.kp + 168); F.ws = *(unsigned char* const AS4*)(F.kp + 176);
        bf16* HN = (bf16*)F.out; bf16* MIX = HN; bf16* P = (bf16*)(F.ws + WS_P); bf16* HFF = P; bf16* XB = (bf16*)(F.ws + WS_XB);
        float* BA = (float*)(F.ws + WS_BA);
        if (ph == 0) {
            weights_phase(F);
            norm_phase<0, false>(F, F.inp(0), F.inp(1), HN, F.inp(2), BA, nullptr, XB);
        } else {
#ifdef MK_ONLY_K
            const int l = (ph - 1) / PH_PER_LAYER, k = MK_ONLY_K;
#else
            const int l = (ph - 1) / PH_PER_LAYER, k = (ph - 1) % PH_PER_LAYER;
#endif
            const unsigned char* wb = F.ws + WS_W + (size_t)l * W_LAYER;
            if (k == 0) {
                pg8::Gemm g{(const pg8::bf16_t*)HN, (const pg8::bf16_t*)(wb + W_IN_OFF), M, NP, D}; pg8::StaticOrder S; S.init(M, NP, F.G, (int)blockIdx.x);
                pg8::EpiBf16FL E{(pg8::bf16_t*)P, NP, rep ? MK_NOSTORE : 0};
                pg8::gemm_phase<pg8::EpiBf16FL, pg8::StaticOrder, true, true>(F.lds, g, S, E, tid);
            } else if (k == 1) {
                unsigned* flags = (unsigned*)(F.ws + WS_CTL) + CW_FLAGS + l * NCHUNK;
                const int sub = rep ? MK_REPSUB : MK_SUB;
                if ((int)blockIdx.x < BATCH * 4) { if (sub & 1) dn_scan(F, l, (int)blockIdx.x, flags); }
                else {
                    if (sub & 1) dn_chunk_units(F, l, (int)blockIdx.x - BATCH * 4, F.G - BATCH * 4, P, BA, 9, flags);
                    const int gq = (int)blockIdx.x - BATCH * 4, nq = F.G - BATCH * 4, extra = NCHUNK - (NCHUNK / nq) * nq;
                    if ((sub & 2) && gq >= extra) for (int v = gq - extra; v < M / 128 + M / 64; v += nq - extra) { Frame Fu = F; RELAUNDER(Fu);
                        if (v < M / 128) gmlp_unit(Fu, l, v, P, MIX); else conv_unit(Fu, l, v - M / 128, P, MIX); }
                }
            } else if (k == 2) {
                for (int u = blockIdx.x; u < NCHUNK; u += F.G) { Frame Fu = F; RELAUNDER(Fu); dn_finish_unit(Fu, l, u, P, MIX); }
            } else if (k == 3 || k == 6) {
                pg8::Gemm g{(const pg8::bf16_t*)(k == 3 ? MIX : HFF), (const pg8::bf16_t*)(wb + (k == 3 ? W_O_OFF : W_D_OFF)), M, D, k == 3 ? D : DFF}; pg8::StaticOrder S; S.init(M, D, F.G, (int)blockIdx.x);
                pg8::EpiResB E{(const pg8::bf16_t*)XB, rep ? (pg8::bf16_t*)(F.ws + WS_REC) : (pg8::bf16_t*)XB, D};
                pg8::gemm_phase<pg8::EpiResB, pg8::StaticOrder, true, true>(F.lds, g, S, E, tid);
            } else if (k == 4) {
                norm_phase<0, true>(F, XB, F.inp(16) + l * D, HN, nullptr, nullptr, nullptr, nullptr);
            } else if (k == 5) {
                pg8::Gemm g{(const pg8::bf16_t*)HN, (const pg8::bf16_t*)(wb + W_GU_OFF), M, 2 * DFF, D}; pg8::StaticOrder S; S.init(M, 2 * DFF, F.G, (int)blockIdx.x);
                pg8::EpiSwiGLU E{(pg8::bf16_t*)HFF, DFF};
                gemm_stagger(MK_STAG_GU);
                pg8::gemm_phase<pg8::EpiSwiGLU, pg8::StaticOrder, true, true>(F.lds, g, S, E, tid);
            } else {
                if (l + 1 < DEPTH) norm_phase<0, true>(F, XB, F.inp(1) + (l + 1) * D, HN, F.inp(2) + (size_t)(l + 1) * D * DPROJ, BA, nullptr, nullptr);
                else norm_phase<1, true>(F, XB, F.inp(20), nullptr, nullptr, nullptr, F.out, nullptr);
            }
        }
      }
        if (ph + 1 < hi) { xcd_barrier(bar); for (int xb = 0; xb < MK_XBAR; ++xb) xcd_barrier(bar); }
    }
}

#ifndef MK_SINGLE
#define MK_SINGLE 0
#endif

extern "C" void kernel_launch(void* const* d_in, const int* in_sizes, int n_in, void* d_out, int out_size, void* d_ws, size_t ws_size, hipStream_t stream) {
    static int grid = 0;
    if (grid == 0) {
        if (n_in != 21 || in_sizes[0] != M * D || out_size != M * D || ws_size < WS_END) { fprintf(stderr, "kernel_launch: unexpected shapes (n_in %d, in0 %d, out %d, ws %zu)\n", n_in, n_in > 0 ? in_sizes[0] : -1, out_size, ws_size); grid = -1; return; }
        int dev = 0, cus = 0, per_cu = 0;
        if (hipGetDevice(&dev) != hipSuccess || hipDeviceGetAttribute(&cus, hipDeviceAttributeMultiprocessorCount, dev) != hipSuccess) { grid = -1; return; }
        if (hipFuncSetAttribute((const void*)mk_fwd, hipFuncAttributeMaxDynamicSharedMemorySize, LDS_BYTES) != hipSuccess) { fprintf(stderr, "kernel_launch: hipFuncSetAttribute failed\n"); grid = -1; return; }
        if (hipOccupancyMaxActiveBlocksPerMultiprocessor(&per_cu, (const void*)mk_fwd, NWAVES * 64, LDS_BYTES) != hipSuccess || per_cu < 1) { fprintf(stderr, "kernel_launch: occupancy query says %d blocks per CU\n", per_cu); per_cu = 1; }
        (void)hipGetLastError();
        grid = cus;
        if (grid % 8 != 0 || grid < 32) fprintf(stderr, "kernel_launch: unexpected CU count %d\n", grid);
    }
    if (grid < 0) return;
    (void)hipMemsetAsync((char*)d_ws + WS_CTL, 0, CTL_ZERO_BYTES, stream);
    Args a{};
    for (int i = 0; i < 21; ++i) a.in[i] = (const float*)d_in[i];
    a.out = (float*)d_out; a.ws = (unsigned char*)d_ws;
#if MK_SINGLE
    a.ph_lo = 0; a.ph_hi = N_PHASES;
    hipLaunchKernelGGL(mk_fwd, dim3(grid), dim3(NWAVES * 64), LDS_BYTES, stream, a);
#else
    for (int ph = 0; ph < MK_PH_HI; ++ph) { a.ph_lo = ph; a.ph_hi = ph + 1; hipLaunchKernelGGL(mk_fwd, dim3(grid), dim3(NWAVES * 64), LDS_BYTES, stream, a); }
#endif
}
```

```cpp
#include <hip/hip_runtime.h>
#include <cstdio>
#include <cstdint>
#include <cmath>
namespace pg8 {
#define PG8_LAS __attribute__((address_space(3)))
typedef unsigned short bf16_t;
typedef short bf16x8 __attribute__((ext_vector_type(8)));
typedef float f32x4 __attribute__((ext_vector_type(4)));
typedef unsigned u32x4 __attribute__((ext_vector_type(4)));
constexpr int BM = 256, BK = 64, HALF = 128, HTB = HALF * BK * 2  , STAGE_BYTES = 8 * HTB, NXCD = 8, WGM = 8;

__host__ __device__ __forceinline__ int lds_byte(int r, int c) { const int st = (r >> 4) * 2 + (c >> 5), rr = r & 15, cc = c & 31, ob = rr * 64 + cc * 2; return st * 1024 + (ob ^ (((ob >> 9) & 1) << 5)); }
__host__ __device__ __forceinline__ void stage_rc(int b, int& R, int& C) { const int st = b / 1024, sb = b % 1024, swz = sb ^ (((sb >> 9) & 1) << 5); R = (st >> 1) * 16 + swz / 64; C = (st & 1) * 32 + (swz % 64) / 2; }
__host__ __device__ __forceinline__ int perm32(int rho) { const int n = rho >> 4, i = rho & 15; return 8 * (i >> 2) + 4 * n + (i & 3); }

struct Unit { int pm, pn; };
struct Gemm { const bf16_t* A; const bf16_t* Bt; int M, N, K; };

struct StaticOrder {
    int nM, nN, nwg, G, c;
    __host__ __device__ void init(int M, int N, int G_, int c_) { nM = M / BM; nN = N / BM; nwg = nM * nN; G = G_; c = c_; }
    __host__ __device__ bool next(int i, Unit& u) const {
        const long L = (long)i * G + c; if (L >= nwg) return false;
        int wgid = (int)L; { const int q = nwg / NXCD, r = nwg % NXCD, xcd = wgid % NXCD, off = wgid / NXCD; wgid = (xcd < r ? xcd * (q + 1) : r * (q + 1) + (xcd - r) * q) + off; }
        const int nig = WGM * nN, gid = wgid / nig, fm = gid * WGM, gsz = (nM - fm) < WGM ? (nM - fm) : WGM;
        u.pm = fm + ((wgid % nig) % gsz); u.pn = (wgid % nig) / gsz; return true;
    }
    __device__ __forceinline__ void a_ready(const Unit&) const {}
    __device__ __forceinline__ void done(const Unit&) const {}
};

typedef __bf16 bf16v2p __attribute__((ext_vector_type(2))); typedef float f32v2p __attribute__((ext_vector_type(2)));
__device__ __forceinline__ unsigned cvt_pk_bf16(float lo, float hi) { const f32v2p v = {lo, hi}; return __builtin_bit_cast(unsigned, __builtin_convertvector(v, bf16v2p)); }
typedef float f32x2 __attribute__((ext_vector_type(2)));
__device__ __forceinline__ f32x2 gelu_pk(f32x2 v) {
    const f32x2 av = __builtin_elementwise_abs(v), d = av * 0.2316418882f + 1.0f;
    f32x2 t; t.x = __builtin_amdgcn_rcpf(d.x); t.y = __builtin_amdgcn_rcpf(d.y);
    f32x2 q = t * 0.5307027145f + (-0.7265760135f); q = q * t + 0.7107068705f; q = q * t + (-0.142248368f); q = q * t + 0.127414796f; q = q * t;
    const f32x2 s = (v * v) * (-0.72134752044f);
    f32x2 e; e.x = __builtin_amdgcn_exp2f(s.x); e.y = __builtin_amdgcn_exp2f(s.y);
    const f32x2 m = v * (q * e), r = v - m;
    f32x2 o; o.x = v.x < 0.f ? m.x : r.x; o.y = v.y < 0.f ? m.y : r.y; return o;
}

template <int ACT  > struct EpiBf16 {
    static constexpr bool PERM = true, AFTER_DRAIN = false; static_assert(ACT == 0 || ACT == 1, "EpiBf16: ACT is 0 (none) or 1 (gelu_pk)");
    bf16_t* O; int ldc; const float* bias; int split_cols; size_t split_stride; float scale0;
    __device__ __forceinline__ void operator()(const f32x4 (&acc)[2][2][4][2], const Unit& u, int wr, int wc, int fr, int fq) const {
        const int row0 = u.pm * BM + wr * 64 + fr; int colt = u.pn * BM; bf16_t* base = O;
        float sc = 1.f; if (split_cols) { const int t = colt / split_cols; base += (size_t)t * split_stride; colt -= t * split_cols; if (t == 0) sc = scale0; }
        const int col0 = colt + wc * 32 + 8 * fq, bcol0 = u.pn * BM + wc * 32 + 8 * fq;
        f32x4 bv[2][2];
#pragma unroll
        for (int bj = 0; bj < 2; ++bj)
#pragma unroll
            for (int n = 0; n < 2; ++n) bv[bj][n] = bias ? *(const f32x4*)(bias + bcol0 + bj * HALF + 4 * n) : (f32x4){0.f, 0.f, 0.f, 0.f};
#pragma unroll
        for (int ai = 0; ai < 2; ++ai)
#pragma unroll
            for (int m = 0; m < 4; ++m) { bf16_t* rowp = base + (size_t)(row0 + ai * HALF + m * 16) * ldc + col0;
#pragma unroll
                for (int bj = 0; bj < 2; ++bj) { f32x4 v0 = acc[ai][bj][m][0] + bv[bj][0], v1 = acc[ai][bj][m][1] + bv[bj][1];
                    if (ACT == 1) { f32x2 a = gelu_pk((f32x2){v0[0], v0[1]}), b = gelu_pk((f32x2){v0[2], v0[3]}), c = gelu_pk((f32x2){v1[0], v1[1]}), d = gelu_pk((f32x2){v1[2], v1[3]});
                        v0 = (f32x4){a.x, a.y, b.x, b.y}; v1 = (f32x4){c.x, c.y, d.x, d.y}; }
                    v0 = v0 * sc; v1 = v1 * sc; u32x4 w; w.x = cvt_pk_bf16(v0[0], v0[1]); w.y = cvt_pk_bf16(v0[2], v0[3]); w.z = cvt_pk_bf16(v1[0], v1[1]); w.w = cvt_pk_bf16(v1[2], v1[3]);
                    *(u32x4*)(rowp + bj * HALF) = w; } }
    }
};
struct EpiRes {
    static constexpr bool PERM = false, AFTER_DRAIN = false;
    const float* base; float* out; int ldc; int noread;
    __device__ __forceinline__ void operator()(const f32x4 (&acc)[2][2][4][2], const Unit& u, int wr, int wc, int fr, int fq) const {
        const bool hi = fr >= 8;
        const int row0 = u.pm * BM + wr * 64 + (fr & 7), col0 = u.pn * BM + wc * 32 + 4 * fq + (hi ? 16 : 0);
#pragma unroll
        for (int ai = 0; ai < 2; ++ai) {
            f32x4 bA[4][2], bB[4][2];
#pragma unroll
            for (int m = 0; m < 4; ++m)
#pragma unroll
                for (int bj = 0; bj < 2; ++bj) { const size_t oA = (size_t)(row0 + ai * HALF + m * 16) * ldc + col0 + bj * HALF, oB = oA + (size_t)8 * ldc;
                    bA[m][bj] = (f32x4){0.f, 0.f, 0.f, 0.f}; bB[m][bj] = bA[m][bj]; if (!noread) { bA[m][bj] = *(const f32x4*)(base + oA); bB[m][bj] = *(const f32x4*)(base + oB); } }
            asm volatile("" ::: "memory");
#pragma unroll
            for (int m = 0; m < 4; ++m)
#pragma unroll
                for (int bj = 0; bj < 2; ++bj) { const size_t oA = (size_t)(row0 + ai * HALF + m * 16) * ldc + col0 + bj * HALF, oB = oA + (size_t)8 * ldc;
                    const f32x4 v0 = acc[ai][bj][m][0], v1 = acc[ai][bj][m][1];
                    f32x4 dA, dB;
#define EPI_XCH(e_) { const float s_ = hi ? v0[e_] : v1[e_]; const float r_ = __builtin_bit_cast(float, __builtin_amdgcn_update_dpp(0, __builtin_bit_cast(int, s_), 0x128  , 0xF, 0xF, false)); \
                        dA[e_] = hi ? r_ : v0[e_]; dB[e_] = hi ? v1[e_] : r_; }
                    EPI_XCH(0) EPI_XCH(1) EPI_XCH(2) EPI_XCH(3)
#undef EPI_XCH
                    *(f32x4*)(out + oA) = bA[m][bj] + dA; *(f32x4*)(out + oB) = bB[m][bj] + dB; }
            asm volatile("" ::: "memory");
        }
    }
};
struct EpiSwiGLU {
    static constexpr bool PERM = true, AFTER_DRAIN = false;
    bf16_t* O; int ldo; int nostore; const PG8_LAS float* sS; int pm0;
    __device__ __forceinline__ void operator()(const f32x4 (&acc)[2][2][4][2], const Unit& u, int wr, int wc, int fr, int fq) const {
        const int row0 = u.pm * BM + wr * 64 + fr, col0 = u.pn * HALF + wc * 32 + 8 * fq;
        const PG8_LAS float* sp = sS + (u.pm - pm0) * BM + wr * 64 + fr;
#pragma unroll
        for (int ai = 0; ai < 2; ++ai)
#pragma unroll
            for (int m = 0; m < 4; ++m) { bf16_t* rowp = O + (size_t)(row0 + ai * HALF + m * 16) * ldo + col0;
                const float sc = sS ? sp[ai * HALF + m * 16] : 1.0f;
                float r[8];
#pragma unroll
                for (int n = 0; n < 2; ++n)
#pragma unroll
                    for (int e = 0; e < 4; ++e) { const float g = acc[ai][0][m][n][e] * sc, up = acc[ai][1][m][n][e] * sc; r[4 * n + e] = g * __builtin_amdgcn_rcpf(1.0f + __expf(-g)) * up; }
                u32x4 w; w.x = cvt_pk_bf16(r[0], r[1]); w.y = cvt_pk_bf16(r[2], r[3]); w.z = cvt_pk_bf16(r[4], r[5]); w.w = cvt_pk_bf16(r[6], r[7]);
                if (!nostore) *(u32x4*)rowp = w; else asm volatile("" :: "v"(w.x), "v"(w.y), "v"(w.z), "v"(w.w)); }
    }
};
struct EpiBf16FL {
    static constexpr bool PERM = true, AFTER_DRAIN = false;
    bf16_t* O; int ldc; int nostore; const PG8_LAS float* sS; int pm0;
    __device__ __forceinline__ void operator()(const f32x4 (&acc)[2][2][4][2], const Unit& u, int wr, int wc, int fr, int fq) const {
        const bool hi = fr >= 8;
        const int row0 = u.pm * BM + wr * 64 + (fr & 7), col0 = u.pn * BM + wc * 64 + 8 * fq + (hi ? 32 : 0);
        const PG8_LAS float* sp = sS + (u.pm - pm0) * BM + wr * 64 + fr;
#pragma unroll
        for (int ai = 0; ai < 2; ++ai)
#pragma unroll
            for (int m = 0; m < 4; ++m) { bf16_t* rowp = O + (size_t)(row0 + ai * HALF + m * 16) * ldc + col0;
                const float sc = sp[ai * HALF + m * 16];
                unsigned w0[4], w1[4], dA[4], dB[4];
#pragma unroll
                for (int q = 0; q < 2; ++q) { w0[2 * q] = cvt_pk_bf16(acc[ai][0][m][q][0] * sc, acc[ai][0][m][q][1] * sc); w0[2 * q + 1] = cvt_pk_bf16(acc[ai][0][m][q][2] * sc, acc[ai][0][m][q][3] * sc);
                                              w1[2 * q] = cvt_pk_bf16(acc[ai][1][m][q][0] * sc, acc[ai][1][m][q][1] * sc); w1[2 * q + 1] = cvt_pk_bf16(acc[ai][1][m][q][2] * sc, acc[ai][1][m][q][3] * sc); }
#define EPI_XCH(e_) { const unsigned s_ = hi ? w0[e_] : w1[e_]; const unsigned r_ = (unsigned)__builtin_amdgcn_update_dpp(0, (int)s_, 0x128  , 0xF, 0xF, false); dA[e_] = hi ? r_ : w0[e_]; dB[e_] = hi ? w1[e_] : r_; }
                EPI_XCH(0) EPI_XCH(1) EPI_XCH(2) EPI_XCH(3)
#undef EPI_XCH
                if (!nostore) { *(u32x4*)rowp = (u32x4){dA[0], dA[1], dA[2], dA[3]}; *(u32x4*)(rowp + (size_t)8 * ldc) = (u32x4){dB[0], dB[1], dB[2], dB[3]}; }
                else asm volatile("" :: "v"(dA[0]), "v"(dA[1]), "v"(dA[2]), "v"(dA[3]), "v"(dB[0]), "v"(dB[1]), "v"(dB[2]), "v"(dB[3])); }
    }
};
struct EpiResB {
    static constexpr bool PERM = true, AFTER_DRAIN = false;
    const bf16_t* base; bf16_t* out; int ldc; float* ssp;
    __device__ __forceinline__ void operator()(const f32x4 (&acc)[2][2][4][2], const Unit& u, int wr, int wc, int fr, int fq) const {
        const bool hi = fr >= 8;
        const int row0 = u.pm * BM + wr * 64 + (fr & 7), col0 = u.pn * BM + wc * 64 + 8 * fq + (hi ? 32 : 0);
        u32x4 bA_[2][4], bB_[2][4];
#pragma unroll
        for (int ai = 0; ai < 2; ++ai)
#pragma unroll
            for (int m = 0; m < 4; ++m) { const bf16_t* rp = base + (size_t)(row0 + ai * HALF + m * 16) * ldc + col0; bA_[ai][m] = *(const u32x4*)rp; bB_[ai][m] = *(const u32x4*)(rp + (size_t)8 * ldc); }
        asm volatile("" ::: "memory");
#pragma unroll
        for (int ai = 0; ai < 2; ++ai) {
            float pA[4], pB[4];
            const u32x4 (&bA)[4] = bA_[ai]; const u32x4 (&bB)[4] = bB_[ai];
#pragma unroll
            for (int m = 0; m < 4; ++m) {
                float sA[8], sB[8];
#define EPI_XCH(e_, n_, j_) { const float v0_ = acc[ai][0][m][n_][j_], v1_ = acc[ai][1][m][n_][j_]; const float s_ = hi ? v0_ : v1_; \
                    const float r_ = __builtin_bit_cast(float, __builtin_amdgcn_update_dpp(0, __builtin_bit_cast(int, s_), 0x128  , 0xF, 0xF, false)); sA[e_] = hi ? r_ : v0_; sB[e_] = hi ? v1_ : r_; }
                EPI_XCH(0, 0, 0) EPI_XCH(1, 0, 1) EPI_XCH(2, 0, 2) EPI_XCH(3, 0, 3) EPI_XCH(4, 1, 0) EPI_XCH(5, 1, 1) EPI_XCH(6, 1, 2) EPI_XCH(7, 1, 3)
#undef EPI_XCH
                u32x4 oA, oB; float qa = 0.f, qb = 0.f;
#pragma unroll
                for (int q = 0; q < 4; ++q) {
                    const float a0 = __builtin_bit_cast(float, bA[m][q] << 16) + sA[2 * q], a1 = __builtin_bit_cast(float, bA[m][q] & 0xffff0000u) + sA[2 * q + 1];
                    const float b0 = __builtin_bit_cast(float, bB[m][q] << 16) + sB[2 * q], b1 = __builtin_bit_cast(float, bB[m][q] & 0xffff0000u) + sB[2 * q + 1];
                    qa += a0 * a0 + a1 * a1; qb += b0 * b0 + b1 * b1;
                    oA[q] = cvt_pk_bf16(a0, a1); oB[q] = cvt_pk_bf16(b0, b1); }
                pA[m] = qa; pB[m] = qb;
                bf16_t* wp = out + (size_t)(row0 + ai * HALF + m * 16) * ldc + col0;
                *(u32x4*)wp = oA; *(u32x4*)(wp + (size_t)8 * ldc) = oB; }
            asm volatile("" ::: "memory");
            if (ssp)
#pragma unroll
            for (int m = 0; m < 4; ++m) {
                float a = pA[m], b = pB[m]; asm volatile("" : "+v"(a), "+v"(b));
                a += __builtin_bit_cast(float, __builtin_amdgcn_update_dpp(0, __builtin_bit_cast(int, a), 0x128  , 0xF, 0xF, false));
                b += __builtin_bit_cast(float, __builtin_amdgcn_update_dpp(0, __builtin_bit_cast(int, b), 0x128, 0xF, 0xF, false));
                a += __shfl_xor(a, 16); b += __shfl_xor(b, 16); a += __shfl_xor(a, 32); b += __shfl_xor(b, 32);
                if (fq == 0 && !hi) { float* sp = ssp + (size_t)(row0 + ai * HALF + m * 16) * 16 + u.pn * 4 + wc; sp[0] = a; sp[8 * 16] = b; } }
        }
    }
};
template <class Sched>
__device__ __forceinline__ int rs_prologue(const Sched& S, const float* ssp, PG8_LAS float* sS, int nslots, float inv_d, float eps, int tid) {
    Unit u; if (!S.next(0, u)) return 0;
    const int pm0 = u.pm - (WGM - 1);
    unsigned done = 0;
    for (int i = 0; S.next(i, u); ++i) { const int slot = u.pm - pm0; if (slot < 0 || slot >= nslots || ((done >> slot) & 1u)) continue; done |= 1u << slot;
        const f32x4* p = (const f32x4*)(ssp + (size_t)(u.pm * BM + (tid >> 1)) * 16 + (tid & 1) * 8); const f32x4 a = p[0], b = p[1];
        float s = ((a[0] + a[1]) + (a[2] + a[3])) + ((b[0] + b[1]) + (b[2] + b[3])); asm volatile("" : "+v"(s));
        const float o = __builtin_bit_cast(float, __builtin_amdgcn_update_dpp(0, __builtin_bit_cast(int, s), 0xB1  , 0xF, 0xF, false));
        const float t = (tid & 1) ? o + s : s + o;
        if (!(tid & 1)) sS[slot * BM + (tid >> 1)] = __builtin_amdgcn_rsqf(t * inv_d + eps); }
    __syncthreads();
    return pm0;
}
template <class Epi, class Sched, bool ALIGN_EPI = false, bool SP2 = false>
__device__ __forceinline__ void gemm_phase(PG8_LAS unsigned char* lds, const Gemm g, const Sched& S, const Epi& E, const int tid) {
    const int wid = __builtin_amdgcn_readfirstlane(tid >> 6), lane = tid & 63, wr = wid >> 2, wc = wid & 3, fr = lane & 15, fq = lane >> 4;
    const int K = g.K, nt = K / BK;
    unsigned voffA[2], voffB[2];
#pragma unroll
    for (int i = 0; i < 2; ++i) { int R, C; stage_rc(tid * 16 + i * 8192, R, C); const int Rb = Epi::PERM ? ((R & ~31) + perm32(R & 31)) : R;
        voffA[i] = (unsigned)(R * K + C) * 2u; voffB[i] = (unsigned)(Rb * K + C) * 2u; }
    const size_t kstep = (size_t)(BK * 2);
    const size_t hstep = (size_t)HALF * K * 2;
    const size_t tstep = 2 * hstep;
    const unsigned ldsw = (unsigned)wid * 1024u;
    const int aoff = lds_byte(wr * 64 + fr, fq * 8), boff = lds_byte(wc * 32 + fr, fq * 8);
#define PG8_SA(b, h) (((b) * 2 + (h)) * HTB)
#define PG8_SB(b, h) ((4 + (b) * 2 + (h)) * HTB)
#define PG8_STAGE(bufoff, gbase, voff) do { _Pragma("unroll") for (int _i = 0; _i < 2; ++_i) \
        __builtin_amdgcn_global_load_lds((const unsigned*)((const char*)(gbase) + (voff)[_i]), (PG8_LAS unsigned*)(lds + (bufoff) + ldsw + _i * 8192), 16, 0, 0); } while (0)
#define PG8_LDA(dst, b, h) do { _Pragma("unroll") for (int m = 0; m < 4; ++m) _Pragma("unroll") for (int k = 0; k < 2; ++k) dst[m][k] = *(const PG8_LAS bf16x8*)(lds + PG8_SA(b, h) + aoff + m * 2048 + k * 1024); } while (0)
#define PG8_LDB(dst, b, h) do { _Pragma("unroll") for (int n = 0; n < 2; ++n) _Pragma("unroll") for (int k = 0; k < 2; ++k) dst[n][k] = *(const PG8_LAS bf16x8*)(lds + PG8_SB(b, h) + boff + n * 2048 + k * 1024); } while (0)
#define PG8_MMA(ai, bj, At, Bt) do { __builtin_amdgcn_s_setprio(1); _Pragma("unroll") for (int m = 0; m < 4; ++m) _Pragma("unroll") for (int n = 0; n < 2; ++n) _Pragma("unroll") for (int k = 0; k < 2; ++k) \
        acc[ai][bj][m][n] = __builtin_amdgcn_mfma_f32_16x16x32_bf16(Bt[n][k], At[m][k], acc[ai][bj][m][n], 0, 0, 0); __builtin_amdgcn_s_setprio(0); } while (0)
#define PG8_WAIT_V(n) asm volatile("s_waitcnt vmcnt(" #n ")" ::: "memory")
#define PG8_WAIT_L(n) asm volatile("s_waitcnt lgkmcnt(" #n ")" ::: "memory")
#define PG8_BAR __builtin_amdgcn_s_barrier()
#define PG8_SCHED __builtin_amdgcn_sched_barrier(0)
    Unit cur, nxt; int ui = 0;
    if (!S.next(0, cur)) return;
    f32x4 acc[2][2][4][2];
#pragma unroll
    for (int a = 0; a < 2; ++a)
#pragma unroll
        for (int b = 0; b < 2; ++b)
#pragma unroll
            for (int m = 0; m < 4; ++m)
#pragma unroll
                for (int n = 0; n < 2; ++n) acc[a][b][m][n] = (f32x4){0.f, 0.f, 0.f, 0.f};
    bf16x8 At[4][2], B0[2][2], B1[2][2];
    const char* cA = (const char*)g.A + (size_t)cur.pm * tstep; const char* cB = (const char*)g.Bt + (size_t)cur.pn * tstep;
    S.a_ready(cur);
    if constexpr (SP2) {
        PG8_STAGE(PG8_SB(0, 0), cB, voffB); PG8_STAGE(PG8_SB(0, 1), cB + hstep, voffB); PG8_STAGE(PG8_SA(0, 0), cA, voffA); PG8_STAGE(PG8_SA(0, 1), cA + hstep, voffA);
        if (wr == 1) PG8_BAR;
        PG8_WAIT_V(2); PG8_BAR;
        PG8_STAGE(PG8_SB(1, 0), cB + kstep, voffB); PG8_STAGE(PG8_SA(1, 0), cA + kstep, voffA); PG8_STAGE(PG8_SB(1, 1), cB + hstep + kstep, voffB);
        PG8_WAIT_V(6); PG8_BAR;
    } else {
        PG8_STAGE(PG8_SB(0, 0), cB, voffB); PG8_STAGE(PG8_SA(0, 0), cA, voffA); PG8_STAGE(PG8_SB(0, 1), cB + hstep, voffB); PG8_STAGE(PG8_SA(0, 1), cA + hstep, voffA);
        if (wr == 1) PG8_BAR;
        PG8_WAIT_V(4); PG8_BAR;
        PG8_STAGE(PG8_SB(1, 0), cB + kstep, voffB); PG8_STAGE(PG8_SA(1, 0), cA + kstep, voffA); PG8_STAGE(PG8_SB(1, 1), cB + hstep + kstep, voffB);
        PG8_WAIT_V(6); PG8_BAR;
    }
    for (;;) {
        const bool has_next = S.next(ui + 1, nxt);
        const char* nA = has_next ? (const char*)g.A + (size_t)nxt.pm * tstep : cA; const char* nB = has_next ? (const char*)g.Bt + (size_t)nxt.pn * tstep : cB;
        for (int t = 0; t < nt; t += 2) {
            const bool last = (t == nt - 2);
            const char* a1 = cA + (size_t)(t + 1) * kstep;
            const char* a2 = last ? nA : cA + (size_t)(t + 2) * kstep; const char* b2 = last ? nB : cB + (size_t)(t + 2) * kstep;
            const char* a3 = a2 + kstep; const char* b3 = b2 + kstep;
            if (last && has_next) S.a_ready(nxt);
            if constexpr (SP2) {
            PG8_LDB(B0, 0, 0); PG8_LDB(B1, 0, 1); PG8_SCHED; PG8_LDA(At, 0, 0); PG8_STAGE(PG8_SA(1, 1), a1 + hstep, voffA);
            PG8_WAIT_V(8); PG8_WAIT_L(0); PG8_BAR; PG8_MMA(0, 0, At, B0); PG8_MMA(0, 1, At, B1); PG8_BAR; PG8_SCHED;
            PG8_LDA(At, 0, 1); PG8_STAGE(PG8_SB(0, 0), b2, voffB); PG8_STAGE(PG8_SB(0, 1), b2 + hstep, voffB); PG8_STAGE(PG8_SA(0, 0), a2, voffA);
            PG8_WAIT_V(8); PG8_WAIT_L(0); PG8_BAR; PG8_MMA(1, 0, At, B0); PG8_MMA(1, 1, At, B1); PG8_BAR; PG8_SCHED;
            PG8_LDB(B0, 1, 0); PG8_LDB(B1, 1, 1); PG8_SCHED; PG8_LDA(At, 1, 0); PG8_STAGE(PG8_SA(0, 1), a2 + hstep, voffA);
            PG8_WAIT_V(8); PG8_WAIT_L(0); PG8_BAR; PG8_MMA(0, 0, At, B0); PG8_MMA(0, 1, At, B1); PG8_BAR; PG8_SCHED;
            PG8_LDA(At, 1, 1); PG8_STAGE(PG8_SB(1, 0), b3, voffB); PG8_STAGE(PG8_SB(1, 1), b3 + hstep, voffB); PG8_STAGE(PG8_SA(1, 0), a3, voffA);
            PG8_WAIT_V(8); PG8_WAIT_L(0); PG8_BAR; PG8_MMA(1, 0, At, B0); PG8_MMA(1, 1, At, B1); PG8_BAR; PG8_SCHED;
            } else {
            PG8_LDB(B0, 0, 0); PG8_SCHED; PG8_LDA(At, 0, 0); PG8_STAGE(PG8_SA(1, 1), a1 + hstep, voffA);
            PG8_WAIT_L(8); PG8_BAR; PG8_WAIT_L(0); PG8_MMA(0, 0, At, B0); PG8_BAR; PG8_SCHED;
            PG8_LDB(B1, 0, 1); PG8_STAGE(PG8_SB(0, 0), b2, voffB);
            PG8_BAR; PG8_WAIT_L(0); PG8_MMA(0, 1, At, B1); PG8_BAR;
            PG8_LDA(At, 0, 1); PG8_STAGE(PG8_SA(0, 0), a2, voffA);
            PG8_BAR; PG8_WAIT_L(0); PG8_MMA(1, 0, At, B0); PG8_BAR; PG8_SCHED;
            PG8_STAGE(PG8_SB(0, 1), b2 + hstep, voffB);
            PG8_WAIT_V(6); PG8_BAR; PG8_MMA(1, 1, At, B1); PG8_BAR;
            PG8_LDB(B0, 1, 0); PG8_SCHED; PG8_LDA(At, 1, 0); PG8_STAGE(PG8_SA(0, 1), a2 + hstep, voffA);
            PG8_WAIT_L(8); PG8_BAR; PG8_WAIT_L(0); PG8_MMA(0, 0, At, B0); PG8_BAR; PG8_SCHED;
            PG8_LDB(B1, 1, 1); PG8_STAGE(PG8_SB(1, 0), b3, voffB);
            PG8_BAR; PG8_WAIT_L(0); PG8_MMA(0, 1, At, B1); PG8_BAR;
            PG8_LDA(At, 1, 1); PG8_STAGE(PG8_SA(1, 0), a3, voffA);
            PG8_BAR; PG8_WAIT_L(0); PG8_MMA(1, 0, At, B0); PG8_BAR; PG8_SCHED;
            PG8_STAGE(PG8_SB(1, 1), b3 + hstep, voffB);
            PG8_WAIT_V(6); PG8_BAR; PG8_MMA(1, 1, At, B1); PG8_BAR;
            }
        }
        if constexpr (ALIGN_EPI) { if (wr == 0) PG8_BAR; }
        if constexpr (!Epi::AFTER_DRAIN) { E(acc, cur, wr, wc, fr, fq); S.done(cur); }
        if (!has_next) break;
#pragma unroll
        for (int a = 0; a < 2; ++a)
#pragma unroll
            for (int b = 0; b < 2; ++b)
#pragma unroll
                for (int m = 0; m < 4; ++m)
#pragma unroll
                    for (int n = 0; n < 2; ++n) acc[a][b][m][n] = (f32x4){0.f, 0.f, 0.f, 0.f};
        cur = nxt; cA = nA; cB = nB; ++ui;
        if constexpr (ALIGN_EPI) { if (wr == 1) PG8_BAR; }
    }
    PG8_WAIT_V(0);
    if constexpr (!ALIGN_EPI) { if (wr == 0) PG8_BAR; }
    PG8_BAR;
    if constexpr (Epi::AFTER_DRAIN) { E.fused(acc, cur, wr, wc, fr, fq, lds, wid, lane); S.done(cur); }
#undef PG8_SA
#undef PG8_SB
#undef PG8_STAGE
#undef PG8_LDA
#undef PG8_LDB
#undef PG8_MMA
#undef PG8_WAIT_V
#undef PG8_WAIT_L
#undef PG8_BAR
#undef PG8_SCHED
}
}
#define GAS __attribute__((address_space(1)))
#define LAS __attribute__((address_space(3)))
typedef unsigned short bf16;
typedef unsigned v4u __attribute__((ext_vector_type(4)));
typedef float f32x4 __attribute__((ext_vector_type(4)));
typedef short bf16x8 __attribute__((ext_vector_type(8)));
typedef GAS unsigned gu32;
typedef GAS unsigned long long gu64;
#define RLX_AGENT __ATOMIC_RELAXED, __HIP_MEMORY_SCOPE_AGENT
#define LDS_WAIT() asm volatile("s_waitcnt lgkmcnt(0)" ::: "memory")
#define VM_WAIT() asm volatile("s_waitcnt vmcnt(0)" ::: "memory")
__device__ __forceinline__ unsigned long long rt() { return __builtin_amdgcn_s_memrealtime(); }
__device__ __forceinline__ unsigned f2bf(float f) { unsigned u = __builtin_bit_cast(unsigned, f); return (u + 0x7fffu + ((u >> 16) & 1u)) >> 16; }
typedef __bf16 bf16v2q __attribute__((ext_vector_type(2))); typedef float f32v2q __attribute__((ext_vector_type(2)));
__device__ __forceinline__ unsigned pk2(float lo, float hi) { const f32v2q v = {lo, hi}; return __builtin_bit_cast(unsigned, __builtin_convertvector(v, bf16v2q)); }

#define XB_TMO      128
#define XB_XCNT(j)  (256  + 64 * (j))
#define XB_XSUB(j)  (1280 + 64 * (j))
#define XB_XGEN(j)  (2304 + 64 * (j))
#define XB_TOP      3328
#define XB_TOPGEN   3392
#define XCD_BAR_WORDS 3456
#define XB_SPIN_CAP (1u << 18)

__device__ __forceinline__ unsigned xb_ld(unsigned* p)              { return __hip_atomic_load(p, __ATOMIC_RELAXED, __HIP_MEMORY_SCOPE_AGENT); }
__device__ __forceinline__ unsigned xb_add(unsigned* p, unsigned v) { return __hip_atomic_fetch_add(p, v, __ATOMIC_RELAXED, __HIP_MEMORY_SCOPE_AGENT); }
__device__ __forceinline__ unsigned xb_xcc_id() { return (unsigned)__builtin_amdgcn_s_getreg((3 << 11) | 20) & 0xFu; }
#define XB_SPIN(cond, bar) do { unsigned _sp = 0; while (cond) { __builtin_amdgcn_s_sleep(1); \
    if ((++_sp & 255u) == 0u) { if (xb_ld(&(bar)[XB_TMO])) break; if (_sp > XB_SPIN_CAP) { atomicAdd(&(bar)[XB_TMO], 1u); break; } } } } while (0)

struct XcdBarrier {
    unsigned* bar; unsigned x;
    volatile LAS unsigned* st;
};

__device__ __forceinline__ XcdBarrier xcd_barrier_post(unsigned* bar, volatile LAS unsigned* st) {
    XcdBarrier b; b.bar = bar; b.x = xb_xcc_id(); b.st = st;
    if (threadIdx.x == 0) (void)xb_add(&bar[XB_XCNT(b.x)], 1u);
    return b;
}
__device__ __forceinline__ void xcd_barrier_complete(unsigned* bar, unsigned x, unsigned& nloc, unsigned& nx) {
    const unsigned G = gridDim.x * gridDim.y * gridDim.z;
    unsigned sum, cnt, mine, sp = 0u;
    for (;;) {
        sum = 0u; cnt = 0u; mine = 0u;
#pragma unroll
        for (unsigned j = 0; j < 16; ++j) { const unsigned c = xb_ld(&bar[XB_XCNT(j)]); sum += c; cnt += (c > 0u) ? 1u : 0u; mine = (j == x) ? c : mine; }
        if (sum == G) break;
        __builtin_amdgcn_s_sleep(1);
        if ((++sp & 255u) == 0u) { if (xb_ld(&bar[XB_TMO])) break; if (sp > XB_SPIN_CAP) { atomicAdd(&bar[XB_TMO], 1u); break; } }
    }
    nloc = mine > 0u ? mine : 1u; nx = cnt > 0u ? cnt : 1u;
}

__device__ __forceinline__ void xcd_barrier(const XcdBarrier& b) {
    asm volatile("s_waitcnt vmcnt(0)" ::: "memory");
    __syncthreads();
    if (threadIdx.x == 0) {
        unsigned* bar = b.bar;
        __builtin_amdgcn_s_waitcnt(0);
        unsigned nloc = b.st[0], nx = b.st[1];
        if (nloc == 0u) { xcd_barrier_complete(bar, b.x, nloc, nx); b.st[0] = nloc; b.st[1] = nx; }
        const unsigned old = xb_add(&bar[XB_XSUB(b.x)], 1u);
        const unsigned gen = old / nloc;
        if (old + 1u == (gen + 1u) * nloc) {
            __builtin_amdgcn_fence(__ATOMIC_RELEASE, "agent");
            asm volatile("s_waitcnt vmcnt(0)" ::: "memory");
            const unsigned og = xb_add(&bar[XB_TOP], 1u);
            const unsigned tg = og / nx;
            if (og + 1u == (tg + 1u) * nx) xb_add(&bar[XB_TOPGEN], 1u);
            else XB_SPIN(xb_ld(&bar[XB_TOPGEN]) == tg, bar);
            __builtin_amdgcn_fence(__ATOMIC_ACQUIRE, "agent");
            xb_add(&bar[XB_XGEN(b.x)], 1u);
            asm volatile("s_waitcnt vmcnt(0)" ::: "memory");
        } else {
            XB_SPIN(xb_ld(&bar[XB_XGEN(b.x)]) == gen, bar);
            __builtin_amdgcn_fence(__ATOMIC_ACQUIRE, "agent");
            asm volatile("s_waitcnt vmcnt(0)" ::: "memory");
        }
    }
    __syncthreads();
}

#ifndef MK_PH_HI
#define MK_PH_HI 14
#endif
#ifndef MK_SUB
#define MK_SUB 3
#endif
#ifndef MK_DNSTEP
#define MK_DNSTEP 9
#endif
#ifndef MK_W6
#define MK_W6 1
#endif
#ifndef MK_CVSTEP
#define MK_CVSTEP 9
#endif
#ifndef MK_REP
#define MK_REP 0
#endif
#ifndef MK_REPSUB
#define MK_REPSUB 3
#endif
#ifndef MK_NOREAD
#define MK_NOREAD 0
#endif
#ifndef MK_STAG_A
#define MK_STAG_A 0
#endif
#ifndef MK_STAG_O
#define MK_STAG_O 0
#endif
#ifndef MK_STAG_GU
#define MK_STAG_GU 0
#endif
#ifndef MK_STAG_D
#define MK_STAG_D 0
#endif
#ifndef MK_REPSUB2
#define MK_REPSUB2 3
#endif
#ifndef MK_XBAR
#define MK_XBAR 0
#endif
#ifndef MK_NOSTORE
#define MK_NOSTORE 0
#endif
#ifndef MK_HALFK
#define MK_HALFK 0
#endif
#ifndef MK_IDLE
#define MK_IDLE 0
#endif
#ifndef MK_PHT
#define MK_PHT -1
#endif
#ifndef MK_OLDN2
#define MK_OLDN2 0
#endif
#ifndef MK_GUA
#define MK_GUA 0
#endif
#ifndef MK_SSP
#define MK_SSP 1
#endif
#ifndef MK_LGSPLIT
#define MK_LGSPLIT 1
#endif
#ifndef MK_SPLIT_IDLE
#define MK_SPLIT_IDLE 0
#endif
#ifndef MK_WLATE
#define MK_WLATE 0
#endif
#ifndef MK_NEG
#define MK_NEG 1
#endif

constexpr int NWAVES = 8;
constexpr int D = 1024, BATCH = 8, SEQ = 4096, M = BATCH * SEQ, DEPTH = 2;
constexpr int DFF = 2816, DPROJ = 3080, NP = 3072;
constexpr int CVK = 31, DNCONV = 4;
constexpr float EPS = 1e-6f;
constexpr int NCHUNK = BATCH * 4 * 64;

constexpr size_t MiB = 1u << 20;
constexpr size_t WS_CTL = 0, CTL_ZERO_BYTES = 64 * 1024;
constexpr size_t WS_W = 2 * MiB;
constexpr size_t W_IN_OFF = 0, W_O_OFF = 6 * MiB, W_GU_OFF = 8 * MiB, W_D_OFF = 19 * MiB, W_LAYER = 25 * MiB;
constexpr size_t WS_BA = 53 * MiB;
constexpr size_t WS_CD = 54 * MiB + 512 * 1024;
constexpr size_t WS_XB = 64 * MiB;
constexpr size_t WS_P = 128 * MiB;
constexpr size_t WS_REC = 320 * MiB;
constexpr size_t REC_BYTES = 74752, REC_W = 0, REC_QD = 16384, REC_QK = 32768, REC_KDT = 40960, REC_U = 57344, REC_CD = 73728;
constexpr size_t WS_SSP = 500 * MiB, SSP_BYTES = (size_t)M * 16 * 4;
constexpr size_t WS_WSF = 52 * MiB + 128 * 1024;
constexpr size_t WS_WLG = 52 * MiB;
constexpr int RS_OFF = 131072, RS_SLOTS = 24;
constexpr size_t WS_O = 468 * MiB, WS_END = 510 * MiB;
constexpr int CW_BAR = 4096, CW_FLAGS = 8192;

constexpr int RING_BYTES = 131072;
constexpr int MISC_OFF = 163840 - 256;
constexpr int LDS_BYTES = 163840;

__device__ __forceinline__ float bf2f(unsigned short b) { return __uint_as_float(((unsigned)b) << 16); }
#define dpp_f(old, v, ctrl, row_mask, bound) __builtin_bit_cast(float, __builtin_amdgcn_update_dpp(__builtin_bit_cast(int, (float)(old)), __builtin_bit_cast(int, (float)(v)), (ctrl), (row_mask), 0xF, (bound)))
__device__ __forceinline__ float wave_sum(float v) {
    v += dpp_f(0.f, v, 0xB1, 0xF, true);
    v += dpp_f(0.f, v, 0x4E, 0xF, true);
    v += dpp_f(0.f, v, 0x141, 0xF, true);
    v += dpp_f(0.f, v, 0x140, 0xF, true);
    v += dpp_f(0.f, v, 0x142, 0xA, false);
    v += dpp_f(0.f, v, 0x143, 0xC, false);
    return __builtin_bit_cast(float, __builtin_amdgcn_readlane(__builtin_bit_cast(int, v), 63));
}
#define WAVE_SUM8(v_) do { \
    _Pragma("unroll") for (int i_ = 0; i_ < 8; ++i_) v_[i_] += dpp_f(0.f, v_[i_], 0xB1, 0xF, true); \
    _Pragma("unroll") for (int i_ = 0; i_ < 8; ++i_) v_[i_] += dpp_f(0.f, v_[i_], 0x4E, 0xF, true); \
    _Pragma("unroll") for (int i_ = 0; i_ < 8; ++i_) v_[i_] += dpp_f(0.f, v_[i_], 0x141, 0xF, true); \
    _Pragma("unroll") for (int i_ = 0; i_ < 8; ++i_) v_[i_] += dpp_f(0.f, v_[i_], 0x140, 0xF, true); \
    _Pragma("unroll") for (int i_ = 0; i_ < 8; ++i_) v_[i_] += dpp_f(0.f, v_[i_], 0x142, 0xA, false); \
    _Pragma("unroll") for (int i_ = 0; i_ < 8; ++i_) v_[i_] += dpp_f(0.f, v_[i_], 0x143, 0xC, false); \
    _Pragma("unroll") for (int i_ = 0; i_ < 8; ++i_) v_[i_] = __builtin_bit_cast(float, __builtin_amdgcn_readlane(__builtin_bit_cast(int, v_[i_]), 63)); } while (0)
__device__ __forceinline__ float sigmoidf_(float x) { return __builtin_amdgcn_rcpf(1.0f + __builtin_amdgcn_exp2f(x * -1.4426950408889634f)); }
__device__ __forceinline__ float gelu_erf(float x) { return 0.5f * x * (1.0f + erff(x * 0.70710678118654752f)); }
typedef float f32x16 __attribute__((ext_vector_type(16)));
typedef unsigned u32x2 __attribute__((ext_vector_type(2)));
#define MFMA32(a, b, c) __builtin_amdgcn_mfma_f32_32x32x16_bf16((a), (b), (c), 0, 0, 0)
__device__ __forceinline__ int crow(int reg, int hh) { return (reg & 3) + 8 * (reg >> 2) + 4 * hh; }

#define AS4 __attribute__((address_space(4)))
struct Frame {
    LAS unsigned char* lds;
    int tid, lane, wave, vcu, G;
    const AS4 unsigned char* kp;
    float* out; unsigned char* ws;
    __device__ __forceinline__ const float* inp(int k) const { return *(const float* const AS4*)(kp + 8 * k); }
};

__device__ __forceinline__ void tr_item(const float* W, int ldw, int K, bf16* WT, int kb, int nsrc0, int ndst0, LAS float* scr, int lane, const float* gk = nullptr) {
    const int k0 = 64 * kb;
#pragma unroll 8
    for (int i = 0; i < 32; ++i) { const int kk = 2 * i + (lane >> 5); scr[kk * 33 + (lane & 31)] = W[(size_t)(k0 + kk) * ldw + nsrc0 + (lane & 31)]; }
    LDS_WAIT(); asm volatile("" ::: "memory");
    const int c = lane & 7;
    f32x4 ga = {1.f, 1.f, 1.f, 1.f}, gb = ga; if (gk) { ga = *(const f32x4*)(gk + k0 + 8 * c); gb = *(const f32x4*)(gk + k0 + 8 * c + 4); }
#pragma unroll
    for (int j = 0; j < 4; ++j) { const int n = (lane >> 3) + 8 * j; const LAS float* s = scr + (8 * c) * 33 + n;
        v4u o; o.x = pk2(s[0 * 33] * ga.x, s[1 * 33] * ga.y); o.y = pk2(s[2 * 33] * ga.z, s[3 * 33] * ga.w); o.z = pk2(s[4 * 33] * gb.x, s[5 * 33] * gb.y); o.w = pk2(s[6 * 33] * gb.z, s[7 * 33] * gb.w);
        *(GAS v4u*)(WT + (size_t)(ndst0 + n) * K + k0 + 8 * c) = o; }
    LDS_WAIT(); asm volatile("" ::: "memory");
}
__device__ __forceinline__ void weights_phase(Frame& F, int l_lo, int l_hi) {
    LAS float* scr = (LAS float*)(F.lds + F.wave * 16384);
    const int gw = F.vcu * NWAVES + F.wave, NGW = F.G * NWAVES;
    constexpr int I_IN = 16 * 96, I_O = 16 * 32, I_GU = 16 * 176, I_D = 44 * 32, I_L = I_IN + I_O + I_GU + I_D;
    for (int it = l_lo * I_L + gw; it < l_hi * I_L; it += NGW) {
        const int l = it / I_L; int r = it % I_L;
        bf16* wb = (bf16*)(F.ws + WS_W + (size_t)l * W_LAYER);
        if (r < I_IN) { const int kb = r / 96, nb = r % 96, q8 = nb & 7, nsrc = (nb & ~7) + (q8 & 3) * 2 + (q8 >> 2);
            tr_item(F.inp(2) + (size_t)l * D * DPROJ, DPROJ, D, (bf16*)((unsigned char*)wb + W_IN_OFF), kb, 32 * nsrc, 32 * nb, scr, F.lane, F.inp(1) + l * D); continue; } r -= I_IN;
        if (r < I_O) { const int kb = r / 32, nb = r % 32, q8 = nb & 7, nsrc = (nb & ~7) + (q8 & 3) * 2 + (q8 >> 2); tr_item(F.inp(15) + (size_t)l * D * D, D, D, (bf16*)((unsigned char*)wb + W_O_OFF), kb, 32 * nsrc, 32 * nb, scr, F.lane); continue; } r -= I_O;
        if (r < I_GU) { const int kb = r / 176, nb = r % 176; const int drow = 32 * nb, tile = drow >> 8, within = drow & 255;
            const float* src = (within < 128 ? F.inp(17) : F.inp(18)) + (size_t)l * D * DFF;
            tr_item(src, DFF, D, (bf16*)((unsigned char*)wb + W_GU_OFF), kb, tile * 128 + (within & 127), drow, scr, F.lane, MK_GUA ? (const float*)nullptr : F.inp(16) + l * D); continue; } r -= I_GU;
        { const int kb = r / 32, nb = r % 32, q8 = nb & 7, nsrc = (nb & ~7) + (q8 & 3) * 2 + (q8 >> 2); tr_item(F.inp(19) + (size_t)l * DFF * D, D, DFF, (bf16*)((unsigned char*)wb + W_D_OFF), kb, 32 * nsrc, 32 * nb, scr, F.lane); }
    }
}

typedef __bf16 bf16v8m_t __attribute__((ext_vector_type(8)));
typedef float f32x8m_t __attribute__((ext_vector_type(8)));
__device__ __forceinline__ bf16x8 cvt8(float a0, float a1, float a2, float a3, float a4, float a5, float a6, float a7) { const f32x8m_t v = {a0, a1, a2, a3, a4, a5, a6, a7}; return __builtin_bit_cast(bf16x8, __builtin_convertvector(v, bf16v8m_t)); }
__device__ __forceinline__ void wlg_phase(Frame& F) {
    const int gt = F.vcu * (NWAVES * 64) + F.tid;
    {
        const int it = gt - DEPTH * 16 * D;
        if (it >= 0 && it < DEPTH * 4 * 20 * 64) { const int lane = it & 63, p = (it >> 6) % 20, lh = it / (20 * 64);
            const int ti = p < 2 ? 0 : (p < 6 ? 1 : (p < 12 ? 2 : 3)), s = p - (ti == 0 ? 0 : (ti == 1 ? 2 : (ti == 2 ? 6 : 12)));
            const int r = lane & 31, hh = lane >> 5, i = 32 * ti + r, j0 = 16 * s + 8 * hh;
            const float* ap = F.inp(5) + (size_t)lh * 128 * 128 + i * 128 + j0;
            float v[8];
#pragma unroll
            for (int e = 0; e < 8; ++e) v[e] = (j0 + e <= i) ? ap[e] : 0.f;
            *(bf16x8*)((bf16*)(F.ws + WS_WSF) + (size_t)it * 8) = cvt8(v[0], v[1], v[2], v[3], v[4], v[5], v[6], v[7]); }
    }
    if (gt < DEPTH * 16 * D) { const int l = gt / (16 * D), n = (gt / D) % 16, k = gt % D;
        const float v = n < 8 ? F.inp(2)[(size_t)l * D * DPROJ + (size_t)k * DPROJ + NP + n] * F.inp(1)[l * D + k] : 0.f;
        ((bf16*)(F.ws + WS_WLG))[gt] = f2bf(v); }
}
__device__ __forceinline__ void xin_phase(Frame& F, const float* x, bf16* xb, float* ssp) {
    const int gw = F.vcu * NWAVES + F.wave, NGW = F.G * NWAVES;
    f32x4 nv[4];
    if (gw < M) { const f32x4* xr = (const f32x4*)(x + (size_t)gw * D) + F.lane;
#pragma unroll
        for (int j = 0; j < 4; ++j) nv[j] = xr[64 * j]; }
    for (int m = gw; m < M; m += NGW) {
        f32x4 v[4]; float ss = 0.f;
#pragma unroll
        for (int j = 0; j < 4; ++j) v[j] = nv[j];
        { const int mn = (m + NGW < M) ? m + NGW : m; const f32x4* xr = (const f32x4*)(x + (size_t)mn * D) + F.lane;
#pragma unroll
            for (int j = 0; j < 4; ++j) nv[j] = xr[64 * j]; }
        unsigned long long* o8 = (unsigned long long*)(xb + (size_t)m * D) + F.lane;
#pragma unroll
        for (int j = 0; j < 4; ++j) { o8[64 * j] = (unsigned long long)pk2(v[j].x, v[j].y) | ((unsigned long long)pk2(v[j].z, v[j].w) << 32); ss += (v[j].x * v[j].x + v[j].y * v[j].y) + (v[j].z * v[j].z + v[j].w * v[j].w); }
        const float tot = wave_sum(ss);
        if (F.lane < 4) ((f32x4*)(ssp + (size_t)m * 16))[F.lane] = (f32x4){F.lane == 0 ? tot : 0.f, 0.f, 0.f, 0.f};
    }
}
__device__ __forceinline__ void logits_phase(Frame& F, int l, const bf16* xb, const float* ssp, float* ba) {
    const bf16* wl = (const bf16*)(F.ws + WS_WLG) + (size_t)l * 16 * D;
    const int fr = F.lane & 15, fq = F.lane >> 4;
    for (int rb = (F.vcu * NWAVES + F.wave) * 16; rb < M; rb += F.G * NWAVES * 16) {
        const pg8::bf16x8* xp = (const pg8::bf16x8*)(xb + (size_t)(rb + fr) * D + 8 * fq);
        const pg8::bf16x8* wp = (const pg8::bf16x8*)(wl + (size_t)fr * D + 8 * fq);
        const f32x4* pp = (const f32x4*)(ssp + (size_t)(rb + fr) * 16);
        const f32x4 p0 = pp[0], p1 = pp[1], p2 = pp[2], p3 = pp[3];
        f32x4 acc = {0.f, 0.f, 0.f, 0.f};
        pg8::bf16x8 xa[8], wa[8], xc[8], wc[8];
#pragma unroll
        for (int j = 0; j < 8; ++j) { xa[j] = xp[4 * j]; wa[j] = wp[4 * j]; }
#pragma unroll
        for (int j = 0; j < 8; ++j) { xc[j] = xp[4 * (8 + j)]; wc[j] = wp[4 * (8 + j)]; }
#pragma unroll
        for (int j = 0; j < 8; ++j) acc = __builtin_amdgcn_mfma_f32_16x16x32_bf16(wa[j], xa[j], acc, 0, 0, 0);
#pragma unroll
        for (int j = 0; j < 8; ++j) { xa[j] = xp[4 * (16 + j)]; wa[j] = wp[4 * (16 + j)]; }
#pragma unroll
        for (int j = 0; j < 8; ++j) acc = __builtin_amdgcn_mfma_f32_16x16x32_bf16(wc[j], xc[j], acc, 0, 0, 0);
#pragma unroll
        for (int j = 0; j < 8; ++j) { xc[j] = xp[4 * (24 + j)]; wc[j] = wp[4 * (24 + j)]; }
#pragma unroll
        for (int j = 0; j < 8; ++j) acc = __builtin_amdgcn_mfma_f32_16x16x32_bf16(wa[j], xa[j], acc, 0, 0, 0);
#pragma unroll
        for (int j = 0; j < 8; ++j) acc = __builtin_amdgcn_mfma_f32_16x16x32_bf16(wc[j], xc[j], acc, 0, 0, 0);
        const float ssum = (((p0[0] + p0[1]) + (p0[2] + p0[3])) + ((p1[0] + p1[1]) + (p1[2] + p1[3]))) + (((p2[0] + p2[1]) + (p2[2] + p2[3])) + ((p3[0] + p3[1]) + (p3[2] + p3[3])));
        const float rs = __builtin_amdgcn_rsqf(ssum * (1.0f / D) + EPS);
        if (fq < 2) *(f32x4*)(ba + (size_t)(rb + fr) * 8 + 4 * fq) = acc * rs;
    }
}

template <int MODE, bool XBF>
__device__ __forceinline__ void norm_phase(Frame& F, const void* xin_, const float* g, bf16* hn, const float* wlog, float* ba, float* fout, bf16* xb_out) {
    const int gw = F.vcu * NWAVES + F.wave, NGW = F.G * NWAVES;
    f32x4 gv[4];
#pragma unroll
    for (int j = 0; j < 4; ++j) gv[j] = ((const f32x4*)g)[64 * j + F.lane];
    LAS float* sW = (LAS float*)F.lds;
    if (MODE == 0 && wlog) {
        __syncthreads();
#pragma unroll
        for (int q = 0; q < 2; ++q) { const int k = 2 * F.tid + q; const f32x4* wr = (const f32x4*)(wlog + (size_t)k * DPROJ + NP); const f32x4 w0 = wr[0], w1 = wr[1];
            sW[0 * 1024 + k] = w0.x; sW[1 * 1024 + k] = w0.y; sW[2 * 1024 + k] = w0.z; sW[3 * 1024 + k] = w0.w; sW[4 * 1024 + k] = w1.x; sW[5 * 1024 + k] = w1.y; sW[6 * 1024 + k] = w1.z; sW[7 * 1024 + k] = w1.w; }
        __syncthreads();
    }
    u32x2 nr[4];
    if (XBF && gw < M) { const u32x2* xr = (const u32x2*)((const bf16*)xin_ + (size_t)gw * D) + F.lane;
#pragma unroll
        for (int j = 0; j < 4; ++j) nr[j] = xr[64 * j]; }
    for (int m = gw; m < M; m += NGW) {
        f32x4 v[4]; float ss = 0.f;
        if (XBF) {
#pragma unroll
            for (int j = 0; j < 4; ++j) { const u32x2 r2 = nr[j]; v[j].x = __uint_as_float(r2.x << 16); v[j].y = __uint_as_float(r2.x & 0xffff0000u); v[j].z = __uint_as_float(r2.y << 16); v[j].w = __uint_as_float(r2.y & 0xffff0000u); }
            { const int mn = (m + NGW < M) ? m + NGW : m; const u32x2* xr = (const u32x2*)((const bf16*)xin_ + (size_t)mn * D) + F.lane;
#pragma unroll
                for (int j = 0; j < 4; ++j) nr[j] = xr[64 * j]; }
        } else { const f32x4* xr = (const f32x4*)((const float*)xin_ + (size_t)m * D) + F.lane;
#pragma unroll
            for (int j = 0; j < 4; ++j) v[j] = xr[64 * j];
            if (xb_out) { unsigned long long* o8 = (unsigned long long*)(xb_out + (size_t)m * D) + F.lane;
#pragma unroll
                for (int j = 0; j < 4; ++j) o8[64 * j] = (unsigned long long)pk2(v[j].x, v[j].y) | ((unsigned long long)pk2(v[j].z, v[j].w) << 32); } }
#pragma unroll
        for (int j = 0; j < 4; ++j) ss += (v[j].x * v[j].x + v[j].y * v[j].y) + (v[j].z * v[j].z + v[j].w * v[j].w);
        const float rstd = __builtin_amdgcn_rsqf(wave_sum(ss) * (1.0f / D) + EPS);
#pragma unroll
        for (int j = 0; j < 4; ++j) v[j] = v[j] * rstd * gv[j];
        if (MODE == 0) {
            unsigned long long* o8 = (unsigned long long*)(hn + (size_t)m * D) + F.lane;
#pragma unroll
            for (int j = 0; j < 4; ++j) o8[64 * j] = (unsigned long long)pk2(v[j].x, v[j].y) | ((unsigned long long)pk2(v[j].z, v[j].w) << 32);
            if (wlog) {
                float acc[8];
#pragma unroll
                for (int t = 0; t < 8; ++t) { acc[t] = 0.f;
#pragma unroll
                    for (int j = 0; j < 4; ++j) { const f32x4 w = *(const LAS f32x4*)(sW + t * 1024 + 256 * j + 4 * F.lane); acc[t] += (v[j].x * w.x + v[j].y * w.y) + (v[j].z * w.z + v[j].w * w.w); } }
#pragma unroll
                for (int t = 0; t < 8; ++t) acc[t] = wave_sum(acc[t]);
                if (F.lane == 0) { *(f32x4*)(ba + (size_t)m * 8) = (f32x4){acc[0], acc[1], acc[2], acc[3]}; *(f32x4*)(ba + (size_t)m * 8 + 4) = (f32x4){acc[4], acc[5], acc[6], acc[7]}; }
            }
        } else {
            f32x4* o = (f32x4*)(fout + (size_t)m * D) + F.lane;
#pragma unroll
            for (int j = 0; j < 4; ++j) o[64 * j] = v[j];
        }
    }
}

__device__ __forceinline__ float gelu_as(float v) {
    const float d = fabsf(v) * 0.2316418882f + 1.0f, t = __builtin_amdgcn_rcpf(d);
    float q = t * 0.5307027145f + (-0.7265760135f); q = q * t + 0.7107068705f; q = q * t + (-0.142248368f); q = q * t + 0.127414796f; q = q * t;
    const float e = __builtin_amdgcn_exp2f((v * v) * (-0.72134752044f));
    const float m = v * (q * e), r = v - m;
    return v < 0.f ? m : r;
}
__device__ __forceinline__ void gmlp_unit(Frame& F, int l, int unit, const bf16* P, bf16* MIX) {
    const int m0 = unit * 128;
    LAS bf16* sVt = (LAS bf16*)F.lds;
    LAS float* sBias = (LAS float*)(F.lds + 69632);
    sBias[F.tid] = F.inp(6)[l * 512 + F.tid];
    {
        float lg[4], lb[4];
#pragma unroll
        for (int e = 0; e < 4; ++e) { lg[e] = F.inp(3)[l * 256 + F.lane + 64 * e]; lb[e] = F.inp(4)[l * 256 + F.lane + 64 * e]; }
        unsigned short rv[16][4];
#pragma unroll
        for (int jj = 0; jj < 16; ++jj) { const bf16* pr = P + (size_t)(m0 + 16 * F.wave + jj) * NP + 256 + F.lane;
#pragma unroll
            for (int e = 0; e < 4; ++e) rv[jj][e] = pr[64 * e]; }
#pragma unroll
        for (int jj = 0; jj < 16; ++jj) {
            const int j = 16 * F.wave + jj;
            float v[4];
#pragma unroll
            for (int e = 0; e < 4; ++e) v[e] = gelu_as(bf2f(rv[jj][e]));
            const float mean = wave_sum((v[0] + v[1]) + (v[2] + v[3])) * (1.0f / 256.0f);
#pragma unroll
            for (int e = 0; e < 4; ++e) v[e] -= mean;
            const float var = wave_sum((v[0] * v[0] + v[1] * v[1]) + (v[2] * v[2] + v[3] * v[3])) * (1.0f / 256.0f);
            const float r = __builtin_amdgcn_rsqf(var + EPS);
#pragma unroll
            for (int e = 0; e < 4; ++e) sVt[(F.lane + 64 * e) * 136 + j] = (bf16)(pk2(v[e] * r * lg[e] + lb[e], 0.f) & 0xffffu);
        }
    }
    __syncthreads();
    {
        const int r = F.lane & 31, hh = F.lane >> 5, h = F.wave >> 1, c = 32 * F.wave + r;
        const bf16x8* wf = (const bf16x8*)(F.ws + WS_WSF) + (size_t)(l * 4 + h) * 20 * 64 + F.lane;
        const LAS float* sBh = sBias + h * 128;
        bf16x8 bfr[8];
#pragma unroll
        for (int s = 0; s < 8; ++s) bfr[s] = *(const LAS bf16x8*)(sVt + c * 136 + 16 * s + 8 * hh);
        unsigned short ua[16], ub[16]; bf16x8 fa[6], fb[8];
#define GM_LOADU(u_, ti_) { _Pragma("unroll") for (int e = 0; e < 16; ++e) u_[e] = P[(size_t)(m0 + 32 * (ti_) + crow(e, hh)) * NP + c]; }
#define GM_LOADF(buf_, ti_) { _Pragma("unroll") for (int s = 0; s < 2 * (ti_) + 2; ++s) buf_[s] = wf[(size_t)((ti_) * ((ti_) + 1) + s) * 64]; }
#define GM_TILE(buf_, u_, ti_) { f32x16 acc; _Pragma("unroll") for (int e = 0; e < 16; ++e) acc[e] = 0.f; \
            _Pragma("unroll") for (int s = 0; s < 2 * (ti_) + 2; ++s) acc = MFMA32(buf_[s], bfr[s], acc); \
            _Pragma("unroll") for (int e = 0; e < 16; ++e) { const int io = 32 * (ti_) + crow(e, hh); const float u = gelu_as(bf2f(u_[e])); \
                MIX[(size_t)(m0 + io) * D + c] = (bf16)(pk2(u * (acc[e] + sBh[io]), 0.f) & 0xffffu); } asm volatile("" ::: "memory"); }
        GM_LOADU(ua, 0) GM_LOADF(fa, 0) GM_LOADU(ub, 1) GM_LOADF(fb, 1)
        asm volatile("" ::: "memory");
        GM_TILE(fa, ua, 0) GM_LOADU(ua, 2) GM_LOADF(fa, 2) asm volatile("" ::: "memory");
        GM_TILE(fb, ub, 1) GM_LOADU(ub, 3) GM_LOADF(fb, 3) asm volatile("" ::: "memory");
        GM_TILE(fa, ua, 2) GM_TILE(fb, ub, 3)
#undef GM_LOADU
#undef GM_LOADF
#undef GM_TILE
    }
    __syncthreads();
}

__device__ __forceinline__ void conv_unit(Frame& F, int l, int unit, const bf16* P, bf16* MIX) {
    const int b = unit >> 6, t0 = (unit & 63) * 64, m0 = b * SEQ + t0;
    LAS float* sY = (LAS float*)F.lds;
    const int c = F.tid & 255, hf = F.wave >> 2;
    float w[CVK];
#pragma unroll
    for (int k = 0; k < CVK; ++k) w[k] = F.inp(7)[(size_t)(l * CVK + k) * 256 + c];
    const float bias = F.inp(8)[l * 256 + c];
    {
        u32x2 ra[12], rg[12];
#pragma unroll
        for (int q = 0; q < 12; ++q) { const int r = F.wave + 8 * q, rc = r < 94 ? r : 93; const int t = t0 - 30 + rc, tc = t >= 0 ? t : 0;
            const bf16* pr = P + (size_t)(b * SEQ + tc) * NP + 4 * F.lane; ra[q] = *(const u32x2*)(pr + 512); rg[q] = *(const u32x2*)(pr + 768); }
#pragma unroll
        for (int q = 0; q < 12; ++q) { const int r = F.wave + 8 * q; const int t = t0 - 30 + r;
            f32x4 y;
            y.x = bf2f((unsigned short)(ra[q].x & 0xffffu)) * sigmoidf_(bf2f((unsigned short)(rg[q].x & 0xffffu)));
            y.y = bf2f((unsigned short)(ra[q].x >> 16)) * sigmoidf_(bf2f((unsigned short)(rg[q].x >> 16)));
            y.z = bf2f((unsigned short)(ra[q].y & 0xffffu)) * sigmoidf_(bf2f((unsigned short)(rg[q].y & 0xffffu)));
            y.w = bf2f((unsigned short)(ra[q].y >> 16)) * sigmoidf_(bf2f((unsigned short)(rg[q].y >> 16)));
            if (t < 0) y = (f32x4){0.f, 0.f, 0.f, 0.f};
            if (r < 94) *(LAS f32x4*)(sY + r * 256 + 4 * F.lane) = y; }
    }
    __syncthreads();
    float o[32];
    typedef float cvx2_t __attribute__((ext_vector_type(2)));
    cvx2_t we[15], wo[15];
#pragma unroll
    for (int j = 0; j < 15; ++j) { we[j] = (cvx2_t){w[2 * j], w[2 * j + 1]}; wo[j] = (cvx2_t){w[2 * j + 1], w[2 * j + 2]}; }
#pragma unroll
    for (int g = 0; g < 4; ++g) {
        cvx2_t yp[19];
#pragma unroll
        for (int q = 0; q < 19; ++q) { yp[q].x = sY[(hf * 32 + 8 * g + 2 * q) * 256 + c]; yp[q].y = sY[(hf * 32 + 8 * g + 2 * q + 1) * 256 + c]; }
#pragma unroll
        for (int s = 0; s < 4; ++s) {
            cvx2_t ae = {bias, w[30] * yp[s + 15].x}, ao = {bias, w[0] * yp[s].y};
#pragma unroll
            for (int j = 0; j < 15; ++j) { ae = __builtin_elementwise_fma(we[j], yp[s + j], ae); ao = __builtin_elementwise_fma(wo[j], yp[s + 1 + j], ao); }
            o[8 * g + 2 * s] = ae.x + ae.y; o[8 * g + 2 * s + 1] = ao.x + ao.y;
        }
    }
    __syncthreads();
#pragma unroll
    for (int tt = 0; tt < 32; ++tt) sY[(hf * 32 + tt) * 256 + c] = o[tt];
    __syncthreads();
    const f32x4 g4 = *(const f32x4*)(F.inp(9) + l * 256 + 4 * F.lane), b4 = *(const f32x4*)(F.inp(10) + l * 256 + 4 * F.lane);
    for (int i = F.wave; i < 64; i += NWAVES) {
        f32x4 v = *(LAS f32x4*)(sY + i * 256 + 4 * F.lane);
        const float mean = wave_sum((v.x + v.y) + (v.z + v.w)) * (1.0f / 256.0f);
        v = v - mean;
        const float var = wave_sum((v.x * v.x + v.y * v.y) + (v.z * v.z + v.w * v.w)) * (1.0f / 256.0f);
        const float r = __builtin_amdgcn_rsqf(var + EPS);
        v = v * r * g4 + b4;
        v.x *= sigmoidf_(v.x); v.y *= sigmoidf_(v.y); v.z *= sigmoidf_(v.z); v.w *= sigmoidf_(v.w);
        *(unsigned long long*)(MIX + (size_t)(m0 + i) * D + 256 + 4 * F.lane) = (unsigned long long)pk2(v.x, v.y) | ((unsigned long long)pk2(v.z, v.w) << 32);
    }
    __syncthreads();
}

__device__ __forceinline__ void conv_units(Frame& F0, int l, int first, int stride, const bf16* P, bf16* MIX, const int end = M / 64) {
    if (first >= end) return;
    typedef float cvx2_t __attribute__((ext_vector_type(2)));
    LAS float* sY = (LAS float*)F0.lds;
    cvx2_t we[15], wo[15]; float w0, w30, bias;
    {   const int c = F0.tid & 255; float w[CVK];
#pragma unroll
        for (int k = 0; k < CVK; ++k) w[k] = F0.inp(7)[(size_t)(l * CVK + k) * 256 + c];
#pragma unroll
        for (int j = 0; j < 15; ++j) { we[j] = (cvx2_t){w[2 * j], w[2 * j + 1]}; wo[j] = (cvx2_t){w[2 * j + 1], w[2 * j + 2]}; }
        w0 = w[0]; w30 = w[30]; bias = F0.inp(8)[l * 256 + c]; }
    const f32x4 g4 = *(const f32x4*)(F0.inp(9) + l * 256 + 4 * F0.lane), b4 = *(const f32x4*)(F0.inp(10) + l * 256 + 4 * F0.lane);
    u32x2 ra[12], rg[12];
#define CV_LOAD(u_) do { const int b_ = (u_) >> 6, t0_ = ((u_) & 63) * 64; _Pragma("unroll") for (int q = 0; q < 12; ++q) { const int r = F0.wave + 8 * q, rc = r < 94 ? r : 93; const int t = t0_ - 30 + rc, tc = t >= 0 ? t : 0; \
        const bf16* pr = P + (size_t)(b_ * SEQ + tc) * NP + 4 * F0.lane; ra[q] = *(const u32x2*)(pr + 512); rg[q] = *(const u32x2*)(pr + 768); } } while (0)
    CV_LOAD(first);
    for (int unit = first; unit < end; unit += stride) {
        Frame F = F0; asm volatile("" : "+v"(F.tid)); F.lane = F.tid & 63; F.wave = __builtin_amdgcn_readfirstlane(F.tid >> 6);
        const int b = unit >> 6, t0 = (unit & 63) * 64, m0 = b * SEQ + t0;
        const int c = F.tid & 255, hf = F.wave >> 2;
#pragma unroll
        for (int q = 0; q < 12; ++q) { const int r = F.wave + 8 * q; const int t = t0 - 30 + r;
            f32x4 y;
            y.x = bf2f((unsigned short)(ra[q].x & 0xffffu)) * sigmoidf_(bf2f((unsigned short)(rg[q].x & 0xffffu)));
            y.y = bf2f((unsigned short)(ra[q].x >> 16)) * sigmoidf_(bf2f((unsigned short)(rg[q].x >> 16)));
            y.z = bf2f((unsigned short)(ra[q].y & 0xffffu)) * sigmoidf_(bf2f((unsigned short)(rg[q].y & 0xffffu)));
            y.w = bf2f((unsigned short)(ra[q].y >> 16)) * sigmoidf_(bf2f((unsigned short)(rg[q].y >> 16)));
            if (t < 0) y = (f32x4){0.f, 0.f, 0.f, 0.f};
            if (r < 94) *(LAS f32x4*)(sY + r * 256 + 4 * F.lane) = y; }
        __syncthreads();
        { const int nu = (unit + stride < end) ? unit + stride : unit; CV_LOAD(nu); }
        float o[32];
#pragma unroll
        for (int g = 0; g < 4; ++g) {
            cvx2_t yp[19];
#pragma unroll
            for (int q = 0; q < 19; ++q) { yp[q].x = sY[(hf * 32 + 8 * g + 2 * q) * 256 + c]; yp[q].y = sY[(hf * 32 + 8 * g + 2 * q + 1) * 256 + c]; }
#pragma unroll
            for (int s = 0; s < 4; ++s) {
                cvx2_t ae = {bias, w30 * yp[s + 15].x}, ao = {bias, w0 * yp[s].y};
#pragma unroll
                for (int j = 0; j < 15; ++j) { ae = __builtin_elementwise_fma(we[j], yp[s + j], ae); ao = __builtin_elementwise_fma(wo[j], yp[s + 1 + j], ao); }
                o[8 * g + 2 * s] = ae.x + ae.y; o[8 * g + 2 * s + 1] = ao.x + ao.y;
            }
        }
        __syncthreads();
#pragma unroll
        for (int tt = 0; tt < 32; ++tt) sY[(hf * 32 + tt) * 256 + c] = o[tt];
        __syncthreads();
        {
            f32x4 v[8]; float mu[8], var[8];
#pragma unroll
            for (int rr = 0; rr < 8; ++rr) { v[rr] = *(LAS f32x4*)(sY + (F.wave + 8 * rr) * 256 + 4 * F.lane); mu[rr] = (v[rr].x + v[rr].y) + (v[rr].z + v[rr].w); }
            WAVE_SUM8(mu);
#pragma unroll
            for (int rr = 0; rr < 8; ++rr) mu[rr] *= (1.0f / 256.0f);
#pragma unroll
            for (int rr = 0; rr < 8; ++rr) { v[rr] = v[rr] - mu[rr]; var[rr] = (v[rr].x * v[rr].x + v[rr].y * v[rr].y) + (v[rr].z * v[rr].z + v[rr].w * v[rr].w); }
            WAVE_SUM8(var);
#pragma unroll
            for (int rr = 0; rr < 8; ++rr) var[rr] *= (1.0f / 256.0f);
#pragma unroll
            for (int rr = 0; rr < 8; ++rr) { const float r = __builtin_amdgcn_rsqf(var[rr] + EPS); f32x4 x = v[rr] * r * g4 + b4;
                x.x *= sigmoidf_(x.x); x.y *= sigmoidf_(x.y); x.z *= sigmoidf_(x.z); x.w *= sigmoidf_(x.w);
                *(unsigned long long*)(MIX + (size_t)(m0 + F.wave + 8 * rr) * D + 256 + 4 * F.lane) = (unsigned long long)pk2(x.x, x.y) | ((unsigned long long)pk2(x.z, x.w) << 32); }
        }
        __syncthreads();
    }
#undef CV_LOAD
}

#ifndef MK_CMPDLY
#define MK_CMPDLY 0
#endif
#ifndef MK_C1DLY
#define MK_C1DLY 0
#endif
#ifndef MK_SCANDLY
#define MK_SCANDLY 0
#endif
#ifndef MK_TS
#define MK_TS 0
#endif
#ifndef MK_TK
#define MK_TK 4
#endif
#define TS_BEGIN(id) long long ts0_##id = 0; if (MK_TS == (id)) { asm volatile("s_waitcnt vmcnt(0) lgkmcnt(0)" ::: "memory"); ts0_##id = clock64(); }
#define TS_END(id) if (MK_TS == (id)) { asm volatile("s_waitcnt vmcnt(0) lgkmcnt(0)" ::: "memory"); const long long t1_ = clock64(), d_ = (t1_ - ts0_##id) * MK_TK; while (clock64() - t1_ < d_) __builtin_amdgcn_s_sleep(1); }
typedef __bf16 bf16v2_t __attribute__((ext_vector_type(2)));
typedef __bf16 bf16v8_t __attribute__((ext_vector_type(8)));
typedef float f32x2_t __attribute__((ext_vector_type(2)));
typedef float f32x8_t __attribute__((ext_vector_type(8)));
__device__ __forceinline__ unsigned cpk2(float lo, float hi) { const f32x2_t v = {lo, hi}; return __builtin_bit_cast(unsigned, __builtin_convertvector(v, bf16v2_t)); }
__device__ __forceinline__ v4u cpk8(float a0, float a1, float a2, float a3, float a4, float a5, float a6, float a7) { const f32x8_t v = {a0, a1, a2, a3, a4, a5, a6, a7}; return __builtin_bit_cast(v4u, __builtin_convertvector(v, bf16v8_t)); }
__device__ __forceinline__ bf16x8 pack_step(const f32x16& x, int s) { return __builtin_bit_cast(bf16x8, cpk8(x[8 * s], x[8 * s + 1], x[8 * s + 2], x[8 * s + 3], x[8 * s + 4], x[8 * s + 5], x[8 * s + 6], x[8 * s + 7])); }

template <int J> __device__ __forceinline__ void dn_load_col(f32x4 (&dst)[4], const LAS float* sAth, const f32x4& tie) {
    if constexpr (J < 63) {
        const LAS float* acol = sAth + J * 64;
        asm volatile("" : "+v"(acol) : "v"(tie.x));
#pragma unroll
        for (int q = (J >> 4); q < 4; ++q) dst[q] = *(const LAS f32x4*)(acol + 16 * q);
    }
}
template <int J> __device__ __forceinline__ void dn_solve_cols2(f32x4 (&au)[4], f32x4 (&aw)[4], const LAS float* sAth, f32x4 (&cur)[4], f32x4 (&nxt)[4]) {
    if constexpr (J < 63) {
        constexpr int GJ = J >> 2, Q0 = GJ >> 2, OWN = GJ & 3, BC = OWN * 0x55;
        f32x4 nn[4];
        dn_load_col<J + 2>(nn, sAth, au[Q0]);
        float mu = au[Q0][J & 3], mw = aw[Q0][J & 3];
        asm volatile("" : "+v"(mu), "+v"(mw));
        const float su = __builtin_bit_cast(float, __builtin_amdgcn_update_dpp(0, __builtin_bit_cast(int, mu), BC, 0xF, 0xF, false));
        const float sw = __builtin_bit_cast(float, __builtin_amdgcn_update_dpp(0, __builtin_bit_cast(int, mw), BC, 0xF, 0xF, false));
        const float nsu = -su, nsw = -sw;
#pragma unroll
        for (int q = Q0; q < 4; ++q) { au[q] = __builtin_elementwise_fma(cur[q], (f32x4){nsu, nsu, nsu, nsu}, au[q]); aw[q] = __builtin_elementwise_fma(cur[q], (f32x4){nsw, nsw, nsw, nsw}, aw[q]); }
        dn_solve_cols2<J + 1>(au, aw, sAth, nxt, nn);
    }
}

template <int J> __device__ __forceinline__ void dn_load_blk(f32x4 (&dst)[2], const LAS float* sAb, const f32x4& tie) {
    if constexpr (J < 31) {
        const LAS float* acol = sAb + J * 64;
        asm volatile("" : "+v"(acol) : "v"(tie.x));
#pragma unroll
        for (int q = (J >> 4); q < 2; ++q) dst[q] = *(const LAS f32x4*)(acol + 16 * q);
    }
}
template <int J> __device__ __forceinline__ void dn_solve_blk(f32x4 (&au)[2], const LAS float* sAb, f32x4 (&cur)[2], f32x4 (&nxt)[2]) {
    if constexpr (J < 31) {
        constexpr int GJ = J >> 2, Q0 = GJ >> 2, OWN = GJ & 3, BC = OWN * 0x55;
        f32x4 nn[2];
        dn_load_blk<J + 2>(nn, sAb, au[Q0]);
        float mu = au[Q0][J & 3];
        asm volatile("" : "+v"(mu));
        const float su = __builtin_bit_cast(float, __builtin_amdgcn_update_dpp(0, __builtin_bit_cast(int, mu), BC, 0xF, 0xF, false));
        const float nsu = -su;
#pragma unroll
        for (int q = Q0; q < 2; ++q) au[q] = __builtin_elementwise_fma(cur[q], (f32x4){nsu, nsu, nsu, nsu}, au[q]);
        dn_solve_blk<J + 1>(au, sAb, nxt, nn);
    }
}

template <int J> __device__ __forceinline__ void dn_solve_cols1(f32x4 (&au)[4], const LAS float* sAth, f32x4 (&cur)[4], f32x4 (&nxt)[4]) {
    if constexpr (J < 63) {
        constexpr int GJ = J >> 2, Q0 = GJ >> 2, OWN = GJ & 3, BC = OWN * 0x55;
        f32x4 nn[4];
        dn_load_col<J + 2>(nn, sAth, au[Q0]);
        float mu = au[Q0][J & 3];
        asm volatile("" : "+v"(mu));
        const float su = __builtin_bit_cast(float, __builtin_amdgcn_update_dpp(0, __builtin_bit_cast(int, mu), BC, 0xF, 0xF, false));
        const float nsu = -su;
#pragma unroll
        for (int q = Q0; q < 4; ++q) au[q] = __builtin_elementwise_fma(cur[q], (f32x4){nsu, nsu, nsu, nsu}, au[q]);
        dn_solve_cols1<J + 1>(au, sAth, nxt, nn);
    }
}

__device__ __forceinline__ void dn_load_raw(v4u (&raw)[7], const bf16* P, int cu, int tid) {
    const int b = cu >> 8, h = (cu >> 6) & 3, n = cu & 63, m0 = b * SEQ + n * 64;
    const bf16* pbase = P + 1024 + h * 128;
#pragma unroll
    for (int it = 0; it < 7; ++it) { int item = tid + 512 * it; item = item < 3 * 67 * 16 ? item : 3 * 67 * 16 - 1;
        const int sel = item / (67 * 16), rem = item - sel * (67 * 16), t = rem >> 4, pc = rem & 15;
        const int tr = (n > 0 || t >= 3) ? t : 3;
        raw[it] = *(const v4u*)(pbase + (long)(m0 - 3 + tr) * NP + sel * 512 + pc * 8);
        if (!(n > 0 || t >= 3)) raw[it] = (v4u){0u, 0u, 0u, 0u}; }
}
#define DN_ST16(ptr_, val_) __builtin_amdgcn_raw_buffer_store_b128((val_), rsrc, (int)((const unsigned char*)(ptr_) - recbase), 0, 16)
#define DN_UNIT2CU(v_) ((((v_) & 31) << 6) | ((v_) >> 5))
__device__ __forceinline__ void dn_chunk_units(Frame& F0, int l, int first, int stride, const bf16* P, const float* BA, const int stepmax, unsigned* flags) {
  if (stepmax < 1 || first >= NCHUNK) return;
  v4u rawn[7]; dn_load_raw(rawn, P, DN_UNIT2CU(first), F0.tid);
  f32x2_t cwn[12]; float ban[4];
#define DN_LOAD_AUX(cu_) do { const int h_ = ((cu_) >> 6) & 3, m_ = ((cu_) >> 8) * SEQ + ((cu_) & 63) * 64; const float* cw_ = F0.inp(11) + (size_t)l * DNCONV * 1536 + h_ * 128 + 2 * (F0.tid & 63); \
        _Pragma("unroll") for (int s_ = 0; s_ < 3; ++s_) _Pragma("unroll") for (int t_ = 0; t_ < 4; ++t_) cwn[4 * s_ + t_] = *(const f32x2_t*)(cw_ + s_ * 512 + t_ * 1536); \
        ban[0] = BA[(size_t)(m_ + F0.lane) * 8 + h_]; ban[1] = BA[(size_t)(m_ + F0.lane) * 8 + 4 + h_]; ban[2] = F0.inp(13)[l * 4 + h_]; ban[3] = F0.inp(12)[l * 4 + h_]; } while (0)
  DN_LOAD_AUX(DN_UNIT2CU(first));
  float c_la = 0.f, c_beta = 0.f, c_eg = 0.f, c_ed = 0.f;
#define DN_CUMSUM(b0_, b1_, b2_, b3_) do { const float beta_ = sigmoidf_(b0_), z_ = (b1_) + (b2_); \
        const float sp_ = fmaxf(z_, 0.f) + 0.6931471805599453f * __builtin_amdgcn_logf(1.0f + __builtin_amdgcn_exp2f(-1.4426950408889634f * fabsf(z_)));     \
        float la_ = -__builtin_amdgcn_exp2f(1.4426950408889634f * (b3_)) * sp_; \
        _Pragma("unroll") for (int off_ = 1; off_ < 64; off_ <<= 1) { const float t_ = __shfl_up(la_, off_); if ((int)F0.lane >= off_) la_ += t_; } \
        const float gl_ = __shfl(la_, 63); c_la = la_; c_beta = beta_; c_eg = __builtin_amdgcn_exp2f(1.4426950408889634f * la_); c_ed = __builtin_amdgcn_exp2f(1.4426950408889634f * (gl_ - la_)); } while (0)
  if (F0.wave == 7) DN_CUMSUM(ban[0], ban[1], ban[2], ban[3]);
  int pend = -1;
  const unsigned char* recbase = F0.ws + WS_REC;
  const __amdgpu_buffer_rsrc_t rsrc = __builtin_amdgcn_make_buffer_rsrc((void*)recbase, 0, (int)(NCHUNK * REC_BYTES), 0x00020000);
  for (int vu = first; vu < NCHUNK; vu += stride) {
    const int cu = DN_UNIT2CU(vu);
    Frame F = F0; asm volatile("" : "+v"(F.tid)); F.lane = F.tid & 63; F.wave = __builtin_amdgcn_readfirstlane(F.tid >> 6);
    const int b = cu >> 8, h = (cu >> 6) & 3, n = cu & 63, m0 = b * SEQ + n * 64;
    LAS float* sQ = (LAS float*)F.lds;
    LAS float* sK = (LAS float*)(F.lds + 32768);
    LAS float* sV = (LAS float*)(F.lds + 65536);
    LAS bf16* sQb = (LAS bf16*)(F.lds + 98304);
    LAS bf16* sKb = (LAS bf16*)(F.lds + 115712);
    LAS bf16* sVt = (LAS bf16*)(F.lds + 65536);
    LAS bf16* sKt = (LAS bf16*)(F.lds + 65536 + 16384);
    LAS bf16* sTu = (LAS bf16*)(F.lds + 98304);
    LAS bf16* sTw = (LAS bf16*)(F.lds + 98304 + 9216);
#define DN_CM(row_, j_) ((row_) * 64 + ((((j_) >> 3) ^ ((row_) & 7)) << 3) + ((j_) & 7))
    LAS bf16* sRaw = (LAS bf16*)(F.lds + 98304);
    LAS float* sGam = (LAS float*)(F.lds + 149760);
    LAS float* sBeta = (LAS float*)(F.lds + 150016);
    LAS float* sEg = (LAS float*)(F.lds + 150272);
    LAS float* sEd = (LAS float*)(F.lds + 150528);
    LAS float* sA = (LAS float*)(F.lds + 133120);
    bf16* rec = (bf16*)(F.ws + WS_REC + (size_t)cu * REC_BYTES);
    bf16* Uo = rec + REC_U / 2; float* CD = (float*)((unsigned char*)rec + REC_CD);
    if (MK_C1DLY > 0) { const unsigned long long t0_ = __builtin_amdgcn_s_memrealtime(); while (__builtin_amdgcn_s_memrealtime() - t0_ < (unsigned long long)MK_C1DLY) __builtin_amdgcn_s_sleep(1); }
    TS_BEGIN(1)
    {
#pragma unroll
        for (int it = 0; it < 7; ++it) { const int item = F.tid + 512 * it; if (item < 3 * 67 * 16) *(LAS v4u*)(sRaw + item * 8) = rawn[it]; }
    }
    f32x2_t cwc[12];
#pragma unroll
    for (int t = 0; t < 12; ++t) cwc[t] = cwn[t];
    __syncthreads();
    TS_END(1)
#ifdef MK_X
    if (stepmax == 1) continue;
#endif
    TS_BEGIN(2)
#ifndef MK_Y
#define MK_Y 0
#endif
#ifndef MK_Z
#define MK_Z 0
#endif
    {
        const int p = F.tid & 63, te = F.tid >> 6;
#pragma unroll
        for (int sel = 0; sel < 3; ++sel) {
            const f32x2_t w0 = cwc[4 * sel + 0], w1 = cwc[4 * sel + 1], w2 = cwc[4 * sel + 2], w3 = cwc[4 * sel + 3];
            const LAS unsigned* xc = (const LAS unsigned*)(sRaw + (sel * 67 + 8 * te) * 128 + 2 * p);
            f32x2_t x[11];
#pragma unroll
            for (int j = 0; j < 11; ++j) { const unsigned u = xc[j * 64]; x[j].x = __uint_as_float(u << 16); x[j].y = __uint_as_float(u & 0xffff0000u); }
            f32x2_t s8[8];
#pragma unroll
            for (int i = 0; i < 8; ++i) {
                const f32x2_t y = __builtin_elementwise_fma(w3, x[i + 3], __builtin_elementwise_fma(w2, x[i + 2], __builtin_elementwise_fma(w1, x[i + 1], w0 * x[i])));
                const f32x2_t a = y * (f32x2_t){-1.4426950408889634f, -1.4426950408889634f};
                f32x2_t ex; ex.x = __builtin_amdgcn_exp2f(a.x); ex.y = __builtin_amdgcn_exp2f(a.y);
                const f32x2_t den = ex + (f32x2_t){1.0f, 1.0f};
                f32x2_t rc; rc.x = __builtin_amdgcn_rcpf(den.x); rc.y = __builtin_amdgcn_rcpf(den.y);
                s8[i] = y * rc;
            }
            if (sel < 2) {
                LAS float* dst = (sel == 0 ? sQ : sK) + (8 * te) * 128 + 2 * p;
#pragma unroll
                for (int i = 0; i < 8; ++i) *(LAS f32x2_t*)(dst + i * 128) = s8[i];
            } else {
                *(LAS v4u*)(sVt + DN_CM(2 * p, 8 * te)) = cpk8(s8[0].x, s8[1].x, s8[2].x, s8[3].x, s8[4].x, s8[5].x, s8[6].x, s8[7].x);
                *(LAS v4u*)(sVt + DN_CM(2 * p + 1, 8 * te)) = cpk8(s8[0].y, s8[1].y, s8[2].y, s8[3].y, s8[4].y, s8[5].y, s8[6].y, s8[7].y);
            }
        }
    }
    if (F.wave == 7) { const int i = F.lane; sGam[i] = c_la; sBeta[i] = c_beta; sEg[i] = c_eg; sEd[i] = c_ed; }
    if (pend >= 0) asm volatile("s_waitcnt vmcnt(0)" ::: "memory");
    __syncthreads();
    if (pend >= 0 && F.tid == 0) __hip_atomic_store(flags + pend, 1u, __ATOMIC_RELAXED, __HIP_MEMORY_SCOPE_AGENT);
    if (F.wave == 7 && F.lane == 63) __hip_atomic_store(CD, c_eg, __ATOMIC_RELAXED, __HIP_MEMORY_SCOPE_AGENT);
    {
        const int cn = (vu + stride < NCHUNK) ? DN_UNIT2CU(vu + stride) : cu;
        dn_load_raw(rawn, P, cn, F.tid);
        DN_LOAD_AUX(cn);
    }
    TS_END(2)
    TS_BEGIN(3)
    {
        float q0[8], q1[8], k0[8], k1[8], sq[8], sk[8];
#pragma unroll
        for (int rr = 0; rr < 8; ++rr) { const int i = 8 * F.wave + rr;
            q0[rr] = sQ[i * 128 + F.lane]; q1[rr] = sQ[i * 128 + 64 + F.lane]; k0[rr] = sK[i * 128 + F.lane]; k1[rr] = sK[i * 128 + 64 + F.lane];
            sq[rr] = q0[rr] * q0[rr] + q1[rr] * q1[rr]; sk[rr] = k0[rr] * k0[rr] + k1[rr] * k1[rr]; }
#define DN_RSTAGE(ctrl_, rm_, bc_) { _Pragma("unroll") for (int rr = 0; rr < 8; ++rr) { sq[rr] += dpp_f(0.f, sq[rr], ctrl_, rm_, bc_); sk[rr] += dpp_f(0.f, sk[rr], ctrl_, rm_, bc_); } }
        DN_RSTAGE(0xB1, 0xF, true) DN_RSTAGE(0x4E, 0xF, true) DN_RSTAGE(0x141, 0xF, true) DN_RSTAGE(0x140, 0xF, true) DN_RSTAGE(0x142, 0xA, false) DN_RSTAGE(0x143, 0xC, false)
#undef DN_RSTAGE
#pragma unroll
        for (int rr = 0; rr < 8; ++rr) { sq[rr] = __builtin_bit_cast(float, __builtin_amdgcn_readlane(__builtin_bit_cast(int, sq[rr]), 63)); sk[rr] = __builtin_bit_cast(float, __builtin_amdgcn_readlane(__builtin_bit_cast(int, sk[rr]), 63)); }
#pragma unroll
        for (int rr = 0; rr < 8; ++rr) { const int i = 8 * F.wave + rr;
            const float rq = __builtin_amdgcn_rsqf(sq[rr] + EPS) * 0.08838834764831845f, rk = __builtin_amdgcn_rsqf(sk[rr] + EPS);
            q0[rr] *= rq; q1[rr] *= rq; k0[rr] *= rk; k1[rr] *= rk;
            sQ[i * 128 + F.lane] = q0[rr]; sQ[i * 128 + 64 + F.lane] = q1[rr]; sK[i * 128 + F.lane] = k0[rr]; sK[i * 128 + 64 + F.lane] = k1[rr];
            sQb[i * 136 + F.lane] = (bf16)(cpk2(q0[rr], 0.f) & 0xffffu); sQb[i * 136 + 64 + F.lane] = (bf16)(cpk2(q1[rr], 0.f) & 0xffffu);
            sKb[i * 136 + F.lane] = (bf16)(cpk2(k0[rr], 0.f) & 0xffffu); sKb[i * 136 + 64 + F.lane] = (bf16)(cpk2(k1[rr], 0.f) & 0xffffu); }
        *(LAS v4u*)(sKt + DN_CM(F.lane, 8 * F.wave)) = cpk8(k0[0], k0[1], k0[2], k0[3], k0[4], k0[5], k0[6], k0[7]);
        *(LAS v4u*)(sKt + DN_CM(F.lane + 64, 8 * F.wave)) = cpk8(k1[0], k1[1], k1[2], k1[3], k1[4], k1[5], k1[6], k1[7]);
    }
    __syncthreads();
    TS_END(3)
    TS_BEGIN(4)
    TS_END(4)
    TS_BEGIN(5)
    {
        const int mat = F.wave >> 2, ti = (F.wave >> 1) & 1, tj = F.wave & 1, r = F.lane & 31, hh = F.lane >> 5;
        f32x16 acc;
#pragma unroll
        for (int e = 0; e < 16; ++e) acc[e] = 0.f;
        if (!(ti == 0 && tj == 1)) {
            const LAS bf16* Ab = sKb + (32 * (mat ? tj : ti) + r) * 136 + 8 * hh;
            const LAS bf16* Bb = (mat ? sQb + (32 * ti + r) * 136 : sKb + (32 * tj + r) * 136) + 8 * hh;
#pragma unroll
            for (int s = 0; s < 8; ++s) { const bf16x8 a = *(const LAS bf16x8*)(Ab + 16 * s), bb = *(const LAS bf16x8*)(Bb + 16 * s); acc = MFMA32(a, bb, acc); }
        }
        if (mat == 0) {
            const int j = 32 * tj + r; const float gj = sGam[j];
#pragma unroll
            for (int g = 0; g < 4; ++g) { const int i0 = 32 * ti + 8 * g + 4 * hh; f32x4 o;
#pragma unroll
                for (int q = 0; q < 4; ++q) { const int i = i0 + q; o[q] = (j < i) ? sBeta[i] * acc[4 * g + q] * __expf(sGam[i] - gj) : 0.f; }
                *(LAS f32x4*)(sA + j * 64 + i0) = o; }
        } else {
            const int i = 32 * ti + r; const float gi = sGam[i];
            float v[16];
#pragma unroll
            for (int e = 0; e < 16; ++e) { const int j = 32 * tj + crow(e, hh); v[e] = (j <= i) ? acc[e] * __expf(gi - sGam[j]) : 0.f; }
            bf16* qk = rec + REC_QK / 2 + ((ti * 2 + tj) * 2) * 512 + F.lane * 8;
            DN_ST16(qk, cpk8(v[0], v[1], v[2], v[3], v[4], v[5], v[6], v[7]));
            DN_ST16(qk + 512, cpk8(v[8], v[9], v[10], v[11], v[12], v[13], v[14], v[15]));
        }
    }
    __syncthreads();
    TS_END(5)
    TS_BEGIN(6)
    LAS float* sT11t = (LAS float*)(F.lds + 151040);
    LAS float* sT22 = (LAS float*)(F.lds + 155648);
    if (F.wave < 4) {
        const int g = F.tid >> 2, h4 = F.tid & 3, blk = g >> 5, gl = g & 31, base = 32 * blk;
        const LAS float* sAb = sA + base * 65 + 4 * h4;
        f32x4 au[2];
#pragma unroll
        for (int q = 0; q < 2; ++q)
#pragma unroll
            for (int e = 0; e < 4; ++e) au[q][e] = (16 * q + 4 * h4 + e == gl) ? 1.0f : 0.0f;
        { f32x4 c0[2], c1[2]; dn_load_blk<0>(c0, sAb, au[0]); dn_load_blk<1>(c1, sAb, au[0]); dn_solve_blk<0>(au, sAb, c0, c1); }
        const float bu = sBeta[g], eu = bu * sEg[g];
#pragma unroll
        for (int q = 0; q < 2; ++q)
#pragma unroll
            for (int e = 0; e < 4; ++e) { const int il = 16 * q + 4 * h4 + e, i = base + il;
                sTu[i * 72 + g] = (bf16)(cpk2(au[q][e] * bu, 0.f) & 0xffffu); sTw[i * 72 + g] = (bf16)(cpk2(au[q][e] * eu, 0.f) & 0xffffu);
                if (blk == 1) { sTu[il * 72 + g] = (bf16)0; sTw[il * 72 + g] = (bf16)0; sT22[il * 36 + gl] = au[q][e]; } }
        if (blk == 0) {
#pragma unroll
            for (int q = 0; q < 2; ++q) *(LAS f32x4*)(sT11t + gl * 36 + 16 * q + 4 * h4) = au[q]; }
    } else {
        if (F.wave == 7) asm volatile("" : "+v"(ban[0]), "+v"(ban[1]), "+v"(ban[2]), "+v"(ban[3]));
        for (int item = F.tid - 256; item < 2048; item += 256) {
            const int f = (item >> 6) & 15, ln = item & 63, r = ln & 31, hh = ln >> 5;
            if (item < 1024) {
                const int rt = f >> 3, kt = (f >> 1) & 3, s_ = f & 1, i = 32 * rt + r, d0 = 32 * kt + 16 * s_ + 4 * hh;
                const float eg = sEg[i];
                const f32x4 a = *(LAS f32x4*)(sQ + i * 128 + d0), c = *(LAS f32x4*)(sQ + i * 128 + d0 + 8);
                DN_ST16(rec + REC_QD / 2 + f * 512 + ln * 8, cpk8(a.x * eg, a.y * eg, a.z * eg, a.w * eg, c.x * eg, c.y * eg, c.z * eg, c.w * eg));
            } else {
                const int a = f >> 2, t = (f >> 1) & 1, s_ = f & 1, dk = 32 * a + r, j0 = 32 * t + 16 * s_ + 4 * hh;
                float kv[8];
#pragma unroll
                for (int jj = 0; jj < 8; ++jj) { const int j = j0 + 8 * (jj >> 2) + (jj & 3); kv[jj] = sK[j * 128 + dk] * sEd[j]; }
                DN_ST16(rec + REC_KDT / 2 + f * 512 + ln * 8, cpk8(kv[0], kv[1], kv[2], kv[3], kv[4], kv[5], kv[6], kv[7]));
            }
        }
        if (F.wave == 7) DN_CUMSUM(ban[0], ban[1], ban[2], ban[3]);
    }
    __syncthreads();
    if (F.wave == 0) {
        const int r = F.lane & 31, hh = F.lane >> 5;
        f32x16 X, Y;
#pragma unroll
        for (int e = 0; e < 16; ++e) { X[e] = 0.f; Y[e] = 0.f; }
#pragma unroll
        for (int s = 0; s < 2; ++s) { float av[8];
#pragma unroll
            for (int j = 0; j < 8; ++j) av[j] = sA[(16 * s + 8 * hh + j) * 64 + 32 + r];
            const f32x4 b0 = *(const LAS f32x4*)(sT11t + r * 36 + 16 * s + 8 * hh), b1 = *(const LAS f32x4*)(sT11t + r * 36 + 16 * s + 8 * hh + 4);
            X = MFMA32(cvt8(av[0], av[1], av[2], av[3], av[4], av[5], av[6], av[7]), cvt8(b0.x, b0.y, b0.z, b0.w, b1.x, b1.y, b1.z, b1.w), X); }
#pragma unroll
        for (int s = 0; s < 2; ++s) {
            const f32x4 a0 = *(const LAS f32x4*)(sT22 + r * 36 + 16 * s + 4 * hh), a1 = *(const LAS f32x4*)(sT22 + r * 36 + 16 * s + 8 + 4 * hh);
            Y = MFMA32(cvt8(a0.x, a0.y, a0.z, a0.w, a1.x, a1.y, a1.z, a1.w), pack_step(X, s), Y); }
        const float bu = sBeta[r], eu = bu * sEg[r];
#pragma unroll
        for (int e = 0; e < 16; ++e) { const int i = 32 + crow(e, hh);
            sTu[i * 72 + r] = (bf16)(cpk2(-Y[e] * bu, 0.f) & 0xffffu); sTw[i * 72 + r] = (bf16)(cpk2(-Y[e] * eu, 0.f) & 0xffffu); }
    }
    __syncthreads();
    TS_END(6)
    TS_BEGIN(7)
    {
        const int r = F.lane & 31, hh = F.lane >> 5;
        {
            const int t = F.wave & 1, wv = F.wave >> 1;
            f32x16 acc;
#pragma unroll
            for (int e = 0; e < 16; ++e) acc[e] = 0.f;
#pragma unroll
            for (int ks = 0; ks < 4; ++ks) { const bf16x8 a = *(const LAS bf16x8*)(sTu + (32 * t + r) * 72 + 16 * ks + 8 * hh), bb = *(const LAS bf16x8*)(sVt + DN_CM(32 * wv + r, 16 * ks + 8 * hh)); acc = MFMA32(a, bb, acc); }
            bf16* up = Uo + (wv * 2 + t) * 1024 + F.lane * 8;
            DN_ST16(up, cpk8(acc[0], acc[1], acc[2], acc[3], acc[4], acc[5], acc[6], acc[7])); DN_ST16(up + 512, cpk8(acc[8], acc[9], acc[10], acc[11], acc[12], acc[13], acc[14], acc[15]));
        }
        {
            const int a = F.wave >> 1, ti = F.wave & 1;
            f32x16 acc;
#pragma unroll
            for (int e = 0; e < 16; ++e) acc[e] = 0.f;
#pragma unroll
            for (int ks = 0; ks < 4; ++ks) { const bf16x8 ka = *(const LAS bf16x8*)(sKt + DN_CM(32 * a + r, 16 * ks + 8 * hh)), tb = *(const LAS bf16x8*)(sTw + (32 * ti + r) * 72 + 16 * ks + 8 * hh); acc = MFMA32(ka, tb, acc); }
            bf16* wp = rec + REC_W / 2 + ((ti * 4 + a) * 2) * 512 + F.lane * 8;
            DN_ST16(wp, cpk8(acc[0], acc[1], acc[2], acc[3], acc[4], acc[5], acc[6], acc[7])); DN_ST16(wp + 512, cpk8(acc[8], acc[9], acc[10], acc[11], acc[12], acc[13], acc[14], acc[15]));
        }
    }
    if (vu == first) asm volatile("s_waitcnt vmcnt(0)" ::: "memory");
    __syncthreads();
    if (vu == first && F.tid == 0) __hip_atomic_store(flags + cu, 1u, __ATOMIC_RELAXED, __HIP_MEMORY_SCOPE_AGENT);
    pend = (vu == first) ? -1 : cu;
    TS_END(7)
  }
  asm volatile("s_waitcnt vmcnt(0)" ::: "memory");
  __syncthreads();
  if (pend >= 0 && F0.tid == 0) __hip_atomic_store(flags + pend, 1u, __ATOMIC_RELAXED, __HIP_MEMORY_SCOPE_AGENT);
#undef DN_LOAD_AUX
#undef DN_CUMSUM
}

#define DN_BAR() do { asm volatile("s_waitcnt lgkmcnt(0)" ::: "memory"); __builtin_amdgcn_s_barrier(); asm volatile("" ::: "memory"); } while (0)
__device__ __forceinline__ void dn_scan(Frame& F, int l, int bh, unsigned* flags) {
    LAS unsigned char* ring = F.lds;
    const unsigned char* recs = F.ws + WS_REC + (size_t)(bh * 64) * REC_BYTES;
    if (F.wave >= 4) {
        const int v = F.wave - 4;
#define DN_DMA_E(n_) do { const unsigned char* src_ = recs + (size_t)(n_) * REC_BYTES + v * 1024 + F.lane * 16; LAS unsigned char* dst_ = ring + ((n_) & 1) * (int)REC_BYTES + v * 1024; \
        _Pragma("unroll") for (int q_ = 0; q_ < 8; ++q_) __builtin_amdgcn_global_load_lds((const unsigned*)(src_ + q_ * 4096), (LAS unsigned*)(dst_ + q_ * 4096), 16, 0, 16  ); } while (0)
#define DN_DMA_L(n_) do { const unsigned char* src_ = recs + (size_t)(n_) * REC_BYTES + (32 + v) * 1024 + F.lane * 16; LAS unsigned char* dst_ = ring + ((n_) & 1) * (int)REC_BYTES + (32 + v) * 1024; \
        _Pragma("unroll") for (int q_ = 0; q_ < 11; ++q_) if (32 + v + 4 * q_ < 73) __builtin_amdgcn_global_load_lds((const unsigned*)(src_ + q_ * 4096), (LAS unsigned*)(dst_ + q_ * 4096), 16, 0, 16); } while (0)
#define DN_WAITREC(n_) do { unsigned sp_ = 0; while (__builtin_amdgcn_readfirstlane(__hip_atomic_load(flags + bh * 64 + (n_), __ATOMIC_RELAXED, __HIP_MEMORY_SCOPE_AGENT)) == 0u) { \
            __builtin_amdgcn_s_sleep(2); if (++sp_ > (1u << 21)) break; } asm volatile("" ::: "memory"); } while (0)
        LAS unsigned* fslot = (LAS unsigned*)(ring + 2 * (int)REC_BYTES) + v * 256;
#define DN_DMA_F(k_) __builtin_amdgcn_global_load_lds((const unsigned*)(flags + bh * 64 + (k_)), fslot + ((k_) & 3) * 64, 4, 0, 16)
#define DN_VMW(c_) do { if ((c_) >= 20) asm volatile("s_waitcnt vmcnt(20)" ::: "memory"); else if ((c_) == 19) asm volatile("s_waitcnt vmcnt(19)" ::: "memory"); else if ((c_) == 18) asm volatile("s_waitcnt vmcnt(18)" ::: "memory"); \
        else if ((c_) == 11) asm volatile("s_waitcnt vmcnt(11)" ::: "memory"); else if ((c_) == 10) asm volatile("s_waitcnt vmcnt(10)" ::: "memory"); else asm volatile("s_waitcnt vmcnt(0)" ::: "memory"); } while (0)
        const int cE = 8, cL = (v == 0) ? 11 : 10;
        DN_WAITREC(0); DN_DMA_E(0); DN_DMA_L(0); DN_DMA_F(2); DN_WAITREC(1); DN_DMA_E(1);
        asm volatile("s_waitcnt vmcnt(8)" ::: "memory");
        DN_BAR();
        for (int n = 0; n < 64; ++n) {
            if (MK_SCANDLY > 0) { const unsigned long long t0_ = __builtin_amdgcn_s_memrealtime(); while (__builtin_amdgcn_s_memrealtime() - t0_ < (unsigned long long)MK_SCANDLY) __builtin_amdgcn_s_sleep(1); }
            if (n + 1 < 64) DN_DMA_L(n + 1);
            if (n + 3 < 64) DN_DMA_F(n + 3);
            { const int c = (n + 1 < 64) ? cE + cL + ((n + 3 < 64) ? 1 : 0) : 0; DN_VMW(c); }
            if (n + 2 < 64) { const unsigned fv = __builtin_amdgcn_readfirstlane(*(volatile LAS unsigned*)(fslot + ((n + 2) & 3) * 64)); if (fv == 0u) DN_WAITREC(n + 2); }
            DN_BAR();
            if (n + 2 < 64) DN_DMA_E(n + 2);
            { const int c = (n + 1 < 64) ? cL + ((n + 3 < 64) ? 1 : 0) + ((n + 2 < 64) ? cE : 0) : 0; DN_VMW(c); }
            DN_BAR();
        }
#undef DN_DMA_F
#undef DN_VMW
#undef DN_DMA_E
#undef DN_DMA_L
#undef DN_WAITREC
    } else {
        const int w = F.wave;
        f32x16 S0, S1, S2, S3;
#pragma unroll
        for (int e = 0; e < 16; ++e) { S0[e] = 0.f; S1[e] = 0.f; S2[e] = 0.f; S3[e] = 0.f; }
        bf16* Ob = (bf16*)(F.ws + WS_O) + (size_t)(bh * 64) * 8192 + (w * 2) * 1024 + F.lane * 8;
        DN_BAR();
        for (int n = 0; n < 64; ++n) {
            const LAS unsigned char* buf = ring + (n & 1) * (int)REC_BYTES + F.lane * 16;
            if (MK_CMPDLY > 0) { const unsigned long long t0_ = __builtin_amdgcn_s_memrealtime(); while (__builtin_amdgcn_s_memrealtime() - t0_ < (unsigned long long)MK_CMPDLY) __builtin_amdgcn_s_sleep(1); }
#define DN_A(off_, f_) (*(const LAS bf16x8*)(buf + (off_) + (f_) * 1024))
#define DN_FENCE() __builtin_amdgcn_sched_barrier(0)
            f32x16 W0, W1, Q0, Q1;
#pragma unroll
            for (int e = 0; e < 16; ++e) { W0[e] = 0.f; W1[e] = 0.f; Q0[e] = 0.f; Q1[e] = 0.f; }
            bf16x8 fa0, fa1, fa2, fa3, fb0, fb1, fb2, fb3;
#define DN_LDK(d0, d1, d2, d3, a_, s_) do { d0 = DN_A(REC_W, (0 * 4 + (a_)) * 2 + (s_)); d1 = DN_A(REC_W, (1 * 4 + (a_)) * 2 + (s_)); d2 = DN_A(REC_QD, (0 * 4 + (a_)) * 2 + (s_)); d3 = DN_A(REC_QD, (1 * 4 + (a_)) * 2 + (s_)); } while (0)
#define DN_MMK(d0, d1, d2, d3, Sa_, s_) do { const bf16x8 sb_ = pack_step(Sa_, s_); W0 = MFMA32(d0, sb_, W0); W1 = MFMA32(d1, sb_, W1); Q0 = MFMA32(d2, sb_, Q0); Q1 = MFMA32(d3, sb_, Q1); } while (0)
            DN_LDK(fa0, fa1, fa2, fa3, 0, 0); DN_FENCE();
            DN_LDK(fb0, fb1, fb2, fb3, 0, 1); DN_FENCE(); DN_MMK(fa0, fa1, fa2, fa3, S0, 0); DN_FENCE();
            DN_LDK(fa0, fa1, fa2, fa3, 1, 0); DN_FENCE(); DN_MMK(fb0, fb1, fb2, fb3, S0, 1); DN_FENCE();
            DN_LDK(fb0, fb1, fb2, fb3, 1, 1); DN_FENCE(); DN_MMK(fa0, fa1, fa2, fa3, S1, 0); DN_FENCE();
            DN_LDK(fa0, fa1, fa2, fa3, 2, 0); DN_FENCE(); DN_MMK(fb0, fb1, fb2, fb3, S1, 1); DN_FENCE();
            DN_LDK(fb0, fb1, fb2, fb3, 2, 1); DN_FENCE(); DN_MMK(fa0, fa1, fa2, fa3, S2, 0); DN_FENCE();
            DN_LDK(fa0, fa1, fa2, fa3, 3, 0); DN_FENCE(); DN_MMK(fb0, fb1, fb2, fb3, S2, 1); DN_FENCE();
            DN_LDK(fb0, fb1, fb2, fb3, 3, 1); DN_FENCE(); DN_MMK(fa0, fa1, fa2, fa3, S3, 0); DN_FENCE();
            DN_BAR();
            const float cd = *(const LAS float*)(ring + (n & 1) * (int)REC_BYTES + REC_CD);
            const v4u u00 = *(const LAS v4u*)(buf + REC_U + (w * 2 + 0) * 2048), u01 = *(const LAS v4u*)(buf + REC_U + (w * 2 + 0) * 2048 + 1024);
            const v4u u10 = *(const LAS v4u*)(buf + REC_U + (w * 2 + 1) * 2048), u11 = *(const LAS v4u*)(buf + REC_U + (w * 2 + 1) * 2048 + 1024);
            fa0 = DN_A(REC_QK, (0 * 2 + 0) * 2 + 0); fa1 = DN_A(REC_QK, (0 * 2 + 0) * 2 + 1); fa2 = DN_A(REC_QK, (0 * 2 + 1) * 2 + 0); fa3 = DN_A(REC_QK, (0 * 2 + 1) * 2 + 1); DN_FENCE();
            DN_MMK(fb0, fb1, fb2, fb3, S3, 1); DN_FENCE();
#undef DN_LDK
#undef DN_MMK
            {
                const unsigned uu0[8] = {u00.x, u00.y, u00.z, u00.w, u01.x, u01.y, u01.z, u01.w}, uu1[8] = {u10.x, u10.y, u10.z, u10.w, u11.x, u11.y, u11.z, u11.w};
#pragma unroll
                for (int e = 0; e < 16; ++e) { const unsigned a0 = uu0[e >> 1], a1 = uu1[e >> 1];
                    W0[e] = ((e & 1) ? __uint_as_float(a0 & 0xffff0000u) : __uint_as_float(a0 << 16)) - W0[e];
                    W1[e] = ((e & 1) ? __uint_as_float(a1 & 0xffff0000u) : __uint_as_float(a1 << 16)) - W1[e]; }
            }
            const bf16x8 ub00 = pack_step(W0, 0), ub01 = pack_step(W0, 1), ub10 = pack_step(W1, 0), ub11 = pack_step(W1, 1);
            DN_FENCE();
            fb0 = DN_A(REC_QK, (1 * 2 + 0) * 2 + 0); fb1 = DN_A(REC_QK, (1 * 2 + 0) * 2 + 1); fb2 = DN_A(REC_QK, (1 * 2 + 1) * 2 + 0); fb3 = DN_A(REC_QK, (1 * 2 + 1) * 2 + 1); DN_FENCE();
            Q0 = MFMA32(fa0, ub00, Q0); Q0 = MFMA32(fa1, ub01, Q0); Q0 = MFMA32(fa2, ub10, Q0); Q0 = MFMA32(fa3, ub11, Q0); DN_FENCE();
#define DN_LDS_(d0, d1, d2, d3, a_) do { d0 = DN_A(REC_KDT, ((a_) * 2 + 0) * 2 + 0); d1 = DN_A(REC_KDT, ((a_) * 2 + 0) * 2 + 1); d2 = DN_A(REC_KDT, ((a_) * 2 + 1) * 2 + 0); d3 = DN_A(REC_KDT, ((a_) * 2 + 1) * 2 + 1); } while (0)
#define DN_SUPD(Sa_, d0, d1, d2, d3) do { Sa_ = MFMA32(d0, ub00, Sa_); Sa_ = MFMA32(d1, ub01, Sa_); Sa_ = MFMA32(d2, ub10, Sa_); Sa_ = MFMA32(d3, ub11, Sa_); } while (0)
            DN_LDS_(fa0, fa1, fa2, fa3, 0); DN_FENCE();
            Q1 = MFMA32(fb0, ub00, Q1); Q1 = MFMA32(fb1, ub01, Q1); Q1 = MFMA32(fb2, ub10, Q1); Q1 = MFMA32(fb3, ub11, Q1); DN_FENCE();
            S0 = S0 * cd; S1 = S1 * cd; S2 = S2 * cd; S3 = S3 * cd;
            DN_LDS_(fb0, fb1, fb2, fb3, 1); DN_FENCE(); DN_SUPD(S0, fa0, fa1, fa2, fa3); DN_FENCE();
            DN_LDS_(fa0, fa1, fa2, fa3, 2); DN_FENCE(); DN_SUPD(S1, fb0, fb1, fb2, fb3); DN_FENCE();
            DN_LDS_(fb0, fb1, fb2, fb3, 3); DN_FENCE(); DN_SUPD(S2, fa0, fa1, fa2, fa3); DN_FENCE();
            DN_SUPD(S3, fb0, fb1, fb2, fb3); DN_FENCE();
#undef DN_LDS_
#undef DN_SUPD
#undef DN_A
#undef DN_FENCE
            bf16* op = Ob + (size_t)n * 8192;
            *(v4u*)op = cpk8(Q0[0], Q0[1], Q0[2], Q0[3], Q0[4], Q0[5], Q0[6], Q0[7]); *(v4u*)(op + 512) = cpk8(Q0[8], Q0[9], Q0[10], Q0[11], Q0[12], Q0[13], Q0[14], Q0[15]);
            *(v4u*)(op + 1024) = cpk8(Q1[0], Q1[1], Q1[2], Q1[3], Q1[4], Q1[5], Q1[6], Q1[7]); *(v4u*)(op + 1536) = cpk8(Q1[8], Q1[9], Q1[10], Q1[11], Q1[12], Q1[13], Q1[14], Q1[15]);
            DN_BAR();
        }
    }
}
#undef DN_BAR

__device__ __forceinline__ void dn_finish_units(Frame& F0, int l, int first, int stride, const bf16* P, bf16* MIX) {
    if (first >= NCHUNK) return;
    const float ng0 = F0.inp(14)[l * 128 + 2 * F0.lane], ng1 = F0.inp(14)[l * 128 + 2 * F0.lane + 1];
    v4u na, nc, na2, nc2; unsigned ng[8], ng2[8];
#define DN_FIN_LOAD(a_, c_, g_, cu_) do { const int b_ = (cu_) >> 8, h_ = ((cu_) >> 6) & 3, n_ = (cu_) & 63, m_ = b_ * SEQ + n_ * 64; \
        const bf16* ip_ = (const bf16*)(F0.ws + WS_O) + (size_t)(cu_) * 8192 + F0.wave * 1024 + F0.lane * 8; a_ = *(const v4u*)ip_; c_ = *(const v4u*)(ip_ + 512); \
        _Pragma("unroll") for (int rr_ = 0; rr_ < 8; ++rr_) g_[rr_] = *((const unsigned*)(P + (size_t)(m_ + 8 * F0.wave + rr_) * NP + 2560 + h_ * 128) + F0.lane); } while (0)
    DN_FIN_LOAD(na, nc, ng, first);
    { const int c2 = (first + stride < NCHUNK) ? first + stride : first; DN_FIN_LOAD(na2, nc2, ng2, c2); }
    for (int cu = first; cu < NCHUNK; cu += stride) {
        Frame F = F0; asm volatile("" : "+v"(F.tid)); F.lane = F.tid & 63; F.wave = __builtin_amdgcn_readfirstlane(F.tid >> 6);
        const int b = cu >> 8, h = (cu >> 6) & 3, n = cu & 63, m0 = b * SEQ + n * 64;
        LAS float* sO = (LAS float*)F.lds;
        const v4u a = na, c = nc; unsigned g8[8];
#pragma unroll
        for (int rr = 0; rr < 8; ++rr) g8[rr] = ng[rr];
        na = na2; nc = nc2;
#pragma unroll
        for (int rr = 0; rr < 8; ++rr) ng[rr] = ng2[rr];
        { const int cn = (cu + 2 * stride < NCHUNK) ? cu + 2 * stride : cu; DN_FIN_LOAD(na2, nc2, ng2, cn); }
        {
            const int wt = F.wave, w = wt >> 1, t = wt & 1, r = F.lane & 31, hh = F.lane >> 5;
            const unsigned uu[8] = {a.x, a.y, a.z, a.w, c.x, c.y, c.z, c.w};
#pragma unroll
            for (int e = 0; e < 16; ++e) { const unsigned x = uu[e >> 1]; sO[(32 * t + crow(e, hh)) * 132 + 32 * w + r] = (e & 1) ? __uint_as_float(x & 0xffff0000u) : __uint_as_float(x << 16); }
        }
        __syncthreads();
        f32x2_t ov[8]; float os[8];
#pragma unroll
        for (int rr = 0; rr < 8; ++rr) { ov[rr] = *(const LAS f32x2_t*)(sO + (8 * F.wave + rr) * 132 + 2 * F.lane); os[rr] = ov[rr].x * ov[rr].x + ov[rr].y * ov[rr].y; }
        WAVE_SUM8(os);
#pragma unroll
        for (int rr = 0; rr < 8; ++rr) {
            const int i = 8 * F.wave + rr;
            const f32x2_t o = ov[rr];
            const unsigned g = g8[rr];
            const float rs = __builtin_amdgcn_rsqf(os[rr] * (1.0f / 128.0f) + EPS);
            const float g0 = __uint_as_float(g << 16), g1 = __uint_as_float(g & 0xffff0000u);
            *((unsigned*)(MIX + (size_t)(m0 + i) * D + 512 + h * 128) + F.lane) = cpk2(o.x * rs * ng0 * (g0 * sigmoidf_(g0)), o.y * rs * ng1 * (g1 * sigmoidf_(g1)));
        }
        __syncthreads();
    }
#undef DN_FIN_LOAD
}
struct Args { const float* in[21]; float* out; unsigned char* ws; int ph_lo, ph_hi; };
constexpr int PH_PER_LAYER = 6, N_PHASES = 2 + PH_PER_LAYER * DEPTH;

#define RELAUNDER(Fx) do { asm volatile("" : "+v"((Fx).tid)); (Fx).lane = (Fx).tid & 63; (Fx).wave = __builtin_amdgcn_readfirstlane((Fx).tid >> 6); } while (0)
__device__ __forceinline__ void gemm_stagger(int us) {
    if (us > 0 && (blockIdx.x & 4)) { const unsigned long long t0 = __builtin_amdgcn_s_memrealtime(); while (__builtin_amdgcn_s_memrealtime() - t0 < (unsigned long long)us * 100ull) __builtin_amdgcn_s_sleep(8); }
}
__device__ __forceinline__ void idle_us(int us) { if (us > 0) { const unsigned long long t0 = __builtin_amdgcn_s_memrealtime(); while (__builtin_amdgcn_s_memrealtime() - t0 < (unsigned long long)us * 100ull) __builtin_amdgcn_s_sleep(8); } }
__global__ void __launch_bounds__(NWAVES * 64, 2) mk_fwd(Args args) {
    extern __shared__ __attribute__((aligned(16))) unsigned char lds[];
    {
        volatile LAS unsigned* MISC0 = (volatile LAS unsigned*)((LAS unsigned char*)lds + MISC_OFF);
        if (threadIdx.x < 32) MISC0[threadIdx.x] = 0u;
    }
    __syncthreads();
    const int lo = args.ph_lo, hi = args.ph_hi;
    XcdBarrier bar; bar.bar = (unsigned*)(args.ws + WS_CTL) + CW_BAR; bar.x = 0; bar.st = nullptr;
    if (hi - lo > 1) bar = xcd_barrier_post((unsigned*)(args.ws + WS_CTL) + CW_BAR, (volatile LAS unsigned*)((LAS unsigned char*)lds + MISC_OFF) + 8);

    for (int ph = lo; ph < hi; ++ph) {
        const bool pht_ = (MK_PHT >= 0) && ((ph == 0) ? (MK_PHT == 7) : ((ph - 1) % PH_PER_LAYER == MK_PHT));
        unsigned long long pht0_ = 0; if (pht_) pht0_ = __builtin_amdgcn_s_memrealtime();
      for (int rep = 0; rep < 2; ++rep) {
        if (rep == 1 && !((ph > 0 && ph < N_PHASES - 1 && ((MK_REP >> ((ph - 1) % PH_PER_LAYER)) & 1)) || (ph == 0 && (MK_REP & 512)))) break;
        int tid = threadIdx.x; asm volatile("" : "+v"(tid));
        Frame F;
        F.kp = (const AS4 unsigned char*)__builtin_amdgcn_kernarg_segment_ptr(); asm volatile("" : "+s"(F.kp));
        F.lds = (LAS unsigned char*)lds;
        F.tid = tid; F.lane = tid & 63; F.wave = __builtin_amdgcn_readfirstlane(tid >> 6);
        F.G = gridDim.x; { const int bx = blockIdx.x; F.vcu = (F.G % 8 == 0) ? (bx % 8) * (F.G / 8) + bx / 8 : bx; }
        F.out = *(float* const AS4*)(F.kp + 168); F.ws = *(unsigned char* const AS4*)(F.kp + 176);
        bf16* HN = (bf16*)F.out; bf16* MIX = HN; bf16* P = (bf16*)(F.ws + WS_P); bf16* HFF = P; bf16* XB = (bf16*)(F.ws + WS_XB);
        float* BA = (float*)(F.ws + WS_BA);
        if (ph == 0) {
            weights_phase(F, 0, MK_WLATE ? 1 : DEPTH); wlg_phase(F);
            xin_phase(F, F.inp(0), XB, (float*)(F.ws + WS_SSP));
        } else if (ph == N_PHASES - 1) {
            norm_phase<1, true>(F, XB, F.inp(20), nullptr, nullptr, nullptr, F.out, nullptr);
        } else {
            const int l = (ph - 1) / PH_PER_LAYER, k = (ph - 1) % PH_PER_LAYER;
            const unsigned char* wb = F.ws + WS_W + (size_t)l * W_LAYER;
            if (k == 0) {
                const float* ssp = (const float*)(F.ws + WS_SSP + (size_t)(2 * l) * SSP_BYTES);
                const bool lg_late = MK_LGSPLIT && (((int)blockIdx.x >> 3) & 1);
                if (!rep && !lg_late) logits_phase(F, l, XB, ssp, BA);
                pg8::Gemm g{(const pg8::bf16_t*)XB, (const pg8::bf16_t*)(wb + W_IN_OFF), M, NP, D}; pg8::StaticOrder S; S.init(M, NP, F.G, (int)blockIdx.x);
                const int pm0 = pg8::rs_prologue(S, ssp, (LAS float*)(F.lds + RS_OFF), RS_SLOTS, 1.0f / D, EPS, tid);
                pg8::EpiBf16FL E{(pg8::bf16_t*)P, NP, rep ? MK_NOSTORE : 0, (const LAS float*)(F.lds + RS_OFF), pm0};
                pg8::gemm_phase<pg8::EpiBf16FL, pg8::StaticOrder, true, true>(F.lds, g, S, E, tid);
                if (!rep && lg_late) { Frame Fl = F; RELAUNDER(Fl); logits_phase(Fl, l, XB, ssp, BA); }
            } else if (k == 1) {
                unsigned* flags = (unsigned*)(F.ws + WS_CTL) + CW_FLAGS + l * NCHUNK;
                const int sub = rep ? MK_REPSUB : MK_SUB;
                if ((int)blockIdx.x < BATCH * 4) { if (sub & 1) dn_scan(F, l, (int)blockIdx.x, flags); }
                else {
                    if (sub & 1) dn_chunk_units(F, l, (int)blockIdx.x - BATCH * 4, F.G - BATCH * 4, P, BA, 9, flags);
                    const int gq = (int)blockIdx.x - BATCH * 4, nq = F.G - BATCH * 4, extra = NCHUNK - (NCHUNK / nq) * nq, nrest = nq - extra;
                    if (sub & 2) {
                        if (nq == 224) {
                            if (gq < 32) { Frame Fu = F; RELAUNDER(Fu); conv_units(Fu, l, 384 + gq, 32, P, MIX); }
                            else { const int j = gq - 32;
                                { Frame Fu = F; RELAUNDER(Fu); gmlp_unit(Fu, l, j, P, MIX); }
                                if (j < 64) { Frame Fu = F; RELAUNDER(Fu); gmlp_unit(Fu, l, 192 + j, P, MIX); }
                                else { Frame Fu = F; RELAUNDER(Fu); conv_units(Fu, l, j - 64, 128, P, MIX, 384); } }
                        } else if (gq >= extra) {
                            for (int v = gq - extra; v < M / 128; v += nrest) { Frame Fu = F; RELAUNDER(Fu); gmlp_unit(Fu, l, v, P, MIX); }
                            { Frame Fu = F; RELAUNDER(Fu); conv_units(Fu, l, gq - extra, nrest, P, MIX); }
                        }
                    }
                }
            } else if (k == 2) {
                dn_finish_units(F, l, (int)blockIdx.x, F.G, P, MIX);
                if (MK_WLATE && !rep && l + 1 < DEPTH) { __syncthreads(); Frame Fw = F; RELAUNDER(Fw); weights_phase(Fw, l + 1, l + 2); }
            } else if (k == 3 || k == 5) {
                pg8::Gemm g{(const pg8::bf16_t*)(k == 3 ? MIX : HFF), (const pg8::bf16_t*)(wb + (k == 3 ? W_O_OFF : W_D_OFF)), M, D, k == 3 ? D : DFF}; pg8::StaticOrder S; S.init(M, D, F.G, (int)blockIdx.x);
                float* ssp = (float*)(F.ws + WS_SSP + (size_t)(2 * l + (k == 3 ? 1 : 2)) * SSP_BYTES);
                pg8::EpiResB E{(const pg8::bf16_t*)XB, rep ? (pg8::bf16_t*)(F.ws + WS_REC) : (pg8::bf16_t*)XB, D, rep ? (MK_NOSTORE ? (float*)nullptr : (float*)(F.ws + WS_REC + 128 * MiB)) : (MK_SSP ? ssp : (float*)nullptr)};
                const bool late_ = (((int)blockIdx.x >> 3) & 1);
                if (!late_) idle_us(MK_SPLIT_IDLE);
                pg8::gemm_phase<pg8::EpiResB, pg8::StaticOrder, true, true>(F.lds, g, S, E, tid);
                if (late_) idle_us(MK_SPLIT_IDLE);
            } else if (k == 4) {
                pg8::Gemm g{(const pg8::bf16_t*)(MK_GUA ? HN : XB), (const pg8::bf16_t*)(wb + W_GU_OFF), M, 2 * DFF, (rep && MK_HALFK) ? D / 2 : D}; pg8::StaticOrder S; S.init(M, 2 * DFF, F.G, (int)blockIdx.x);
                if (MK_OLDN2 || MK_GUA) { norm_phase<0, true>(F, XB, F.inp(16) + l * D, HN, nullptr, nullptr, nullptr, nullptr); xcd_barrier(bar); }
                if (MK_IDLE > 0) { const unsigned long long t0 = __builtin_amdgcn_s_memrealtime(); while (__builtin_amdgcn_s_memrealtime() - t0 < (unsigned long long)MK_IDLE * 100ull) __builtin_amdgcn_s_sleep(8); }
                const LAS float* sS = (const LAS float*)(F.lds + RS_OFF);
                const int pm0 = MK_GUA ? 0 : pg8::rs_prologue(S, (const float*)(F.ws + WS_SSP + (size_t)(2 * l + 1) * SSP_BYTES), (LAS float*)(F.lds + RS_OFF), RS_SLOTS, 1.0f / D, EPS, tid);
                pg8::EpiSwiGLU E{(pg8::bf16_t*)HFF, DFF, rep ? MK_NOSTORE : 0, MK_GUA ? (const LAS float*)nullptr : sS, pm0};
                const bool late_ = (((int)blockIdx.x >> 3) & 1);
                if (!late_) idle_us(MK_SPLIT_IDLE);
                pg8::gemm_phase<pg8::EpiSwiGLU, pg8::StaticOrder, true, true>(F.lds, g, S, E, tid);
                if (late_) idle_us(MK_SPLIT_IDLE);
            }
        }
      }
        if (pht_) { asm volatile("s_waitcnt vmcnt(0) lgkmcnt(0)" ::: "memory"); const unsigned long long t1_ = __builtin_amdgcn_s_memrealtime(), d_ = t1_ - pht0_; while (__builtin_amdgcn_s_memrealtime() - t1_ < d_) __builtin_amdgcn_s_sleep(4); }
        if (ph + 1 < hi) { xcd_barrier(bar); for (int xb = 0; xb < MK_XBAR; ++xb) xcd_barrier(bar); }
    }
}

#ifndef MK_SINGLE
#define MK_SINGLE 1
#endif

extern "C" void kernel_launch(void* const* d_in, const int* in_sizes, int n_in, void* d_out, int out_size, void* d_ws, size_t ws_size, hipStream_t stream) {
    static int grid = 0;
    if (grid == 0) {
        if (n_in != 21 || in_sizes[0] != M * D || out_size != M * D || ws_size < WS_END) { fprintf(stderr, "kernel_launch: unexpected shapes (n_in %d, in0 %d, out %d, ws %zu)\n", n_in, n_in > 0 ? in_sizes[0] : -1, out_size, ws_size); grid = -1; return; }
        int dev = 0, cus = 0, per_cu = 0;
        if (hipGetDevice(&dev) != hipSuccess || hipDeviceGetAttribute(&cus, hipDeviceAttributeMultiprocessorCount, dev) != hipSuccess) { grid = -1; return; }
        if (hipFuncSetAttribute((const void*)mk_fwd, hipFuncAttributeMaxDynamicSharedMemorySize, LDS_BYTES) != hipSuccess) { fprintf(stderr, "kernel_launch: hipFuncSetAttribute failed\n"); grid = -1; return; }
        if (hipOccupancyMaxActiveBlocksPerMultiprocessor(&per_cu, (const void*)mk_fwd, NWAVES * 64, LDS_BYTES) != hipSuccess || per_cu < 1) { fprintf(stderr, "kernel_launch: occupancy query says %d blocks per CU\n", per_cu); per_cu = 1; }
        (void)hipGetLastError();
        grid = cus;
        if (grid % 8 != 0 || grid < 32) fprintf(stderr, "kernel_launch: unexpected CU count %d\n", grid);
    }
    if (grid < 0) return;
    (void)hipMemsetAsync((char*)d_ws + WS_CTL, 0, CTL_ZERO_BYTES, stream);
    Args a{};
    for (int i = 0; i < 21; ++i) a.in[i] = (const float*)d_in[i];
    a.out = (float*)d_out; a.ws = (unsigned char*)d_ws;
#if MK_SINGLE
    a.ph_lo = 0; a.ph_hi = N_PHASES;
    hipLaunchKernelGGL(mk_fwd, dim3(grid), dim3(NWAVES * 64), LDS_BYTES, stream, a);
#else
    for (int ph = 0; ph < MK_PH_HI; ++ph) { a.ph_lo = ph; a.ph_hi = ph + 1; hipLaunchKernelGGL(mk_fwd, dim3(grid), dim3(NWAVES * 64), LDS_BYTES, stream, a); }
#endif
}
```
